# Optimizing an MI355X kernel written in HIP

```python
import math
import jax, jax.numpy as jnp
from jax import lax
import numpy as np

D_MODEL = 1024
BATCH = 16
SEQ = 2048
DEPTH = 2

HEAD_DIM = 64
DIFF_HEADS = 4
DIFF_V_DIM = 2 * HEAD_DIM
DSA_HEADS = 4
DSA_LATENT = 128
DSA_V_DIM = 64
IDX_HEADS = 8
IDX_DIM = 32
DSA_TOPK_MAX = 256
MOBA_HEADS = 4
MOBA_BLOCK = 256
MOBA_TOPK_MAX = 3
N_BUCKETS = 32
MAX_DISTANCE = 128
N_BIAS_HEADS = DIFF_HEADS + DSA_HEADS + MOBA_HEADS
D_FF = 4 * D_MODEL
Q_BLOCK = 128
MOBA_Q_CHUNK = 32
EPS = 1e-6

A_Q = DIFF_HEADS * 2 * HEAD_DIM
A_K = DIFF_HEADS * 2 * HEAD_DIM
A_V = DIFF_HEADS * DIFF_V_DIM
B_Q = DSA_HEADS * DSA_LATENT
B_KV = DSA_LATENT
B_IQ = IDX_HEADS * IDX_DIM
B_IK = IDX_DIM
B_IW = IDX_HEADS
C_QKV = MOBA_HEADS * HEAD_DIM
G_COLS = 3 * D_MODEL
SPLIT_SIZES = (A_Q, A_K, A_V, B_Q, B_KV, B_IQ, B_IK, B_IW, C_QKV, C_QKV, C_QKV, G_COLS)
IN_COLS = A_Q + A_K + A_V + B_Q + B_KV + B_IQ + B_IK + B_IW + 3 * C_QKV + G_COLS

kernel_name = 'hybrid_gated_diff_dsa_moba_block'


def rmsnorm(x, g):
    xf = x.astype(jnp.float32)
    y = xf * lax.rsqrt(jnp.mean(xf * xf, axis=-1, keepdims=True) + EPS)
    return y.astype(x.dtype) * g


def split_cols(p):
    out = []
    off = 0
    for n in SPLIT_SIZES:
        out.append(p[..., off:off + n])
        off += n
    return out


def t5_bucket(dist):
    max_exact = N_BUCKETS // 2
    n = jnp.maximum(dist, 0)
    nf = jnp.maximum(n, 1).astype(jnp.float32)
    large = max_exact + (jnp.log(nf / max_exact) / math.log(MAX_DISTANCE / max_exact)
                         * (N_BUCKETS - max_exact)).astype(jnp.int32)
    large = jnp.minimum(large, N_BUCKETS - 1)
    return jnp.where(n < max_exact, n, large)


def diff_attention(q, k, v, lam, lam_init, subln_g, bias_a):
    B, S, H = q.shape[0], q.shape[1], q.shape[2]
    E = v.shape[-1]
    kpos = jnp.arange(S)
    scale = HEAD_DIM ** -0.5
    bias_t = bias_a.T

    def block(i):
        q0 = i * Q_BLOCK
        qb = lax.dynamic_slice_in_dim(q, q0, Q_BLOCK, axis=1)
        qpos = q0 + jnp.arange(Q_BLOCK)
        dist = qpos[:, None] - kpos[None, :]
        bias = bias_t[:, t5_bucket(dist)]
        logits = jnp.einsum('bqhmd,bkhmd->bhmqk', qb, k).astype(jnp.float32) * scale + bias[None, :, None]
        logits = jnp.where(dist >= 0, logits, -jnp.inf)
        p = jax.nn.softmax(logits, axis=-1)
        attn = p[:, :, 0] - lam * p[:, :, 1]
        return jnp.einsum('bhqk,bkhe->bqhe', attn.astype(v.dtype), v)

    o = lax.map(block, jnp.arange(S // Q_BLOCK))
    o = jnp.moveaxis(o, 0, 1).reshape(B, S, H, E)
    o = rmsnorm(o, subln_g) * (1.0 - lam_init)
    return o.reshape(B, S, H * E)


def dsa_attention(q_lat, kv_lat, iq, ik, iw, w_uv, bias_b):
    B, S, H, R = q_lat.shape
    topk = min(DSA_TOPK_MAX, S // 4)
    kpos = jnp.arange(S)
    bidx = jnp.arange(B)[:, None, None]
    hidx = jnp.arange(H)[None, None, :, None]
    bias_t = bias_b.T
    idx_scale = (IDX_HEADS ** -0.5) * (IDX_DIM ** -0.5)

    def block(i):
        q0 = i * Q_BLOCK
        qpos = q0 + jnp.arange(Q_BLOCK)
        qb = lax.dynamic_slice_in_dim(q_lat, q0, Q_BLOCK, axis=1)
        iqb = lax.dynamic_slice_in_dim(iq, q0, Q_BLOCK, axis=1)
        iwb = lax.dynamic_slice_in_dim(iw, q0, Q_BLOCK, axis=1)
        causal = qpos[:, None] >= kpos[None, :]
        s_idx = jax.nn.relu(jnp.einsum('bqhd,bkd->bqhk', iqb, ik))
        score = jnp.einsum('bqhk,bqh->bqk', s_idx, iwb).astype(jnp.float32) * idx_scale
        score = jnp.where(causal[None], score, -jnp.inf)
        _, sel = lax.top_k(score, topk)
        dist = qpos[None, :, None] - sel
        valid = dist >= 0
        kv_sel = kv_lat[bidx, sel]
        logits = jnp.einsum('bqhr,bqkr->bqhk', qb, kv_sel).astype(jnp.float32) * (R ** -0.5)
        bias = bias_t[hidx, t5_bucket(dist)[:, :, None, :]]
        logits = jnp.where(valid[:, :, None, :], logits + bias, -jnp.inf)
        p = jax.nn.softmax(logits, axis=-1)
        return jnp.einsum('bqhk,bqkr->bqhr', p.astype(kv_sel.dtype), kv_sel)

    o = lax.map(block, jnp.arange(S // Q_BLOCK))
    o = jnp.moveaxis(o, 0, 1).reshape(B, S, H, R)
    o = jnp.einsum('bshr,hre->bshe', o, w_uv)
    return o.reshape(B, S, H * DSA_V_DIM)


def moba_attention(q, k, v, bias_c):
    B, S, H, Dh = q.shape
    nb = -(-S // MOBA_BLOCK)
    sp = nb * MOBA_BLOCK
    pad = ((0, 0), (0, sp - S), (0, 0), (0, 0))
    k_bh = jnp.pad(k, pad).reshape(B, nb, MOBA_BLOCK, H, Dh).transpose(0, 3, 1, 2, 4)
    v_bh = jnp.pad(v, pad).reshape(B, nb, MOBA_BLOCK, H, Dh).transpose(0, 3, 1, 2, 4)
    k_mean = jnp.mean(k_bh, axis=3)
    topb = min(MOBA_TOPK_MAX, nb)
    bias_t = bias_c.T
    bi = jnp.arange(B)[:, None, None, None]
    hi = jnp.arange(H)[None, :, None, None]
    hi5 = jnp.arange(H)[None, :, None, None, None]
    blk_ids = jnp.arange(nb)
    in_blk = jnp.arange(MOBA_BLOCK)
    scale = Dh ** -0.5

    def chunk(i):
        q0 = i * MOBA_Q_CHUNK
        qpos = q0 + jnp.arange(MOBA_Q_CHUNK)
        j = q0 // MOBA_BLOCK
        qc = lax.dynamic_slice_in_dim(q, q0, MOBA_Q_CHUNK, axis=1).transpose(0, 2, 1, 3)
        gate = jnp.einsum('bhqd,bhnd->bhqn', qc, k_mean).astype(jnp.float32)
        gate = jnp.where(blk_ids < j, gate, -jnp.inf)
        _, sel = lax.top_k(gate, topb)
        sel_valid = sel < j
        k_sel = k_bh[bi, hi, sel]
        v_sel = v_bh[bi, hi, sel]
        lp = jnp.einsum('bhqd,bhqnkd->bhqnk', qc, k_sel).astype(jnp.float32) * scale
        dist_p = qpos[None, None, :, None, None] - (sel[..., None] * MOBA_BLOCK + in_blk)
        lp = lp + bias_t[hi5, t5_bucket(dist_p)]
        lp = jnp.where(sel_valid[..., None], lp, -jnp.inf).reshape(B, H, MOBA_Q_CHUNK, topb * MOBA_BLOCK)
        k_own = lax.dynamic_slice_in_dim(k_bh, j, 1, axis=2)[:, :, 0]
        v_own = lax.dynamic_slice_in_dim(v_bh, j, 1, axis=2)[:, :, 0]
        lo = jnp.einsum('bhqd,bhkd->bhqk', qc, k_own).astype(jnp.float32) * scale
        dist_o = qpos[:, None] - (j * MOBA_BLOCK + in_blk)[None, :]
        lo = jnp.where(dist_o >= 0, lo + bias_t[:, t5_bucket(dist_o)][None], -jnp.inf)
        p = jax.nn.softmax(jnp.concatenate([lp, lo], axis=-1), axis=-1)
        pp = p[..., :topb * MOBA_BLOCK].reshape(B, H, MOBA_Q_CHUNK, topb, MOBA_BLOCK)
        po = p[..., topb * MOBA_BLOCK:]
        o = (jnp.einsum('bhqnk,bhqnkd->bhqd', pp.astype(v.dtype), v_sel)
             + jnp.einsum('bhqk,bhkd->bhqd', po.astype(v.dtype), v_own))
        return o.transpose(0, 2, 1, 3)

    o = lax.map(chunk, jnp.arange(S // MOBA_Q_CHUNK))
    return jnp.moveaxis(o, 0, 1).reshape(B, S, H * Dh)


def setup_inputs(seed: int = 0) -> dict:
    key = jax.random.key(seed)
    ks = jax.random.split(key, 20)

    def nrm(k, shape, s):
        return jax.random.normal(k, shape, jnp.float32) * s

    return {
        'x': nrm(ks[0], (BATCH, SEQ, D_MODEL), 1.0),
        'c': nrm(ks[1], (BATCH, D_MODEL), 1.0),
        'rel_bias': nrm(ks[2], (N_BUCKETS, N_BIAS_HEADS), 0.5),
        'ada_w': nrm(ks[3], (DEPTH, D_MODEL, 6 * D_MODEL), D_MODEL ** -0.5),
        'ada_b': nrm(ks[4], (DEPTH, 6 * D_MODEL), 0.02),
        'norm_mix': 1.0 + nrm(ks[5], (DEPTH, D_MODEL), 0.02),
        'w_in': nrm(ks[6], (DEPTH, D_MODEL, IN_COLS), D_MODEL ** -0.5),
        'gate_b': nrm(ks[7], (DEPTH, G_COLS), 0.02),
        'diff_lambda': nrm(ks[8], (DEPTH, 4, HEAD_DIM), 0.1),
        'diff_subln': 1.0 + nrm(ks[9], (DEPTH, DIFF_V_DIM), 0.02),
        'dsa_kv_norm': 1.0 + nrm(ks[10], (DEPTH, DSA_LATENT), 0.02),
        'dsa_w_uv': nrm(ks[11], (DEPTH, DSA_HEADS, DSA_LATENT, DSA_V_DIM), DSA_LATENT ** -0.5),
        'w_br_a': nrm(ks[12], (DEPTH, A_V, D_MODEL), A_V ** -0.5),
        'w_br_b': nrm(ks[13], (DEPTH, DSA_HEADS * DSA_V_DIM, D_MODEL), (DSA_HEADS * DSA_V_DIM) ** -0.5),
        'w_br_c': nrm(ks[14], (DEPTH, C_QKV, D_MODEL), C_QKV ** -0.5),
        'w_o': nrm(ks[15], (DEPTH, D_MODEL, D_MODEL), D_MODEL ** -0.5),
        'norm_mlp': 1.0 + nrm(ks[16], (DEPTH, D_MODEL), 0.02),
        'w_ff1': nrm(ks[17], (DEPTH, D_MODEL, D_FF), D_MODEL ** -0.5),
        'w_ff2': nrm(ks[18], (DEPTH, D_FF, D_MODEL), D_FF ** -0.5),
        'norm_final': 1.0 + nrm(ks[19], (D_MODEL,), 0.02),
    }


def reference(x, c, rel_bias, ada_w, ada_b, norm_mix, w_in, gate_b, diff_lambda, diff_subln,
              dsa_kv_norm, dsa_w_uv, w_br_a, w_br_b, w_br_c, w_o, norm_mlp, w_ff1, w_ff2,
              norm_final):
    B, S, _ = x.shape
    bias_tab = rel_bias.astype(jnp.float32)
    bias_a = bias_tab[:, :DIFF_HEADS]
    bias_b = bias_tab[:, DIFF_HEADS:DIFF_HEADS + DSA_HEADS]
    bias_c = bias_tab[:, DIFF_HEADS + DSA_HEADS:]
    cond = jax.nn.silu(c)
    for l in range(DEPTH):
        mod = (cond @ ada_w[l] + ada_b[l]).reshape(B, 6, D_MODEL)[:, :, None, :]
        shift1, scale1, gate1 = mod[:, 0], mod[:, 1], mod[:, 2]
        shift2, scale2, gate2 = mod[:, 3], mod[:, 4], mod[:, 5]

        u = rmsnorm(x, norm_mix[l]) * (1.0 + scale1) + shift1
        aq, ak, av, bq, bkv, biq, bik, biw, cq, ck, cv, g = split_cols(u @ w_in[l])

        lam_init = 0.8 - 0.6 * math.exp(-0.3 * l)
        dl = diff_lambda[l].astype(jnp.float32)
        lam = jnp.exp(jnp.sum(dl[0] * dl[1])) - jnp.exp(jnp.sum(dl[2] * dl[3])) + lam_init
        y_a = diff_attention(aq.reshape(B, S, DIFF_HEADS, 2, HEAD_DIM),
                             ak.reshape(B, S, DIFF_HEADS, 2, HEAD_DIM),
                             av.reshape(B, S, DIFF_HEADS, DIFF_V_DIM),
                             lam, lam_init, diff_subln[l], bias_a) @ w_br_a[l]
        y_b = dsa_attention(bq.reshape(B, S, DSA_HEADS, DSA_LATENT),
                            rmsnorm(bkv, dsa_kv_norm[l]),
                            biq.reshape(B, S, IDX_HEADS, IDX_DIM), bik, biw,
                            dsa_w_uv[l], bias_b) @ w_br_b[l]
        y_c = moba_attention(cq.reshape(B, S, MOBA_HEADS, HEAD_DIM),
                             ck.reshape(B, S, MOBA_HEADS, HEAD_DIM),
                             cv.reshape(B, S, MOBA_HEADS, HEAD_DIM), bias_c) @ w_br_c[l]
        gates = jax.nn.sigmoid(g + gate_b[l]).reshape(B, S, 3, D_MODEL)
        merged = gates[:, :, 0] * y_a + gates[:, :, 1] * y_b + gates[:, :, 2] * y_c
        x = x + gate1 * (merged @ w_o[l])

        u2 = rmsnorm(x, norm_mlp[l]) * (1.0 + scale2) + shift2
        h = jnp.square(jax.nn.relu(u2 @ w_ff1[l]))
        x = x + gate2 * (h @ w_ff2[l])
    return rmsnorm(x, norm_final)
```

```cpp
#include <hip/hip_runtime.h>
#include <cstdio>
#include <cstdint>
#ifndef REP_N1
#define REP_N1 1
#endif
#ifndef REP_G1
#define REP_G1 1
#endif
#ifndef REP_SEL
#define REP_SEL 1
#endif
#ifndef REP_ATT
#define REP_ATT 1
#endif
#ifndef REP_G2
#define REP_G2 1
#endif
#ifndef REP_G5
#define REP_G5 1
#endif
#ifndef REP_P0
#define REP_P0 1
#endif
#ifndef REP_SCORE
#define REP_SCORE 1
#endif
#ifndef REP_RADIX
#define REP_RADIX 1
#endif
#ifndef REP_DIFF
#define REP_DIFF 1
#endif
#ifndef REP_MOBA
#define REP_MOBA 1
#endif
#ifndef REP_DSA
#define REP_DSA 1
#endif

#define LAS __attribute__((address_space(3)))
#define GAS __attribute__((address_space(1)))
typedef _Float16 f16;
typedef _Float16 f16x8 __attribute__((ext_vector_type(8)));
typedef _Float16 f16x4 __attribute__((ext_vector_type(4)));
typedef _Float16 f16x2 __attribute__((ext_vector_type(2)));
typedef float f32x4 __attribute__((ext_vector_type(4)));
typedef float f32x2 __attribute__((ext_vector_type(2)));
typedef unsigned u32x4 __attribute__((ext_vector_type(4)));
typedef unsigned u32x2 __attribute__((ext_vector_type(2)));

constexpr int NB = 16, SEQ = 2048, DM = 1024, MTOK = NB * SEQ, DEPTH = 2, DFF = 4096;
constexpr int IN_COLS = 6312, PCOLS = 3240, PP = 3328  , GCOLS = 3072;
constexpr int C_AQ = 0, C_AK = 512, C_AV = 1024, C_BQ = 1536, C_BKV = 2048, C_BIQ = 2176, C_BIK = 2432, C_BIW = 2464, C_CQ = 2472, C_CK = 2728, C_CV = 2984, C_G = 3240;
constexpr float EPS = 1e-6f, LOG2E = 1.4426950408889634f;
constexpr int TABN = 384;
constexpr int TAB2 = 320, TAB2H = 2 * TAB2;

__device__ __forceinline__ unsigned pk2h(float lo, float hi) { f32x2 v = {lo, hi}; f16x2 h = __builtin_convertvector(v, f16x2); return __builtin_bit_cast(unsigned, h); }

__device__ __forceinline__ int lane_id() { int l; asm volatile("v_mbcnt_lo_u32_b32 %0, -1, 0\n\tv_mbcnt_hi_u32_b32 %0, -1, %0" : "=v"(l)); return l; }

namespace pg8 {
#define PG8_LAS __attribute__((address_space(3)))
constexpr int BM = 256, BK = 64, HALF = 128, HTB = HALF * BK * 2, STAGE_BYTES = 8 * HTB, NXCD = 8, WGM = 8;
__host__ __device__ __forceinline__ int lds_byte(int r, int c) { const int st = (r >> 4) * 2 + (c >> 5), rr = r & 15, cc = c & 31, ob = rr * 64 + cc * 2; return st * 1024 + (ob ^ (((ob >> 9) & 1) << 5)); }
__host__ __device__ __forceinline__ void stage_rc(int b, int& R, int& C) { const int st = b / 1024, sb = b % 1024, swz = sb ^ (((sb >> 9) & 1) << 5); R = (st >> 1) * 16 + swz / 64; C = (st & 1) * 32 + (swz % 64) / 2; }
__host__ __device__ __forceinline__ int perm32(int rho) { const int n = rho >> 4, i = rho & 15; return 8 * (i >> 2) + 4 * n + (i & 3); }

struct Unit { int pm, pn, idx; };
struct Gemm { const f16* A; const f16* Bt; int M, N, K; };

struct StaticOrder {
    int nM, nN, nwg, G, c;
    __host__ __device__ void init(int M, int N, int G_, int c_) { nM = M / BM; nN = N / BM; nwg = nM * nN; G = G_; c = c_; }
    __host__ __device__ bool next(int i, Unit& u) const {
        const long L = (long)i * G + c; if (L >= nwg) return false;
        int wgid = (int)L; { const int q = nwg / NXCD, r = nwg % NXCD, xcd = wgid % NXCD, off = wgid / NXCD; wgid = (xcd < r ? xcd * (q + 1) : r * (q + 1) + (xcd - r) * q) + off; }
        const int nig = WGM * nN, gid = wgid / nig, fm = gid * WGM, gsz = (nM - fm) < WGM ? (nM - fm) : WGM;
        u.pm = fm + ((wgid % nig) % gsz); u.pn = (wgid % nig) / gsz; u.idx = i; return true;
    }
    __device__ __forceinline__ void a_ready(const Unit&) const {}
    __device__ __forceinline__ void done(const Unit&) const {}
};
struct TripleOrder {
    StaticOrder so;
    __host__ __device__ void init(int M, int G_, int c_) { so.init(M, 1024, G_, c_); }
    __host__ __device__ bool next(int i, Unit& u) const { if (!so.next(i / 3, u)) return false; u.pn += 4 * (i % 3); u.idx = i; return true; }
    __device__ __forceinline__ void a_ready(const Unit&) const {}
    __device__ __forceinline__ void done(const Unit&) const {}
};

template <int ACT  > struct EpiF16 {
    static constexpr bool PERM = true, AFTER_DRAIN = false;
    f16* O; int ldc;
    __device__ __forceinline__ void operator()(const f32x4 (&acc)[2][2][4][2], const Unit& u, int wr, int wc, int fr, int fq) const {
        const int row0 = u.pm * BM + wr * 64 + fr; const int col0 = u.pn * BM + wc * 32 + 8 * fq;
#pragma unroll
        for (int ai = 0; ai < 2; ++ai)
#pragma unroll
            for (int m = 0; m < 4; ++m) { f16* rowp = O + (size_t)(row0 + ai * HALF + m * 16) * ldc + col0;
#pragma unroll
                for (int bj = 0; bj < 2; ++bj) { f32x4 v0 = acc[ai][bj][m][0], v1 = acc[ai][bj][m][1];
                    if (ACT == 1) {
#pragma unroll
                        for (int e = 0; e < 4; ++e) { const float a = fmaxf(v0[e], 0.f), b = fmaxf(v1[e], 0.f); v0[e] = a * a; v1[e] = b * b; } }
                    u32x4 w; w.x = pk2h(v0[0], v0[1]); w.y = pk2h(v0[2], v0[3]); w.z = pk2h(v1[0], v1[1]); w.w = pk2h(v1[2], v1[3]);
                    *(u32x4*)(rowp + bj * HALF) = w; } }
    }
};
constexpr int RSTD_LDS = 131072;
__device__ __forceinline__ void row_rstd(const Unit& u, int wr, int fr, float (&rs)[2][4]) {
    const PG8_LAS float* rt = (const PG8_LAS float*)(uintptr_t)(RSTD_LDS + u.idx * 1024) + wr * 64 + fr;
#pragma unroll
    for (int ai = 0; ai < 2; ++ai)
#pragma unroll
        for (int m = 0; m < 4; ++m) rs[ai][m] = rt[ai * HALF + m * 16];
}
template <class Sched> __device__ __forceinline__ void fill_rstd(const float* SS, const Sched& S, int tid) {
    for (int i = 0; i < 8; ++i) { Unit u; if (!S.next(i, u)) break;
        if (tid < 256) { const f32x4* sp = (const f32x4*)(SS + (size_t)(u.pm * BM + tid) * 16);
            const f32x4 a = sp[0], b = sp[1], c = sp[2], d = sp[3]; const f32x4 t = (a + b) + (c + d);
            ((PG8_LAS float*)(uintptr_t)(RSTD_LDS + i * 1024))[tid] = __builtin_amdgcn_rsqf(((t.x + t.y) + (t.z + t.w)) * (1.f / DM) + EPS); } }
    __syncthreads();
}
template <int ACT  > struct EpiNormF16 {
    static constexpr bool PERM = true, AFTER_DRAIN = false;
    f16* O; int ldc; const float* cvec;
    __device__ __forceinline__ void operator()(const f32x4 (&acc)[2][2][4][2], const Unit& u, int wr, int wc, int fr, int fq) const {
        const int row0 = u.pm * BM + wr * 64 + fr; const int col0 = u.pn * BM + wc * 32 + 8 * fq; const int b = (u.pm * BM) / SEQ;
        float rs[2][4]; row_rstd(u, wr, fr, rs);
        const __amdgpu_buffer_rsrc_t rsrc = __builtin_amdgcn_make_buffer_rsrc(O, 0, 0x7fffffff, 0x00020000);
        f32x4 cv[2][2];
#pragma unroll
        for (int bj = 0; bj < 2; ++bj)
#pragma unroll
            for (int n = 0; n < 2; ++n) cv[bj][n] = *(const f32x4*)(cvec + (size_t)b * 4096 + col0 + bj * HALF + 4 * n);
#pragma unroll
        for (int ai = 0; ai < 2; ++ai)
#pragma unroll
            for (int m = 0; m < 4; ++m) { const unsigned rowo = (unsigned)((row0 + ai * HALF + m * 16) * ldc + col0) * 2u; const float r = rs[ai][m];
#pragma unroll
                for (int bj = 0; bj < 2; ++bj) { f32x4 v0 = acc[ai][bj][m][0] * r + cv[bj][0], v1 = acc[ai][bj][m][1] * r + cv[bj][1];
                    if (ACT == 1) {
#pragma unroll
                        for (int e = 0; e < 4; ++e) { const float a = fmaxf(v0[e], 0.f), b2 = fmaxf(v1[e], 0.f); v0[e] = a * a; v1[e] = b2 * b2; } }
                    u32x4 w; w.x = pk2h(v0[0], v0[1]); w.y = pk2h(v0[2], v0[3]); w.z = pk2h(v1[0], v1[1]); w.w = pk2h(v1[2], v1[3]);
                    __builtin_amdgcn_raw_buffer_store_b128(w, rsrc, rowo + bj * HALF * 2, 0, 16  ); } }
    }
};
struct EpiGateMerge {
    static constexpr bool PERM = true, AFTER_DRAIN = false;
    f16* Y; f16* merged; const float* gb; const float* cvec;
    __device__ __forceinline__ void operator()(const f32x4 (&acc)[2][2][4][2], const Unit& u, int wr, int wc, int fr, int fq) const {
        const int br = u.pn >> 2, pc = u.pn & 3;
        const int row0 = u.pm * BM + wr * 64 + fr; const int col0 = pc * BM + wc * 32 + 8 * fq;
        if (br == 2) { __builtin_amdgcn_fence(__ATOMIC_ACQUIRE, "agent"); }
        const int b = (u.pm * BM) / SEQ; float rs[2][4]; row_rstd(u, wr, fr, rs);
        f32x4 bv[2][2];
#pragma unroll
        for (int bj = 0; bj < 2; ++bj)
#pragma unroll
            for (int n = 0; n < 2; ++n) bv[bj][n] = *(const f32x4*)(gb + br * 1024 + col0 + bj * HALF + 4 * n) + *(const f32x4*)(cvec + (size_t)b * 4096 + br * 1024 + col0 + bj * HALF + 4 * n);
        f16* Yb = Y + (size_t)br * MTOK * 1024;
#pragma unroll
        for (int ai = 0; ai < 2; ++ai)
#pragma unroll
            for (int m = 0; m < 4; ++m) { const size_t off = (size_t)(row0 + ai * HALF + m * 16) * 1024 + col0;
#pragma unroll
                for (int bj = 0; bj < 2; ++bj) {
                    const f32x4 g0 = acc[ai][bj][m][0] * rs[ai][m] + bv[bj][0], g1 = acc[ai][bj][m][1] * rs[ai][m] + bv[bj][1];
                    const f16x8 yv = *(const f16x8*)(Yb + off + bj * HALF);
                    float z[8];
#pragma unroll
                    for (int e = 0; e < 4; ++e) { z[e] = (float)yv[e] * __builtin_amdgcn_rcpf(1.f + __builtin_amdgcn_exp2f(-LOG2E * g0[e])); z[4 + e] = (float)yv[4 + e] * __builtin_amdgcn_rcpf(1.f + __builtin_amdgcn_exp2f(-LOG2E * g1[e])); }
                    if (br == 2) {
                        const f16x8 za = *(const f16x8*)(Y + off + bj * HALF), zb = *(const f16x8*)(Y + (size_t)MTOK * 1024 + off + bj * HALF);
#pragma unroll
                        for (int e = 0; e < 8; ++e) z[e] += (float)za[e] + (float)zb[e];
                    }
                    u32x4 w; w.x = pk2h(z[0], z[1]); w.y = pk2h(z[2], z[3]); w.z = pk2h(z[4], z[5]); w.w = pk2h(z[6], z[7]);
                    f16* dst = (br == 2) ? merged : Yb;
                    *(u32x4*)(dst + off + bj * HALF) = w; } }
    }
};
struct EpiResidual {
    static constexpr bool PERM = false, AFTER_DRAIN = false;
    const float* xin32; const f16* xin16; f16* out; const float* gate; int gpitch; f16* U; const float* nw; const float* nsc; float* SS;
    __device__ __forceinline__ void operator()(const f32x4 (&acc)[2][2][4][2], const Unit& u, int wr, int wc, int fr, int fq) const {
        const int col0 = u.pn * BM + wc * 32 + 4 * fq; const int b = (u.pm * BM) / SEQ;
        f32x4 gv[2][2], Gv[2][2];
#pragma unroll
        for (int bj = 0; bj < 2; ++bj)
#pragma unroll
            for (int n = 0; n < 2; ++n) { gv[bj][n] = *(const f32x4*)(gate + (size_t)b * gpitch + col0 + bj * HALF + n * 16);
                if (U) Gv[bj][n] = *(const f32x4*)(nw + col0 + bj * HALF + n * 16) * (*(const f32x4*)(nsc + (size_t)b * gpitch + col0 + bj * HALF + n * 16) + 1.f); }
#pragma unroll
        for (int ai = 0; ai < 2; ++ai)
#pragma unroll
            for (int m = 0; m < 4; ++m) { const int row = u.pm * BM + ai * HALF + wr * 64 + m * 16 + fr; const size_t off = (size_t)row * DM + col0; float ss = 0.f;
#pragma unroll
                for (int bj = 0; bj < 2; ++bj)
#pragma unroll
                    for (int n = 0; n < 2; ++n) { f32x4 xv;
                        if (xin32) xv = *(const f32x4*)(xin32 + off + bj * HALF + n * 16);
                        else { const f16x4 h4 = *(const f16x4*)(xin16 + off + bj * HALF + n * 16); xv = (f32x4){(float)h4[0], (float)h4[1], (float)h4[2], (float)h4[3]}; }
                        const f32x4 xn = xv + gv[bj][n] * acc[ai][bj][m][n];
                        { u32x2 w; w.x = pk2h(xn.x, xn.y); w.y = pk2h(xn.z, xn.w); *(u32x2*)(out + off + bj * HALF + n * 16) = w; }
                        if (U) { ss += (xn.x * xn.x + xn.y * xn.y) + (xn.z * xn.z + xn.w * xn.w); const f32x4 y = xn * Gv[bj][n];
                            u32x2 w; w.x = pk2h(y.x, y.y); w.y = pk2h(y.z, y.w); *(u32x2*)(U + off + bj * HALF + n * 16) = w; } }
                if (U) { ss += __shfl_xor(ss, 16); ss += __shfl_xor(ss, 32); if (fq == 0) SS[(size_t)row * 16 + u.pn * 4 + wc] = ss; } }
    }
};

template <class Epi, class Sched, bool ALIGN_EPI = false, bool SP2 = false>
__device__ __forceinline__ void gemm_phase(PG8_LAS unsigned char* lds, const Gemm g, const Sched& S, const Epi& E, const int wid) {
    const int lane = lane_id(), tid = wid * 64 + lane, wr = wid >> 2, wc = wid & 3, fr = lane & 15, fq = lane >> 4;
    const int K = g.K, nt = K / BK;
    unsigned voffA[2], voffB[2];
#pragma unroll
    for (int i = 0; i < 2; ++i) { int R, C; stage_rc(tid * 16 + i * 8192, R, C); const int Rb = Epi::PERM ? ((R & ~31) + perm32(R & 31)) : R;
        voffA[i] = (unsigned)(R * K + C) * 2u; voffB[i] = (unsigned)(Rb * K + C) * 2u; }
    const size_t kstep = (size_t)(BK * 2);
    const size_t hstep = (size_t)HALF * K * 2;
    const size_t tstep = 2 * hstep;
    const unsigned ldsw = (unsigned)wid * 1024u;
    const int aoff = lds_byte(wr * 64 + fr, fq * 8), boff = lds_byte(wc * 32 + fr, fq * 8);
#define PG8_SA(b, h) (((b) * 2 + (h)) * HTB)
#define PG8_SB(b, h) ((4 + (b) * 2 + (h)) * HTB)
#define PG8_STAGE(bufoff, gbase, voff) do { _Pragma("unroll") for (int _i = 0; _i < 2; ++_i) \
        __builtin_amdgcn_global_load_lds((const unsigned*)((const char*)(gbase) + (voff)[_i]), (PG8_LAS unsigned*)(lds + (bufoff) + ldsw + _i * 8192), 16, 0, 0); } while (0)
#define PG8_LDA(dst, b, h) do { _Pragma("unroll") for (int m = 0; m < 4; ++m) _Pragma("unroll") for (int k = 0; k < 2; ++k) dst[m][k] = *(const PG8_LAS f16x8*)(lds + PG8_SA(b, h) + aoff + m * 2048 + k * 1024); } while (0)
#define PG8_LDB(dst, b, h) do { _Pragma("unroll") for (int n = 0; n < 2; ++n) _Pragma("unroll") for (int k = 0; k < 2; ++k) dst[n][k] = *(const PG8_LAS f16x8*)(lds + PG8_SB(b, h) + boff + n * 2048 + k * 1024); } while (0)
#define PG8_MMA(ai, bj, At, Bt) do { __builtin_amdgcn_s_setprio(1); _Pragma("unroll") for (int m = 0; m < 4; ++m) _Pragma("unroll") for (int n = 0; n < 2; ++n) _Pragma("unroll") for (int k = 0; k < 2; ++k) \
        acc[ai][bj][m][n] = __builtin_amdgcn_mfma_f32_16x16x32_f16(Bt[n][k], At[m][k], acc[ai][bj][m][n], 0, 0, 0); __builtin_amdgcn_s_setprio(0); } while (0)
#define PG8_WAIT_V(n) asm volatile("s_waitcnt vmcnt(" #n ")" ::: "memory")
#define PG8_WAIT_L(n) asm volatile("s_waitcnt lgkmcnt(" #n ")" ::: "memory")
#define PG8_BAR __builtin_amdgcn_s_barrier()
#define PG8_SCHED __builtin_amdgcn_sched_barrier(0)
    Unit cur, nxt; int ui = 0;
    if (!S.next(0, cur)) return;
    f32x4 acc[2][2][4][2];
#pragma unroll
    for (int a = 0; a < 2; ++a)
#pragma unroll
        for (int b = 0; b < 2; ++b)
#pragma unroll
            for (int m = 0; m < 4; ++m)
#pragma unroll
                for (int n = 0; n < 2; ++n) acc[a][b][m][n] = (f32x4){0.f, 0.f, 0.f, 0.f};
    f16x8 At[4][2], B0[2][2], B1[2][2];
    const char* cA = (const char*)g.A + (size_t)cur.pm * tstep; const char* cB = (const char*)g.Bt + (size_t)cur.pn * tstep;
    S.a_ready(cur);
    if constexpr (SP2) {
        PG8_STAGE(PG8_SB(0, 0), cB, voffB); PG8_STAGE(PG8_SB(0, 1), cB + hstep, voffB); PG8_STAGE(PG8_SA(0, 0), cA, voffA); PG8_STAGE(PG8_SA(0, 1), cA + hstep, voffA);
        if (wr == 1) PG8_BAR;
        PG8_WAIT_V(2); PG8_BAR;
        PG8_STAGE(PG8_SB(1, 0), cB + kstep, voffB); PG8_STAGE(PG8_SA(1, 0), cA + kstep, voffA); PG8_STAGE(PG8_SB(1, 1), cB + hstep + kstep, voffB);
        PG8_WAIT_V(6); PG8_BAR;
    } else {
        PG8_STAGE(PG8_SB(0, 0), cB, voffB); PG8_STAGE(PG8_SA(0, 0), cA, voffA); PG8_STAGE(PG8_SB(0, 1), cB + hstep, voffB); PG8_STAGE(PG8_SA(0, 1), cA + hstep, voffA);
        if (wr == 1) PG8_BAR;
        PG8_WAIT_V(4); PG8_BAR;
        PG8_STAGE(PG8_SB(1, 0), cB + kstep, voffB); PG8_STAGE(PG8_SA(1, 0), cA + kstep, voffA); PG8_STAGE(PG8_SB(1, 1), cB + hstep + kstep, voffB);
        PG8_WAIT_V(6); PG8_BAR;
    }
    for (;;) {
        const bool has_next = S.next(ui + 1, nxt);
        const char* nA = has_next ? (const char*)g.A + (size_t)nxt.pm * tstep : cA; const char* nB = has_next ? (const char*)g.Bt + (size_t)nxt.pn * tstep : cB;
        for (int t = 0; t < nt; t += 2) {
            const bool last = (t == nt - 2);
            const char* a1 = cA + (size_t)(t + 1) * kstep;
            const char* a2 = last ? nA : cA + (size_t)(t + 2) * kstep; const char* b2 = last ? nB : cB + (size_t)(t + 2) * kstep;
            const char* a3 = a2 + kstep; const char* b3 = b2 + kstep;
            if (last && has_next) S.a_ready(nxt);
            if constexpr (SP2) {
            PG8_LDB(B0, 0, 0); PG8_LDB(B1, 0, 1); PG8_SCHED; PG8_LDA(At, 0, 0); PG8_STAGE(PG8_SA(1, 1), a1 + hstep, voffA);
            PG8_WAIT_V(8); PG8_WAIT_L(0); PG8_BAR; PG8_MMA(0, 0, At, B0); PG8_MMA(0, 1, At, B1); PG8_BAR; PG8_SCHED;
            PG8_LDA(At, 0, 1); PG8_STAGE(PG8_SB(0, 0), b2, voffB); PG8_STAGE(PG8_SB(0, 1), b2 + hstep, voffB); PG8_STAGE(PG8_SA(0, 0), a2, voffA);
            PG8_WAIT_V(8); PG8_WAIT_L(0); PG8_BAR; PG8_MMA(1, 0, At, B0); PG8_MMA(1, 1, At, B1); PG8_BAR; PG8_SCHED;
            PG8_LDB(B0, 1, 0); PG8_LDB(B1, 1, 1); PG8_SCHED; PG8_LDA(At, 1, 0); PG8_STAGE(PG8_SA(0, 1), a2 + hstep, voffA);
            PG8_WAIT_V(8); PG8_WAIT_L(0); PG8_BAR; PG8_MMA(0, 0, At, B0); PG8_MMA(0, 1, At, B1); PG8_BAR; PG8_SCHED;
            PG8_LDA(At, 1, 1); PG8_STAGE(PG8_SB(1, 0), b3, voffB); PG8_STAGE(PG8_SB(1, 1), b3 + hstep, voffB); PG8_STAGE(PG8_SA(1, 0), a3, voffA);
            PG8_WAIT_V(8); PG8_WAIT_L(0); PG8_BAR; PG8_MMA(1, 0, At, B0); PG8_MMA(1, 1, At, B1); PG8_BAR; PG8_SCHED;
            } else {
            PG8_LDB(B0, 0, 0); PG8_SCHED; PG8_LDA(At, 0, 0); PG8_STAGE(PG8_SA(1, 1), a1 + hstep, voffA);
            PG8_WAIT_L(8); PG8_BAR; PG8_WAIT_L(0); PG8_MMA(0, 0, At, B0); PG8_BAR; PG8_SCHED;
            PG8_LDB(B1, 0, 1); PG8_STAGE(PG8_SB(0, 0), b2, voffB);
            PG8_BAR; PG8_WAIT_L(0); PG8_MMA(0, 1, At, B1); PG8_BAR;
            PG8_LDA(At, 0, 1); PG8_STAGE(PG8_SA(0, 0), a2, voffA);
            PG8_BAR; PG8_WAIT_L(0); PG8_MMA(1, 0, At, B0); PG8_BAR; PG8_SCHED;
            PG8_STAGE(PG8_SB(0, 1), b2 + hstep, voffB);
            PG8_WAIT_V(6); PG8_BAR; PG8_MMA(1, 1, At, B1); PG8_BAR;
            PG8_LDB(B0, 1, 0); PG8_SCHED; PG8_LDA(At, 1, 0); PG8_STAGE(PG8_SA(0, 1), a2 + hstep, voffA);
            PG8_WAIT_L(8); PG8_BAR; PG8_WAIT_L(0); PG8_MMA(0, 0, At, B0); PG8_BAR; PG8_SCHED;
            PG8_LDB(B1, 1, 1); PG8_STAGE(PG8_SB(1, 0), b3, voffB);
            PG8_BAR; PG8_WAIT_L(0); PG8_MMA(0, 1, At, B1); PG8_BAR;
            PG8_LDA(At, 1, 1); PG8_STAGE(PG8_SA(1, 0), a3, voffA);
            PG8_BAR; PG8_WAIT_L(0); PG8_MMA(1, 0, At, B0); PG8_BAR; PG8_SCHED;
            PG8_STAGE(PG8_SB(1, 1), b3 + hstep, voffB);
            PG8_WAIT_V(6); PG8_BAR; PG8_MMA(1, 1, At, B1); PG8_BAR;
            }
        }
        if constexpr (ALIGN_EPI) { if (wr == 0) PG8_BAR; }
        if constexpr (!Epi::AFTER_DRAIN) { E(acc, cur, wr, wc, fr, fq); S.done(cur); }
        if (!has_next) break;
#pragma unroll
        for (int a = 0; a < 2; ++a)
#pragma unroll
            for (int b = 0; b < 2; ++b)
#pragma unroll
                for (int m = 0; m < 4; ++m)
#pragma unroll
                    for (int n = 0; n < 2; ++n) acc[a][b][m][n] = (f32x4){0.f, 0.f, 0.f, 0.f};
        cur = nxt; cA = nA; cB = nB; ++ui;
        if constexpr (ALIGN_EPI) { if (wr == 1) PG8_BAR; }
    }
    PG8_WAIT_V(0);
    if constexpr (!ALIGN_EPI) { if (wr == 0) PG8_BAR; }
    PG8_BAR;
#undef PG8_SA
#undef PG8_SB
#undef PG8_STAGE
#undef PG8_LDA
#undef PG8_LDB
#undef PG8_MMA
#undef PG8_WAIT_V
#undef PG8_WAIT_L
#undef PG8_BAR
#undef PG8_SCHED
}
}

constexpr size_t MiB = 1u << 20;
constexpr size_t WS_CTL = 0, CTL_ZERO_BYTES = 1 * MiB;
constexpr size_t WS_MOD = 1 * MiB;
constexpr size_t WS_MISC = 2 * MiB;
constexpr size_t WS_WIN = 4 * MiB;
constexpr size_t WS_WG = 18 * MiB;
constexpr size_t WS_WA = 30 * MiB;
constexpr size_t WS_WBC = 32 * MiB;
constexpr size_t WS_WC = 34 * MiB;
constexpr size_t WS_WO = 36 * MiB;
constexpr size_t WS_W1 = 40 * MiB;
constexpr size_t WS_W2 = 56 * MiB;
constexpr size_t WS_U = 72 * MiB;
constexpr size_t WS_KVN = 136 * MiB;
constexpr size_t WS_MASK = 144 * MiB;
constexpr size_t WS_OA = 152 * MiB;
constexpr size_t WS_OB = 184 * MiB;
constexpr size_t WS_OC = 216 * MiB;
constexpr size_t WS_R1 = 232 * MiB;
constexpr size_t WS_SS = 488 * MiB;
constexpr size_t WS_END = 490 * MiB;
constexpr size_t WS_CVEC = WS_MISC + 256 * 1024;
constexpr int CW_TMO = 0, CW_BAR = 4096, CW_QUEUE = 16384;

constexpr int NWAVES = 8;
constexpr int RING_BYTES = 131072, LDSCTL_OFF = 139264, MISC_OFF = LDSCTL_OFF + 320, LDS_BYTES = LDSCTL_OFF + 16384;

#define RLX_AGENT __ATOMIC_RELAXED, __HIP_MEMORY_SCOPE_AGENT
#define LDS_WAIT() asm volatile("s_waitcnt lgkmcnt(0)" ::: "memory")

#define XB_TMO      128
#define XB_XCNT(j)  (256  + 64 * (j))
#define XB_XSUB(j)  (1280 + 64 * (j))
#define XB_XGEN(j)  (2304 + 64 * (j))
#define XB_TOP      3328
#define XB_TOPGEN   3392
#define XCD_BAR_WORDS 3456
#define XB_SPIN_CAP (1u << 22)
__device__ __forceinline__ unsigned xb_ld(unsigned* p)              { return __hip_atomic_load(p, __ATOMIC_RELAXED, __HIP_MEMORY_SCOPE_AGENT); }
__device__ __forceinline__ unsigned xb_add(unsigned* p, unsigned v) { return __hip_atomic_fetch_add(p, v, __ATOMIC_RELAXED, __HIP_MEMORY_SCOPE_AGENT); }
__device__ __forceinline__ unsigned xb_xcc_id() { return (unsigned)__builtin_amdgcn_s_getreg((3 << 11) | 20) & 0xFu; }
#define XB_SPIN(cond, bar) do { unsigned _sp = 0; while (cond) { __builtin_amdgcn_s_sleep(1); \
    if ((++_sp & 255u) == 0u) { if (xb_ld(&(bar)[XB_TMO])) break; if (_sp > XB_SPIN_CAP) { atomicAdd(&(bar)[XB_TMO], 1u); break; } } } } while (0)
struct XcdBarrier { unsigned* bar; unsigned x; volatile LAS unsigned* st; };
__device__ __forceinline__ XcdBarrier xcd_barrier_post(unsigned* bar, volatile LAS unsigned* st, int wave) {
    XcdBarrier b; b.bar = bar; b.x = xb_xcc_id(); b.st = st;
    if (wave == 0 && lane_id() == 0) (void)xb_add(&bar[XB_XCNT(b.x)], 1u);
    return b;
}
__device__ __forceinline__ void xcd_barrier_complete(unsigned* bar, unsigned x, unsigned& nloc, unsigned& nx) {
    const unsigned G = gridDim.x * gridDim.y * gridDim.z;
    unsigned sum, cnt, mine, sp = 0u;
    for (;;) {
        sum = 0u; cnt = 0u; mine = 0u;
#pragma unroll
        for (unsigned j = 0; j < 16; ++j) { const unsigned c = xb_ld(&bar[XB_XCNT(j)]); sum += c; cnt += (c > 0u) ? 1u : 0u; mine = (j == x) ? c : mine; }
        if (sum == G) break;
        __builtin_amdgcn_s_sleep(1);
        if ((++sp & 255u) == 0u) { if (xb_ld(&bar[XB_TMO])) break; if (sp > XB_SPIN_CAP) { atomicAdd(&bar[XB_TMO], 1u); break; } }
    }
    nloc = mine > 0u ? mine : 1u; nx = cnt > 0u ? cnt : 1u;
}
__device__ __forceinline__ void xcd_barrier(const XcdBarrier& b, int wave) {
    asm volatile("s_waitcnt vmcnt(0)" ::: "memory");
    __syncthreads();
    if (wave == 0 && lane_id() == 0) {
        unsigned* bar = b.bar; asm volatile("" : "+s"(bar)); unsigned bx = b.x; asm volatile("" : "+s"(bx));
        __builtin_amdgcn_s_waitcnt(0);
        unsigned nloc = b.st[0], nx = b.st[1];
        if (nloc == 0u) { xcd_barrier_complete(bar, bx, nloc, nx); b.st[0] = nloc; b.st[1] = nx; }
        const unsigned old = xb_add(&bar[XB_XSUB(bx)], 1u);
        const unsigned gen = old / nloc;
        if (old + 1u == (gen + 1u) * nloc) {
            __builtin_amdgcn_fence(__ATOMIC_RELEASE, "agent");
            asm volatile("s_waitcnt vmcnt(0)" ::: "memory");
            const unsigned og = xb_add(&bar[XB_TOP], 1u);
            const unsigned tg = og / nx;
            if (og + 1u == (tg + 1u) * nx) xb_add(&bar[XB_TOPGEN], 1u);
            else XB_SPIN(xb_ld(&bar[XB_TOPGEN]) == tg, bar);
            __builtin_amdgcn_fence(__ATOMIC_ACQUIRE, "agent");
            xb_add(&bar[XB_XGEN(bx)], 1u);
            asm volatile("s_waitcnt vmcnt(0)" ::: "memory");
        } else {
            XB_SPIN(xb_ld(&bar[XB_XGEN(bx)]) == gen, bar);
            __builtin_amdgcn_fence(__ATOMIC_ACQUIRE, "agent");
            asm volatile("s_waitcnt vmcnt(0)" ::: "memory");
        }
    }
    __syncthreads();
}

__device__ __forceinline__ float wave_sum(float v) {
#pragma unroll
    for (int o = 1; o < 64; o <<= 1) v += __shfl_xor(v, o);
    return v;
}
__device__ __forceinline__ float wave_max(float v) {
#pragma unroll
    for (int o = 1; o < 64; o <<= 1) v = fmaxf(v, __shfl_xor(v, o));
    return v;
}
__device__ __forceinline__ int wave_isum(int v) {
#pragma unroll
    for (int o = 1; o < 64; o <<= 1) v += __shfl_xor(v, o);
    return v;
}

__device__ __forceinline__ int t5_bucket(int n) {
    if (n < 16) return n;
    if (n >= 113) return 31;
    const int first[16] = {16, 19, 21, 24, 27, 31, 35, 40, 46, 52, 59, 67, 77, 87, 99, 113};
    int b = 16;
#pragma unroll
    for (int i = 1; i < 16; ++i) b += (n >= first[i]) ? 1 : 0;
    return b;
}

struct Frame {
    LAS unsigned char* lds;
    int wave, gw, NGW, G;
};

template <class ScaleFn>
__device__ __forceinline__ void transpose_item(const float* W, int ldw, int col0, int nvalid, int K, f16* WT, int nblk, LAS float* scr, int item, int lane, ScaleFn sf) {
    const int kb = item / nblk, nb = item % nblk, k0 = 64 * kb, n0 = 32 * nb;
    const int nn = n0 + (lane & 31);
    const bool ok = nn < nvalid;
    const float sc = sf(nn);
    float wv[32];
#pragma unroll
    for (int i = 0; i < 32; ++i) { const int kk = 2 * i + (lane >> 5); wv[i] = ok ? *(const GAS float*)(W + (size_t)(k0 + kk) * ldw + col0 + nn) : 0.f; }
#pragma unroll
    for (int i = 0; i < 32; ++i) { const int kk = 2 * i + (lane >> 5); scr[kk * 33 + (lane & 31)] = wv[i] * sc; }
    LDS_WAIT(); asm volatile("" ::: "memory");
    const int c = lane & 7;
#pragma unroll
    for (int j = 0; j < 4; ++j) { const int n = (lane >> 3) + 8 * j; const LAS float* s = scr + (8 * c) * 33 + n;
        u32x4 o; o.x = pk2h(s[0 * 33], s[1 * 33]); o.y = pk2h(s[2 * 33], s[3 * 33]); o.z = pk2h(s[4 * 33], s[5 * 33]); o.w = pk2h(s[6 * 33], s[7 * 33]);
        *(u32x4*)(WT + (size_t)(n0 + n) * K + k0 + 8 * c) = o; }
    LDS_WAIT(); asm volatile("" ::: "memory");
}
struct ScaleOne { __device__ __forceinline__ float operator()(int) const { return 1.f; } };
struct ScaleIn {
    __device__ __forceinline__ float operator()(int n) const {
        if (n < 512) return 0.125f * LOG2E;
        if (n >= C_BQ && n < C_BKV) return 0.08838834764831845f * LOG2E;
        if (n >= C_CQ && n < C_CK) return 0.125f * LOG2E;
        return 1.f; }
};

__device__ __forceinline__ void norm_row_pre(const float* xrow, const float* g, const float* scale, f16* orow, float* ssrow, int lane) {
    const f32x4* xr = (const f32x4*)xrow + lane;
    f32x4 v[4]; float s = 0.f;
#pragma unroll
    for (int j = 0; j < 4; ++j) { v[j] = xr[64 * j]; s += (v[j].x * v[j].x + v[j].y * v[j].y) + (v[j].z * v[j].z + v[j].w * v[j].w); }
    s = wave_sum(s);
#pragma unroll
    for (int j = 0; j < 4; ++j) {
        const f32x4 gv = ((const f32x4*)g)[lane + 64 * j], sc = ((const f32x4*)scale)[lane + 64 * j];
        const f32x4 y = v[j] * gv * (sc + 1.f);
        u32x2 w; w.x = pk2h(y.x, y.y); w.y = pk2h(y.z, y.w);
        ((u32x2*)orow)[lane + 64 * j] = w; }
    if (lane < 4) ((f32x4*)ssrow)[lane] = (f32x4){lane == 0 ? s : 0.f, 0.f, 0.f, 0.f};
}

template <int DQK, int DV>
__device__ __forceinline__ void naive_attn(LAS float* scl  , const f16* q, const f16* Kb, int kpitch, const f16* Vb, int vpitch, int t, unsigned sel, const float* tab, int lane, float (&o)[DV / 64]) {
    const int nslots = (t >> 6) + 1;
    float mx = -INFINITY;
#pragma unroll 1
    for (int j = 0; j < nslots; ++j) {
        float s = -INFINITY; const int k = 64 * j + lane;
        if (k <= t && ((sel >> j) & 1u)) {
            const f16* kr = Kb + (size_t)k * kpitch; float a = 0.f;
#pragma unroll 4
            for (int c = 0; c < DQK / 8; ++c) { const f16x8 kv = *(const f16x8*)(kr + 8 * c); const f16x8 qv = *(const f16x8*)(q + 8 * c);
#pragma unroll
                for (int e = 0; e < 8; ++e) a += (float)kv[e] * (float)qv[e]; }
            const int dist = t - k; s = a + tab[(dist < 128 ? dist : 128) + 255];
        }
        scl[k] = s; mx = fmaxf(mx, s);
    }
    mx = wave_max(mx);
    float l = 0.f;
#pragma unroll 1
    for (int j = 0; j < nslots; ++j) { const float p = __builtin_amdgcn_exp2f(scl[64 * j + lane] - mx); scl[64 * j + lane] = p; l += p; }
    l = wave_sum(l);
    const float inv = 1.f / l;
#pragma unroll
    for (int i = 0; i < DV / 64; ++i) o[i] = 0.f;
    LDS_WAIT(); asm volatile("" ::: "memory");
#pragma unroll 1
    for (int k = 0; k < 64 * nslots; k += 4) {
        const f32x4 p = *(const LAS f32x4*)(scl + k);
        if (p.x != 0.f || p.y != 0.f || p.z != 0.f || p.w != 0.f) { const f16* vr = Vb + (size_t)k * vpitch;
            float v[4][DV / 64];
#pragma unroll
            for (int r = 0; r < 4; ++r)
#pragma unroll
                for (int i = 0; i < DV / 64; ++i) v[r][i] = (float)vr[(size_t)r * vpitch + lane + 64 * i];
#pragma unroll
            for (int i = 0; i < DV / 64; ++i) o[i] += (p.x * v[0][i] + p.y * v[1][i]) + (p.z * v[2][i] + p.w * v[3][i]); }
    }
#pragma unroll
    for (int i = 0; i < DV / 64; ++i) o[i] *= inv;
    LDS_WAIT(); asm volatile("" ::: "memory");
}

__device__ __forceinline__ unsigned char* launder(unsigned char* p) { asm volatile("" : "+s"(p)); return p; }
__device__ __forceinline__ int launder_i(int v) { asm volatile("" : "+s"(v)); return v; }
constexpr int PTAB_OFF = LDSCTL_OFF + 512;
__device__ __forceinline__ const float* inptr(LAS unsigned char* lds, int i) {
    unsigned saddr = (unsigned)(uintptr_t)(lds + PTAB_OFF) + 8u * (unsigned)i, addr;
    asm volatile("v_mov_b32 %0, %1" : "=v"(addr) : "s"(saddr));
    const unsigned long long v = *(volatile LAS unsigned long long*)(uintptr_t)addr;
    const unsigned lo = __builtin_amdgcn_readfirstlane((unsigned)v), hi = __builtin_amdgcn_readfirstlane((unsigned)(v >> 32));
    return (const float*)(((unsigned long long)hi << 32) | lo);
}
__device__ __forceinline__ unsigned ordkey(float f) { const unsigned u = __float_as_uint(f); return u ^ ((unsigned)((int)u >> 31) | 0x80000000u); }

namespace fa {
typedef float f32x16 __attribute__((ext_vector_type(16)));
typedef short v4i16_t __attribute__((ext_vector_type(4)));
__device__ __forceinline__ int crow(int r, int hi) { return (r & 3) + 8 * (r >> 2) + 4 * hi; }
constexpr int TAB_OFF = 139264 + 1024;
constexpr int SUB_OFF = TAB_OFF + 10240;
constexpr int STASH_OFF = 73728;
template <int DQK, int DV, bool KVSAME> struct Lay {
    static constexpr int RSK = DQK * 2 + 16, RSV = DV * 2 + 64;
    static constexpr int KBUF = 64 * RSK, VBUF = 64 * RSV;
    static constexpr int VOFF0 = 2 * KBUF, END = 2 * KBUF + 2 * VBUF;
    static constexpr int NKC = DQK / 64, NVC = KVSAME ? 0 : DV / 64;
    static_assert(END <= 77824, "attention LDS map");
};
__device__ __forceinline__ f16x8 pack8(const f32x16& p, int b) {
    u32x4 w; w.x = pk2h(p[b + 0], p[b + 1]); w.y = pk2h(p[b + 2], p[b + 3]); w.z = pk2h(p[b + 4], p[b + 5]); w.w = pk2h(p[b + 6], p[b + 7]);
    return __builtin_bit_cast(f16x8, w);
}
__device__ __forceinline__ float max3f(float a, float b, float c) { float r; asm("v_max3_f32 %0, %1, %2, %3" : "=v"(r) : "v"(a), "v"(b), "v"(c)); return r; }
__device__ __forceinline__ float rowmax32(const f32x16& a, const f32x16& b) {
    float x = max3f(a[0], a[1], b[0]), y = max3f(a[2], a[3], b[1]); x = max3f(x, b[2], b[3]);
#pragma unroll
    for (int r = 4; r < 16; r += 4) { x = max3f(x, a[r], a[r + 1]); y = max3f(y, a[r + 2], a[r + 3]); x = max3f(x, b[r], b[r + 1]); y = max3f(y, b[r + 2], b[r + 3]); }
    return max3f(x, y, y);
}
__device__ __forceinline__ float half_max(float x) { const auto rr = __builtin_amdgcn_permlane32_swap(__float_as_uint(x), __float_as_uint(x), false, false); return fmaxf(__uint_as_float(rr[0]), __uint_as_float(rr[1])); }
__device__ __forceinline__ float half_sum(float x) { const auto rr = __builtin_amdgcn_permlane32_swap(__float_as_uint(x), __float_as_uint(x), false, false); return __uint_as_float(rr[0]) + __uint_as_float(rr[1]); }
template <int DQK, int DV, int MODE>
__device__ __forceinline__ void attn_pass(LAS unsigned char* lds, const int wave, const int lane,
        const f16* Qw, const int qpitch, const f16* Kg, const int kpitch, const f16* Vg, const int vpitch,
        const int ntiles, const int qpos0, const LAS float* tab, const unsigned selb, const int jblk, const unsigned* maskw,
        f32x16 (&o)[DV / 32]) {
    typedef Lay<DQK, DV, MODE == 2> L;
    constexpr int NB_ = DV / 32;
    const int r32 = lane & 31, hi = lane >> 5, tid = wave * 64 + lane;
    f16x8 qf[DQK / 16];
#pragma unroll
    for (int d0 = 0; d0 < DQK / 16; ++d0) qf[d0] = __builtin_bit_cast(f16x8, *(const GAS u32x4*)(Qw + (size_t)r32 * qpitch + d0 * 16 + hi * 8));
#pragma unroll
    for (int blk = 0; blk < NB_; ++blk)
#pragma unroll
        for (int r = 0; r < 16; ++r) o[blk][r] = 0.f;
    float m = -INFINITY, l = 0.f;
    u32x4 kreg[L::NKC], vreg[L::NVC > 0 ? L::NVC : 1];
    unsigned wnext = 0u;
#define FA_LOAD(kt_) do { \
        _Pragma("unroll") for (int c = 0; c < L::NKC; ++c) { const int id = tid + 512 * c, row = id / (DQK / 8), ch = id % (DQK / 8); \
            kreg[c] = *(const GAS u32x4*)(Kg + (size_t)((kt_) * 64 + row) * kpitch + ch * 8); } \
        _Pragma("unroll") for (int c = 0; c < L::NVC; ++c) { const int id = tid + 512 * c, row = id / (DV / 8), ch = id % (DV / 8); \
            vreg[c] = *(const GAS u32x4*)(Vg + (size_t)((kt_) * 64 + row) * vpitch + ch * 8); } \
        if (MODE == 2) wnext = *(const GAS unsigned*)(maskw + (kt_) * 64 + lane); } while (0)
#define FA_WRITE(buf_) do { \
        _Pragma("unroll") for (int c = 0; c < L::NKC; ++c) { const int id = tid + 512 * c, row = id / (DQK / 8), ch = id % (DQK / 8); \
            *(LAS u32x4*)(lds + (buf_) * L::KBUF + row * L::RSK + ch * 16) = kreg[c]; \
            if (MODE == 2) *(LAS u32x4*)(lds + L::VOFF0 + (buf_) * L::VBUF + row * L::RSV + ch * 16) = kreg[c]; } \
        _Pragma("unroll") for (int c = 0; c < L::NVC; ++c) { const int id = tid + 512 * c, row = id / (DV / 8), ch = id % (DV / 8); \
            *(LAS u32x4*)(lds + L::VOFF0 + (buf_) * L::VBUF + row * L::RSV + ch * 16) = vreg[c]; } } while (0)
#define FA_VREAD(dst_, ks_) do { _Pragma("unroll") for (int blk = 0; blk < NB_; ++blk) { \
        const v4i16_t a_ = __builtin_amdgcn_ds_read_tr16_b64_v4i16((LAS v4i16_t*)(vb + 16 * (ks_) * L::RSV + blk * 64)); \
        const v4i16_t b_ = __builtin_amdgcn_ds_read_tr16_b64_v4i16((LAS v4i16_t*)(vb + (16 * (ks_) + 8) * L::RSV + blk * 64)); \
        const f16x4 a4_ = __builtin_bit_cast(f16x4, a_), b4_ = __builtin_bit_cast(f16x4, b_); \
        dst_[blk] = (f16x8){a4_[0], a4_[1], a4_[2], a4_[3], b4_[0], b4_[1], b4_[2], b4_[3]}; } } while (0)
#define FA_PV(src_, ks_) do { _Pragma("unroll") for (int blk = 0; blk < NB_; ++blk) o[blk] = __builtin_amdgcn_mfma_f32_32x32x16_f16(src_[blk], pf[ks_], o[blk], 0, 0, 0); } while (0)
    FA_LOAD(0);
    unsigned wcur = wnext;
    FA_WRITE(0);
    __syncthreads();
#pragma unroll 1
    for (int kt = 0; kt < ntiles; ++kt) {
        const int cur = kt & 1;
        if (kt + 1 < ntiles) FA_LOAD(kt + 1);
        const int k0 = kt * 64;
        if (k0 <= qpos0 + 31) {
            f32x16 p0, p1;
            if (MODE == 2) {
                const unsigned nw = ~wcur;
#pragma unroll
                for (int r = 0; r < 16; ++r) { p0[r] = __uint_as_float((unsigned)__builtin_amdgcn_sbfe((int)nw, r, 1) & 0xff800000u); p1[r] = __uint_as_float((unsigned)__builtin_amdgcn_sbfe((int)nw, 16 + r, 1) & 0xff800000u); }
            } else if (MODE == 1) {
                const int n = kt >> 2; const float cv = (n == jblk || ((selb >> n) & 1u)) ? 0.f : -INFINITY;
#pragma unroll
                for (int r = 0; r < 16; ++r) { p0[r] = cv; p1[r] = cv; }
            } else {
#pragma unroll
                for (int r = 0; r < 16; ++r) { p0[r] = 0.f; p1[r] = 0.f; }
            }
            const LAS unsigned char* kb = lds + cur * L::KBUF + r32 * L::RSK + hi * 16;
            const LAS unsigned char* vb = lds + L::VOFF0 + cur * L::VBUF + (4 * hi + ((lane & 15) >> 2)) * L::RSV + (16 * ((lane >> 4) & 1) + 4 * (lane & 3)) * 2;
#pragma unroll
            for (int db = 0; db < DQK / 64; ++db) {
                f16x8 kf0[4], kf1[4];
#pragma unroll
                for (int d = 0; d < 4; ++d) { kf0[d] = *(const LAS f16x8*)(kb + (4 * db + d) * 32); kf1[d] = *(const LAS f16x8*)(kb + 32 * L::RSK + (4 * db + d) * 32); }
                __builtin_amdgcn_sched_barrier(0);
#pragma unroll
                for (int d = 0; d < 4; ++d) {
                    p0 = __builtin_amdgcn_mfma_f32_32x32x16_f16(kf0[d], qf[4 * db + d], p0, 0, 0, 0);
                    p1 = __builtin_amdgcn_mfma_f32_32x32x16_f16(kf1[d], qf[4 * db + d], p1, 0, 0, 0); }
                __builtin_amdgcn_sched_barrier(0);
            }
            f16x8 vfa[NB_], vfb[NB_];
            FA_VREAD(vfa, 0);
            __builtin_amdgcn_sched_barrier(0);
            if (qpos0 - (k0 + 63) < 128) {
                const int base = qpos0 + r32 - k0 - 4 * hi + 255;
#pragma unroll
                for (int r = 0; r < 16; ++r) { const int i0 = base - ((r & 3) + 8 * (r >> 2)), i1 = i0 - 32;
                    p0[r] += tab[i0 < 383 ? i0 : 383]; p1[r] += tab[i1 < 383 ? i1 : 383]; }
            }
            float rm = fmaxf(p0[0], p1[0]);
#pragma unroll
            for (int r = 1; r < 16; ++r) rm = fmaxf(rm, fmaxf(p0[r], p1[r]));
            rm = half_max(rm);
            const float mn = fmaxf(m, rm), mu = (mn == -INFINITY) ? 0.f : mn;
            if (__any(mn > m)) { const float al = __builtin_amdgcn_exp2f(m - mu); l *= al;
#pragma unroll
                for (int blk = 0; blk < NB_; ++blk)
#pragma unroll
                    for (int r = 0; r < 16; ++r) o[blk][r] *= al; }
            m = mn;
            float ls = 0.f;
#pragma unroll
            for (int r = 0; r < 16; ++r) { p0[r] = __builtin_amdgcn_exp2f(p0[r] - mu); p1[r] = __builtin_amdgcn_exp2f(p1[r] - mu); ls += p0[r] + p1[r]; }
            l += ls;
            f16x8 pf[4]; pf[0] = pack8(p0, 0); pf[1] = pack8(p0, 8); pf[2] = pack8(p1, 0); pf[3] = pack8(p1, 8);
            __builtin_amdgcn_sched_barrier(0);
            FA_VREAD(vfb, 1); FA_PV(vfa, 0); __builtin_amdgcn_sched_barrier(0);
            FA_VREAD(vfa, 2); FA_PV(vfb, 1); __builtin_amdgcn_sched_barrier(0);
            FA_VREAD(vfb, 3); FA_PV(vfa, 2); __builtin_amdgcn_sched_barrier(0);
            FA_PV(vfb, 3);
        }
        if (kt + 1 < ntiles) FA_WRITE(cur ^ 1);
        wcur = wnext;
        __syncthreads();
    }
#undef FA_LOAD
#undef FA_WRITE
#undef FA_VREAD
#undef FA_PV
    l = half_sum(l);
    const float inv = 1.f / l;
#pragma unroll
    for (int blk = 0; blk < NB_; ++blk)
#pragma unroll
        for (int r = 0; r < 16; ++r) o[blk][r] *= inv;
}
__device__ __forceinline__ int fsw8(int row) { return (row >> 1) & 7; }
__device__ __forceinline__ int fsw16(int row) { return ((row & 3) << 2) | ((row >> 2) & 3); }
__device__ __forceinline__ int fswv8(int row) { return ((row >> 1) & 1) << 2; }
template <int DQK, int DV, int MODE, int S> struct LayD {
    static constexpr int CPRK = DQK / 8, CPRV = DV / 8;
    static constexpr int KB = 64 * DQK * 2, VB = (MODE == 2) ? 0 : 64 * DV * 2, STG = KB + VB;
    static constexpr int PK = CPRK, PV = (MODE == 2) ? 0 : CPRV, NP = (PK + PV) / 8, NPW = NP + (MODE == 2 ? 1 : 0);
    static constexpr int MASKOFF = S * STG;
    static constexpr int END = MASKOFF + (MODE == 2 ? 8 * S * 256 : 0);
    __device__ static __forceinline__ int fk(int row) { return CPRK == 8 ? fsw8(row) : fsw16(row); }
    __device__ static __forceinline__ int fv(int row) { return MODE == 2 ? fsw16(row) : (CPRV == 8 ? fswv8(row) : fsw16(row)); }
};
#define FA_WAITV(n) asm volatile("s_waitcnt vmcnt(%0)" :: "n"(n) : "memory")
template <int DQK, int DV, int MODE, int S>
__device__ __forceinline__ void attn_pass_dma(LAS unsigned char* lds, const int wave, const int lane,
        const f16* Qw, const int qpitch, const f16* Kg, const int kpitch, const f16* Vg, const int vpitch,
        const int ntiles, const int qpos0, const LAS float* tab, const unsigned selb, const int jblk, const unsigned* maskw,
        f32x16 (&o)[DV / 32]) {
    typedef LayD<DQK, DV, MODE, S> L;
    constexpr int NB_ = DV / 32;
    const int r32 = lane & 31, hi = lane >> 5;
    f16x8 qf[DQK / 16];
#pragma unroll
    for (int d0 = 0; d0 < DQK / 16; ++d0) qf[d0] = __builtin_bit_cast(f16x8, *(const GAS u32x4*)(Qw + (size_t)r32 * qpitch + d0 * 16 + hi * 8));
#pragma unroll
    for (int blk = 0; blk < NB_; ++blk)
#pragma unroll
        for (int r = 0; r < 16; ++r) o[blk][r] = 0.f;
    float m = -INFINITY, l = 0.f;
    unsigned goff[L::NP];
#pragma unroll
    for (int c = 0; c < L::NP; ++c) { const int pc = wave + 8 * c;
        if (pc < L::PK) { const int s2 = 64 * pc + lane, row = s2 / L::CPRK, ch = (s2 % L::CPRK) ^ L::fk(row); goff[c] = (unsigned)(row * kpitch + ch * 8); }
        else { const int s2 = 64 * (pc - L::PK) + lane, row = s2 / L::CPRV, ch = (s2 % L::CPRV) ^ L::fv(row); goff[c] = (unsigned)(row * vpitch + ch * 8); } }
#define FA_ISSUE(kt_, st_) do { \
        if (MODE == 2) __builtin_amdgcn_global_load_lds((const GAS unsigned*)(maskw + (kt_) * 64 + lane), (LAS unsigned*)(lds + L::MASKOFF + (wave * S + (st_)) * 256), 4, 0, 0); \
        _Pragma("unroll") for (int c = 0; c < L::NP; ++c) { const int pc = wave + 8 * c; \
            if (pc < L::PK) __builtin_amdgcn_global_load_lds((const GAS unsigned*)(Kg + (size_t)(kt_) * 64 * kpitch + goff[c]), (LAS unsigned*)(lds + (st_) * L::STG + pc * 1024), 16, 0, 0); \
            else __builtin_amdgcn_global_load_lds((const GAS unsigned*)(Vg + (size_t)(kt_) * 64 * vpitch + goff[c]), (LAS unsigned*)(lds + (st_) * L::STG + L::KB + (pc - L::PK) * 1024), 16, 0, 0); } } while (0)
    int koff[DQK / 16];
#pragma unroll
    for (int d0 = 0; d0 < DQK / 16; ++d0) koff[d0] = (r32 * L::CPRK + ((2 * d0 + hi) ^ L::fk(r32))) * 16;
    int voff[2][NB_];
    { const int q = (lane & 15) >> 2, g1 = (lane >> 4) & 1, p = lane & 3;
#pragma unroll
      for (int sec = 0; sec < 2; ++sec)
#pragma unroll
        for (int blk = 0; blk < NB_; ++blk) { const int row = 4 * hi + q + 8 * sec; voff[sec][blk] = L::KB * (MODE == 2 ? 0 : 1) + (row * L::CPRV + ((4 * blk + 2 * g1 + (p >> 1)) ^ L::fv(row))) * 16 + 8 * (p & 1); } }
#define FA_VREADD(dst_, ks_) do { _Pragma("unroll") for (int blk = 0; blk < NB_; ++blk) { \
        const v4i16_t a_ = __builtin_amdgcn_ds_read_tr16_b64_v4i16((LAS v4i16_t*)(sb + voff[0][blk] + 16 * (ks_) * L::CPRV * 16)); \
        const v4i16_t b_ = __builtin_amdgcn_ds_read_tr16_b64_v4i16((LAS v4i16_t*)(sb + voff[1][blk] + 16 * (ks_) * L::CPRV * 16)); \
        const f16x4 a4_ = __builtin_bit_cast(f16x4, a_), b4_ = __builtin_bit_cast(f16x4, b_); \
        dst_[blk] = (f16x8){a4_[0], a4_[1], a4_[2], a4_[3], b4_[0], b4_[1], b4_[2], b4_[3]}; } } while (0)
#define FA_PVD(src_, ks_) do { _Pragma("unroll") for (int blk = 0; blk < NB_; ++blk) o[blk] = __builtin_amdgcn_mfma_f32_32x32x16_f16(src_[blk], pf[ks_], o[blk], 0, 0, 0); } while (0)
#pragma unroll
    for (int t0 = 0; t0 < S - 1; ++t0) if (t0 < ntiles) FA_ISSUE(t0, t0);
    int st = 0, sti = S - 1;
#pragma unroll 1
    for (int kt = 0; kt < ntiles; ++kt) {
        if (kt + S - 2 < ntiles) FA_WAITV(L::NPW * (S - 2)); else FA_WAITV(0);
        __builtin_amdgcn_s_barrier();
        asm volatile("" ::: "memory");
        if (kt + S - 1 < ntiles) FA_ISSUE(kt + S - 1, sti);
        const int k0 = kt * 64;
        if (k0 <= qpos0 + 31) {
            const LAS unsigned char* sb = lds + st * L::STG;
            f32x16 p0, p1;
            if (MODE == 2) {
                const unsigned nw = ~*(const LAS unsigned*)(lds + L::MASKOFF + (wave * S + st) * 256 + lane * 4);
#pragma unroll
                for (int r = 0; r < 16; ++r) { p0[r] = __uint_as_float((unsigned)__builtin_amdgcn_sbfe((int)nw, r, 1) & 0xff800000u); p1[r] = __uint_as_float((unsigned)__builtin_amdgcn_sbfe((int)nw, 16 + r, 1) & 0xff800000u); }
            } else if (MODE == 1) {
                const int n = kt >> 2; const float cv = (n == jblk || ((selb >> n) & 1u)) ? 0.f : -INFINITY;
#pragma unroll
                for (int r = 0; r < 16; ++r) { p0[r] = cv; p1[r] = cv; }
            } else {
#pragma unroll
                for (int r = 0; r < 16; ++r) { p0[r] = 0.f; p1[r] = 0.f; }
            }
#pragma unroll
            for (int db = 0; db < DQK / 64; ++db) {
                f16x8 kf0[4], kf1[4];
#pragma unroll
                for (int d = 0; d < 4; ++d) { kf0[d] = *(const LAS f16x8*)(sb + koff[4 * db + d]); kf1[d] = *(const LAS f16x8*)(sb + koff[4 * db + d] + 32 * L::CPRK * 16); }
                __builtin_amdgcn_sched_barrier(0);
#pragma unroll
                for (int d = 0; d < 4; ++d) {
                    p0 = __builtin_amdgcn_mfma_f32_32x32x16_f16(kf0[d], qf[4 * db + d], p0, 0, 0, 0);
                    p1 = __builtin_amdgcn_mfma_f32_32x32x16_f16(kf1[d], qf[4 * db + d], p1, 0, 0, 0); }
                __builtin_amdgcn_sched_barrier(0);
            }
            f16x8 vfa[NB_], vfb[NB_];
            FA_VREADD(vfa, 0);
            __builtin_amdgcn_sched_barrier(0);
            if (qpos0 - (k0 + 63) < 128) {
                const int j0 = 224 - (qpos0 + r32 - k0 - 4 * hi), sf = j0 & 1; const LAS float* rp = tab + sf * TAB2 + (j0 - sf);
#pragma unroll
                for (int g = 0; g < 4; ++g) { const f32x2 x0 = *(const LAS f32x2*)(rp + 8 * g), x1 = *(const LAS f32x2*)(rp + 8 * g + 2), y0 = *(const LAS f32x2*)(rp + 32 + 8 * g), y1 = *(const LAS f32x2*)(rp + 34 + 8 * g);
                    p0[4 * g] += x0.x; p0[4 * g + 1] += x0.y; p0[4 * g + 2] += x1.x; p0[4 * g + 3] += x1.y; p1[4 * g] += y0.x; p1[4 * g + 1] += y0.y; p1[4 * g + 2] += y1.x; p1[4 * g + 3] += y1.y; }
            }
            float rm = rowmax32(p0, p1);
            rm = half_max(rm);
            if (__any(rm > m + 8.f)) { const float mn = fmaxf(m, rm), mu2 = (mn == -INFINITY) ? 0.f : mn; const float al = __builtin_amdgcn_exp2f(m - mu2); l *= al; m = mn;
#pragma unroll
                for (int blk = 0; blk < NB_; ++blk)
#pragma unroll
                    for (int r = 0; r < 16; ++r) o[blk][r] *= al; }
            const float mu = (m == -INFINITY) ? 0.f : m;
            float ls = 0.f;
#pragma unroll
            for (int r = 0; r < 16; ++r) { p0[r] = __builtin_amdgcn_exp2f(p0[r] - mu); p1[r] = __builtin_amdgcn_exp2f(p1[r] - mu); ls += p0[r] + p1[r]; }
            l += ls;
            f16x8 pf[4]; pf[0] = pack8(p0, 0); pf[1] = pack8(p0, 8); pf[2] = pack8(p1, 0); pf[3] = pack8(p1, 8);
            __builtin_amdgcn_sched_barrier(0);
            FA_VREADD(vfb, 1); FA_PVD(vfa, 0); __builtin_amdgcn_sched_barrier(0);
            FA_VREADD(vfa, 2); FA_PVD(vfb, 1); __builtin_amdgcn_sched_barrier(0);
            FA_VREADD(vfb, 3); FA_PVD(vfa, 2); __builtin_amdgcn_sched_barrier(0);
            FA_PVD(vfb, 3);
        }
        st = (st + 1 == S) ? 0 : st + 1; sti = (sti + 1 == S) ? 0 : sti + 1;
    }
    asm volatile("s_waitcnt lgkmcnt(0)" ::: "memory");
    __builtin_amdgcn_s_barrier();
    asm volatile("" ::: "memory");
#undef FA_ISSUE
#undef FA_VREADD
#undef FA_PVD
    l = half_sum(l);
    const float inv = 1.f / l;
#pragma unroll
    for (int blk = 0; blk < NB_; ++blk)
#pragma unroll
        for (int r = 0; r < 16; ++r) o[blk][r] *= inv;
}
template <int DQK, int DV, int MODE, int S>
__device__ __forceinline__ void attn_pass_pipe(LAS unsigned char* lds, const int wave, const int lane,
        const f16* Qw, const int qpitch, const f16* Kg, const int kpitch, const f16* Vg, const int vpitch,
        const int ntiles, const int qpos0, const LAS float* tab, const unsigned selb, const int jblk, const unsigned* maskw,
        f32x16 (&o)[DV / 32]) {
    typedef LayD<DQK, DV, MODE, S> L;
    constexpr int NB_ = DV / 32;
    const int r32 = lane & 31, hi = lane >> 5;
    f16x8 qf[DQK / 16];
#pragma unroll
    for (int d0 = 0; d0 < DQK / 16; ++d0) qf[d0] = __builtin_bit_cast(f16x8, *(const GAS u32x4*)(Qw + (size_t)r32 * qpitch + d0 * 16 + hi * 8));
#pragma unroll
    for (int blk = 0; blk < NB_; ++blk)
#pragma unroll
        for (int r = 0; r < 16; ++r) o[blk][r] = 0.f;
    float m = -INFINITY, l = 0.f;
    unsigned goff[L::NP];
#pragma unroll
    for (int c = 0; c < L::NP; ++c) { const int pc = wave + 8 * c;
        if (pc < L::PK) { const int s2 = 64 * pc + lane, row = s2 / L::CPRK, ch = (s2 % L::CPRK) ^ L::fk(row); goff[c] = (unsigned)(row * kpitch + ch * 8); }
        else { const int s2 = 64 * (pc - L::PK) + lane, row = s2 / L::CPRV, ch = (s2 % L::CPRV) ^ L::fv(row); goff[c] = (unsigned)(row * vpitch + ch * 8); } }
#define FP_ISSUE(kt_, st_) do { \
        if (MODE == 2) __builtin_amdgcn_global_load_lds((const GAS unsigned*)(maskw + (kt_) * 64 + lane), (LAS unsigned*)(lds + L::MASKOFF + (wave * S + (st_)) * 256), 4, 0, 0); \
        _Pragma("unroll") for (int c = 0; c < L::NP; ++c) { const int pc = wave + 8 * c; \
            if (pc < L::PK) __builtin_amdgcn_global_load_lds((const GAS unsigned*)(Kg + (size_t)(kt_) * 64 * kpitch + goff[c]), (LAS unsigned*)(lds + (st_) * L::STG + pc * 1024), 16, 0, 0); \
            else __builtin_amdgcn_global_load_lds((const GAS unsigned*)(Vg + (size_t)(kt_) * 64 * vpitch + goff[c]), (LAS unsigned*)(lds + (st_) * L::STG + L::KB + (pc - L::PK) * 1024), 16, 0, 0); } } while (0)
    int koff[DQK / 16];
#pragma unroll
    for (int d0 = 0; d0 < DQK / 16; ++d0) koff[d0] = (r32 * L::CPRK + ((2 * d0 + hi) ^ L::fk(r32))) * 16;
    int voff[2][NB_];
    { const int q = (lane & 15) >> 2, g1 = (lane >> 4) & 1, p = lane & 3;
#pragma unroll
      for (int sec = 0; sec < 2; ++sec)
#pragma unroll
        for (int blk = 0; blk < NB_; ++blk) { const int row = 4 * hi + q + 8 * sec; voff[sec][blk] = L::KB * (MODE == 2 ? 0 : 1) + (row * L::CPRV + ((4 * blk + 2 * g1 + (p >> 1)) ^ L::fv(row))) * 16 + 8 * (p & 1); } }
    const int nact = ((qpos0 + 31) >> 6) + 1 < ntiles ? ((qpos0 + 31) >> 6) + 1 : ntiles;
#define FP_QK(a0_, a1_, kt_, st_, ref_) do { \
        const LAS unsigned char* sb_ = lds + (st_) * L::STG; const float nr_ = -(ref_); \
        if (MODE == 2) { const unsigned w_ = *(const LAS unsigned*)(lds + L::MASKOFF + (wave * S + (st_)) * 256 + lane * 4); const unsigned nrb_ = __float_as_uint(nr_); \
            _Pragma("unroll") for (int r = 0; r < 16; ++r) { const unsigned s0_ = (unsigned)__builtin_amdgcn_sbfe((int)w_, r, 1), s1_ = (unsigned)__builtin_amdgcn_sbfe((int)w_, 16 + r, 1); \
                a0_[r] = __uint_as_float((s0_ & nrb_) | (~s0_ & 0xff800000u)); a1_[r] = __uint_as_float((s1_ & nrb_) | (~s1_ & 0xff800000u)); } } \
        else if (MODE == 1) { const int n_ = (kt_) >> 2; const float cv_ = (n_ == jblk || ((selb >> n_) & 1u)) ? nr_ : -INFINITY; \
            _Pragma("unroll") for (int r = 0; r < 16; ++r) { a0_[r] = cv_; a1_[r] = cv_; } } \
        else { _Pragma("unroll") for (int r = 0; r < 16; ++r) { a0_[r] = nr_; a1_[r] = nr_; } } \
        _Pragma("unroll") for (int db = 0; db < DQK / 32; ++db) { f16x8 kf0_[2], kf1_[2]; \
            _Pragma("unroll") for (int d = 0; d < 2; ++d) { kf0_[d] = *(const LAS f16x8*)(sb_ + koff[2 * db + d]); kf1_[d] = *(const LAS f16x8*)(sb_ + koff[2 * db + d] + 32 * L::CPRK * 16); } \
            _Pragma("unroll") for (int d = 0; d < 2; ++d) { \
                a0_ = __builtin_amdgcn_mfma_f32_32x32x16_f16(kf0_[d], qf[2 * db + d], a0_, 0, 0, 0); \
                a1_ = __builtin_amdgcn_mfma_f32_32x32x16_f16(kf1_[d], qf[2 * db + d], a1_, 0, 0, 0); } } } while (0)
#define FP_PREP(a0_, a1_, kt_) do { const int k0_ = (kt_) * 64; \
        if (qpos0 - (k0_ + 63) < 128) { const int j0_ = 224 - (qpos0 + r32 - k0_ - 4 * hi), sf_ = j0_ & 1; const LAS float* rp_ = tab + sf_ * TAB2 + (j0_ - sf_); \
            _Pragma("unroll") for (int g = 0; g < 4; ++g) { const f32x2 x0_ = *(const LAS f32x2*)(rp_ + 8 * g), x1_ = *(const LAS f32x2*)(rp_ + 8 * g + 2), y0_ = *(const LAS f32x2*)(rp_ + 32 + 8 * g), y1_ = *(const LAS f32x2*)(rp_ + 34 + 8 * g); \
                a0_[4 * g] += x0_.x; a0_[4 * g + 1] += x0_.y; a0_[4 * g + 2] += x1_.x; a0_[4 * g + 3] += x1_.y; a1_[4 * g] += y0_.x; a1_[4 * g + 1] += y0_.y; a1_[4 * g + 2] += y1_.x; a1_[4 * g + 3] += y1_.y; } } \
        rmrel = half_max(rowmax32(a0_, a1_)); } while (0)
#define FP_VREAD(dst_, ks_, st_) do { const LAS unsigned char* sv_ = lds + (st_) * L::STG; _Pragma("unroll") for (int blk = 0; blk < NB_; ++blk) { \
        const v4i16_t a_ = __builtin_amdgcn_ds_read_tr16_b64_v4i16((LAS v4i16_t*)(sv_ + voff[0][blk] + 16 * (ks_) * L::CPRV * 16)); \
        const v4i16_t b_ = __builtin_amdgcn_ds_read_tr16_b64_v4i16((LAS v4i16_t*)(sv_ + voff[1][blk] + 16 * (ks_) * L::CPRV * 16)); \
        const f16x4 a4_ = __builtin_bit_cast(f16x4, a_), b4_ = __builtin_bit_cast(f16x4, b_); \
        dst_[blk] = (f16x8){a4_[0], a4_[1], a4_[2], a4_[3], b4_[0], b4_[1], b4_[2], b4_[3]}; } } while (0)
#define FP_PV(src_, ks_) do { _Pragma("unroll") for (int blk = 0; blk < NB_; ++blk) o[blk] = __builtin_amdgcn_mfma_f32_32x32x16_f16(src_[blk], pf[ks_], o[blk], 0, 0, 0); } while (0)
#define FP_STEP(c0_, c1_, n0_, n1_, kt_) do { \
        if (S > 3 && (kt_) + S - 2 < ntiles) FA_WAITV(L::NPW * (S - 3)); else FA_WAITV(0); \
        __builtin_amdgcn_s_barrier(); asm volatile("" ::: "memory"); \
        if ((kt_) + S - 1 < ntiles) FP_ISSUE((kt_) + S - 1, sti); \
        if ((kt_) < nact) { \
            const float mu_ = (m == -INFINITY) ? 0.f : m; const bool more_ = (kt_) + 1 < nact; float rmrel = -INFINITY; \
            if (more_) FP_QK(n0_, n1_, (kt_) + 1, st1, mu_); \
            if (__any(dl != 0.f)) { _Pragma("unroll") for (int r = 0; r < 16; ++r) { c0_[r] -= dl; c1_[r] -= dl; } } \
            float ls_ = 0.f; \
            _Pragma("unroll") for (int r = 0; r < 16; ++r) { c0_[r] = __builtin_amdgcn_exp2f(c0_[r]); c1_[r] = __builtin_amdgcn_exp2f(c1_[r]); ls_ += c0_[r] + c1_[r]; } \
            l += ls_; \
            f16x8 pf[4]; pf[0] = pack8(c0_, 0); pf[1] = pack8(c0_, 8); pf[2] = pack8(c1_, 0); pf[3] = pack8(c1_, 8); \
            if (NB_ <= 2) { f16x8 vfa[NB_], vfb[NB_]; \
                FP_VREAD(vfa, 0, st); FP_VREAD(vfb, 1, st); \
                if (more_) FP_PREP(n0_, n1_, (kt_) + 1); \
                FP_PV(vfa, 0); FP_VREAD(vfa, 2, st); FP_PV(vfb, 1); FP_VREAD(vfb, 3, st); FP_PV(vfa, 2); FP_PV(vfb, 3); \
            } else { f16x8 vfa[NB_]; \
                FP_VREAD(vfa, 0, st); \
                if (more_) FP_PREP(n0_, n1_, (kt_) + 1); \
                FP_PV(vfa, 0); __builtin_amdgcn_sched_barrier(0); FP_VREAD(vfa, 1, st); FP_PV(vfa, 1); __builtin_amdgcn_sched_barrier(0); \
                FP_VREAD(vfa, 2, st); FP_PV(vfa, 2); __builtin_amdgcn_sched_barrier(0); FP_VREAD(vfa, 3, st); FP_PV(vfa, 3); } \
            dl = 0.f; \
              \
            if (more_ && __any(rmrel > 8.f || (m == -INFINITY && rmrel > -INFINITY))) { \
                const float mnew_ = fmaxf(m, rmrel + mu_), mun_ = (mnew_ == -INFINITY) ? 0.f : mnew_; dl = mun_ - mu_; m = mnew_; \
                const float al_ = __builtin_amdgcn_exp2f(-dl); l *= al_; \
                _Pragma("unroll") for (int blk = 0; blk < NB_; ++blk) _Pragma("unroll") for (int r = 0; r < 16; ++r) o[blk][r] *= al_; } \
        } \
        st = st1; st1 = (st1 + 1 == S) ? 0 : st1 + 1; sti = (sti + 1 == S) ? 0 : sti + 1; } while (0)
#pragma unroll
    for (int t0 = 0; t0 < S - 1; ++t0) if (t0 < ntiles) FP_ISSUE(t0, t0);
    f32x16 sa0, sa1, sb0, sb1; float dl;
    if (ntiles >= S - 1) FA_WAITV(L::NPW * (S - 2)); else FA_WAITV(0);
    __builtin_amdgcn_s_barrier(); asm volatile("" ::: "memory");
    { float rmrel; FP_QK(sa0, sa1, 0, 0, 0.f); FP_PREP(sa0, sa1, 0); m = rmrel; dl = (m == -INFINITY) ? 0.f : m; }
    int st = 0, st1 = 1, sti = S - 1;
#pragma unroll 1
    for (int kt = 0; kt < ntiles; kt += 2) {
        FP_STEP(sa0, sa1, sb0, sb1, kt);
        if (kt + 1 < ntiles) FP_STEP(sb0, sb1, sa0, sa1, kt + 1);
    }
    asm volatile("s_waitcnt lgkmcnt(0)" ::: "memory");
    __builtin_amdgcn_s_barrier(); asm volatile("" ::: "memory");
#undef FP_ISSUE
#undef FP_QK
#undef FP_PREP
#undef FP_VREAD
#undef FP_PV
#undef FP_STEP
    l = half_sum(l);
    const float inv = 1.f / l;
#pragma unroll
    for (int blk = 0; blk < NB_; ++blk)
#pragma unroll
        for (int r = 0; r < 16; ++r) o[blk][r] *= inv;
}
template <int DV> __device__ __forceinline__ void store_o(const f32x16 (&o)[DV / 32], f16* dst, int hi) {
#pragma unroll
    for (int blk = 0; blk < DV / 32; ++blk)
#pragma unroll
        for (int g = 0; g < 4; ++g) { u32x2 w; w.x = pk2h(o[blk][4 * g], o[blk][4 * g + 1]); w.y = pk2h(o[blk][4 * g + 2], o[blk][4 * g + 3]);
            *(u32x2*)(dst + 32 * blk + 8 * g + 4 * hi) = w; }
}
}

struct Args { const float* in[20]; float* out; unsigned char* ws; };

__global__ void __launch_bounds__(NWAVES * 64, 2) mega_fwd(Args args) {
    extern __shared__ __attribute__((aligned(16))) unsigned char lds_raw[];
    Frame F;
    F.lds = (LAS unsigned char*)0;
    (void)lds_raw;
    F.wave = __builtin_amdgcn_readfirstlane(threadIdx.x >> 6);
    F.G = gridDim.x; F.gw = blockIdx.x * NWAVES + F.wave; F.NGW = F.G * NWAVES;
    volatile LAS unsigned* MISC = (volatile LAS unsigned*)(F.lds + MISC_OFF);
    for (int u = threadIdx.x; u < (LDS_BYTES - LDSCTL_OFF) / 4; u += NWAVES * 64) ((LAS unsigned*)(F.lds + LDSCTL_OFF))[u] = 0u;
    __syncthreads();
    unsigned* ctl = (unsigned*)(args.ws + WS_CTL);
    XcdBarrier bar = xcd_barrier_post(ctl + CW_BAR, MISC + 8, F.wave);

    if (threadIdx.x < 20) ((volatile LAS unsigned long long*)(F.lds + PTAB_OFF))[threadIdx.x] = (unsigned long long)args.in[threadIdx.x];
    __syncthreads();
#define IN(i) inptr(F.lds, (i))
#define LANE lane_id()
#define LL launder_i(l)
#define GW launder_i(F.gw)
#define TID (F.wave * 64 + lane_id())
#define WSP(T, off) ((T*)(launder(args.ws) + (off)))
    enum { I_X = 0, I_C, I_RELB, I_ADAW, I_ADAB, I_NMIX, I_WIN, I_GATEB, I_DLAM, I_SUBLN, I_KVNORM, I_WUV, I_WBRA, I_WBRB, I_WBRC, I_WO, I_NMLP, I_WFF1, I_WFF2, I_NFINAL };
    float* xout = args.out;
    for (int rp0 = 0; rp0 < launder_i(REP_P0); ++rp0) {
        LAS float* scr = (LAS float*)(F.lds + F.wave * 16384);
        for (int it = F.gw; it < 2 * 8192; it += F.NGW) {
            const int l = it >> 13; int r = it & 8191;
            if (r < 1664) { transpose_item(IN(I_WIN) + (size_t)l * DM * IN_COLS, IN_COLS, 0, PCOLS, DM, WSP(f16, WS_WIN) + (size_t)l * PP * DM, PP / 32, scr, r, LANE, ScaleIn()); continue; } r -= 1664;
            if (r < 1536) { transpose_item(IN(I_WIN) + (size_t)l * DM * IN_COLS, IN_COLS, C_G, GCOLS, DM, WSP(f16, WS_WG) + (size_t)l * GCOLS * DM, GCOLS / 32, scr, r, LANE, ScaleOne()); continue; } r -= 1536;
            if (r < 256) { transpose_item(IN(I_WBRA) + (size_t)l * 512 * DM, DM, 0, DM, 512, WSP(f16, WS_WA) + (size_t)l * DM * 512, DM / 32, scr, r, LANE, ScaleOne()); continue; } r -= 256;
            if (r < 128) { transpose_item(IN(I_WBRC) + (size_t)l * 256 * DM, DM, 0, DM, 256, WSP(f16, WS_WC) + (size_t)l * DM * 256, DM / 32, scr, r, LANE, ScaleOne()); continue; } r -= 128;
            if (r < 512) { transpose_item(IN(I_WO) + (size_t)l * DM * DM, DM, 0, DM, DM, WSP(f16, WS_WO) + (size_t)l * DM * DM, DM / 32, scr, r, LANE, ScaleOne()); continue; } r -= 512;
            if (r < 2048) { transpose_item(IN(I_WFF1) + (size_t)l * DM * DFF, DFF, 0, DFF, DM, WSP(f16, WS_W1) + (size_t)l * DFF * DM, DFF / 32, scr, r, LANE, ScaleOne()); continue; } r -= 2048;
            transpose_item(IN(I_WFF2) + (size_t)l * DFF * DM, DM, 0, DM, DFF, WSP(f16, WS_W2) + (size_t)l * DM * DFF, DM / 32, scr, r, LANE, ScaleOne());
        }
        for (int it = F.gw; it < 2048; it += F.NGW) {
            const int l = it >> 10, kb = (it >> 4) & 63, nb = it & 15; const int kk0 = kb * 8, h = kk0 >> 7, r0 = kk0 & 127, n = nb * 64 + LANE;
            const float* uv = IN(I_WUV) + ((size_t)(l * 4 + h) * 128 + r0) * 64; const float* wb = IN(I_WBRB) + ((size_t)l * 256 + h * 64) * DM + n;
            float a[8];
#pragma unroll
            for (int j = 0; j < 8; ++j) a[j] = 0.f;
            for (int e = 0; e < 64; ++e) { const float b = wb[(size_t)e * DM];
#pragma unroll
                for (int j = 0; j < 8; ++j) a[j] += uv[j * 64 + e] * b; }
            u32x4 o; o.x = pk2h(a[0], a[1]); o.y = pk2h(a[2], a[3]); o.z = pk2h(a[4], a[5]); o.w = pk2h(a[6], a[7]);
            *(u32x4*)(WSP(f16, WS_WBC) + ((size_t)l * DM + n) * 512 + kk0) = o;
        }
        __syncthreads();
        if (blockIdx.x < 192) {
            const int l = blockIdx.x / 96, j0 = (blockIdx.x % 96) * 64;
            LAS float* cond = (LAS float*)F.lds;
            LAS float* part = (LAS float*)(F.lds + 65536);
            const float* c_in = IN(I_C);
            for (int i = TID; i < NB * DM; i += 512) { const float v = c_in[i]; cond[i] = v / (1.f + __expf(-v)); }
            __syncthreads();
            float a[16];
#pragma unroll
            for (int b = 0; b < 16; ++b) a[b] = 0.f;
            const float* wp = IN(I_ADAW) + (size_t)l * DM * 6144 + j0 + LANE;
            for (int k = F.wave * 128; k < F.wave * 128 + 128; ++k) { const float w = wp[(size_t)k * 6144];
#pragma unroll
                for (int b = 0; b < 16; ++b) a[b] += cond[b * 1024 + k] * w; }
#pragma unroll
            for (int b = 0; b < 16; ++b) part[(F.wave * 16 + b) * 64 + LANE] = a[b];
            __syncthreads();
            const float* ada_b = IN(I_ADAB); float* mod = WSP(float, WS_MOD);
            for (int i = TID; i < 1024; i += 512) { const int b = i >> 6, j = i & 63; float s = ada_b[l * 6144 + j0 + j];
#pragma unroll
                for (int w = 0; w < 8; ++w) s += part[(w * 16 + b) * 64 + j];
                mod[((size_t)l * 16 + b) * 6144 + j0 + j] = s; }
            __syncthreads();
        } else if (blockIdx.x == 192) {
            const float* rel_bias = IN(I_RELB); float* tabs = WSP(float, WS_MISC + 1024); float* lamv = WSP(float, WS_MISC);
            for (int i = TID; i < 12 * TABN; i += 512) { const int hh = i / TABN, idx = i % TABN, dist = idx - 255;
                float v; if (dist < 0) v = -INFINITY; else if (dist >= 128) v = 0.f; else v = (rel_bias[t5_bucket(dist) * 12 + hh] - rel_bias[31 * 12 + hh]) * LOG2E;
                tabs[i] = v; }
            float* tabs2 = WSP(float, WS_MISC + 32768);
            for (int i = TID; i < 12 * TAB2H; i += 512) { const int hh = i / TAB2H, sft = (i % TAB2H) / TAB2, j = (i % TAB2) + sft, dist = 224 - j;
                float v; if (dist < 0) v = -INFINITY; else if (dist >= 128) v = 0.f; else v = (rel_bias[t5_bucket(dist) * 12 + hh] - rel_bias[31 * 12 + hh]) * LOG2E;
                tabs2[i] = v; }
            if (F.wave < 2) { const int l = F.wave; const float* dl = IN(I_DLAM) + l * 256;
                const float s1 = wave_sum(dl[LANE] * dl[64 + LANE]), s2 = wave_sum(dl[128 + LANE] * dl[192 + LANE]);
                const float lam_init = 0.8f - 0.6f * expf(-0.3f * (float)l);
                if (LANE == 0) lamv[l] = expf(s1) - expf(s2) + lam_init; }
        }
    }
    xcd_barrier(bar, F.wave);
    { const int grp = blockIdx.x % 6, bi = blockIdx.x / 6, nbl = (F.G - grp + 5) / 6, l = grp / 3, which = grp % 3; const int lane = LANE;
      const float* modl = WSP(float, WS_MOD) + (size_t)l * 16 * 6144 + (which == 2 ? 3 : 0) * DM;
      LAS float* sh = (LAS float*)F.lds;
      for (int i2 = F.wave * 64 + lane; i2 < 16 * 1024; i2 += 512) sh[i2] = modl[(size_t)(i2 >> 10) * 6144 + (i2 & 1023)];
      __syncthreads();
      const f16* Bt = which == 0 ? WSP(f16, WS_WIN) + (size_t)l * PP * DM : (which == 1 ? WSP(f16, WS_WG) + (size_t)l * GCOLS * DM : WSP(f16, WS_W1) + (size_t)l * DFF * DM);
      const int nrows = which == 0 ? PP : (which == 1 ? GCOLS : DFF);
      float* cv = WSP(float, WS_CVEC) + (size_t)grp * 16 * 4096;
      for (int n = bi * 8 + F.wave; n < nrows; n += nbl * 8) {
          float w[16];
#pragma unroll
          for (int j = 0; j < 4; ++j) { const f16x4 v = *(const f16x4*)(Bt + (size_t)n * DM + 256 * j + lane * 4); w[4 * j] = (float)v[0]; w[4 * j + 1] = (float)v[1]; w[4 * j + 2] = (float)v[2]; w[4 * j + 3] = (float)v[3]; }
          float a[16];
#pragma unroll
          for (int b = 0; b < 16; ++b) { a[b] = 0.f;
#pragma unroll
              for (int j = 0; j < 4; ++j) { const f32x4 sv = *(const LAS f32x4*)(sh + b * 1024 + 256 * j + lane * 4); a[b] += (w[4 * j] * sv.x + w[4 * j + 1] * sv.y) + (w[4 * j + 2] * sv.z + w[4 * j + 3] * sv.w); } }
#pragma unroll
          for (int st = 0; st < 4; ++st) { const int msk = 32 >> st, nh = 8 >> st; const bool up = (lane & msk) != 0;
#pragma unroll
              for (int i3 = 0; i3 < nh; ++i3) { const float send = up ? a[i3] : a[i3 + nh], keep = up ? a[i3 + nh] : a[i3]; a[i3] = keep + __shfl_xor(send, msk); } }
          a[0] += __shfl_xor(a[0], 1); a[0] += __shfl_xor(a[0], 2);
          if ((lane & 3) == 0) cv[(size_t)(((lane >> 5) & 1) * 8 + ((lane >> 4) & 1) * 4 + ((lane >> 3) & 1) * 2 + ((lane >> 2) & 1)) * 4096 + n] = a[0];
      }
      __syncthreads();
    }

#pragma unroll 1
    for (int l = 0; l < DEPTH; ++l) {
        if (LL == 0) for (int rep = 0; rep < REP_N1; ++rep) {
        { const float* xcur = (LL == 0) ? IN(I_X) : xout; const float* modl = WSP(float, WS_MOD) + (size_t)LL * 16 * 6144; const float* nw = IN(I_NMIX) + LL * DM; f16* U = WSP(f16, WS_U);
          for (int m = GW; m < MTOK; m += F.NGW) { const int b = m / SEQ;
            norm_row_pre(xcur + (size_t)m * DM, nw, modl + (size_t)b * 6144 + 1 * DM, U + (size_t)m * DM, WSP(float, WS_SS) + (size_t)m * 16, LANE); } }
        xcd_barrier(bar, F.wave);
        }
        for (int rep = 0; rep < REP_G1; ++rep) {
#ifndef NO_G1
        { pg8::Gemm g{WSP(f16, WS_U), WSP(f16, WS_WIN) + (size_t)LL * PP * DM, MTOK, PP, DM}; pg8::StaticOrder S; S.init(MTOK, PP, F.G, (int)blockIdx.x);
          pg8::EpiNormF16<0> E{WSP(f16, WS_R1), PP, WSP(float, WS_CVEC) + (size_t)(LL * 3 + 0) * 16 * 4096};
          pg8::fill_rstd(WSP(float, WS_SS), S, TID);
          pg8::gemm_phase<pg8::EpiNormF16<0>, pg8::StaticOrder, true, true>(F.lds, g, S, E, F.wave); }
#endif
        xcd_barrier(bar, F.wave);
        }
        for (int rep = 0; rep < launder_i(REP_SEL); ++rep) {
        { const f16* P = WSP(f16, WS_R1); f16* KVN = WSP(f16, WS_KVN); const float* kvw = IN(I_KVNORM) + LL * 128; float* kmean = WSP(float, WS_MISC + 65536);
          { const int lane = LANE, sub = lane >> 4, cl = lane & 15;
            float kw[8];
#pragma unroll
            for (int e = 0; e < 8; ++e) kw[e] = kvw[cl * 8 + e];
            for (int m0 = GW * 4; m0 < MTOK; m0 += 16 * F.NGW) {
                f16x8 v[4]; float ss[4];
#pragma unroll
                for (int j = 0; j < 4; ++j) v[j] = __builtin_bit_cast(f16x8, *(const GAS u32x4*)(P + (size_t)(m0 + j * 4 * F.NGW + sub) * PP + C_BKV + cl * 8));
#pragma unroll
                for (int j = 0; j < 4; ++j) { ss[j] = 0.f;
#pragma unroll
                    for (int e = 0; e < 8; ++e) ss[j] += (float)v[j][e] * (float)v[j][e]; }
#pragma unroll
                for (int o = 1; o < 16; o <<= 1)
#pragma unroll
                    for (int j = 0; j < 4; ++j) ss[j] += __shfl_xor(ss[j], o);
#pragma unroll
                for (int j = 0; j < 4; ++j) { const float r = __builtin_amdgcn_rsqf(ss[j] * (1.f / 128.f) + EPS);
                    u32x4 w; w.x = pk2h((float)v[j][0] * r * kw[0], (float)v[j][1] * r * kw[1]); w.y = pk2h((float)v[j][2] * r * kw[2], (float)v[j][3] * r * kw[3]);
                    w.z = pk2h((float)v[j][4] * r * kw[4], (float)v[j][5] * r * kw[5]); w.w = pk2h((float)v[j][6] * r * kw[6], (float)v[j][7] * r * kw[7]);
                    *(GAS u32x4*)(KVN + (size_t)(m0 + j * 4 * F.NGW + sub) * 128 + cl * 8) = w; }
            } }
          for (int it = GW; it < NB * 4 * 8; it += F.NGW) { const int b = it >> 5, h = (it >> 3) & 3, blk = it & 7; const int lane = LANE, rg = lane >> 3, ch = lane & 7;
            const f16* src = P + ((size_t)b * SEQ + blk * 256 + rg) * PP + C_CK + h * 64 + ch * 8; float a8[8];
#pragma unroll
            for (int e = 0; e < 8; ++e) a8[e] = 0.f;
#pragma unroll 8
            for (int r = 0; r < 32; ++r) { const f16x8 v = __builtin_bit_cast(f16x8, *(const GAS u32x4*)(src + (size_t)(8 * r) * PP));
#pragma unroll
                for (int e = 0; e < 8; ++e) a8[e] += (float)v[e]; }
#pragma unroll
            for (int e = 0; e < 8; ++e) { a8[e] += __shfl_xor(a8[e], 8); a8[e] += __shfl_xor(a8[e], 16); a8[e] += __shfl_xor(a8[e], 32); }
            if (rg == 0) { f32x4 o0 = {a8[0], a8[1], a8[2], a8[3]}, o1 = {a8[4], a8[5], a8[6], a8[7]};
                *(f32x4*)(kmean + (size_t)it * 64 + ch * 8) = o0 * (1.f / 256.f); *(f32x4*)(kmean + (size_t)it * 64 + ch * 8 + 4) = o1 * (1.f / 256.f); } } }
#ifndef NAIVE_DSA
#ifdef NAIVE_SELECT
        { const f16* P = WSP(f16, WS_R1); unsigned* MASK = WSP(unsigned, WS_MASK); LAS unsigned* keyl = (LAS unsigned*)(F.lds + F.wave * 16384 + 8192);
          for (int task = GW; task < NB * SEQ; task += F.NGW) {
            const int b = task / SEQ, t = (task % SEQ + 37 * b) % SEQ; const size_t row = (size_t)b * SEQ + t; const int lane = LANE;
            const int nslots = (t >> 6) + 1;
            unsigned sel = 0xffffffffu;
            if (t >= 256) {
                const f16* iq = P + row * PP + C_BIQ; const f16* iwp = P + row * PP + C_BIW;
#pragma unroll 1
                for (int j = 0; j < nslots; ++j) { unsigned kk = 0u; const int k = 64 * j + lane;
                    if (k <= t) { const f16* ik = P + ((size_t)b * SEQ + k) * PP + C_BIK; f16x8 kv[4];
#pragma unroll
                        for (int c = 0; c < 4; ++c) kv[c] = *(const f16x8*)(ik + 8 * c);
                        float sc = 0.f;
#pragma unroll 1
                        for (int hh = 0; hh < 8; ++hh) { float d = 0.f;
#pragma unroll
                            for (int c = 0; c < 4; ++c) { const f16x8 qv = *(const f16x8*)(iq + hh * 32 + 8 * c);
#pragma unroll
                                for (int e = 0; e < 8; ++e) d += (float)qv[e] * (float)kv[c][e]; }
                            sc += fmaxf(d, 0.f) * (float)iwp[hh]; }
                        kk = ordkey(sc); }
                    keyl[k] = kk; }
                unsigned thr = 0u;
#pragma unroll 1
                for (int bit = 31; bit >= 0; --bit) { const unsigned cand = thr | (1u << bit); int c = 0;
#pragma unroll 1
                    for (int j = 0; j < nslots; ++j) c += (keyl[64 * j + lane] >= cand) ? 1 : 0;
                    if (wave_isum(c) >= 256) thr = cand; }
                int cgt = 0;
#pragma unroll 1
                for (int j = 0; j < nslots; ++j) cgt += (keyl[64 * j + lane] > thr) ? 1 : 0;
                cgt = wave_isum(cgt);
                const int need = 256 - cgt; int run = 0; sel = 0u;
#pragma unroll 1
                for (int j = 0; j < nslots; ++j) { const unsigned kk = keyl[64 * j + lane]; const bool tie = kk == thr; const unsigned long long bal = __ballot(tie);
                    const int pre = run + __popcll(bal & ((1ull << lane) - 1ull));
                    if (kk > thr || (tie && pre < need)) sel |= 1u << j;
                    run += __popcll(bal); }
            }
            const int bb = lane & 31, kkq = 32 * (bb >> 4) + (bb & 3) + 8 * ((bb & 15) >> 2) + 4 * (lane >> 5);
            unsigned* mrow = MASK + ((size_t)(b * 64 + (t >> 5)) * 32) * 64 + (t & 31);
#pragma unroll 1
            for (int j = 0; j < nslots; ++j) { const unsigned long long bal = __ballot((sel >> j) & 1u);
                const unsigned long long w64 = __ballot((bal >> kkq) & 1ull);
                if (lane == 0) { mrow[j * 64] = (unsigned)w64; mrow[j * 64 + 32] = (unsigned)(w64 >> 32); } }
          } }
#else
        { const f16* P = WSP(f16, WS_R1); unsigned* MASK = WSP(unsigned, WS_MASK);
          unsigned* qctr = (unsigned*)launder(args.ws) + CW_QUEUE + 64 * ((rep * 2 + LL) * 4 + 3);
          LAS unsigned* hist = (LAS unsigned*)F.lds;
          constexpr int HSTR = 257;
          for (;;) {
            __syncthreads();
            if (TID == 0) MISC[16] = __hip_atomic_fetch_add(qctr, 1u, __ATOMIC_RELAXED, __HIP_MEMORY_SCOPE_AGENT);
            __syncthreads();
            const int ui = __builtin_amdgcn_readfirstlane((int)MISC[16]);
            if (ui >= 1024) break;
            const int qg = 63 - (ui >> 4), b = ui & 15; const int lane = LANE, tid = F.wave * 64 + lane, r32 = lane & 31, hi = lane >> 5;
            const int ntiles = (qg >> 1) + 1, t = 32 * qg + r32; const size_t brow = (size_t)b * SEQ;
            unsigned* mbase = MASK + ((size_t)(b * 64 + qg) * 32) * 64 + lane;
            if (qg < 8) { for (int kt = F.wave; kt < ntiles; kt += 8) mbase[kt * 64] = 0xffffffffu; continue; }
            unsigned keys[4][32];
            {
              const f16* iqp = P + (brow + t) * PP + C_BIQ; const f16* iwp = P + (brow + t) * PP + C_BIW;
              LAS u32x4* iqL = (LAS u32x4*)(F.lds + 45056);
              const f16x8 iwv = *(const f16x8*)iwp;
              unsigned sgnbits = 0u;
#pragma unroll
              for (int h = 0; h < 8; ++h) sgnbits |= ((float)iwv[h] < 0.f) ? (1u << h) : 0u;
              { float wsel = 0.f;
#pragma unroll
                for (int h = 0; h < 8; ++h) wsel = (h == F.wave) ? (float)iwv[h] : wsel;
#pragma unroll
                for (int s2 = 0; s2 < 2; ++s2) { const f16x8 v = *(const f16x8*)(iqp + F.wave * 32 + 16 * s2 + 8 * hi);
                    u32x4 pw; pw.x = pk2h(wsel * (float)v[0], wsel * (float)v[1]); pw.y = pk2h(wsel * (float)v[2], wsel * (float)v[3]); pw.z = pk2h(wsel * (float)v[4], wsel * (float)v[5]); pw.w = pk2h(wsel * (float)v[6], wsel * (float)v[7]);
                    iqL[(F.wave * 2 + s2) * 64 + lane] = pw; } }
              if (F.wave == 0) {
#pragma unroll
                for (int s2 = 0; s2 < 2; ++s2) { float ca[8];
#pragma unroll
                    for (int e = 0; e < 8; ++e) ca[e] = 0.f;
#pragma unroll
                    for (int h = 0; h < 8; ++h) { const f16x8 v = *(const f16x8*)(iqp + h * 32 + 16 * s2 + 8 * hi); const float w = (float)iwv[h];
#pragma unroll
                        for (int e = 0; e < 8; ++e) ca[e] += w * (float)v[e]; }
                    u32x4 pw; pw.x = pk2h(ca[0], ca[1]); pw.y = pk2h(ca[2], ca[3]); pw.z = pk2h(ca[4], ca[5]); pw.w = pk2h(ca[6], ca[7]);
                    iqL[(16 + s2) * 64 + lane] = pw; } }
              __syncthreads();
#if REP_SCORE > 1
#pragma unroll 1
              for (int rs = 0; rs < launder_i(REP_SCORE); ++rs)
#endif
#pragma unroll
              for (int ti = 0; ti < 4; ++ti) { const int kt = F.wave + 8 * ti;
                if (kt < ntiles) { const int k0 = 64 * kt;
#pragma unroll
                    for (int half = 0; half < 2; ++half) { const f16* ikp = P + (brow + k0 + 32 * half + r32) * PP + C_BIK + 8 * hi;
                        const f16x8 kf0 = *(const f16x8*)ikp, kf1 = *(const f16x8*)(ikp + 16);
                        fa::f32x16 sc;
#pragma unroll
                        for (int r = 0; r < 16; ++r) sc[r] = 0.f;
                        sc = __builtin_amdgcn_mfma_f32_32x32x16_f16(kf0, __builtin_bit_cast(f16x8, iqL[16 * 64 + lane]), sc, 0, 0, 0);
                        sc = __builtin_amdgcn_mfma_f32_32x32x16_f16(kf1, __builtin_bit_cast(f16x8, iqL[17 * 64 + lane]), sc, 0, 0, 0);
#pragma unroll 2
                        for (int h = 0; h < 8; ++h) { fa::f32x16 a;
#pragma unroll
                            for (int r = 0; r < 16; ++r) a[r] = 0.f;
                            a = __builtin_amdgcn_mfma_f32_32x32x16_f16(kf0, __builtin_bit_cast(f16x8, iqL[(2 * h) * 64 + lane]), a, 0, 0, 0);
                            a = __builtin_amdgcn_mfma_f32_32x32x16_f16(kf1, __builtin_bit_cast(f16x8, iqL[(2 * h + 1) * 64 + lane]), a, 0, 0, 0);
                            const float sg = ((sgnbits >> h) & 1u) ? -1.f : 1.f;
#pragma unroll
                            for (int r = 0; r < 16; ++r) sc[r] = __builtin_fmaf(__builtin_fabsf(a[r]), sg, sc[r]); }
#pragma unroll
                        for (int r = 0; r < 16; ++r) keys[ti][16 * half + r] = ordkey(sc[r]);
                        if (k0 + 63 > 32 * qg) {
#pragma unroll
                            for (int r = 0; r < 16; ++r) { const int kidx = k0 + 32 * half + fa::crow(r, hi); keys[ti][16 * half + r] = (kidx <= t) ? keys[ti][16 * half + r] : 0u; } } }
                } else {
#pragma unroll
                    for (int e = 0; e < 32; ++e) keys[ti][e] = 0u; } } }
            unsigned prefix = 0u;
#if REP_RADIX > 1
#pragma unroll 1
            for (int rr = 0; rr < launder_i(REP_RADIX); ++rr)
#endif
#pragma unroll 1
            for (int pass = 0; pass < 4; ++pass) { const int shift = 24 - 8 * pass;
                LAS unsigned* qst = (LAS unsigned*)(F.lds + 40960 + (pass & 1) * 512); LAS unsigned* qstn = (LAS unsigned*)(F.lds + 40960 + ((pass & 1) ^ 1) * 512);
                for (int i2 = tid; i2 < 32 * HSTR; i2 += 512) hist[i2] = 0u;
                __syncthreads();
                if (pass > 0) prefix = qst[2 * r32];
                const int pshift = (pass == 0) ? 31 : shift + 8; const unsigned pmask = (pass == 0) ? 0u : 0xffffffffu;
#pragma unroll
                for (int ti = 0; ti < 4; ++ti)
#pragma unroll
                    for (int e = 0; e < 32; ++e) { const unsigned k = keys[ti][e];
                        const unsigned x = ((k >> pshift) ^ prefix) & pmask; const unsigned inc = 1u - __builtin_elementwise_min(x, 1u);
                        if (F.wave + 8 * ti < ntiles) __hip_atomic_fetch_add(hist + r32 * HSTR + ((k >> shift) & 255u), inc, __ATOMIC_RELAXED, __HIP_MEMORY_SCOPE_WORKGROUP);
                        if ((e & 7) == 7) __builtin_amdgcn_sched_barrier(0); }
                __syncthreads();
#pragma unroll
                for (int qq = 0; qq < 4; ++qq) { const int q = F.wave * 4 + qq; const int need = (pass == 0) ? 256 : (int)qst[2 * q + 1]; const unsigned pfx = (pass == 0) ? 0u : qst[2 * q];
                    const int c0 = (int)hist[q * HSTR + 4 * lane], c1 = (int)hist[q * HSTR + 4 * lane + 1], c2 = (int)hist[q * HSTR + 4 * lane + 2], c3 = (int)hist[q * HSTR + 4 * lane + 3];
                    const int c = c0 + c1 + c2 + c3; int S = c;
#pragma unroll
                    for (int off = 1; off < 64; off <<= 1) { const int v = __shfl_down(S, off); if (lane + off < 64) S += v; }
                    const unsigned long long bal = __ballot(S >= need); const int L = __popcll(bal) - 1;
                    if (lane == L) { int cum = S - c, d;
                        if (cum + c3 >= need) d = 3; else { cum += c3; if (cum + c2 >= need) d = 2; else { cum += c2; if (cum + c1 >= need) d = 1; else { cum += c1; d = 0; } } }
                        qstn[2 * q] = (pfx << 8) | (unsigned)(4 * L + d); qstn[2 * q + 1] = (unsigned)(need - cum); } }
                __syncthreads();
            }
            const unsigned thr = ((LAS unsigned*)(F.lds + 40960))[2 * r32];
#pragma unroll
            for (int ti = 0; ti < 4; ++ti) { const int kt = F.wave + 8 * ti;
                if (kt < ntiles) { unsigned w = 0u;
#pragma unroll
                    for (int e = 0; e < 32; ++e) { w |= (keys[ti][e] >= thr) ? (1u << e) : 0u; if ((e & 7) == 7) __builtin_amdgcn_sched_barrier(0); }
                    mbase[kt * 64] = w; } }
          } }
#endif
#endif
        xcd_barrier(bar, F.wave);
        }
        for (int rep = 0; rep < REP_ATT; ++rep) {
        {
            LAS float* scl = (LAS float*)(F.lds + F.wave * 16384); LAS unsigned* keyl = (LAS unsigned*)(F.lds + F.wave * 16384 + 8192);
#ifndef NO_DIFF
            { const f16* P = WSP(f16, WS_R1); f16* OA = WSP(f16, WS_OA); const float* tabs = WSP(float, WS_MISC + 32768); const float* subln = IN(I_SUBLN) + LL * 128;
              unsigned* qctr = (unsigned*)launder(args.ws) + CW_QUEUE + 64 * ((rep * 2 + LL) * 4 + 0);
              LAS float* tabl = (LAS float*)(F.lds + fa::TAB_OFF); LAS float* subl = (LAS float*)(F.lds + fa::SUB_OFF);
              { const int tid0 = TID;
                for (int i2 = tid0; i2 < 4 * TAB2H; i2 += 512) tabl[i2] = tabs[i2];
                if (tid0 < 128) subl[tid0] = subln[tid0] * ((LL == 0) ? 0.8f : 0.6444909f); }
              for (int rep2 = 0; rep2 < launder_i(REP_DIFF); ++rep2) for (;;) {
                __syncthreads();
                if (TID == 0) MISC[16] = __hip_atomic_fetch_add(qctr + 1024 * rep2, 1u, __ATOMIC_RELAXED, __HIP_MEMORY_SCOPE_AGENT);
                __syncthreads();
                const int ui = __builtin_amdgcn_readfirstlane((int)MISC[16]);
                if (ui >= 512) break;
                const int qb = 7 - (ui >> 6), bh = ui & 63, b = bh >> 2, h = bh & 3; const int lane = LANE, tid = F.wave * 64 + lane;
                const int qpos0 = qb * 256 + F.wave * 32, ntiles = 4 * qb + 4; const size_t brow = (size_t)b * SEQ;
                fa::f32x16 o0[4];
                fa::attn_pass_pipe<64, 128, 0, 3>(F.lds, F.wave, lane, P + (brow + qpos0) * PP + C_AQ + h * 128, PP, P + brow * PP + C_AK + h * 128, PP, P + brow * PP + C_AV + h * 128, PP, ntiles, qpos0, tabl + h * TAB2H, 0u, 0, nullptr, o0);
                { LAS unsigned* st = (LAS unsigned*)(F.lds + fa::STASH_OFF + F.wave * 8192) + lane;
#pragma unroll
                  for (int blk = 0; blk < 4; ++blk)
#pragma unroll
                    for (int r = 0; r < 16; r += 2) st[(blk * 8 + (r >> 1)) * 64] = pk2h(o0[blk][r], o0[blk][r + 1]); }
                fa::attn_pass_pipe<64, 128, 0, 3>(F.lds, F.wave, LANE, P + (brow + qpos0) * PP + C_AQ + h * 128 + 64, PP, P + brow * PP + C_AK + h * 128 + 64, PP, P + brow * PP + C_AV + h * 128, PP, ntiles, qpos0, tabl + h * TAB2H, 0u, 0, nullptr, o0);
                const int lane2 = LANE, hi = lane2 >> 5; float ss = 0.f; const float lam = WSP(float, WS_MISC)[LL];
                { const LAS unsigned* st = (const LAS unsigned*)(F.lds + fa::STASH_OFF + F.wave * 8192) + lane2;
#pragma unroll
                  for (int blk = 0; blk < 4; ++blk)
#pragma unroll
                    for (int r = 0; r < 16; r += 2) { const f16x2 v = __builtin_bit_cast(f16x2, st[(blk * 8 + (r >> 1)) * 64]);
                        const float a0 = (float)v[0] - lam * o0[blk][r], a1 = (float)v[1] - lam * o0[blk][r + 1]; o0[blk][r] = a0; o0[blk][r + 1] = a1; ss += a0 * a0 + a1 * a1; } }
                ss += __shfl_xor(ss, 32);
                const float rstd = 1.f / sqrtf(ss * (1.f / 128.f) + EPS);
#pragma unroll
                for (int blk = 0; blk < 4; ++blk)
#pragma unroll
                    for (int r = 0; r < 16; ++r) o0[blk][r] *= rstd * subl[32 * blk + fa::crow(r, hi)];
                fa::store_o<128>(o0, OA + (brow + qpos0 + (lane2 & 31)) * 512 + h * 128, hi);
              } }
#endif
#ifndef NO_MOBA
#ifdef NAIVE_MOBA
            { const f16* P = WSP(f16, WS_R1); f16* OC = WSP(f16, WS_OC); const float* tabs = WSP(float, WS_MISC + 1024); const float* kmean = WSP(float, WS_MISC + 65536);
              for (int task = GW; task < NB * 4 * SEQ; task += F.NGW) {
                const int bh = task / SEQ, b = bh >> 2, h = bh & 3, t = (task % SEQ + 37 * bh) % SEQ; const size_t row = (size_t)b * SEQ + t; const int j = t >> 8;
                const f16* q = P + row * PP + C_CQ + h * 64; const float qd = (float)q[LANE];
                float gate[8];
#pragma unroll
                for (int n = 0; n < 8; ++n) gate[n] = (n < j) ? wave_sum(qd * kmean[((size_t)bh * 8 + n) * 64 + LANE]) : -INFINITY;
                unsigned selb = 1u << j;
#pragma unroll
                for (int pick = 0; pick < 3; ++pick) { float best = -INFINITY; int bi = -1;
#pragma unroll
                    for (int n = 0; n < 8; ++n) if (!((selb >> n) & 1u) && gate[n] > best) { best = gate[n]; bi = n; }
                    if (bi >= 0) selb |= 1u << bi; }
                unsigned sel = 0u;
#pragma unroll
                for (int jj = 0; jj < 32; ++jj) sel |= ((selb >> (jj >> 2)) & 1u) << jj;
                float o[1];
                naive_attn<64, 64>(scl, q, P + (size_t)b * SEQ * PP + C_CK + h * 64, PP, P + (size_t)b * SEQ * PP + C_CV + h * 64, PP, t, sel, tabs + (8 + h) * TABN, LANE, o);
                OC[row * 256 + h * 64 + LANE] = (f16)o[0];
              } }
#else
            { const f16* P = WSP(f16, WS_R1); f16* OC = WSP(f16, WS_OC); const float* tabs2 = WSP(float, WS_MISC + 32768); const float* kmean = WSP(float, WS_MISC + 65536);
              unsigned* qctr = (unsigned*)launder(args.ws) + CW_QUEUE + 64 * ((rep * 2 + LL) * 4 + 1);
              LAS float* tabl = (LAS float*)(F.lds + fa::TAB_OFF);
              __syncthreads();
              for (int i2 = TID; i2 < 4 * TAB2H; i2 += 512) tabl[i2] = tabs2[8 * TAB2H + i2];
              for (int rep2 = 0; rep2 < launder_i(REP_MOBA); ++rep2) for (;;) {
                __syncthreads();
                if (TID == 0) MISC[16] = __hip_atomic_fetch_add(qctr + 1024 * rep2, 1u, __ATOMIC_RELAXED, __HIP_MEMORY_SCOPE_AGENT);
                __syncthreads();
                const int ui = __builtin_amdgcn_readfirstlane((int)MISC[16]);
                if (ui >= 512) break;
                const int qb = 7 - (ui >> 6), bh = ui & 63, b = bh >> 2, h = bh & 3; const int lane = LANE, tid = F.wave * 64 + lane, r32 = lane & 31, hi = lane >> 5;
                const int qpos0 = qb * 256 + F.wave * 32, ntiles = 4 * qb + 4; const size_t brow = (size_t)b * SEQ;
                const f16* Qw = P + (brow + qpos0) * PP + C_CQ + h * 64;
                unsigned selb = 0u;
                { f16x8 qv[4];
#pragma unroll
                  for (int d0 = 0; d0 < 4; ++d0) qv[d0] = *(const f16x8*)(Qw + (size_t)r32 * PP + d0 * 16 + hi * 8);
                  float gate[8];
#pragma unroll
                  for (int n = 0; n < 8; ++n) { float g = -INFINITY;
                    if (n < qb) { const float* km = kmean + ((size_t)bh * 8 + n) * 64 + 8 * hi; g = 0.f;
#pragma unroll
                        for (int d0 = 0; d0 < 4; ++d0)
#pragma unroll
                            for (int e = 0; e < 8; ++e) g += (float)qv[d0][e] * km[16 * d0 + e];
                        g += __shfl_xor(g, 32); }
                    gate[n] = g; }
#pragma unroll
                  for (int pick = 0; pick < 3; ++pick) { float best = -INFINITY; int bi = -1;
#pragma unroll
                    for (int n = 0; n < 8; ++n) if (!((selb >> n) & 1u) && gate[n] > best) { best = gate[n]; bi = n; }
                    if (bi >= 0) selb |= 1u << bi; } }
                fa::f32x16 o[2];
                fa::attn_pass_pipe<64, 64, 1, 4>(F.lds, F.wave, lane, Qw, PP, P + brow * PP + C_CK + h * 64, PP, P + brow * PP + C_CV + h * 64, PP, ntiles, qpos0, tabl + h * TAB2H, selb, qb, nullptr, o);
                fa::store_o<64>(o, OC + (brow + qpos0 + r32) * 256 + h * 64, hi);
              } }
#endif
#endif
#ifndef NO_DSA
#ifdef NAIVE_DSA
            { const f16* P = WSP(f16, WS_R1); f16* OB = WSP(f16, WS_OB); const f16* KVN = WSP(f16, WS_KVN); const float* tabs = WSP(float, WS_MISC + 1024);
              for (int task = GW; task < NB * SEQ; task += F.NGW) {
                const int b = task / SEQ, t = (task % SEQ + 37 * b) % SEQ; const size_t row = (size_t)b * SEQ + t; const int lane = LANE;
                unsigned sel = 0xffffffffu;
                if (t >= 256) {
                    const int nslots = (t >> 6) + 1; const f16* iq = P + row * PP + C_BIQ; const f16* iwp = P + row * PP + C_BIW;
#pragma unroll 1
                    for (int j = 0; j < nslots; ++j) { unsigned kk = 0u; const int k = 64 * j + lane;
                        if (k <= t) { const f16* ik = P + ((size_t)b * SEQ + k) * PP + C_BIK; f16x8 kv[4];
#pragma unroll
                            for (int c = 0; c < 4; ++c) kv[c] = *(const f16x8*)(ik + 8 * c);
                            float s = 0.f;
#pragma unroll 1
                            for (int hh = 0; hh < 8; ++hh) { float d = 0.f;
#pragma unroll
                                for (int c = 0; c < 4; ++c) { const f16x8 qv = *(const f16x8*)(iq + hh * 32 + 8 * c);
#pragma unroll
                                    for (int e = 0; e < 8; ++e) d += (float)qv[e] * (float)kv[c][e]; }
                                s += fmaxf(d, 0.f) * (float)iwp[hh]; }
                            kk = ordkey(s); }
                        keyl[k] = kk; }
                    unsigned thr = 0u;
#pragma unroll 1
                    for (int bit = 31; bit >= 0; --bit) { const unsigned cand = thr | (1u << bit); int c = 0;
#pragma unroll 1
                        for (int j = 0; j < nslots; ++j) c += (keyl[64 * j + lane] >= cand) ? 1 : 0;
                        if (wave_isum(c) >= 256) thr = cand; }
                    int cgt = 0;
#pragma unroll 1
                    for (int j = 0; j < nslots; ++j) cgt += (keyl[64 * j + lane] > thr) ? 1 : 0;
                    cgt = wave_isum(cgt);
                    const int need = 256 - cgt; int run = 0; sel = 0u;
#pragma unroll 1
                    for (int j = 0; j < nslots; ++j) { const unsigned kk = keyl[64 * j + lane]; const bool tie = kk == thr; const unsigned long long bal = __ballot(tie);
                        const int pre = run + __popcll(bal & ((1ull << lane) - 1ull));
                        if (kk > thr || (tie && pre < need)) sel |= 1u << j;
                        run += __popcll(bal); }
                }
#pragma unroll 1
                for (int h = 0; h < 4; ++h) { float o[2];
                    naive_attn<128, 128>(scl, P + row * PP + C_BQ + h * 128, KVN + (size_t)b * SEQ * 128, 128, KVN + (size_t)b * SEQ * 128, 128, t, sel, tabs + (4 + h) * TABN, LANE, o);
                    OB[row * 512 + h * 128 + LANE] = (f16)o[0]; OB[row * 512 + h * 128 + 64 + LANE] = (f16)o[1]; }
              } }
#else
            { const f16* P = WSP(f16, WS_R1); f16* OB = WSP(f16, WS_OB); const f16* KVN = WSP(f16, WS_KVN); const float* tabs2 = WSP(float, WS_MISC + 32768); const unsigned* MASK = WSP(unsigned, WS_MASK);
              unsigned* qctr = (unsigned*)launder(args.ws) + CW_QUEUE + 64 * ((rep * 2 + LL) * 4 + 2);
              LAS float* tabl = (LAS float*)(F.lds + fa::TAB_OFF);
              __syncthreads();
              for (int i2 = TID; i2 < 4 * TAB2H; i2 += 512) tabl[i2] = tabs2[4 * TAB2H + i2];
              for (int rep2 = 0; rep2 < launder_i(REP_DSA); ++rep2) for (;;) {
                __syncthreads();
                if (TID == 0) MISC[16] = __hip_atomic_fetch_add(qctr + 1024 * rep2, 1u, __ATOMIC_RELAXED, __HIP_MEMORY_SCOPE_AGENT);
                __syncthreads();
                const int ui = __builtin_amdgcn_readfirstlane((int)MISC[16]);
                if (ui >= 512) break;
                const int qi = 31 - (ui >> 4), b = ui & 15; const int lane = LANE, tid = F.wave * 64 + lane, r32 = lane & 31, hi = lane >> 5;
                const int head = F.wave & 3, qpos0 = 64 * qi + 32 * (F.wave >> 2), ntiles = qi + 1; const size_t brow = (size_t)b * SEQ;
                fa::f32x16 o[4];
                fa::attn_pass_dma<128, 128, 2, 4>(F.lds, F.wave, lane, P + (brow + qpos0) * PP + C_BQ + head * 128, PP, KVN + brow * 128, 128, KVN + brow * 128, 128, ntiles, qpos0, tabl + head * TAB2H, 0u, 0,
                                           MASK + ((size_t)(b * 64 + (qpos0 >> 5)) * 32) * 64, o);
                fa::store_o<128>(o, OB + (brow + qpos0 + r32) * 512 + head * 128, hi);
              } }
#endif
#endif
        }
        xcd_barrier(bar, F.wave);
        }
        for (int rep = 0; rep < REP_G2; ++rep) {
#ifndef NO_G2
        { pg8::StaticOrder S; S.init(MTOK, DM, F.G, (int)blockIdx.x);
          { pg8::Gemm g{WSP(f16, WS_OA), WSP(f16, WS_WA) + (size_t)LL * DM * 512, MTOK, DM, 512}; pg8::EpiF16<0> E{WSP(f16, WS_R1), DM}; pg8::gemm_phase<pg8::EpiF16<0>, pg8::StaticOrder, true, true>(F.lds, g, S, E, F.wave); }
          { pg8::Gemm g{WSP(f16, WS_OB), WSP(f16, WS_WBC) + (size_t)LL * DM * 512, MTOK, DM, 512}; pg8::EpiF16<0> E{WSP(f16, WS_R1) + (size_t)MTOK * DM, DM}; pg8::gemm_phase<pg8::EpiF16<0>, pg8::StaticOrder, true, true>(F.lds, g, S, E, F.wave); }
          { pg8::Gemm g{WSP(f16, WS_OC), WSP(f16, WS_WC) + (size_t)LL * DM * 256, MTOK, DM, 256}; pg8::EpiF16<0> E{WSP(f16, WS_R1) + (size_t)2 * MTOK * DM, DM}; pg8::gemm_phase<pg8::EpiF16<0>, pg8::StaticOrder, true, true>(F.lds, g, S, E, F.wave); } }
#endif
        xcd_barrier(bar, F.wave);
        }
#ifndef NO_G3
        { pg8::Gemm g{WSP(f16, WS_U), WSP(f16, WS_WG) + (size_t)LL * GCOLS * DM, MTOK, GCOLS, DM}; pg8::TripleOrder S; S.init(MTOK, F.G, (int)blockIdx.x);
          pg8::EpiGateMerge E{WSP(f16, WS_R1), WSP(f16, WS_R1 + 192 * MiB), IN(I_GATEB) + LL * GCOLS, WSP(float, WS_CVEC) + (size_t)(LL * 3 + 1) * 16 * 4096};
          pg8::fill_rstd(WSP(float, WS_SS), S, TID);
          pg8::gemm_phase<pg8::EpiGateMerge, pg8::TripleOrder, true, true>(F.lds, g, S, E, F.wave); }
#endif
        xcd_barrier(bar, F.wave);
#ifndef NO_G4
        { pg8::Gemm g{WSP(f16, WS_R1 + 192 * MiB), WSP(f16, WS_WO) + (size_t)LL * DM * DM, MTOK, DM, DM}; pg8::StaticOrder S; S.init(MTOK, DM, F.G, (int)blockIdx.x);
          pg8::EpiResidual E{(LL == 0) ? IN(I_X) : (const float*)nullptr, (const f16*)xout, (f16*)xout, WSP(float, WS_MOD) + (size_t)LL * 16 * 6144 + 2 * DM, 6144, WSP(f16, WS_U), IN(I_NMLP) + LL * DM, WSP(float, WS_MOD) + (size_t)LL * 16 * 6144 + 4 * DM, WSP(float, WS_SS)};
          pg8::gemm_phase<pg8::EpiResidual, pg8::StaticOrder, true, true>(F.lds, g, S, E, F.wave); }
#endif
        xcd_barrier(bar, F.wave);
        for (int rep = 0; rep < REP_G5; ++rep) {
#ifndef NO_G5
        { pg8::Gemm g{WSP(f16, WS_U), WSP(f16, WS_W1) + (size_t)LL * DFF * DM, MTOK, DFF, DM}; pg8::StaticOrder S; S.init(MTOK, DFF, F.G, (int)blockIdx.x);
          pg8::EpiNormF16<1> E{WSP(f16, WS_R1), DFF, WSP(float, WS_CVEC) + (size_t)(LL * 3 + 2) * 16 * 4096};
          pg8::fill_rstd(WSP(float, WS_SS), S, TID);
          pg8::gemm_phase<pg8::EpiNormF16<1>, pg8::StaticOrder, true, true>(F.lds, g, S, E, F.wave); }
#endif
        xcd_barrier(bar, F.wave);
        }
#ifndef NO_G6
        { pg8::Gemm g{WSP(f16, WS_R1), WSP(f16, WS_W2) + (size_t)LL * DM * DFF, MTOK, DM, DFF}; pg8::StaticOrder S; S.init(MTOK, DM, F.G, (int)blockIdx.x);
          const bool more_layers = LL + 1 < DEPTH;
          pg8::EpiResidual E{(const float*)nullptr, (const f16*)xout, more_layers ? (f16*)xout : WSP(f16, WS_U), WSP(float, WS_MOD) + (size_t)LL * 16 * 6144 + 5 * DM, 6144, more_layers ? WSP(f16, WS_U) : (f16*)nullptr, IN(I_NMIX) + (more_layers ? LL + 1 : 0) * DM, WSP(float, WS_MOD) + (size_t)(more_layers ? LL + 1 : 0) * 16 * 6144 + 1 * DM, WSP(float, WS_SS)};
          pg8::gemm_phase<pg8::EpiResidual, pg8::StaticOrder, true, true>(F.lds, g, S, E, F.wave); }
#endif
        xcd_barrier(bar, F.wave);
    }
    { const float* nf = IN(I_NFINAL); const f16* xf = WSP(f16, WS_U);
      for (int m = GW; m < MTOK; m += F.NGW) { const int lane = LANE;
        const GAS u32x2* xr = (const GAS u32x2*)(xf + (size_t)m * DM) + lane;
        f32x4 v[4]; float s = 0.f;
#pragma unroll
        for (int j = 0; j < 4; ++j) { const u32x2 w = xr[64 * j]; const unsigned wx = w.x, wy = w.y; const f16x2 a = __builtin_bit_cast(f16x2, wx), b2 = __builtin_bit_cast(f16x2, wy);
            v[j] = (f32x4){(float)a[0], (float)a[1], (float)b2[0], (float)b2[1]}; s += (v[j].x * v[j].x + v[j].y * v[j].y) + (v[j].z * v[j].z + v[j].w * v[j].w); }
        const float rstd = 1.f / sqrtf(wave_sum(s) * (1.f / DM) + EPS);
        GAS f32x4* orow = (GAS f32x4*)(xout + (size_t)m * DM) + lane;
#pragma unroll
        for (int j = 0; j < 4; ++j) orow[64 * j] = v[j] * rstd * ((const f32x4*)nf)[lane + 64 * j];
      } }
#undef IN
#undef WSP
#undef LANE
#undef LL
#undef GW
#undef TID
}

extern "C" void kernel_launch(void* const* d_in, const int* in_sizes, int n_in, void* d_out, int out_size, void* d_ws, size_t ws_size, hipStream_t stream) {
    static int grid = 0;
    if (grid == 0) {
        if (n_in != 20 || in_sizes[0] != MTOK * DM || out_size != MTOK * DM || ws_size < WS_END) { fprintf(stderr, "kernel_launch: shape/workspace mismatch (n_in %d, ws %zu); nothing launched\n", n_in, ws_size); grid = -1; return; }
        int dev = 0, cus = 0, per_cu = 0;
        if (hipGetDevice(&dev) != hipSuccess || hipDeviceGetAttribute(&cus, hipDeviceAttributeMultiprocessorCount, dev) != hipSuccess) { grid = -1; return; }
        if (hipFuncSetAttribute((const void*)mega_fwd, hipFuncAttributeMaxDynamicSharedMemorySize, LDS_BYTES) != hipSuccess) { fprintf(stderr, "kernel_launch: hipFuncSetAttribute failed\n"); grid = -1; return; }
        if (hipOccupancyMaxActiveBlocksPerMultiprocessor(&per_cu, (const void*)mega_fwd, NWAVES * 64, LDS_BYTES) != hipSuccess || per_cu < 1) { fprintf(stderr, "kernel_launch: occupancy query says %d blocks per CU\n", per_cu); }
        (void)hipGetLastError();
        grid = cus;
    }
    if (grid < 0) return;
    if (hipMemsetAsync((char*)d_ws + WS_CTL, 0, CTL_ZERO_BYTES, stream) != hipSuccess) return;
    Args a{};
    for (int i = 0; i < 20; ++i) a.in[i] = (const float*)d_in[i];
    a.out = (float*)d_out; a.ws = (unsigned char*)d_ws;
    hipLaunchKernelGGL(mega_fwd, dim3(grid), dim3(NWAVES * 64), LDS_BYTES, stream, a);
}
```

```cpp
#include <hip/hip_runtime.h>
#include <cstdio>
#include <cstdint>
#ifndef REP_N1
#define REP_N1 1
#endif
#ifndef REP_G1
#define REP_G1 1
#endif
#ifndef REP_SEL
#define REP_SEL 1
#endif
#ifndef REP_ATT
#define REP_ATT 1
#endif
#ifndef REP_G2
#define REP_G2 1
#endif
#ifndef REP_G5
#define REP_G5 1
#endif
#ifndef REP_P0
#define REP_P0 1
#endif
#ifndef REP_SCORE
#define REP_SCORE 1
#endif
#ifndef REP_RADIX
#define REP_RADIX 1
#endif
#ifndef REP_DIFF
#define REP_DIFF 1
#endif
#ifndef REP_MOBA
#define REP_MOBA 1
#endif
#ifndef REP_DSA
#define REP_DSA 1
#endif

#define LAS __attribute__((address_space(3)))
#define GAS __attribute__((address_space(1)))
typedef _Float16 f16;
typedef _Float16 f16x8 __attribute__((ext_vector_type(8)));
typedef _Float16 f16x4 __attribute__((ext_vector_type(4)));
typedef _Float16 f16x2 __attribute__((ext_vector_type(2)));
typedef float f32x4 __attribute__((ext_vector_type(4)));
typedef float f32x2 __attribute__((ext_vector_type(2)));
typedef unsigned u32x4 __attribute__((ext_vector_type(4)));
typedef unsigned u32x2 __attribute__((ext_vector_type(2)));

constexpr int NB = 16, SEQ = 2048, DM = 1024, MTOK = NB * SEQ, DEPTH = 2, DFF = 4096;
constexpr int IN_COLS = 6312, PCOLS = 3240, PP = 3328  , GCOLS = 3072;
constexpr int C_AQ = 0, C_AK = 512, C_AV = 1024, C_BQ = 1536, C_BKV = 2048, C_BIQ = 2176, C_BIK = 2432, C_BIW = 2464, C_CQ = 2472, C_CK = 2728, C_CV = 2984, C_G = 3240;
constexpr float EPS = 1e-6f, LOG2E = 1.4426950408889634f;
constexpr int TABN = 384;
constexpr int TAB2 = 320, TAB2H = 2 * TAB2;

__device__ __forceinline__ unsigned pk2h(float lo, float hi) { f32x2 v = {lo, hi}; f16x2 h = __builtin_convertvector(v, f16x2); return __builtin_bit_cast(unsigned, h); }

__device__ __forceinline__ int lane_id() { int l; asm volatile("v_mbcnt_lo_u32_b32 %0, -1, 0\n\tv_mbcnt_hi_u32_b32 %0, -1, %0" : "=v"(l)); return l; }

constexpr size_t SLAB_E = 16u * 1024u * 1024u;
constexpr size_t GAPP = SLAB_E - (size_t)4096 * 3328, GAPY = SLAB_E - (size_t)4096 * 1024, YSTR = (size_t)4096 * 1024;
namespace pg8 {
#define PG8_LAS __attribute__((address_space(3)))
#ifndef PG8_GRACE
#define PG8_GRACE 1
#endif
constexpr int BM = 256, BK = 64, HALF = 128, HTB = HALF * BK * 2, STAGE_BYTES = 8 * HTB, NXCD = 8, WGM = 8;
__host__ __device__ __forceinline__ int lds_byte(int r, int c) { const int st = (r >> 4) * 2 + (c >> 5), rr = r & 15, cc = c & 31, ob = rr * 64 + cc * 2; return st * 1024 + (ob ^ (((ob >> 9) & 1) << 5)); }
__host__ __device__ __forceinline__ void stage_rc(int b, int& R, int& C) { const int st = b / 1024, sb = b % 1024, swz = sb ^ (((sb >> 9) & 1) << 5); R = (st >> 1) * 16 + swz / 64; C = (st & 1) * 32 + (swz % 64) / 2; }
__host__ __device__ __forceinline__ int perm32(int rho) { const int n = rho >> 4, i = rho & 15; return 8 * (i >> 2) + 4 * n + (i & 3); }

struct Unit { int pm, pn, idx; };
struct Gemm { const f16* A; const f16* Bt; int M, N, K; unsigned gapA = 0u; };

struct StaticOrder {
    int nM, nN, nwg, G, c;
    __host__ __device__ void init(int M, int N, int G_, int c_) { nM = M / BM; nN = N / BM; nwg = nM * nN; G = G_; c = c_; }
    __host__ __device__ bool next(int i, Unit& u) const {
        const long L = (long)i * G + c; if (L >= nwg) return false;
        int wgid = (int)L; { const int q = nwg / NXCD, r = nwg % NXCD, xcd = wgid % NXCD, off = wgid / NXCD; wgid = (xcd < r ? xcd * (q + 1) : r * (q + 1) + (xcd - r) * q) + off; }
        const int nig = WGM * nN, gid = wgid / nig, fm = gid * WGM, gsz = (nM - fm) < WGM ? (nM - fm) : WGM;
        u.pm = fm + ((wgid % nig) % gsz); u.pn = (wgid % nig) / gsz; u.idx = i; return true;
    }
    __device__ __forceinline__ void a_ready(const Unit&) const {}
    __device__ __forceinline__ void done(const Unit&) const {}
};
struct TripleOrder {
    StaticOrder so;
    __host__ __device__ void init(int M, int G_, int c_) { so.init(M, 1024, G_, c_); }
    __host__ __device__ bool next(int i, Unit& u) const { if (!so.next(i / 3, u)) return false; u.pn += 4 * (i % 3); u.idx = i; return true; }
    __device__ __forceinline__ void a_ready(const Unit&) const {}
    __device__ __forceinline__ void done(const Unit&) const {}
};

typedef int i32x4 __attribute__((ext_vector_type(4)));
typedef u32x4 __attribute__((address_space(1))) g_u32x4;
typedef u32x2 __attribute__((address_space(1))) g_u32x2;
typedef f32x4 __attribute__((address_space(1))) g_f32x4;
typedef float __attribute__((address_space(1))) g_f32;
typedef f16x8 __attribute__((address_space(1))) g_f16x8;
__device__ __forceinline__ void gst16(void* p, const u32x4 w) { *(g_u32x4*)(p) = w; }
__device__ __forceinline__ void gst8(void* p, const u32x2 w) { *(g_u32x2*)(p) = w; }
template <int ACT  > struct EpiF16 {
    static constexpr bool PERM = true, AFTER_DRAIN = false; static constexpr int NSTORE = 16;
    f16* O; int ldc; size_t gap;
    __device__ __forceinline__ void operator()(const f32x4 (&acc)[2][2][4][2], const Unit& u, int wr, int wc, int fr, int fq) const {
        const int row0 = u.pm * BM + wr * 64 + fr; const int col0 = u.pn * BM + wc * 32 + 8 * fq;
#pragma unroll
        for (int ai = 0; ai < 2; ++ai)
#pragma unroll
            for (int m = 0; m < 4; ++m) { f16* rowp = O + (size_t)(row0 + ai * HALF + m * 16) * ldc + (size_t)((row0 + ai * HALF + m * 16) >> 12) * gap + col0;
#pragma unroll
                for (int bj = 0; bj < 2; ++bj) { f32x4 v0 = acc[ai][bj][m][0], v1 = acc[ai][bj][m][1];
                    if (ACT == 1) {
#pragma unroll
                        for (int e = 0; e < 4; ++e) { const float a = fmaxf(v0[e], 0.f), b = fmaxf(v1[e], 0.f); v0[e] = a * a; v1[e] = b * b; } }
                    u32x4 w; w.x = pk2h(v0[0], v0[1]); w.y = pk2h(v0[2], v0[3]); w.z = pk2h(v1[0], v1[1]); w.w = pk2h(v1[2], v1[3]);
                    gst16(rowp + bj * HALF, w); } }
    }
};
constexpr int RSTD_LDS = 131072, CV_LDS_ = 139264 + 1024, SB_LDS = CV_LDS_ + 8192;
__device__ __forceinline__ void row_rstd(const Unit& u, int wr, int fr, float (&rs)[2][4]) {
    const PG8_LAS float* rt = (const PG8_LAS float*)(uintptr_t)(RSTD_LDS + u.idx * 1024) + wr * 64 + fr;
#pragma unroll
    for (int ai = 0; ai < 2; ++ai)
#pragma unroll
        for (int m = 0; m < 4; ++m) rs[ai][m] = rt[ai * HALF + m * 16];
}
constexpr int CV_LDS = 139264 + 1024;
template <class Sched> __device__ __forceinline__ void fill_rstd(const float* SS, const float* cvec, const float* gb, const Sched& S, int tid) {
    for (int i = 0; i < 8; ++i) { Unit u; if (!S.next(i, u)) break;
        if (tid < 256) { const f32x4* sp = (const f32x4*)(SS + (size_t)(u.pm * BM + tid) * 16);
            const f32x4 a = sp[0], b = sp[1], c = sp[2], d = sp[3]; const f32x4 t = (a + b) + (c + d);
            ((PG8_LAS float*)(uintptr_t)(RSTD_LDS + i * 1024))[tid] = __builtin_amdgcn_rsqf(((t.x + t.y) + (t.z + t.w)) * (1.f / DM) + EPS); }
        else { const int c = tid - 256; float v = cvec[(size_t)((u.pm * BM) / SEQ) * 4096 + u.pn * BM + c]; if (gb) v += gb[u.pn * BM + c];
            ((PG8_LAS float*)(uintptr_t)(CV_LDS + i * 1024))[c] = v; } }
    __syncthreads();
}
template <class Sched> __device__ __forceinline__ void fill_tabs_q(const float* rowfac, const float* cvec, const float* gb, const float* sbv, const Sched& S, int tid) {
    for (int i = 0; i < 8; ++i) { Unit u; if (!S.next(i, u)) break;
        if (tid < 256) ((PG8_LAS float*)(uintptr_t)(RSTD_LDS + i * 1024))[tid] = rowfac[u.pm * BM + tid];
        else { const int c = tid - 256; float v = cvec[(size_t)((u.pm * BM) / SEQ) * 4096 + u.pn * BM + c]; if (gb) v += gb[u.pn * BM + c];
            ((PG8_LAS float*)(uintptr_t)(CV_LDS + i * 1024))[c] = v; ((PG8_LAS float*)(uintptr_t)(SB_LDS + i * 1024))[c] = sbv[u.pn * BM + c]; } }
    __syncthreads();
}
template <int ACT  , bool I8 = false, bool TILED = false> struct EpiNormF16 {
    static constexpr bool PERM = true, AFTER_DRAIN = false; static constexpr int NSTORE = 16;
    f16* O; int ldc; size_t gap;
    __device__ __forceinline__ void operator()(const f32x4 (&acc)[2][2][4][2], const Unit& u, int wr, int wc, int fr, int fq) const {
        const int row0 = u.pm * BM + wr * 64 + fr; const int col0 = u.pn * BM + wc * 32 + 8 * fq; const int b = (u.pm * BM) / SEQ;
        float rs[2][4]; row_rstd(u, wr, fr, rs);
        f32x4 cv[2][2];
#pragma unroll
        for (int bj = 0; bj < 2; ++bj)
#pragma unroll
            for (int n = 0; n < 2; ++n) cv[bj][n] = *(const PG8_LAS f32x4*)(uintptr_t)(CV_LDS + u.idx * 1024 + (wc * 32 + 8 * fq + bj * HALF + 4 * n) * 4);
        f32x4 sv[2][2];
        if constexpr (I8) {
#pragma unroll
            for (int bj = 0; bj < 2; ++bj)
#pragma unroll
                for (int n = 0; n < 2; ++n) sv[bj][n] = *(const PG8_LAS f32x4*)(uintptr_t)(SB_LDS + u.idx * 1024 + (wc * 32 + 8 * fq + bj * HALF + 4 * n) * 4); }
#pragma unroll
        for (int ai = 0; ai < 2; ++ai)
#pragma unroll
            for (int m = 0; m < 4; ++m) { const int rowg = row0 + ai * HALF + m * 16;
                f16* rowp = TILED ? O + ((size_t)((rowg >> 8) * (ldc >> 6) + (col0 >> 6)) * 256 + (rowg & 255)) * 64 + (col0 & 63) : O + (size_t)rowg * ldc + (size_t)(rowg >> 12) * gap + col0; const float r = rs[ai][m];
#pragma unroll
                for (int bj = 0; bj < 2; ++bj) { f32x4 a0 = acc[ai][bj][m][0], a1 = acc[ai][bj][m][1];
                    if constexpr (I8) { const i32x4 i0 = __builtin_bit_cast(i32x4, a0), i1 = __builtin_bit_cast(i32x4, a1);
                        a0 = (f32x4){(float)i0.x, (float)i0.y, (float)i0.z, (float)i0.w} * sv[bj][0]; a1 = (f32x4){(float)i1.x, (float)i1.y, (float)i1.z, (float)i1.w} * sv[bj][1]; }
                    f32x4 v0 = a0 * r + cv[bj][0], v1 = a1 * r + cv[bj][1];
                    if (ACT == 1) {
#pragma unroll
                        for (int e = 0; e < 4; ++e) { const float a = fmaxf(v0[e], 0.f), b2 = fmaxf(v1[e], 0.f); v0[e] = a * a; v1[e] = b2 * b2; } }
                    u32x4 w; w.x = pk2h(v0[0], v0[1]); w.y = pk2h(v0[2], v0[3]); w.z = pk2h(v1[0], v1[1]); w.w = pk2h(v1[2], v1[3]);
                    gst16(rowp + (TILED ? bj * 2 * 256 * 64 : bj * HALF), w); } }
    }
};
template <bool I8> struct EpiGateMerge {
    static constexpr bool PERM = true, AFTER_DRAIN = false; static constexpr int NSTORE = 28;
    f16* Y; f16* merged;
    __device__ __forceinline__ void operator()(const f32x4 (&acc)[2][2][4][2], const Unit& u, int wr, int wc, int fr, int fq) const {
        const int br = u.pn >> 2, pc = u.pn & 3;
        const int row0 = u.pm * BM + wr * 64 + fr; const int col0 = pc * BM + wc * 32 + 8 * fq;
        if (br == 2) { __builtin_amdgcn_fence(__ATOMIC_ACQUIRE, "agent"); }
        const int b = (u.pm * BM) / SEQ; float rs[2][4]; row_rstd(u, wr, fr, rs);
        f32x4 bv[2][2];
#pragma unroll
        for (int bj = 0; bj < 2; ++bj)
#pragma unroll
            for (int n = 0; n < 2; ++n) bv[bj][n] = *(const PG8_LAS f32x4*)(uintptr_t)(CV_LDS + u.idx * 1024 + (wc * 32 + 8 * fq + bj * HALF + 4 * n) * 4);
        f32x4 sv[2][2];
        if constexpr (I8) {
#pragma unroll
            for (int bj = 0; bj < 2; ++bj)
#pragma unroll
                for (int n = 0; n < 2; ++n) sv[bj][n] = *(const PG8_LAS f32x4*)(uintptr_t)(SB_LDS + u.idx * 1024 + (wc * 32 + 8 * fq + bj * HALF + 4 * n) * 4); }
        f16* Yb = Y + (size_t)br * YSTR;
#pragma unroll
        for (int ai = 0; ai < 2; ++ai)
#pragma unroll
            for (int m = 0; m < 4; ++m) { const size_t off = (size_t)(row0 + ai * HALF + m * 16) * 1024 + (size_t)((row0 + ai * HALF + m * 16) >> 12) * GAPY + col0;
#pragma unroll
                for (int bj = 0; bj < 2; ++bj) {
                    f32x4 a0 = acc[ai][bj][m][0], a1 = acc[ai][bj][m][1];
                    if constexpr (I8) { const i32x4 i0 = __builtin_bit_cast(i32x4, a0), i1 = __builtin_bit_cast(i32x4, a1);
                        a0 = (f32x4){(float)i0.x, (float)i0.y, (float)i0.z, (float)i0.w} * sv[bj][0]; a1 = (f32x4){(float)i1.x, (float)i1.y, (float)i1.z, (float)i1.w} * sv[bj][1]; }
                    const f32x4 g0 = a0 * rs[ai][m] + bv[bj][0], g1 = a1 * rs[ai][m] + bv[bj][1];
                    const f16x8 yv = *(const f16x8*)(Yb + off + bj * HALF);
                    float z[8];
#pragma unroll
                    for (int e = 0; e < 4; ++e) { z[e] = (float)yv[e] * __builtin_amdgcn_rcpf(1.f + __builtin_amdgcn_exp2f(-LOG2E * g0[e])); z[4 + e] = (float)yv[4 + e] * __builtin_amdgcn_rcpf(1.f + __builtin_amdgcn_exp2f(-LOG2E * g1[e])); }
                    if (br == 2) {
                        const f16x8 za = *(const f16x8*)(Y + off + bj * HALF), zb = *(const f16x8*)(Y + YSTR + off + bj * HALF);
#pragma unroll
                        for (int e = 0; e < 8; ++e) z[e] += (float)za[e] + (float)zb[e];
                    }
                    u32x4 w; w.x = pk2h(z[0], z[1]); w.y = pk2h(z[2], z[3]); w.z = pk2h(z[4], z[5]); w.w = pk2h(z[6], z[7]);
                    f16* dst = (br == 2) ? merged : Yb;
                    *(u32x4*)(dst + off + bj * HALF) = w; } }
    }
};
struct EpiResidual {
    static constexpr bool PERM = true, AFTER_DRAIN = false; static constexpr int NSTORE = 32;
    const f16* xin16; f16* out; const float* gate; int gpitch; f16* U; const float* nw; const float* nsc; float* SS;
    __device__ __forceinline__ void operator()(const f32x4 (&acc)[2][2][4][2], const Unit& u, int wr, int wc, int fr, int fq) const {
        const int col0 = u.pn * BM + wc * 32 + 8 * fq; const int b = (u.pm * BM) / SEQ;
        f32x4 gv[2][2], Gv[2][2];
#pragma unroll
        for (int bj = 0; bj < 2; ++bj)
#pragma unroll
            for (int n = 0; n < 2; ++n) gv[bj][n] = *(const g_f32x4*)(gate + (size_t)b * gpitch + col0 + bj * HALF + 4 * n);
        if (U) {
#pragma unroll
            for (int bj = 0; bj < 2; ++bj)
#pragma unroll
                for (int n = 0; n < 2; ++n) Gv[bj][n] = *(const g_f32x4*)(nw + col0 + bj * HALF + 4 * n) * (*(const g_f32x4*)(nsc + (size_t)b * gpitch + col0 + bj * HALF + 4 * n) + 1.f); }
#pragma unroll
        for (int ai = 0; ai < 2; ++ai) {
            const int rowa = u.pm * BM + ai * HALF + wr * 64 + fr;
            f16x8 xh[4][2];
#pragma unroll
            for (int m = 0; m < 4; ++m)
#pragma unroll
                for (int bj = 0; bj < 2; ++bj) xh[m][bj] = *(const g_f16x8*)(xin16 + (size_t)(rowa + m * 16) * DM + col0 + bj * HALF);
#pragma unroll
            for (int m = 0; m < 4; ++m) { const int row = rowa + m * 16; const size_t off = (size_t)row * DM + col0; float ss = 0.f;
#pragma unroll
                for (int bj = 0; bj < 2; ++bj) { const f16x8 h = xh[m][bj];
                    const f32x4 xn0 = (f32x4){(float)h[0], (float)h[1], (float)h[2], (float)h[3]} + gv[bj][0] * acc[ai][bj][m][0];
                    const f32x4 xn1 = (f32x4){(float)h[4], (float)h[5], (float)h[6], (float)h[7]} + gv[bj][1] * acc[ai][bj][m][1];
                    { u32x4 w; w.x = pk2h(xn0.x, xn0.y); w.y = pk2h(xn0.z, xn0.w); w.z = pk2h(xn1.x, xn1.y); w.w = pk2h(xn1.z, xn1.w); gst16(out + off + bj * HALF, w); }
                    if (U) { ss += ((xn0.x * xn0.x + xn0.y * xn0.y) + (xn0.z * xn0.z + xn0.w * xn0.w)) + ((xn1.x * xn1.x + xn1.y * xn1.y) + (xn1.z * xn1.z + xn1.w * xn1.w));
                        const f32x4 y0 = xn0 * Gv[bj][0], y1 = xn1 * Gv[bj][1];
                        u32x4 w; w.x = pk2h(y0.x, y0.y); w.y = pk2h(y0.z, y0.w); w.z = pk2h(y1.x, y1.y); w.w = pk2h(y1.z, y1.w); gst16(U + off + bj * HALF, w); } }
                if (U) { ss += __shfl_xor(ss, 16); ss += __shfl_xor(ss, 32); if (fq == 0) *(g_f32*)(SS + (size_t)row * 16 + u.pn * 4 + wc) = ss; } } }
    }
};

__device__ __forceinline__ unsigned sgpr_opaque(unsigned x) { asm volatile("" : "+s"(x)); return x; }
template <class Epi, class Sched, bool ALIGN_EPI = false, bool SP2 = false, bool I8 = false, bool ATILED = false>
__device__ __forceinline__ void gemm_phase(PG8_LAS unsigned char* lds, const Gemm g, const Sched& S, const Epi& E, const int wid) {
    const int lane = lane_id(), tid = wid * 64 + lane, wr = wid >> 2, wc = wid & 3, fr = lane & 15, fq = lane >> 4;
    const int K = g.K, nt = K / BK;
    unsigned voffA[2], voffB[2];
#pragma unroll
    for (int i = 0; i < 2; ++i) { int R, C; stage_rc(tid * 16 + i * 8192, R, C); const int Rb = Epi::PERM ? ((R & ~31) + perm32(R & 31)) : R;
        voffA[i] = (unsigned)(R * (ATILED ? BK : K) + C) * 2u; voffB[i] = (unsigned)(Rb * K + C) * 2u; }
    const unsigned kstep = (unsigned)(BK * 2);
    const unsigned hstep = (unsigned)HALF * K * 2;
    const unsigned tstep = 2 * hstep;
    const unsigned kstepA = ATILED ? (unsigned)(BM * BK * 2) : kstep, hstepA = ATILED ? (unsigned)(HALF * BK * 2) : hstep, tstepA = ATILED ? (unsigned)nt * (unsigned)(BM * BK * 2) : tstep;
    const __amdgpu_buffer_rsrc_t rsA = __builtin_amdgcn_make_buffer_rsrc((void*)g.A, 0, 0x7fffffff, 0x00020000), rsB = __builtin_amdgcn_make_buffer_rsrc((void*)g.Bt, 0, 0x7fffffff, 0x00020000);
    const unsigned ldsw = (unsigned)wid * 1024u;
    const int aoff = lds_byte(wr * 64 + fr, fq * 8), boff = lds_byte(wc * 32 + fr, fq * 8);
#define PG8_SA(b, h) (((b) * 2 + (h)) * HTB)
#define PG8_SB(b, h) ((4 + (b) * 2 + (h)) * HTB)
#define PG8_STAGE(bufoff, RS, soff, voff) do { _Pragma("unroll") for (int _i = 0; _i < 2; ++_i) \
        __builtin_amdgcn_raw_ptr_buffer_load_lds(RS, (PG8_LAS void*)(lds + (bufoff) + sgpr_opaque(ldsw) + _i * 8192), 16, (int)(voff)[_i], (int)(soff), 0, 0); } while (0)
#define PG8_LDA(dst, b, h) do { _Pragma("unroll") for (int m = 0; m < 4; ++m) _Pragma("unroll") for (int k = 0; k < 2; ++k) dst[m][k] = *(const PG8_LAS f16x8*)(lds + PG8_SA(b, h) + aoff + m * 2048 + k * 1024); } while (0)
#define PG8_LDB(dst, b, h) do { _Pragma("unroll") for (int n = 0; n < 2; ++n) _Pragma("unroll") for (int k = 0; k < 2; ++k) dst[n][k] = *(const PG8_LAS f16x8*)(lds + PG8_SB(b, h) + boff + n * 2048 + k * 1024); } while (0)
#define PG8_MMA(ai, bj, At, Bt) do { __builtin_amdgcn_s_setprio(1); _Pragma("unroll") for (int m = 0; m < 4; ++m) _Pragma("unroll") for (int n = 0; n < 2; ++n) _Pragma("unroll") for (int k = 0; k < 2; ++k) \
        { if constexpr (I8) acc[ai][bj][m][n] = __builtin_bit_cast(f32x4, __builtin_amdgcn_mfma_i32_16x16x64_i8(__builtin_bit_cast(i32x4, Bt[n][k]), __builtin_bit_cast(i32x4, At[m][k]), __builtin_bit_cast(i32x4, acc[ai][bj][m][n]), 0, 0, 0)); \
          else acc[ai][bj][m][n] = __builtin_amdgcn_mfma_f32_16x16x32_f16(Bt[n][k], At[m][k], acc[ai][bj][m][n], 0, 0, 0); } __builtin_amdgcn_s_setprio(0); } while (0)
#define PG8_WAIT_V(n) asm volatile("s_waitcnt vmcnt(" #n ")" ::: "memory")
#define PG8_WAIT_L(n) asm volatile("s_waitcnt lgkmcnt(" #n ")" ::: "memory")
#define PG8_BAR __builtin_amdgcn_s_barrier()
#define PG8_SCHED __builtin_amdgcn_sched_barrier(0)
    Unit cur, nxt; int ui = 0;
    if (!S.next(0, cur)) return;
    f32x4 acc[2][2][4][2];
#pragma unroll
    for (int a = 0; a < 2; ++a)
#pragma unroll
        for (int b = 0; b < 2; ++b)
#pragma unroll
            for (int m = 0; m < 4; ++m)
#pragma unroll
                for (int n = 0; n < 2; ++n) acc[a][b][m][n] = (f32x4){0.f, 0.f, 0.f, 0.f};
    f16x8 At[4][2], B0[2][2], B1[2][2];
    unsigned cA = (unsigned)cur.pm * tstepA + (unsigned)(cur.pm >> 4) * g.gapA, cB = (unsigned)cur.pn * tstep;
    S.a_ready(cur);
    if constexpr (SP2) {
        PG8_STAGE(PG8_SB(0, 0), rsB, cB, voffB); PG8_STAGE(PG8_SB(0, 1), rsB, cB + hstep, voffB); PG8_STAGE(PG8_SA(0, 0), rsA, cA, voffA); PG8_STAGE(PG8_SA(0, 1), rsA, cA + hstepA, voffA);
        if (wr == 1) PG8_BAR;
        PG8_WAIT_V(2); PG8_BAR;
        PG8_STAGE(PG8_SB(1, 0), rsB, cB + kstep, voffB); PG8_STAGE(PG8_SA(1, 0), rsA, cA + kstepA, voffA); PG8_STAGE(PG8_SB(1, 1), rsB, cB + hstep + kstep, voffB);
        PG8_WAIT_V(6); PG8_BAR;
    } else {
        PG8_STAGE(PG8_SB(0, 0), rsB, cB, voffB); PG8_STAGE(PG8_SA(0, 0), rsA, cA, voffA); PG8_STAGE(PG8_SB(0, 1), rsB, cB + hstep, voffB); PG8_STAGE(PG8_SA(0, 1), rsA, cA + hstepA, voffA);
        if (wr == 1) PG8_BAR;
        PG8_WAIT_V(4); PG8_BAR;
        PG8_STAGE(PG8_SB(1, 0), rsB, cB + kstep, voffB); PG8_STAGE(PG8_SA(1, 0), rsA, cA + kstepA, voffA); PG8_STAGE(PG8_SB(1, 1), rsB, cB + hstep + kstep, voffB);
        PG8_WAIT_V(6); PG8_BAR;
    }
    for (;;) {
        const bool has_next = S.next(ui + 1, nxt);
        const unsigned nA = has_next ? (unsigned)nxt.pm * tstepA + (unsigned)(nxt.pm >> 4) * g.gapA : cA, nB = has_next ? (unsigned)nxt.pn * tstep : cB;
        for (int t = 0; t < nt; t += 2) {
            const bool last = (t == nt - 2);
            const unsigned a1 = cA + (unsigned)(t + 1) * kstepA;
            const unsigned a2 = last ? nA : cA + (unsigned)(t + 2) * kstepA, b2 = last ? nB : cB + (unsigned)(t + 2) * kstep;
            const unsigned a3 = a2 + kstepA, b3 = b2 + kstep;
            if (last && has_next) S.a_ready(nxt);
            if constexpr (SP2) {
            const int grace = __builtin_amdgcn_readfirstlane((PG8_GRACE && Epi::NSTORE > 0 && t == 0 && ui > 0) ? 1 : 0);
#define PG8_WAIT_VG do { if constexpr (PG8_GRACE && Epi::NSTORE > 0) asm volatile("s_cmp_lg_u32 %0, 0\n\ts_cbranch_scc1 .Lgr%=\n\ts_waitcnt vmcnt(8)\n.Lgr%=:\n\ts_waitcnt vmcnt(%1)" :: "s"(grace), "n"(8 + Epi::NSTORE) : "memory", "scc"); \
                         else PG8_WAIT_V(8); } while (0)
            PG8_LDB(B0, 0, 0); PG8_LDB(B1, 0, 1); PG8_SCHED; PG8_LDA(At, 0, 0); PG8_STAGE(PG8_SA(1, 1), rsA, a1 + hstepA, voffA);
            PG8_WAIT_VG; PG8_WAIT_L(0); PG8_BAR; PG8_MMA(0, 0, At, B0); PG8_MMA(0, 1, At, B1); PG8_BAR; PG8_SCHED;
            PG8_LDA(At, 0, 1); PG8_STAGE(PG8_SB(0, 0), rsB, b2, voffB); PG8_STAGE(PG8_SB(0, 1), rsB, b2 + hstep, voffB); PG8_STAGE(PG8_SA(0, 0), rsA, a2, voffA);
            PG8_WAIT_VG; PG8_WAIT_L(0); PG8_BAR; PG8_MMA(1, 0, At, B0); PG8_MMA(1, 1, At, B1); PG8_BAR; PG8_SCHED;
            PG8_LDB(B0, 1, 0); PG8_LDB(B1, 1, 1); PG8_SCHED; PG8_LDA(At, 1, 0); PG8_STAGE(PG8_SA(0, 1), rsA, a2 + hstepA, voffA);
            PG8_WAIT_VG; PG8_WAIT_L(0); PG8_BAR; PG8_MMA(0, 0, At, B0); PG8_MMA(0, 1, At, B1); PG8_BAR; PG8_SCHED;
            PG8_LDA(At, 1, 1); PG8_STAGE(PG8_SB(1, 0), rsB, b3, voffB); PG8_STAGE(PG8_SB(1, 1), rsB, b3 + hstep, voffB); PG8_STAGE(PG8_SA(1, 0), rsA, a3, voffA);
            PG8_WAIT_VG; PG8_WAIT_L(0); PG8_BAR; PG8_MMA(1, 0, At, B0); PG8_MMA(1, 1, At, B1); PG8_BAR; PG8_SCHED;
#undef PG8_WAIT_VG
            } else {
            PG8_LDB(B0, 0, 0); PG8_SCHED; PG8_LDA(At, 0, 0); PG8_STAGE(PG8_SA(1, 1), rsA, a1 + hstepA, voffA);
            PG8_WAIT_L(8); PG8_BAR; PG8_WAIT_L(0); PG8_MMA(0, 0, At, B0); PG8_BAR; PG8_SCHED;
            PG8_LDB(B1, 0, 1); PG8_STAGE(PG8_SB(0, 0), rsB, b2, voffB);
            PG8_BAR; PG8_WAIT_L(0); PG8_MMA(0, 1, At, B1); PG8_BAR;
            PG8_LDA(At, 0, 1); PG8_STAGE(PG8_SA(0, 0), rsA, a2, voffA);
            PG8_BAR; PG8_WAIT_L(0); PG8_MMA(1, 0, At, B0); PG8_BAR; PG8_SCHED;
            PG8_STAGE(PG8_SB(0, 1), rsB, b2 + hstep, voffB);
            PG8_WAIT_V(6); PG8_BAR; PG8_MMA(1, 1, At, B1); PG8_BAR;
            PG8_LDB(B0, 1, 0); PG8_SCHED; PG8_LDA(At, 1, 0); PG8_STAGE(PG8_SA(0, 1), rsA, a2 + hstepA, voffA);
            PG8_WAIT_L(8); PG8_BAR; PG8_WAIT_L(0); PG8_MMA(0, 0, At, B0); PG8_BAR; PG8_SCHED;
            PG8_LDB(B1, 1, 1); PG8_STAGE(PG8_SB(1, 0), rsB, b3, voffB);
            PG8_BAR; PG8_WAIT_L(0); PG8_MMA(0, 1, At, B1); PG8_BAR;
            PG8_LDA(At, 1, 1); PG8_STAGE(PG8_SA(1, 0), rsA, a3, voffA);
            PG8_BAR; PG8_WAIT_L(0); PG8_MMA(1, 0, At, B0); PG8_BAR; PG8_SCHED;
            PG8_STAGE(PG8_SB(1, 1), rsB, b3 + hstep, voffB);
            PG8_WAIT_V(6); PG8_BAR; PG8_MMA(1, 1, At, B1); PG8_BAR;
            }
        }
        if constexpr (ALIGN_EPI) { if (wr == 0) PG8_BAR; }
        if constexpr (!Epi::AFTER_DRAIN) { E(acc, cur, wr, wc, fr, fq); S.done(cur); }
        if (!has_next) break;
#pragma unroll
        for (int a = 0; a < 2; ++a)
#pragma unroll
            for (int b = 0; b < 2; ++b)
#pragma unroll
                for (int m = 0; m < 4; ++m)
#pragma unroll
                    for (int n = 0; n < 2; ++n) acc[a][b][m][n] = (f32x4){0.f, 0.f, 0.f, 0.f};
        cur = nxt; cA = nA; cB = nB; ++ui;
        if constexpr (ALIGN_EPI) { if (wr == 1) PG8_BAR; }
    }
    PG8_WAIT_V(0);
    if constexpr (!ALIGN_EPI) { if (wr == 0) PG8_BAR; }
    PG8_BAR;
#undef PG8_SA
#undef PG8_SB
#undef PG8_STAGE
#undef PG8_LDA
#undef PG8_LDB
#undef PG8_MMA
#undef PG8_WAIT_V
#undef PG8_WAIT_L
#undef PG8_BAR
#undef PG8_SCHED
}
}

constexpr size_t MiB = 1u << 20;
constexpr size_t WS_CTL = 0, CTL_ZERO_BYTES = 1 * MiB;
constexpr size_t WS_MOD = 1 * MiB;
constexpr size_t WS_MISC = 2 * MiB;
constexpr size_t WS_WIN = 4 * MiB;
constexpr size_t WS_WG = 18 * MiB;
constexpr size_t WS_WA = 30 * MiB;
constexpr size_t WS_WBC = 32 * MiB;
constexpr size_t WS_WC = 34 * MiB;
constexpr size_t WS_WO = 36 * MiB;
constexpr size_t WS_W1 = 40 * MiB;
constexpr size_t WS_W2 = 56 * MiB;
constexpr size_t WS_U = 72 * MiB;
constexpr size_t WS_KVN = 136 * MiB;
constexpr size_t WS_MASK = 144 * MiB;
constexpr size_t WS_OA = 152 * MiB;
constexpr size_t WS_OB = 184 * MiB;
constexpr size_t WS_OC = 216 * MiB;
constexpr size_t WS_R1 = 232 * MiB;
constexpr size_t WS_SS = 488 * MiB;
constexpr size_t WS_WQG = 490 * MiB;
constexpr size_t WS_WQIN = 496 * MiB;
constexpr size_t WS_WQ1 = 503 * MiB;
constexpr size_t WS_END = 511 * MiB;
constexpr size_t WS_CVEC = WS_MISC + 256 * 1024;
constexpr size_t WS_SB = WS_MISC + 1792 * 1024;
constexpr int CW_CMAX = 65536  , CW_RF = 131072  ;
constexpr int CW_TMO = 0, CW_BAR = 4096, CW_QUEUE = 16384;

constexpr int NWAVES = 8;
constexpr int RING_BYTES = 131072, LDSCTL_OFF = 139264, MISC_OFF = LDSCTL_OFF + 320, LDS_BYTES = LDSCTL_OFF + 24576;

#define RLX_AGENT __ATOMIC_RELAXED, __HIP_MEMORY_SCOPE_AGENT
#define LDS_WAIT() asm volatile("s_waitcnt lgkmcnt(0)" ::: "memory")

#define XB_TMO      128
#define XB_XCNT(j)  (256  + 64 * (j))
#define XB_XSUB(j)  (1280 + 64 * (j))
#define XB_XGEN(j)  (2304 + 64 * (j))
#define XB_TOP      3328
#define XB_TOPGEN   3392
#define XCD_BAR_WORDS 3456
#define XB_SPIN_CAP (1u << 22)
__device__ __forceinline__ unsigned xb_ld(unsigned* p)              { return __hip_atomic_load(p, __ATOMIC_RELAXED, __HIP_MEMORY_SCOPE_AGENT); }
__device__ __forceinline__ unsigned xb_add(unsigned* p, unsigned v) { return __hip_atomic_fetch_add(p, v, __ATOMIC_RELAXED, __HIP_MEMORY_SCOPE_AGENT); }
__device__ __forceinline__ unsigned xb_xcc_id() { return (unsigned)__builtin_amdgcn_s_getreg((3 << 11) | 20) & 0xFu; }
__device__ __forceinline__ int xq_take(unsigned* ctr, const int per, volatile LAS unsigned* misc) {
    __syncthreads();
    if (threadIdx.x == 0) { unsigned q = misc[17]; int res = -1; const unsigned x = xb_xcc_id();
        while (q < 8u) { const unsigned xx = (x + q) & 7u; const unsigned v = __hip_atomic_fetch_add(ctr + 64 * xx, 1u, __ATOMIC_RELAXED, __HIP_MEMORY_SCOPE_AGENT);
            if (v < (unsigned)per) { res = (int)(xx * (unsigned)per + v); break; } ++q; }
        misc[17] = q; misc[16] = (unsigned)res; }
    __syncthreads();
    return __builtin_amdgcn_readfirstlane((int)misc[16]);
}
__device__ __forceinline__ int unit_pick(const int k, const int per, unsigned* ctr, volatile LAS unsigned* misc) {
    if (gridDim.x == 256u) { __syncthreads(); if (k >= (per >> 5)) return -1;
        const int s_ = (int)(blockIdx.x >> 3), x_ = (int)(blockIdx.x & 7u); return x_ * per + (k >> 1) * 64 + ((k & 1) ? 63 - s_ : s_); }
    return xq_take(ctr, per, misc);
}
#define XB_SPIN(cond, bar) do { unsigned _sp = 0; while (cond) { __builtin_amdgcn_s_sleep(1); \
    if ((++_sp & 255u) == 0u) { if (xb_ld(&(bar)[XB_TMO])) break; if (_sp > XB_SPIN_CAP) { atomicAdd(&(bar)[XB_TMO], 1u); break; } } } } while (0)
struct XcdBarrier { unsigned* bar; unsigned x; volatile LAS unsigned* st; };
__device__ __forceinline__ XcdBarrier xcd_barrier_post(unsigned* bar, volatile LAS unsigned* st, int wave) {
    XcdBarrier b; b.bar = bar; b.x = xb_xcc_id(); b.st = st;
    if (wave == 0 && lane_id() == 0) (void)xb_add(&bar[XB_XCNT(b.x)], 1u);
    return b;
}
__device__ __forceinline__ void xcd_barrier_complete(unsigned* bar, unsigned x, unsigned& nloc, unsigned& nx) {
    const unsigned G = gridDim.x * gridDim.y * gridDim.z;
    unsigned sum, cnt, mine, sp = 0u;
    for (;;) {
        sum = 0u; cnt = 0u; mine = 0u;
#pragma unroll
        for (unsigned j = 0; j < 16; ++j) { const unsigned c = xb_ld(&bar[XB_XCNT(j)]); sum += c; cnt += (c > 0u) ? 1u : 0u; mine = (j == x) ? c : mine; }
        if (sum == G) break;
        __builtin_amdgcn_s_sleep(1);
        if ((++sp & 255u) == 0u) { if (xb_ld(&bar[XB_TMO])) break; if (sp > XB_SPIN_CAP) { atomicAdd(&bar[XB_TMO], 1u); break; } }
    }
    nloc = mine > 0u ? mine : 1u; nx = cnt > 0u ? cnt : 1u;
}
__device__ __forceinline__ void xcd_barrier(const XcdBarrier& b, int wave) {
    asm volatile("s_waitcnt vmcnt(0)" ::: "memory");
    __syncthreads();
    if (wave == 0 && lane_id() == 0) {
        unsigned* bar = b.bar; asm volatile("" : "+s"(bar)); unsigned bx = b.x; asm volatile("" : "+s"(bx));
        __builtin_amdgcn_s_waitcnt(0);
        unsigned nloc = b.st[0], nx = b.st[1];
        if (nloc == 0u) { xcd_barrier_complete(bar, bx, nloc, nx); b.st[0] = nloc; b.st[1] = nx; }
        const unsigned old = xb_add(&bar[XB_XSUB(bx)], 1u);
        const unsigned gen = old / nloc;
        if (old + 1u == (gen + 1u) * nloc) {
            __builtin_amdgcn_fence(__ATOMIC_RELEASE, "agent");
            asm volatile("s_waitcnt vmcnt(0)" ::: "memory");
            const unsigned og = xb_add(&bar[XB_TOP], 1u);
            const unsigned tg = og / nx;
            __builtin_amdgcn_fence(__ATOMIC_ACQUIRE, "agent");
            if (og + 1u == (tg + 1u) * nx) xb_add(&bar[XB_TOPGEN], 1u);
            else XB_SPIN(xb_ld(&bar[XB_TOPGEN]) == tg, bar);
            xb_add(&bar[XB_XGEN(bx)], 1u);
            asm volatile("s_waitcnt vmcnt(0)" ::: "memory");
        } else {
            __builtin_amdgcn_fence(__ATOMIC_ACQUIRE, "agent");
            XB_SPIN(xb_ld(&bar[XB_XGEN(bx)]) == gen, bar);
            asm volatile("s_waitcnt vmcnt(0)" ::: "memory");
        }
    }
    __syncthreads();
}

constexpr int CW_LB = 200000;
__device__ __forceinline__ void xcd_local_barrier(unsigned* lb, const XcdBarrier& b, int wave) {
    asm volatile("s_waitcnt vmcnt(0)" ::: "memory");
    __syncthreads();
    if (wave == 0 && lane_id() == 0) {
        unsigned* lbp = lb; asm volatile("" : "+s"(lbp));
        const unsigned x = blockIdx.x & 7u; unsigned* cnt = lbp + 64u * x; unsigned* gen = lbp + 64u * (8u + x);
        __builtin_amdgcn_s_waitcnt(0);
        const unsigned g = b.st[3];
        const unsigned old = xb_add(cnt, 1u);
        __builtin_amdgcn_fence(__ATOMIC_ACQUIRE, "agent");
        if (old + 1u == (g + 1u) * 32u) xb_add(gen, 1u);
        else XB_SPIN(xb_ld(gen) == g, b.bar);
        b.st[3] = g + 1u;
        asm volatile("s_waitcnt vmcnt(0)" ::: "memory");
    }
    __syncthreads();
}
__device__ __forceinline__ float wave_sum(float v) {
#pragma unroll
    for (int o = 1; o < 64; o <<= 1) v += __shfl_xor(v, o);
    return v;
}
__device__ __forceinline__ float wave_max(float v) {
#pragma unroll
    for (int o = 1; o < 64; o <<= 1) v = fmaxf(v, __shfl_xor(v, o));
    return v;
}
__device__ __forceinline__ int wave_isum(int v) {
#pragma unroll
    for (int o = 1; o < 64; o <<= 1) v += __shfl_xor(v, o);
    return v;
}

__device__ __forceinline__ int t5_bucket(int n) {
    if (n < 16) return n;
    if (n >= 113) return 31;
    const int first[16] = {16, 19, 21, 24, 27, 31, 35, 40, 46, 52, 59, 67, 77, 87, 99, 113};
    int b = 16;
#pragma unroll
    for (int i = 1; i < 16; ++i) b += (n >= first[i]) ? 1 : 0;
    return b;
}

struct Frame {
    LAS unsigned char* lds;
    int wave, gw, NGW, G;
};

template <class ScaleFn>
__device__ __forceinline__ void transpose_item(const float* W, int ldw, int col0, int nvalid, int K, f16* WT, int nblk, LAS float* scr, int item, int lane, ScaleFn sf, unsigned* cmax = nullptr) {
    const int kb = item / nblk, nb = item % nblk, k0 = 64 * kb, n0 = 32 * nb;
    const int nn = n0 + (lane & 31);
    const bool ok = nn < nvalid;
    const float sc = sf(nn);
    float wv[32];
#pragma unroll
    for (int i = 0; i < 32; ++i) { const int kk = 2 * i + (lane >> 5); wv[i] = ok ? *(const GAS float*)(W + (size_t)(k0 + kk) * ldw + col0 + nn) : 0.f; }
#pragma unroll
    for (int i = 0; i < 32; ++i) { const int kk = 2 * i + (lane >> 5); scr[kk * 33 + (lane & 31)] = wv[i] * sc; }
    if (cmax) { float mx = 0.f;
#pragma unroll
        for (int i = 0; i < 32; ++i) mx = fmaxf(mx, __builtin_fabsf(wv[i] * sc));
        mx = fmaxf(mx, __shfl_xor(mx, 32));
        if (lane < 32) __hip_atomic_fetch_max(cmax + nn, __float_as_uint(mx), __ATOMIC_RELAXED, __HIP_MEMORY_SCOPE_AGENT); }
    LDS_WAIT(); asm volatile("" ::: "memory");
    const int c = lane & 7;
#pragma unroll
    for (int j = 0; j < 4; ++j) { const int n = (lane >> 3) + 8 * j; const LAS float* s = scr + (8 * c) * 33 + n;
        u32x4 o; o.x = pk2h(s[0 * 33], s[1 * 33]); o.y = pk2h(s[2 * 33], s[3 * 33]); o.z = pk2h(s[4 * 33], s[5 * 33]); o.w = pk2h(s[6 * 33], s[7 * 33]);
        *(u32x4*)(WT + (size_t)(n0 + n) * K + k0 + 8 * c) = o; }
    LDS_WAIT(); asm volatile("" ::: "memory");
}
struct TItem { const float* W; int ldw, col0, nvalid, K; f16* WT; int nblk; unsigned* cmax; int item; bool scale_in, tiled; };
struct ScaleOne { __device__ __forceinline__ float operator()(int) const { return 1.f; } };
struct ScaleIn {
    __device__ __forceinline__ float operator()(int n) const {
        if (n < 512) return 0.125f * LOG2E;
        if (n >= C_BQ && n < C_BKV) return 0.08838834764831845f * LOG2E;
        if (n >= C_CQ && n < C_CK) return 0.125f * LOG2E;
        return 1.f; }
};
__device__ __forceinline__ void titem_load(const TItem& d, int lane, float (&wv)[32], float& sc) {
    const int kb = d.item / d.nblk, nb = d.item % d.nblk, k0 = 64 * kb, nn = 32 * nb + (lane & 31);
    const bool ok = nn < d.nvalid;
    sc = d.scale_in ? ScaleIn()(nn) : 1.f;
#pragma unroll
    for (int i = 0; i < 32; ++i) { const int kk = 2 * i + (lane >> 5); wv[i] = ok ? *(const GAS float*)(d.W + (size_t)(k0 + kk) * d.ldw + d.col0 + nn) : 0.f; }
}
__device__ __forceinline__ void titem_store(const TItem& d, int lane, const float (&wv)[32], const float sc, LAS float* scr) {
    const int kb = d.item / d.nblk, nb = d.item % d.nblk, k0 = 64 * kb, n0 = 32 * nb, nn = n0 + (lane & 31);
#pragma unroll
    for (int i = 0; i < 32; ++i) { const int kk = 2 * i + (lane >> 5); scr[kk * 33 + (lane & 31)] = wv[i] * sc; }
    if (d.cmax) { float mx = 0.f;
#pragma unroll
        for (int i = 0; i < 32; ++i) mx = fmaxf(mx, __builtin_fabsf(wv[i] * sc));
        mx = fmaxf(mx, __shfl_xor(mx, 32));
        if (lane < 32) __hip_atomic_fetch_max(d.cmax + nn, __float_as_uint(mx), __ATOMIC_RELAXED, __HIP_MEMORY_SCOPE_AGENT); }
    LDS_WAIT(); asm volatile("" ::: "memory");
    const int c = lane & 7;
#pragma unroll
    for (int j = 0; j < 4; ++j) { const int n = (lane >> 3) + 8 * j; const LAS float* sp = scr + (8 * c) * 33 + n;
        u32x4 o; o.x = pk2h(sp[0 * 33], sp[1 * 33]); o.y = pk2h(sp[2 * 33], sp[3 * 33]); o.z = pk2h(sp[4 * 33], sp[5 * 33]); o.w = pk2h(sp[6 * 33], sp[7 * 33]);
        if (d.tiled) *(u32x4*)(d.WT + ((size_t)(((n0 + n) >> 8) * (d.K >> 6) + kb) * 256 + ((n0 + n) & 255)) * 64 + 8 * c) = o;
        else *(u32x4*)(d.WT + (size_t)(n0 + n) * d.K + k0 + 8 * c) = o; }
    LDS_WAIT(); asm volatile("" ::: "memory");
}

__device__ __forceinline__ void norm_row_pre(const float* xrow, const float* g, const float* scale, f16* orow, f16* x16row, float* ssrow, int lane) {
    const f32x4* xr = (const f32x4*)xrow + lane;
    f32x4 v[4]; float s = 0.f;
#pragma unroll
    for (int j = 0; j < 4; ++j) { v[j] = xr[64 * j]; s += (v[j].x * v[j].x + v[j].y * v[j].y) + (v[j].z * v[j].z + v[j].w * v[j].w); }
    s = wave_sum(s);
#pragma unroll
    for (int j = 0; j < 4; ++j) {
        const f32x4 gv = ((const f32x4*)g)[lane + 64 * j], sc = ((const f32x4*)scale)[lane + 64 * j];
        const f32x4 y = v[j] * gv * (sc + 1.f);
        u32x2 w; w.x = pk2h(y.x, y.y); w.y = pk2h(y.z, y.w);
        ((u32x2*)orow)[lane + 64 * j] = w;
        u32x2 wx; wx.x = pk2h(v[j].x, v[j].y); wx.y = pk2h(v[j].z, v[j].w);
        ((u32x2*)x16row)[lane + 64 * j] = wx; }
    if (lane < 4) ((f32x4*)ssrow)[lane] = (f32x4){lane == 0 ? s : 0.f, 0.f, 0.f, 0.f};
}

__device__ __forceinline__ void nq_gain(const float* g, const float* scale, int lane, float (&gl)[16]) {
#pragma unroll
    for (int c = 0; c < 2; ++c)
#pragma unroll
        for (int h = 0; h < 2; ++h) { const f32x4 gv = *(const GAS f32x4*)(g + 512 * c + 8 * lane + 4 * h), sc = *(const GAS f32x4*)(scale + 512 * c + 8 * lane + 4 * h);
#pragma unroll
            for (int e = 0; e < 4; ++e) gl[8 * c + 4 * h + e] = gv[e] * (sc[e] + 1.f); }
}
__device__ __forceinline__ void nq_finish(const float (&y)[16], float ss, float am, unsigned char* qrow, float* rowfac, int lane) {
    ss = wave_sum(ss); am = wave_max(am);
    const float inv = am > 0.f ? 127.f / am : 0.f;
#pragma unroll
    for (int c = 0; c < 2; ++c) { u32x2 pk; pk.x = 0u; pk.y = 0u;
#pragma unroll
        for (int e = 0; e < 4; ++e) { pk.x |= ((unsigned)(int)__builtin_rintf(y[8 * c + e] * inv) & 255u) << (8 * e); pk.y |= ((unsigned)(int)__builtin_rintf(y[8 * c + 4 + e] * inv) & 255u) << (8 * e); }
        *(GAS u32x2*)(qrow + 512 * c + 8 * lane) = pk; }
    if (lane == 0) *rowfac = am * (1.f / 127.f) * __builtin_amdgcn_rsqf(ss * (1.f / DM) + EPS);
}
__device__ __forceinline__ void norm_quant_rows16(const f16* x16, const float* g, const float* scale, unsigned char* q8, float* rowfac, int m0, int lane) {
    float gl[16]; nq_gain(g, scale, lane, gl);
    u32x4 nx[2];
#pragma unroll
    for (int c = 0; c < 2; ++c) nx[c] = *(const GAS u32x4*)(x16 + (size_t)m0 * DM + 512 * c + 8 * lane);
#pragma unroll 1
    for (int r = 0; r < 16; ++r) { const int m = m0 + r;
        const f16x8 xa = __builtin_bit_cast(f16x8, nx[0]), xb = __builtin_bit_cast(f16x8, nx[1]);
        if (r + 1 < 16) {
#pragma unroll
            for (int c = 0; c < 2; ++c) nx[c] = *(const GAS u32x4*)(x16 + (size_t)(m + 1) * DM + 512 * c + 8 * lane); }
        float y[16]; float ss = 0.f, am = 0.f;
#pragma unroll
        for (int e = 0; e < 8; ++e) { const float x0 = (float)xa[e], x1 = (float)xb[e]; ss += x0 * x0 + x1 * x1; y[e] = x0 * gl[e]; y[8 + e] = x1 * gl[8 + e]; am = fmaxf(am, fmaxf(__builtin_fabsf(y[e]), __builtin_fabsf(y[8 + e]))); }
        nq_finish(y, ss, am, q8 + (size_t)m * DM, rowfac + m, lane); }
}
__device__ __forceinline__ void norm_quant_rows16_0(const float* x, const float* g, const float* scale, f16* x16, unsigned char* q8, float* rowfac, int m0, int lane) {
    float gl[16]; nq_gain(g, scale, lane, gl);
    f32x4 nx[4];
#pragma unroll
    for (int c = 0; c < 2; ++c)
#pragma unroll
        for (int h = 0; h < 2; ++h) nx[2 * c + h] = *(const GAS f32x4*)(x + (size_t)m0 * DM + 512 * c + 8 * lane + 4 * h);
#pragma unroll 1
    for (int r = 0; r < 16; ++r) { const int m = m0 + r;
        f32x4 xa[4];
#pragma unroll
        for (int i = 0; i < 4; ++i) xa[i] = nx[i];
        if (r + 1 < 16) {
#pragma unroll
            for (int c = 0; c < 2; ++c)
#pragma unroll
                for (int h = 0; h < 2; ++h) nx[2 * c + h] = *(const GAS f32x4*)(x + (size_t)(m + 1) * DM + 512 * c + 8 * lane + 4 * h); }
        float y[16]; float ss = 0.f, am = 0.f;
#pragma unroll
        for (int c = 0; c < 2; ++c) { u32x4 w; w.x = pk2h(xa[2 * c].x, xa[2 * c].y); w.y = pk2h(xa[2 * c].z, xa[2 * c].w); w.z = pk2h(xa[2 * c + 1].x, xa[2 * c + 1].y); w.w = pk2h(xa[2 * c + 1].z, xa[2 * c + 1].w);
            *(GAS u32x4*)(x16 + (size_t)m * DM + 512 * c + 8 * lane) = w;
#pragma unroll
            for (int h = 0; h < 2; ++h)
#pragma unroll
                for (int e = 0; e < 4; ++e) { const float xx = xa[2 * c + h][e]; ss += xx * xx; const float v = xx * gl[8 * c + 4 * h + e]; y[8 * c + 4 * h + e] = v; am = fmaxf(am, __builtin_fabsf(v)); } }
        nq_finish(y, ss, am, q8 + (size_t)m * DM, rowfac + m, lane); }
}

template <int DQK, int DV>
__device__ __forceinline__ void naive_attn(LAS float* scl  , const f16* q, const f16* Kb, int kpitch, const f16* Vb, int vpitch, int t, unsigned sel, const float* tab, int lane, float (&o)[DV / 64]) {
    const int nslots = (t >> 6) + 1;
    float mx = -INFINITY;
#pragma unroll 1
    for (int j = 0; j < nslots; ++j) {
        float s = -INFINITY; const int k = 64 * j + lane;
        if (k <= t && ((sel >> j) & 1u)) {
            const f16* kr = Kb + (size_t)k * kpitch; float a = 0.f;
#pragma unroll 4
            for (int c = 0; c < DQK / 8; ++c) { const f16x8 kv = *(const f16x8*)(kr + 8 * c); const f16x8 qv = *(const f16x8*)(q + 8 * c);
#pragma unroll
                for (int e = 0; e < 8; ++e) a += (float)kv[e] * (float)qv[e]; }
            const int dist = t - k; s = a + tab[(dist < 128 ? dist : 128) + 255];
        }
        scl[k] = s; mx = fmaxf(mx, s);
    }
    mx = wave_max(mx);
    float l = 0.f;
#pragma unroll 1
    for (int j = 0; j < nslots; ++j) { const float p = __builtin_amdgcn_exp2f(scl[64 * j + lane] - mx); scl[64 * j + lane] = p; l += p; }
    l = wave_sum(l);
    const float inv = 1.f / l;
#pragma unroll
    for (int i = 0; i < DV / 64; ++i) o[i] = 0.f;
    LDS_WAIT(); asm volatile("" ::: "memory");
#pragma unroll 1
    for (int k = 0; k < 64 * nslots; k += 4) {
        const f32x4 p = *(const LAS f32x4*)(scl + k);
        if (p.x != 0.f || p.y != 0.f || p.z != 0.f || p.w != 0.f) { const f16* vr = Vb + (size_t)k * vpitch;
            float v[4][DV / 64];
#pragma unroll
            for (int r = 0; r < 4; ++r)
#pragma unroll
                for (int i = 0; i < DV / 64; ++i) v[r][i] = (float)vr[(size_t)r * vpitch + lane + 64 * i];
#pragma unroll
            for (int i = 0; i < DV / 64; ++i) o[i] += (p.x * v[0][i] + p.y * v[1][i]) + (p.z * v[2][i] + p.w * v[3][i]); }
    }
#pragma unroll
    for (int i = 0; i < DV / 64; ++i) o[i] *= inv;
    LDS_WAIT(); asm volatile("" ::: "memory");
}

__device__ __forceinline__ unsigned char* launder(unsigned char* p) { asm volatile("" : "+s"(p)); return p; }
__device__ __forceinline__ int launder_i(int v) { asm volatile("" : "+s"(v)); return v; }
constexpr int PTAB_OFF = LDSCTL_OFF + 512;
__device__ __forceinline__ const float* inptr(LAS unsigned char* lds, int i) {
    unsigned saddr = (unsigned)(uintptr_t)(lds + PTAB_OFF) + 8u * (unsigned)i, addr;
    asm volatile("v_mov_b32 %0, %1" : "=v"(addr) : "s"(saddr));
    const unsigned long long v = *(volatile LAS unsigned long long*)(uintptr_t)addr;
    const unsigned lo = __builtin_amdgcn_readfirstlane((unsigned)v), hi = __builtin_amdgcn_readfirstlane((unsigned)(v >> 32));
    return (const float*)(((unsigned long long)hi << 32) | lo);
}
__device__ __forceinline__ unsigned ordkey(float f) { const unsigned u = __float_as_uint(f); return u ^ ((unsigned)((int)u >> 31) | 0x80000000u); }

namespace fa {
typedef float f32x16 __attribute__((ext_vector_type(16)));
typedef short v4i16_t __attribute__((ext_vector_type(4)));
__device__ __forceinline__ int crow(int r, int hi) { return (r & 3) + 8 * (r >> 2) + 4 * hi; }
constexpr int TAB_OFF = 139264 + 1024;
constexpr int SUB_OFF = TAB_OFF + 10240;
constexpr int STASH_OFF = 73728;
template <int DQK, int DV, bool KVSAME> struct Lay {
    static constexpr int RSK = DQK * 2 + 16, RSV = DV * 2 + 64;
    static constexpr int KBUF = 64 * RSK, VBUF = 64 * RSV;
    static constexpr int VOFF0 = 2 * KBUF, END = 2 * KBUF + 2 * VBUF;
    static constexpr int NKC = DQK / 64, NVC = KVSAME ? 0 : DV / 64;
    static_assert(END <= 77824, "attention LDS map");
};
__device__ __forceinline__ f16x8 pack8(const f32x16& p, int b) {
    u32x4 w; w.x = pk2h(p[b + 0], p[b + 1]); w.y = pk2h(p[b + 2], p[b + 3]); w.z = pk2h(p[b + 4], p[b + 5]); w.w = pk2h(p[b + 6], p[b + 7]);
    return __builtin_bit_cast(f16x8, w);
}
__device__ __forceinline__ float psum8(const f16x8& p, float acc) {
    typedef _Float16 h2_t __attribute__((ext_vector_type(2)));
    const u32x4 w = __builtin_bit_cast(u32x4, p); const unsigned w0 = w.x, w1 = w.y, w2 = w.z, w3 = w.w; const h2_t one = {(_Float16)1.f, (_Float16)1.f};
    acc = __builtin_amdgcn_fdot2(__builtin_bit_cast(h2_t, w0), one, acc, false); acc = __builtin_amdgcn_fdot2(__builtin_bit_cast(h2_t, w1), one, acc, false);
    acc = __builtin_amdgcn_fdot2(__builtin_bit_cast(h2_t, w2), one, acc, false); acc = __builtin_amdgcn_fdot2(__builtin_bit_cast(h2_t, w3), one, acc, false);
    return acc;
}
__device__ __forceinline__ float max3f(float a, float b, float c) { float r; asm("v_max3_f32 %0, %1, %2, %3" : "=v"(r) : "v"(a), "v"(b), "v"(c)); return r; }
__device__ __forceinline__ float rowmax32(const f32x16& a, const f32x16& b) {
    float x = max3f(a[0], a[1], b[0]), y = max3f(a[2], a[3], b[1]); x = max3f(x, b[2], b[3]);
#pragma unroll
    for (int r = 4; r < 16; r += 4) { x = max3f(x, a[r], a[r + 1]); y = max3f(y, a[r + 2], a[r + 3]); x = max3f(x, b[r], b[r + 1]); y = max3f(y, b[r + 2], b[r + 3]); }
    return max3f(x, y, y);
}
__device__ __forceinline__ float half_max(float x) { const auto rr = __builtin_amdgcn_permlane32_swap(__float_as_uint(x), __float_as_uint(x), false, false); return fmaxf(__uint_as_float(rr[0]), __uint_as_float(rr[1])); }
__device__ __forceinline__ float half_sum(float x) { const auto rr = __builtin_amdgcn_permlane32_swap(__float_as_uint(x), __float_as_uint(x), false, false); return __uint_as_float(rr[0]) + __uint_as_float(rr[1]); }
template <int DQK, int DV, int MODE>
__device__ __forceinline__ void attn_pass(LAS unsigned char* lds, const int wave, const int lane,
        const f16* Qw, const int qpitch, const f16* Kg, const int kpitch, const f16* Vg, const int vpitch,
        const int ntiles, const int qpos0, const LAS float* tab, const unsigned selb, const int jblk, const unsigned* maskw,
        f32x16 (&o)[DV / 32]) {
    typedef Lay<DQK, DV, MODE == 2> L;
    constexpr int NB_ = DV / 32;
    const int r32 = lane & 31, hi = lane >> 5, tid = wave * 64 + lane;
    f16x8 qf[DQK / 16];
#pragma unroll
    for (int d0 = 0; d0 < DQK / 16; ++d0) qf[d0] = __builtin_bit_cast(f16x8, *(const GAS u32x4*)(Qw + (size_t)r32 * qpitch + d0 * 16 + hi * 8));
#pragma unroll
    for (int blk = 0; blk < NB_; ++blk)
#pragma unroll
        for (int r = 0; r < 16; ++r) o[blk][r] = 0.f;
    float m = -INFINITY, l = 0.f;
    u32x4 kreg[L::NKC], vreg[L::NVC > 0 ? L::NVC : 1];
    unsigned wnext = 0u;
#define FA_LOAD(kt_) do { \
        _Pragma("unroll") for (int c = 0; c < L::NKC; ++c) { const int id = tid + 512 * c, row = id / (DQK / 8), ch = id % (DQK / 8); \
            kreg[c] = *(const GAS u32x4*)(Kg + (size_t)((kt_) * 64 + row) * kpitch + ch * 8); } \
        _Pragma("unroll") for (int c = 0; c < L::NVC; ++c) { const int id = tid + 512 * c, row = id / (DV / 8), ch = id % (DV / 8); \
            vreg[c] = *(const GAS u32x4*)(Vg + (size_t)((kt_) * 64 + row) * vpitch + ch * 8); } \
        if (MODE == 2) wnext = *(const GAS unsigned*)(maskw + (kt_) * 64 + lane); } while (0)
#define FA_WRITE(buf_) do { \
        _Pragma("unroll") for (int c = 0; c < L::NKC; ++c) { const int id = tid + 512 * c, row = id / (DQK / 8), ch = id % (DQK / 8); \
            *(LAS u32x4*)(lds + (buf_) * L::KBUF + row * L::RSK + ch * 16) = kreg[c]; \
            if (MODE == 2) *(LAS u32x4*)(lds + L::VOFF0 + (buf_) * L::VBUF + row * L::RSV + ch * 16) = kreg[c]; } \
        _Pragma("unroll") for (int c = 0; c < L::NVC; ++c) { const int id = tid + 512 * c, row = id / (DV / 8), ch = id % (DV / 8); \
            *(LAS u32x4*)(lds + L::VOFF0 + (buf_) * L::VBUF + row * L::RSV + ch * 16) = vreg[c]; } } while (0)
#define FA_VREAD(dst_, ks_) do { _Pragma("unroll") for (int blk = 0; blk < NB_; ++blk) { \
        const v4i16_t a_ = __builtin_amdgcn_ds_read_tr16_b64_v4i16((LAS v4i16_t*)(vb + 16 * (ks_) * L::RSV + blk * 64)); \
        const v4i16_t b_ = __builtin_amdgcn_ds_read_tr16_b64_v4i16((LAS v4i16_t*)(vb + (16 * (ks_) + 8) * L::RSV + blk * 64)); \
        const f16x4 a4_ = __builtin_bit_cast(f16x4, a_), b4_ = __builtin_bit_cast(f16x4, b_); \
        dst_[blk] = (f16x8){a4_[0], a4_[1], a4_[2], a4_[3], b4_[0], b4_[1], b4_[2], b4_[3]}; } } while (0)
#define FA_PV(src_, ks_) do { _Pragma("unroll") for (int blk = 0; blk < NB_; ++blk) o[blk] = __builtin_amdgcn_mfma_f32_32x32x16_f16(src_[blk], pf[ks_], o[blk], 0, 0, 0); } while (0)
    FA_LOAD(0);
    unsigned wcur = wnext;
    FA_WRITE(0);
    __syncthreads();
#pragma unroll 1
    for (int kt = 0; kt < ntiles; ++kt) {
        const int cur = kt & 1;
        if (kt + 1 < ntiles) FA_LOAD(kt + 1);
        const int k0 = kt * 64;
        if (k0 <= qpos0 + 31) {
            f32x16 p0, p1;
            if (MODE == 2) {
                const unsigned nw = ~wcur;
#pragma unroll
                for (int r = 0; r < 16; ++r) { p0[r] = __uint_as_float((unsigned)__builtin_amdgcn_sbfe((int)nw, r, 1) & 0xff800000u); p1[r] = __uint_as_float((unsigned)__builtin_amdgcn_sbfe((int)nw, 16 + r, 1) & 0xff800000u); }
            } else if (MODE == 1) {
                const int n = kt >> 2; const float cv = (n == jblk || ((selb >> n) & 1u)) ? 0.f : -INFINITY;
#pragma unroll
                for (int r = 0; r < 16; ++r) { p0[r] = cv; p1[r] = cv; }
            } else {
#pragma unroll
                for (int r = 0; r < 16; ++r) { p0[r] = 0.f; p1[r] = 0.f; }
            }
            const LAS unsigned char* kb = lds + cur * L::KBUF + r32 * L::RSK + hi * 16;
            const LAS unsigned char* vb = lds + L::VOFF0 + cur * L::VBUF + (4 * hi + ((lane & 15) >> 2)) * L::RSV + (16 * ((lane >> 4) & 1) + 4 * (lane & 3)) * 2;
#pragma unroll
            for (int db = 0; db < DQK / 64; ++db) {
                f16x8 kf0[4], kf1[4];
#pragma unroll
                for (int d = 0; d < 4; ++d) { kf0[d] = *(const LAS f16x8*)(kb + (4 * db + d) * 32); kf1[d] = *(const LAS f16x8*)(kb + 32 * L::RSK + (4 * db + d) * 32); }
                __builtin_amdgcn_sched_barrier(0);
#pragma unroll
                for (int d = 0; d < 4; ++d) {
                    p0 = __builtin_amdgcn_mfma_f32_32x32x16_f16(kf0[d], qf[4 * db + d], p0, 0, 0, 0);
                    p1 = __builtin_amdgcn_mfma_f32_32x32x16_f16(kf1[d], qf[4 * db + d], p1, 0, 0, 0); }
                __builtin_amdgcn_sched_barrier(0);
            }
            f16x8 vfa[NB_], vfb[NB_];
            FA_VREAD(vfa, 0);
            __builtin_amdgcn_sched_barrier(0);
            if (qpos0 - (k0 + 63) < 128) {
                const int base = qpos0 + r32 - k0 - 4 * hi + 255;
#pragma unroll
                for (int r = 0; r < 16; ++r) { const int i0 = base - ((r & 3) + 8 * (r >> 2)), i1 = i0 - 32;
                    p0[r] += tab[i0 < 383 ? i0 : 383]; p1[r] += tab[i1 < 383 ? i1 : 383]; }
            }
            float rm = fmaxf(p0[0], p1[0]);
#pragma unroll
            for (int r = 1; r < 16; ++r) rm = fmaxf(rm, fmaxf(p0[r], p1[r]));
            rm = half_max(rm);
            const float mn = fmaxf(m, rm), mu = (mn == -INFINITY) ? 0.f : mn;
            if (__any(mn > m)) { const float al = __builtin_amdgcn_exp2f(m - mu); l *= al;
#pragma unroll
                for (int blk = 0; blk < NB_; ++blk)
#pragma unroll
                    for (int r = 0; r < 16; ++r) o[blk][r] *= al; }
            m = mn;
            float ls = 0.f;
#pragma unroll
            for (int r = 0; r < 16; ++r) { p0[r] = __builtin_amdgcn_exp2f(p0[r] - mu); p1[r] = __builtin_amdgcn_exp2f(p1[r] - mu); ls += p0[r] + p1[r]; }
            l += ls;
            f16x8 pf[4]; pf[0] = pack8(p0, 0); pf[1] = pack8(p0, 8); pf[2] = pack8(p1, 0); pf[3] = pack8(p1, 8);
            __builtin_amdgcn_sched_barrier(0);
            FA_VREAD(vfb, 1); FA_PV(vfa, 0); __builtin_amdgcn_sched_barrier(0);
            FA_VREAD(vfa, 2); FA_PV(vfb, 1); __builtin_amdgcn_sched_barrier(0);
            FA_VREAD(vfb, 3); FA_PV(vfa, 2); __builtin_amdgcn_sched_barrier(0);
            FA_PV(vfb, 3);
        }
        if (kt + 1 < ntiles) FA_WRITE(cur ^ 1);
        wcur = wnext;
        __syncthreads();
    }
#undef FA_LOAD
#undef FA_WRITE
#undef FA_VREAD
#undef FA_PV
    l = half_sum(l);
    const float inv = 1.f / l;
#pragma unroll
    for (int blk = 0; blk < NB_; ++blk)
#pragma unroll
        for (int r = 0; r < 16; ++r) o[blk][r] *= inv;
}
__device__ __forceinline__ int fsw8(int row) { return (row >> 1) & 7; }
__device__ __forceinline__ int fsw16(int row) { return ((row & 3) << 2) | ((row >> 2) & 3); }
__device__ __forceinline__ int fswv8(int row) { return ((row >> 1) & 1) << 2; }
template <int DQK, int DV, int MODE, int S> struct LayD {
    static constexpr int CPRK = DQK / 8, CPRV = DV / 8;
    static constexpr int KB = 64 * DQK * 2, VB = (MODE == 2) ? 0 : 64 * DV * 2, STG = KB + VB;
    static constexpr int PK = CPRK, PV = (MODE == 2) ? 0 : CPRV, NP = (PK + PV) / 8, NPW = NP + (MODE == 2 ? 1 : 0);
    static constexpr int MASKOFF = S * STG;
    static constexpr int END = MASKOFF + (MODE == 2 ? 8 * S * 256 : 0);
    __device__ static __forceinline__ int fk(int row) { return CPRK == 8 ? fsw8(row) : fsw16(row); }
    __device__ static __forceinline__ int fv(int row) { return MODE == 2 ? fsw16(row) : (CPRV == 8 ? fswv8(row) : fsw16(row)); }
};
#define FA_WAITV(n) asm volatile("s_waitcnt vmcnt(%0)" :: "n"(n) : "memory")
template <int DQK, int DV, int MODE, int S>
__device__ __forceinline__ void attn_pass_dma(LAS unsigned char* lds, const int wave, const int lane,
        const f16* Qw, const int qpitch, const f16* Kg, const int kpitch, const f16* Vg, const int vpitch,
        const int ntiles, const int qpos0, const LAS float* tab, const unsigned selb, const int jblk, const unsigned* maskw,
        f32x16 (&o)[DV / 32]) {
    typedef LayD<DQK, DV, MODE, S> L;
    constexpr int NB_ = DV / 32;
    const int r32 = lane & 31, hi = lane >> 5;
    f16x8 qf[DQK / 16];
#pragma unroll
    for (int d0 = 0; d0 < DQK / 16; ++d0) qf[d0] = __builtin_bit_cast(f16x8, *(const GAS u32x4*)(Qw + (size_t)r32 * qpitch + d0 * 16 + hi * 8));
#pragma unroll
    for (int blk = 0; blk < NB_; ++blk)
#pragma unroll
        for (int r = 0; r < 16; ++r) o[blk][r] = 0.f;
    float m = -INFINITY, l = 0.f;
    unsigned goff[L::NP];
#pragma unroll
    for (int c = 0; c < L::NP; ++c) { const int pc = wave + 8 * c;
        if (pc < L::PK) { const int s2 = 64 * pc + lane, row = s2 / L::CPRK, ch = (s2 % L::CPRK) ^ L::fk(row); goff[c] = (unsigned)(row * kpitch + ch * 8); }
        else { const int s2 = 64 * (pc - L::PK) + lane, row = s2 / L::CPRV, ch = (s2 % L::CPRV) ^ L::fv(row); goff[c] = (unsigned)(row * vpitch + ch * 8); } }
#define FA_ISSUE(kt_, st_) do { \
        if (MODE == 2) __builtin_amdgcn_global_load_lds((const GAS unsigned*)(maskw + (kt_) * 64 + lane), (LAS unsigned*)(lds + L::MASKOFF + (wave * S + (st_)) * 256), 4, 0, 0); \
        _Pragma("unroll") for (int c = 0; c < L::NP; ++c) { const int pc = wave + 8 * c; \
            if (pc < L::PK) __builtin_amdgcn_global_load_lds((const GAS unsigned*)(Kg + (size_t)(kt_) * 64 * kpitch + goff[c]), (LAS unsigned*)(lds + (st_) * L::STG + pc * 1024), 16, 0, 0); \
            else __builtin_amdgcn_global_load_lds((const GAS unsigned*)(Vg + (size_t)(kt_) * 64 * vpitch + goff[c]), (LAS unsigned*)(lds + (st_) * L::STG + L::KB + (pc - L::PK) * 1024), 16, 0, 0); } } while (0)
    int koff[DQK / 16];
#pragma unroll
    for (int d0 = 0; d0 < DQK / 16; ++d0) koff[d0] = (r32 * L::CPRK + ((2 * d0 + hi) ^ L::fk(r32))) * 16;
    int voff[2][NB_];
    { const int q = (lane & 15) >> 2, g1 = (lane >> 4) & 1, p = lane & 3;
#pragma unroll
      for (int sec = 0; sec < 2; ++sec)
#pragma unroll
        for (int blk = 0; blk < NB_; ++blk) { const int row = 4 * hi + q + 8 * sec; voff[sec][blk] = L::KB * (MODE == 2 ? 0 : 1) + (row * L::CPRV + ((4 * blk + 2 * g1 + (p >> 1)) ^ L::fv(row))) * 16 + 8 * (p & 1); } }
#define FA_VREADD(dst_, ks_) do { _Pragma("unroll") for (int blk = 0; blk < NB_; ++blk) { \
        const v4i16_t a_ = __builtin_amdgcn_ds_read_tr16_b64_v4i16((LAS v4i16_t*)(sb + voff[0][blk] + 16 * (ks_) * L::CPRV * 16)); \
        const v4i16_t b_ = __builtin_amdgcn_ds_read_tr16_b64_v4i16((LAS v4i16_t*)(sb + voff[1][blk] + 16 * (ks_) * L::CPRV * 16)); \
        const f16x4 a4_ = __builtin_bit_cast(f16x4, a_), b4_ = __builtin_bit_cast(f16x4, b_); \
        dst_[blk] = (f16x8){a4_[0], a4_[1], a4_[2], a4_[3], b4_[0], b4_[1], b4_[2], b4_[3]}; } } while (0)
#define FA_PVD(src_, ks_) do { _Pragma("unroll") for (int blk = 0; blk < NB_; ++blk) o[blk] = __builtin_amdgcn_mfma_f32_32x32x16_f16(src_[blk], pf[ks_], o[blk], 0, 0, 0); } while (0)
#pragma unroll
    for (int t0 = 0; t0 < S - 1; ++t0) if (t0 < ntiles) FA_ISSUE(t0, t0);
    int st = 0, sti = S - 1;
#pragma unroll 1
    for (int kt = 0; kt < ntiles; ++kt) {
        if (kt + S - 2 < ntiles) FA_WAITV(L::NPW * (S - 2)); else FA_WAITV(0);
        __builtin_amdgcn_s_barrier();
        asm volatile("" ::: "memory");
        if (kt + S - 1 < ntiles) FA_ISSUE(kt + S - 1, sti);
        const int k0 = kt * 64;
        if (k0 <= qpos0 + 31) {
            const LAS unsigned char* sb = lds + st * L::STG;
            f32x16 p0, p1;
            if (MODE == 2) {
                const unsigned nw = ~*(const LAS unsigned*)(lds + L::MASKOFF + (wave * S + st) * 256 + lane * 4);
#pragma unroll
                for (int r = 0; r < 16; ++r) { p0[r] = __uint_as_float((unsigned)__builtin_amdgcn_sbfe((int)nw, r, 1) & 0xff800000u); p1[r] = __uint_as_float((unsigned)__builtin_amdgcn_sbfe((int)nw, 16 + r, 1) & 0xff800000u); }
            } else if (MODE == 1) {
                const int n = kt >> 2; const float cv = (n == jblk || ((selb >> n) & 1u)) ? 0.f : -INFINITY;
#pragma unroll
                for (int r = 0; r < 16; ++r) { p0[r] = cv; p1[r] = cv; }
            } else {
#pragma unroll
                for (int r = 0; r < 16; ++r) { p0[r] = 0.f; p1[r] = 0.f; }
            }
#pragma unroll
            for (int db = 0; db < DQK / 64; ++db) {
                f16x8 kf0[4], kf1[4];
#pragma unroll
                for (int d = 0; d < 4; ++d) { kf0[d] = *(const LAS f16x8*)(sb + koff[4 * db + d]); kf1[d] = *(const LAS f16x8*)(sb + koff[4 * db + d] + 32 * L::CPRK * 16); }
                __builtin_amdgcn_sched_barrier(0);
#pragma unroll
                for (int d = 0; d < 4; ++d) {
                    p0 = __builtin_amdgcn_mfma_f32_32x32x16_f16(kf0[d], qf[4 * db + d], p0, 0, 0, 0);
                    p1 = __builtin_amdgcn_mfma_f32_32x32x16_f16(kf1[d], qf[4 * db + d], p1, 0, 0, 0); }
                __builtin_amdgcn_sched_barrier(0);
            }
            f16x8 vfa[NB_], vfb[NB_];
            FA_VREADD(vfa, 0);
            __builtin_amdgcn_sched_barrier(0);
            if (qpos0 - (k0 + 63) < 128) {
                const int j0 = 224 - (qpos0 + r32 - k0 - 4 * hi), sf = j0 & 1; const LAS float* rp = tab + sf * TAB2 + (j0 - sf);
#pragma unroll
                for (int g = 0; g < 4; ++g) { const f32x2 x0 = *(const LAS f32x2*)(rp + 8 * g), x1 = *(const LAS f32x2*)(rp + 8 * g + 2), y0 = *(const LAS f32x2*)(rp + 32 + 8 * g), y1 = *(const LAS f32x2*)(rp + 34 + 8 * g);
                    p0[4 * g] += x0.x; p0[4 * g + 1] += x0.y; p0[4 * g + 2] += x1.x; p0[4 * g + 3] += x1.y; p1[4 * g] += y0.x; p1[4 * g + 1] += y0.y; p1[4 * g + 2] += y1.x; p1[4 * g + 3] += y1.y; }
            }
            float rm = rowmax32(p0, p1);
            rm = half_max(rm);
            if (__any(rm > m + 8.f)) { const float mn = fmaxf(m, rm), mu2 = (mn == -INFINITY) ? 0.f : mn; const float al = __builtin_amdgcn_exp2f(m - mu2); l *= al; m = mn;
#pragma unroll
                for (int blk = 0; blk < NB_; ++blk)
#pragma unroll
                    for (int r = 0; r < 16; ++r) o[blk][r] *= al; }
            const float mu = (m == -INFINITY) ? 0.f : m;
            float ls = 0.f;
#pragma unroll
            for (int r = 0; r < 16; ++r) { p0[r] = __builtin_amdgcn_exp2f(p0[r] - mu); p1[r] = __builtin_amdgcn_exp2f(p1[r] - mu); ls += p0[r] + p1[r]; }
            l += ls;
            f16x8 pf[4]; pf[0] = pack8(p0, 0); pf[1] = pack8(p0, 8); pf[2] = pack8(p1, 0); pf[3] = pack8(p1, 8);
            __builtin_amdgcn_sched_barrier(0);
            FA_VREADD(vfb, 1); FA_PVD(vfa, 0); __builtin_amdgcn_sched_barrier(0);
            FA_VREADD(vfa, 2); FA_PVD(vfb, 1); __builtin_amdgcn_sched_barrier(0);
            FA_VREADD(vfb, 3); FA_PVD(vfa, 2); __builtin_amdgcn_sched_barrier(0);
            FA_PVD(vfb, 3);
        }
        st = (st + 1 == S) ? 0 : st + 1; sti = (sti + 1 == S) ? 0 : sti + 1;
    }
    asm volatile("s_waitcnt lgkmcnt(0)" ::: "memory");
    __builtin_amdgcn_s_barrier();
    asm volatile("" ::: "memory");
#undef FA_ISSUE
#undef FA_VREADD
#undef FA_PVD
    l = half_sum(l);
    const float inv = 1.f / l;
#pragma unroll
    for (int blk = 0; blk < NB_; ++blk)
#pragma unroll
        for (int r = 0; r < 16; ++r) o[blk][r] *= inv;
}
template <int DQK, int DV, int MODE, int S>
__device__ __forceinline__ void attn_pass_pipe(LAS unsigned char* lds, const int wave, const int lane,
        const f16* Qw, const int qpitch, const f16* Kg, const int kpitch, const f16* Vg, const int vpitch,
        const int ntiles, const int qpos0, const LAS float* tab, const unsigned selb, const int jblk, const unsigned* maskw,
        f32x16 (&o)[DV / 32]) {
    typedef LayD<DQK, DV, MODE, S> L;
    constexpr int NB_ = DV / 32;
    const int r32 = lane & 31, hi = lane >> 5;
    f16x8 qf[DQK / 16];
#pragma unroll
    for (int d0 = 0; d0 < DQK / 16; ++d0) qf[d0] = __builtin_bit_cast(f16x8, *(const GAS u32x4*)(Qw + (size_t)r32 * qpitch + d0 * 16 + hi * 8));
#pragma unroll
    for (int blk = 0; blk < NB_; ++blk)
#pragma unroll
        for (int r = 0; r < 16; ++r) o[blk][r] = 0.f;
    float m = -INFINITY, l = 0.f;
    unsigned goff[L::NP];
#pragma unroll
    for (int c = 0; c < L::NP; ++c) { const int pc = wave + 8 * c;
        if (pc < L::PK) { const int s2 = 64 * pc + lane, row = s2 / L::CPRK, ch = (s2 % L::CPRK) ^ L::fk(row); goff[c] = (unsigned)(row * kpitch + ch * 8); }
        else { const int s2 = 64 * (pc - L::PK) + lane, row = s2 / L::CPRV, ch = (s2 % L::CPRV) ^ L::fv(row); goff[c] = (unsigned)(row * vpitch + ch * 8); } }
#define FP_ISSUE(kt_, st_) do { \
        if (MODE == 2) __builtin_amdgcn_global_load_lds((const GAS unsigned*)(maskw + (kt_) * 64 + lane), (LAS unsigned*)(lds + L::MASKOFF + (wave * S + (st_)) * 256), 4, 0, 0); \
        _Pragma("unroll") for (int c = 0; c < L::NP; ++c) { const int pc = wave + 8 * c; \
            if (pc < L::PK) __builtin_amdgcn_global_load_lds((const GAS unsigned*)(Kg + (size_t)(kt_) * 64 * kpitch + goff[c]), (LAS unsigned*)(lds + (st_) * L::STG + pc * 1024), 16, 0, 0); \
            else __builtin_amdgcn_global_load_lds((const GAS unsigned*)(Vg + (size_t)(kt_) * 64 * vpitch + goff[c]), (LAS unsigned*)(lds + (st_) * L::STG + L::KB + (pc - L::PK) * 1024), 16, 0, 0); } } while (0)
    int koff[DQK / 16];
#pragma unroll
    for (int d0 = 0; d0 < DQK / 16; ++d0) koff[d0] = (r32 * L::CPRK + ((2 * d0 + hi) ^ L::fk(r32))) * 16;
    int voff[2][NB_];
    { const int q = (lane & 15) >> 2, g1 = (lane >> 4) & 1, p = lane & 3;
#pragma unroll
      for (int sec = 0; sec < 2; ++sec)
#pragma unroll
        for (int blk = 0; blk < NB_; ++blk) { const int row = 4 * hi + q + 8 * sec; voff[sec][blk] = L::KB * (MODE == 2 ? 0 : 1) + (row * L::CPRV + ((4 * blk + 2 * g1 + (p >> 1)) ^ L::fv(row))) * 16 + 8 * (p & 1); } }
    const int nact = ((qpos0 + 31) >> 6) + 1 < ntiles ? ((qpos0 + 31) >> 6) + 1 : ntiles;
#define FP_QK(a0_, a1_, kt_, st_, ref_) do { \
        const LAS unsigned char* sb_ = lds + (st_) * L::STG; const float nr_ = -(ref_); \
        if (MODE == 2) { const unsigned w_ = *(const LAS unsigned*)(lds + L::MASKOFF + (wave * S + (st_)) * 256 + lane * 4); const unsigned nrb_ = __float_as_uint(nr_); \
            _Pragma("unroll") for (int r = 0; r < 16; ++r) { const unsigned s0_ = (unsigned)__builtin_amdgcn_sbfe((int)w_, r, 1), s1_ = (unsigned)__builtin_amdgcn_sbfe((int)w_, 16 + r, 1); \
                a0_[r] = __uint_as_float((s0_ & nrb_) | (~s0_ & 0xff800000u)); a1_[r] = __uint_as_float((s1_ & nrb_) | (~s1_ & 0xff800000u)); } } \
        else if (MODE == 1) { const int n_ = (kt_) >> 2; const float cv_ = (n_ == jblk || ((selb >> n_) & 1u)) ? nr_ : -INFINITY; \
            _Pragma("unroll") for (int r = 0; r < 16; ++r) { a0_[r] = cv_; a1_[r] = cv_; } } \
        else { _Pragma("unroll") for (int r = 0; r < 16; ++r) { a0_[r] = nr_; a1_[r] = nr_; } } \
        _Pragma("unroll") for (int db = 0; db < DQK / 32; ++db) { f16x8 kf0_[2], kf1_[2]; \
            _Pragma("unroll") for (int d = 0; d < 2; ++d) { kf0_[d] = *(const LAS f16x8*)(sb_ + koff[2 * db + d]); kf1_[d] = *(const LAS f16x8*)(sb_ + koff[2 * db + d] + 32 * L::CPRK * 16); } \
            _Pragma("unroll") for (int d = 0; d < 2; ++d) { \
                a0_ = __builtin_amdgcn_mfma_f32_32x32x16_f16(kf0_[d], qf[2 * db + d], a0_, 0, 0, 0); \
                a1_ = __builtin_amdgcn_mfma_f32_32x32x16_f16(kf1_[d], qf[2 * db + d], a1_, 0, 0, 0); } } } while (0)
#define FP_PREP(a0_, a1_, kt_) do { const int k0_ = (kt_) * 64; \
        if (qpos0 - (k0_ + 63) < 128) { const int j0_ = 224 - (qpos0 + r32 - k0_ - 4 * hi), sf_ = j0_ & 1; const LAS float* rp_ = tab + sf_ * TAB2 + (j0_ - sf_); \
            _Pragma("unroll") for (int g = 0; g < 4; ++g) { const f32x2 x0_ = *(const LAS f32x2*)(rp_ + 8 * g), x1_ = *(const LAS f32x2*)(rp_ + 8 * g + 2), y0_ = *(const LAS f32x2*)(rp_ + 32 + 8 * g), y1_ = *(const LAS f32x2*)(rp_ + 34 + 8 * g); \
                a0_[4 * g] += x0_.x; a0_[4 * g + 1] += x0_.y; a0_[4 * g + 2] += x1_.x; a0_[4 * g + 3] += x1_.y; a1_[4 * g] += y0_.x; a1_[4 * g + 1] += y0_.y; a1_[4 * g + 2] += y1_.x; a1_[4 * g + 3] += y1_.y; } } \
        rmrel = half_max(rowmax32(a0_, a1_)); } while (0)
#define FP_VREAD(dst_, ks_, st_) do { const LAS unsigned char* sv_ = lds + (st_) * L::STG; _Pragma("unroll") for (int blk = 0; blk < NB_; ++blk) { \
        const v4i16_t a_ = __builtin_amdgcn_ds_read_tr16_b64_v4i16((LAS v4i16_t*)(sv_ + voff[0][blk] + 16 * (ks_) * L::CPRV * 16)); \
        const v4i16_t b_ = __builtin_amdgcn_ds_read_tr16_b64_v4i16((LAS v4i16_t*)(sv_ + voff[1][blk] + 16 * (ks_) * L::CPRV * 16)); \
        const f16x4 a4_ = __builtin_bit_cast(f16x4, a_), b4_ = __builtin_bit_cast(f16x4, b_); \
        dst_[blk] = (f16x8){a4_[0], a4_[1], a4_[2], a4_[3], b4_[0], b4_[1], b4_[2], b4_[3]}; } } while (0)
#define FP_PV(src_, ks_) do { _Pragma("unroll") for (int blk = 0; blk < NB_; ++blk) o[blk] = __builtin_amdgcn_mfma_f32_32x32x16_f16(src_[blk], pf[ks_], o[blk], 0, 0, 0); } while (0)
#define FP_STEP(c0_, c1_, n0_, n1_, kt_) do { \
        if (S > 3 && (kt_) + S - 2 < ntiles) FA_WAITV(L::NPW * (S - 3)); else FA_WAITV(0); \
        __builtin_amdgcn_s_barrier(); asm volatile("" ::: "memory"); \
        if ((kt_) + S - 1 < ntiles) FP_ISSUE((kt_) + S - 1, sti); \
        if ((kt_) < nact) { \
            const float mu_ = (m == -INFINITY) ? 0.f : m; const bool more_ = (kt_) + 1 < nact; float rmrel = -INFINITY; \
            if (more_) FP_QK(n0_, n1_, (kt_) + 1, st1, mu_); \
            if (__any(dl != 0.f)) { _Pragma("unroll") for (int r = 0; r < 16; ++r) { c0_[r] -= dl; c1_[r] -= dl; } } \
            float ls_ = 0.f; \
            _Pragma("unroll") for (int r = 0; r < 16; ++r) { c0_[r] = __builtin_amdgcn_exp2f(c0_[r]); c1_[r] = __builtin_amdgcn_exp2f(c1_[r]); ls_ += c0_[r] + c1_[r]; } \
            l += ls_; \
            f16x8 pf[4]; pf[0] = pack8(c0_, 0); pf[1] = pack8(c0_, 8); pf[2] = pack8(c1_, 0); pf[3] = pack8(c1_, 8); \
            if (NB_ <= 2) { f16x8 vfa[NB_], vfb[NB_]; \
                FP_VREAD(vfa, 0, st); FP_VREAD(vfb, 1, st); \
                if (more_) FP_PREP(n0_, n1_, (kt_) + 1); \
                FP_PV(vfa, 0); FP_VREAD(vfa, 2, st); FP_PV(vfb, 1); FP_VREAD(vfb, 3, st); FP_PV(vfa, 2); FP_PV(vfb, 3); \
            } else { f16x8 vfa[NB_]; \
                FP_VREAD(vfa, 0, st); \
                if (more_) FP_PREP(n0_, n1_, (kt_) + 1); \
                FP_PV(vfa, 0); __builtin_amdgcn_sched_barrier(0); FP_VREAD(vfa, 1, st); FP_PV(vfa, 1); __builtin_amdgcn_sched_barrier(0); \
                FP_VREAD(vfa, 2, st); FP_PV(vfa, 2); __builtin_amdgcn_sched_barrier(0); FP_VREAD(vfa, 3, st); FP_PV(vfa, 3); } \
            dl = 0.f; \
              \
            if (more_ && __any(rmrel > 8.f || (m == -INFINITY && rmrel > -INFINITY))) { \
                const float mnew_ = fmaxf(m, rmrel + mu_), mun_ = (mnew_ == -INFINITY) ? 0.f : mnew_; dl = mun_ - mu_; m = mnew_; \
                const float al_ = __builtin_amdgcn_exp2f(-dl); l *= al_; \
                _Pragma("unroll") for (int blk = 0; blk < NB_; ++blk) _Pragma("unroll") for (int r = 0; r < 16; ++r) o[blk][r] *= al_; } \
        } \
        st = st1; st1 = (st1 + 1 == S) ? 0 : st1 + 1; sti = (sti + 1 == S) ? 0 : sti + 1; } while (0)
#pragma unroll
    for (int t0 = 0; t0 < S - 1; ++t0) if (t0 < ntiles) FP_ISSUE(t0, t0);
    f32x16 sa0, sa1, sb0, sb1; float dl;
    if (ntiles >= S - 1) FA_WAITV(L::NPW * (S - 2)); else FA_WAITV(0);
    __builtin_amdgcn_s_barrier(); asm volatile("" ::: "memory");
    { float rmrel; FP_QK(sa0, sa1, 0, 0, 0.f); FP_PREP(sa0, sa1, 0); m = rmrel; dl = (m == -INFINITY) ? 0.f : m; }
    int st = 0, st1 = 1, sti = S - 1;
#pragma unroll 1
    for (int kt = 0; kt < ntiles; kt += 2) {
        FP_STEP(sa0, sa1, sb0, sb1, kt);
        if (kt + 1 < ntiles) FP_STEP(sb0, sb1, sa0, sa1, kt + 1);
    }
    asm volatile("s_waitcnt lgkmcnt(0)" ::: "memory");
    __builtin_amdgcn_s_barrier(); asm volatile("" ::: "memory");
#undef FP_ISSUE
#undef FP_QK
#undef FP_PREP
#undef FP_VREAD
#undef FP_PV
#undef FP_STEP
    l = half_sum(l);
    const float inv = 1.f / l;
#pragma unroll
    for (int blk = 0; blk < NB_; ++blk)
#pragma unroll
        for (int r = 0; r < 16; ++r) o[blk][r] *= inv;
}
template <int DV> __device__ __forceinline__ void store_o(const f32x16 (&o)[DV / 32], f16* dst, int hi) {
#pragma unroll
    for (int blk = 0; blk < DV / 32; ++blk)
#pragma unroll
        for (int g = 0; g < 4; ++g) { u32x2 w; w.x = pk2h(o[blk][4 * g], o[blk][4 * g + 1]); w.y = pk2h(o[blk][4 * g + 2], o[blk][4 * g + 3]);
            *(u32x2*)(dst + 32 * blk + 8 * g + 4 * hi) = w; }
}
}

struct Args { const float* in[20]; float* out; unsigned char* ws; };

__global__ void __launch_bounds__(NWAVES * 64, 2) mega_fwd(Args args) {
    extern __shared__ __attribute__((aligned(16))) unsigned char lds_raw[];
    Frame F;
    F.lds = (LAS unsigned char*)0;
    (void)lds_raw;
    F.wave = __builtin_amdgcn_readfirstlane(threadIdx.x >> 6);
    F.G = gridDim.x; F.gw = blockIdx.x * NWAVES + F.wave; F.NGW = F.G * NWAVES;
    volatile LAS unsigned* MISC = (volatile LAS unsigned*)(F.lds + MISC_OFF);
    for (int u = threadIdx.x; u < (LDS_BYTES - LDSCTL_OFF) / 4; u += NWAVES * 64) ((LAS unsigned*)(F.lds + LDSCTL_OFF))[u] = 0u;
    __syncthreads();
    unsigned* ctl = (unsigned*)(args.ws + WS_CTL);
    XcdBarrier bar = xcd_barrier_post(ctl + CW_BAR, MISC + 8, F.wave);
    if (threadIdx.x == 0) __hip_atomic_fetch_or(ctl + CW_LB + 64 * (16 + (int)(blockIdx.x & 7u)), 1u << xb_xcc_id(), __ATOMIC_RELAXED, __HIP_MEMORY_SCOPE_AGENT);

    if (threadIdx.x < 20) ((volatile LAS unsigned long long*)(F.lds + PTAB_OFF))[threadIdx.x] = (unsigned long long)args.in[threadIdx.x];
    __syncthreads();
#define IN(i) inptr(F.lds, (i))
#define LANE lane_id()
#define LL launder_i(l)
#define GW launder_i(F.gw)
#define GWX ((gridDim.x == 256u) ? (int)((((blockIdx.x & 7u) << 5) + (blockIdx.x >> 3)) * 8u) + F.wave : GW)
#define SEAM_L() do { if (__builtin_amdgcn_readfirstlane((int)MISC[19])) xcd_local_barrier((unsigned*)launder(args.ws) + CW_LB, bar, F.wave); else xcd_barrier(bar, F.wave); } while (0)
#define TID (F.wave * 64 + lane_id())
#define WSP(T, off) ((T*)(launder(args.ws) + (off)))
    enum { I_X = 0, I_C, I_RELB, I_ADAW, I_ADAB, I_NMIX, I_WIN, I_GATEB, I_DLAM, I_SUBLN, I_KVNORM, I_WUV, I_WBRA, I_WBRB, I_WBRC, I_WO, I_NMLP, I_WFF1, I_WFF2, I_NFINAL };
    float* xout = args.out;
    for (int rp0 = 0; rp0 < launder_i(REP_P0); ++rp0) {
        LAS float* scr = (LAS float*)(F.lds + F.wave * 16384);
        { auto decode = [&](int it) -> TItem { const int l = it >> 13; int r = it & 8191;
              if (r < 1664) return TItem{IN(I_WIN) + (size_t)l * DM * IN_COLS, IN_COLS, 0, PCOLS, DM, WSP(f16, WS_WIN) + (size_t)l * PP * DM, PP / 32, (unsigned*)launder(args.ws) + CW_CMAX + (l * 3 + 0) * 4096, r, true, false}; r -= 1664;
              if (r < 1536) return TItem{IN(I_WIN) + (size_t)l * DM * IN_COLS, IN_COLS, C_G, GCOLS, DM, WSP(f16, WS_WG) + (size_t)l * GCOLS * DM, GCOLS / 32, (unsigned*)launder(args.ws) + CW_CMAX + (l * 3 + 1) * 4096, r, false, false}; r -= 1536;
              if (r < 256) return TItem{IN(I_WBRA) + (size_t)l * 512 * DM, DM, 0, DM, 512, WSP(f16, WS_WA) + (size_t)l * DM * 512, DM / 32, (unsigned*)nullptr, r, false, false}; r -= 256;
              if (r < 128) return TItem{IN(I_WBRC) + (size_t)l * 256 * DM, DM, 0, DM, 256, WSP(f16, WS_WC) + (size_t)l * DM * 256, DM / 32, (unsigned*)nullptr, r, false, false}; r -= 128;
              if (r < 512) return TItem{IN(I_WO) + (size_t)l * DM * DM, DM, 0, DM, DM, WSP(f16, WS_WO) + (size_t)l * DM * DM, DM / 32, (unsigned*)nullptr, r, false, false}; r -= 512;
              if (r < 2048) return TItem{IN(I_WFF1) + (size_t)l * DM * DFF, DFF, 0, DFF, DM, WSP(f16, WS_W1) + (size_t)l * DFF * DM, DFF / 32, (unsigned*)launder(args.ws) + CW_CMAX + (l * 3 + 2) * 4096, r, false, false}; r -= 2048;
              return TItem{IN(I_WFF2) + (size_t)l * DFF * DM, DM, 0, DM, DFF, WSP(f16, WS_W2) + (size_t)l * DM * DFF, DM / 32, (unsigned*)nullptr, r, false, false}; };
          int it = F.gw;
          if (it < 2 * 8192) { TItem cur = decode(it); float wv[32]; float sc; titem_load(cur, LANE, wv, sc);
#pragma unroll 1
            for (;;) { const int itn = it + F.NGW; const bool more = itn < 2 * 8192;
                TItem nxt = cur; float wn[32]; float scn = 1.f;
                if (more) { nxt = decode(itn); titem_load(nxt, LANE, wn, scn); }
                titem_store(cur, LANE, wv, sc, scr);
                if (!more) break;
#pragma unroll
                for (int i = 0; i < 32; ++i) wv[i] = wn[i];
                sc = scn; cur = nxt; it = itn; } } }
        for (int it = F.gw; it < 2048; it += F.NGW) {
            const int l = it >> 10, kb = (it >> 4) & 63, nb = it & 15; const int kk0 = kb * 8, h = kk0 >> 7, r0 = kk0 & 127, n = nb * 64 + LANE;
            const float* uv = IN(I_WUV) + ((size_t)(l * 4 + h) * 128 + r0) * 64; const float* wb = IN(I_WBRB) + ((size_t)l * 256 + h * 64) * DM + n;
            float a[8];
#pragma unroll
            for (int j = 0; j < 8; ++j) a[j] = 0.f;
#pragma unroll 1
            for (int e0 = 0; e0 < 64; e0 += 16) { float bw[16];
#pragma unroll
                for (int e = 0; e < 16; ++e) bw[e] = *(const GAS float*)(wb + (size_t)(e0 + e) * DM);
#pragma unroll
                for (int e = 0; e < 16; ++e)
#pragma unroll
                    for (int j = 0; j < 8; ++j) a[j] += uv[j * 64 + e0 + e] * bw[e]; }
            u32x4 o; o.x = pk2h(a[0], a[1]); o.y = pk2h(a[2], a[3]); o.z = pk2h(a[4], a[5]); o.w = pk2h(a[6], a[7]);
            *(u32x4*)(WSP(f16, WS_WBC) + ((size_t)l * DM + n) * 512 + kk0) = o;
        }
        __syncthreads();
        if (blockIdx.x < 192) {
            const int l = blockIdx.x / 96, j0 = (blockIdx.x % 96) * 64;
            LAS float* cond = (LAS float*)F.lds;
            LAS float* part = (LAS float*)(F.lds + 65536);
            const float* c_in = IN(I_C);
            for (int i = TID; i < NB * DM; i += 512) { const float v = c_in[i]; cond[i] = v / (1.f + __expf(-v)); }
            __syncthreads();
            float a[16];
#pragma unroll
            for (int b = 0; b < 16; ++b) a[b] = 0.f;
            const float* wp = IN(I_ADAW) + (size_t)l * DM * 6144 + j0 + LANE;
#pragma unroll 1
            for (int k0 = F.wave * 128; k0 < F.wave * 128 + 128; k0 += 16) { float w[16];
#pragma unroll
                for (int i = 0; i < 16; ++i) w[i] = *(const GAS float*)(wp + (size_t)(k0 + i) * 6144);
#pragma unroll
                for (int b = 0; b < 16; ++b)
#pragma unroll
                    for (int i4 = 0; i4 < 4; ++i4) { const f32x4 cvv = *(const LAS f32x4*)(cond + b * 1024 + k0 + 4 * i4);
                        a[b] += (cvv.x * w[4 * i4] + cvv.y * w[4 * i4 + 1]) + (cvv.z * w[4 * i4 + 2] + cvv.w * w[4 * i4 + 3]); } }
#pragma unroll
            for (int b = 0; b < 16; ++b) part[(F.wave * 16 + b) * 64 + LANE] = a[b];
            __syncthreads();
            const float* ada_b = IN(I_ADAB); float* mod = WSP(float, WS_MOD);
            for (int i = TID; i < 1024; i += 512) { const int b = i >> 6, j = i & 63; float s = ada_b[l * 6144 + j0 + j];
#pragma unroll
                for (int w = 0; w < 8; ++w) s += part[(w * 16 + b) * 64 + j];
                mod[((size_t)l * 16 + b) * 6144 + j0 + j] = s; }
            __syncthreads();
        } else if (blockIdx.x == 192) {
            const float* rel_bias = IN(I_RELB); float* tabs = WSP(float, WS_MISC + 1024); float* lamv = WSP(float, WS_MISC);
            for (int i = TID; i < 12 * TABN; i += 512) { const int hh = i / TABN, idx = i % TABN, dist = idx - 255;
                float v; if (dist < 0) v = -INFINITY; else if (dist >= 128) v = 0.f; else v = (rel_bias[t5_bucket(dist) * 12 + hh] - rel_bias[31 * 12 + hh]) * LOG2E;
                tabs[i] = v; }
            float* tabs2 = WSP(float, WS_MISC + 32768);
            for (int i = TID; i < 12 * TAB2H; i += 512) { const int hh = i / TAB2H, sft = (i % TAB2H) / TAB2, j = (i % TAB2) + sft, dist = 224 - j;
                float v; if (dist < 0) v = -INFINITY; else if (dist >= 128) v = 0.f; else v = (rel_bias[t5_bucket(dist) * 12 + hh] - rel_bias[31 * 12 + hh]) * LOG2E;
                tabs2[i] = v; }
            if (F.wave < 2) { const int l = F.wave; const float* dl = IN(I_DLAM) + l * 256;
                const float s1 = wave_sum(dl[LANE] * dl[64 + LANE]), s2 = wave_sum(dl[128 + LANE] * dl[192 + LANE]);
                const float lam_init = 0.8f - 0.6f * expf(-0.3f * (float)l);
                if (LANE == 0) lamv[l] = expf(s1) - expf(s2) + lam_init; }
        }
    }
    xcd_barrier(bar, F.wave);
    if (threadIdx.x == 0) { unsigned ok = (gridDim.x == 256u) ? 1u : 0u, seen = 0u;
#pragma unroll 1
        for (int r = 0; r < 8; ++r) { const unsigned mk = xb_ld((unsigned*)launder(args.ws) + CW_LB + 64 * (16 + r)); if (__builtin_popcount(mk) != 1 || (seen & mk)) ok = 0u; seen |= mk; }
        MISC[19] = ok; }
    __syncthreads();
    { const int grp = blockIdx.x % 6, bi = blockIdx.x / 6, nbl = (F.G - grp + 5) / 6, l = grp / 3, which = grp % 3; const int lane = LANE;
      const float* modl = WSP(float, WS_MOD) + (size_t)l * 16 * 6144 + (which == 2 ? 3 : 0) * DM;
      LAS float* sh = (LAS float*)F.lds;
      for (int i2 = F.wave * 64 + lane; i2 < 16 * 1024; i2 += 512) sh[i2] = modl[(size_t)(i2 >> 10) * 6144 + (i2 & 1023)];
      __syncthreads();
      const f16* Bt = which == 0 ? WSP(f16, WS_WIN) + (size_t)l * PP * DM : (which == 1 ? WSP(f16, WS_WG) + (size_t)l * GCOLS * DM : WSP(f16, WS_W1) + (size_t)l * DFF * DM);
      const int nrows = which == 0 ? PP : (which == 1 ? GCOLS : DFF);
      float* cv = WSP(float, WS_CVEC) + (size_t)grp * 16 * 4096;
      u32x2 nxw[4]; unsigned nxc = 0u;
      { const int n = bi * 8 + F.wave;
        if (n < nrows) { nxc = ((const GAS unsigned*)launder(args.ws))[CW_CMAX + grp * 4096 + n];
#pragma unroll
          for (int j = 0; j < 4; ++j) nxw[j] = *(const GAS u32x2*)(Bt + (size_t)n * DM + 256 * j + lane * 4); } }
      for (int n = bi * 8 + F.wave; n < nrows; n += nbl * 8) {
          float w[16]; const unsigned cmb = nxc;
#pragma unroll
          for (int j = 0; j < 4; ++j) { const unsigned wx = nxw[j].x, wy = nxw[j].y; const f16x2 a = __builtin_bit_cast(f16x2, wx), b2 = __builtin_bit_cast(f16x2, wy);
              w[4 * j] = (float)a[0]; w[4 * j + 1] = (float)a[1]; w[4 * j + 2] = (float)b2[0]; w[4 * j + 3] = (float)b2[1]; }
          { const int n2 = n + nbl * 8;
            if (n2 < nrows) { nxc = ((const GAS unsigned*)launder(args.ws))[CW_CMAX + grp * 4096 + n2];
#pragma unroll
              for (int j = 0; j < 4; ++j) nxw[j] = *(const GAS u32x2*)(Bt + (size_t)n2 * DM + 256 * j + lane * 4); } }
          {
              const float cm = __uint_as_float(cmb), inv = cm > 0.f ? 127.f / cm : 0.f;
              unsigned char* wq = launder(args.ws) + (which == 0 ? WS_WQIN : (which == 1 ? WS_WQG : WS_WQ1)) + ((size_t)l * nrows + n) * 1024;
#pragma unroll
              for (int j = 0; j < 4; ++j) { unsigned pk = 0u;
#pragma unroll
                  for (int e = 0; e < 4; ++e) pk |= ((unsigned)(int)__builtin_rintf(w[4 * j + e] * inv) & 255u) << (8 * e);
                  *(unsigned*)(wq + 256 * j + lane * 4) = pk; }
              if (lane == 0) WSP(float, WS_SB)[grp * 4096 + n] = cm * (1.f / 127.f); }
          float a[16];
#pragma unroll
          for (int b = 0; b < 16; ++b) { a[b] = 0.f;
#pragma unroll
              for (int j = 0; j < 4; ++j) { const f32x4 sv = *(const LAS f32x4*)(sh + b * 1024 + 256 * j + lane * 4); a[b] += (w[4 * j] * sv.x + w[4 * j + 1] * sv.y) + (w[4 * j + 2] * sv.z + w[4 * j + 3] * sv.w); } }
#pragma unroll
          for (int st = 0; st < 4; ++st) { const int msk = 32 >> st, nh = 8 >> st; const bool up = (lane & msk) != 0;
#pragma unroll
              for (int i3 = 0; i3 < nh; ++i3) { const float send = up ? a[i3] : a[i3 + nh], keep = up ? a[i3 + nh] : a[i3]; a[i3] = keep + __shfl_xor(send, msk); } }
          a[0] += __shfl_xor(a[0], 1); a[0] += __shfl_xor(a[0], 2);
          if ((lane & 3) == 0) cv[(size_t)(((lane >> 5) & 1) * 8 + ((lane >> 4) & 1) * 4 + ((lane >> 3) & 1) * 2 + ((lane >> 2) & 1)) * 4096 + n] = a[0];
      }
      __syncthreads();
    }

#pragma unroll 1
    for (int l = 0; l < DEPTH; ++l) {
        if (LL == 0) for (int rep = 0; rep < REP_N1; ++rep) {
        { const float* xcur = IN(I_X); const float* modl = WSP(float, WS_MOD); const float* nw = IN(I_NMIX); unsigned char* U8 = (unsigned char*)xout + (size_t)64 * MiB; float* rf = (float*)launder(args.ws) + CW_RF;
          for (int m0 = GWX * 16; m0 < MTOK; m0 += F.NGW * 16) { const int b = m0 / SEQ;
            norm_quant_rows16_0(xcur, nw, modl + (size_t)b * 6144 + 1 * DM, (f16*)xout, U8, rf, m0, LANE); } }
        xcd_barrier(bar, F.wave);
        if (__builtin_amdgcn_readfirstlane((int)MISC[19])) { for (unsigned i = 0; i < (blockIdx.x & 7u); ++i) __builtin_amdgcn_s_sleep(40); }
        }
        for (int rep = 0; rep < REP_G1; ++rep) {
#ifndef NO_G1
        { pg8::Gemm g{(const f16*)((const unsigned char*)xout + (size_t)64 * MiB), (const f16*)(launder(args.ws) + WS_WQIN + (size_t)LL * PP * 1024), MTOK, PP, DM / 2}; pg8::StaticOrder S; S.init(MTOK, PP, F.G, (int)blockIdx.x);
          pg8::EpiNormF16<0, true> E{WSP(f16, WS_R1), PP, GAPP};
          pg8::fill_tabs_q((const float*)launder(args.ws) + CW_RF, WSP(float, WS_CVEC) + (size_t)(LL * 3 + 0) * 16 * 4096, (const float*)nullptr, WSP(float, WS_SB) + (LL * 3 + 0) * 4096, S, TID);
          pg8::gemm_phase<pg8::EpiNormF16<0, true>, pg8::StaticOrder, true, true, true>(F.lds, g, S, E, F.wave); }
#endif
        SEAM_L();
        }
        for (int rep = 0; rep < launder_i(REP_SEL); ++rep) {
        { const f16* P = WSP(f16, WS_R1); f16* KVN = WSP(f16, WS_KVN); const float* kvw = IN(I_KVNORM) + LL * 128; float* kmean = WSP(float, WS_MISC + 65536);
          { const int lane = LANE, sub = lane >> 4, cl = lane & 15;
            float kw[8];
#pragma unroll
            for (int e = 0; e < 8; ++e) kw[e] = kvw[cl * 8 + e];
            for (int m0 = GWX * 16; m0 < MTOK; m0 += 16 * F.NGW) {
                f16x8 v[4]; float ss[4];
#pragma unroll
                for (int j = 0; j < 4; ++j) v[j] = __builtin_bit_cast(f16x8, *(const GAS u32x4*)(P + (size_t)(m0 + j * 4 + sub) * PP + (size_t)((m0 + j * 4 + sub) >> 12) * GAPP + C_BKV + cl * 8));
#pragma unroll
                for (int j = 0; j < 4; ++j) { ss[j] = 0.f;
#pragma unroll
                    for (int e = 0; e < 8; ++e) ss[j] += (float)v[j][e] * (float)v[j][e]; }
#pragma unroll
                for (int o = 1; o < 16; o <<= 1)
#pragma unroll
                    for (int j = 0; j < 4; ++j) ss[j] += __shfl_xor(ss[j], o);
#pragma unroll
                for (int j = 0; j < 4; ++j) { const float r = __builtin_amdgcn_rsqf(ss[j] * (1.f / 128.f) + EPS);
                    u32x4 w; w.x = pk2h((float)v[j][0] * r * kw[0], (float)v[j][1] * r * kw[1]); w.y = pk2h((float)v[j][2] * r * kw[2], (float)v[j][3] * r * kw[3]);
                    w.z = pk2h((float)v[j][4] * r * kw[4], (float)v[j][5] * r * kw[5]); w.w = pk2h((float)v[j][6] * r * kw[6], (float)v[j][7] * r * kw[7]);
                    *(GAS u32x4*)(KVN + (size_t)(m0 + j * 4 + sub) * 128 + cl * 8) = w; }
            } }
          for (int it = (gridDim.x == 256u) ? (((int)(blockIdx.x >> 3) * 8 + F.wave < 64) ? (int)(blockIdx.x & 7u) * 64 + (int)(blockIdx.x >> 3) * 8 + F.wave : NB * 4 * 8) : GW; it < NB * 4 * 8; it += F.NGW) {
            const int b = it >> 5, h = (it >> 3) & 3, blk = it & 7; const int lane = LANE, rg = lane >> 3, ch = lane & 7;
            const f16* src = P + ((size_t)b * SEQ + blk * 256 + rg) * PP + (size_t)(b >> 1) * GAPP + C_CK + h * 64 + ch * 8; float a8[8];
#pragma unroll
            for (int e = 0; e < 8; ++e) a8[e] = 0.f;
#pragma unroll 8
            for (int r = 0; r < 32; ++r) { const f16x8 v = __builtin_bit_cast(f16x8, *(const GAS u32x4*)(src + (size_t)(8 * r) * PP));
#pragma unroll
                for (int e = 0; e < 8; ++e) a8[e] += (float)v[e]; }
#pragma unroll
            for (int e = 0; e < 8; ++e) { a8[e] += __shfl_xor(a8[e], 8); a8[e] += __shfl_xor(a8[e], 16); a8[e] += __shfl_xor(a8[e], 32); }
            if (rg == 0) { f32x4 o0 = {a8[0], a8[1], a8[2], a8[3]}, o1 = {a8[4], a8[5], a8[6], a8[7]};
                *(f32x4*)(kmean + (size_t)it * 64 + ch * 8) = o0 * (1.f / 256.f); *(f32x4*)(kmean + (size_t)it * 64 + ch * 8 + 4) = o1 * (1.f / 256.f); } } }
#ifndef NAIVE_DSA
#ifdef NAIVE_SELECT
        { const f16* P = WSP(f16, WS_R1); unsigned* MASK = WSP(unsigned, WS_MASK); LAS unsigned* keyl = (LAS unsigned*)(F.lds + F.wave * 16384 + 8192);
          for (int task = GW; task < NB * SEQ; task += F.NGW) {
            const int b = task / SEQ, t = (task % SEQ + 37 * b) % SEQ; const size_t row = (size_t)b * SEQ + t; const int lane = LANE;
            const int nslots = (t >> 6) + 1;
            unsigned sel = 0xffffffffu;
            if (t >= 256) {
                const f16* iq = P + row * PP + C_BIQ; const f16* iwp = P + row * PP + C_BIW;
#pragma unroll 1
                for (int j = 0; j < nslots; ++j) { unsigned kk = 0u; const int k = 64 * j + lane;
                    if (k <= t) { const f16* ik = P + ((size_t)b * SEQ + k) * PP + C_BIK; f16x8 kv[4];
#pragma unroll
                        for (int c = 0; c < 4; ++c) kv[c] = *(const f16x8*)(ik + 8 * c);
                        float sc = 0.f;
#pragma unroll 1
                        for (int hh = 0; hh < 8; ++hh) { float d = 0.f;
#pragma unroll
                            for (int c = 0; c < 4; ++c) { const f16x8 qv = *(const f16x8*)(iq + hh * 32 + 8 * c);
#pragma unroll
                                for (int e = 0; e < 8; ++e) d += (float)qv[e] * (float)kv[c][e]; }
                            sc += fmaxf(d, 0.f) * (float)iwp[hh]; }
                        kk = ordkey(sc); }
                    keyl[k] = kk; }
                unsigned thr = 0u;
#pragma unroll 1
                for (int bit = 31; bit >= 0; --bit) { const unsigned cand = thr | (1u << bit); int c = 0;
#pragma unroll 1
                    for (int j = 0; j < nslots; ++j) c += (keyl[64 * j + lane] >= cand) ? 1 : 0;
                    if (wave_isum(c) >= 256) thr = cand; }
                int cgt = 0;
#pragma unroll 1
                for (int j = 0; j < nslots; ++j) cgt += (keyl[64 * j + lane] > thr) ? 1 : 0;
                cgt = wave_isum(cgt);
                const int need = 256 - cgt; int run = 0; sel = 0u;
#pragma unroll 1
                for (int j = 0; j < nslots; ++j) { const unsigned kk = keyl[64 * j + lane]; const bool tie = kk == thr; const unsigned long long bal = __ballot(tie);
                    const int pre = run + __popcll(bal & ((1ull << lane) - 1ull));
                    if (kk > thr || (tie && pre < need)) sel |= 1u << j;
                    run += __popcll(bal); }
            }
            const int bb = lane & 31, kkq = 32 * (bb >> 4) + (bb & 3) + 8 * ((bb & 15) >> 2) + 4 * (lane >> 5);
            unsigned* mrow = MASK + ((size_t)(b * 64 + (t >> 5)) * 32) * 64 + (t & 31);
#pragma unroll 1
            for (int j = 0; j < nslots; ++j) { const unsigned long long bal = __ballot((sel >> j) & 1u);
                const unsigned long long w64 = __ballot((bal >> kkq) & 1ull);
                if (lane == 0) { mrow[j * 64] = (unsigned)w64; mrow[j * 64 + 32] = (unsigned)(w64 >> 32); } }
          } }
#else
        { const f16* P = WSP(f16, WS_R1); unsigned* MASK = WSP(unsigned, WS_MASK);
          unsigned* qctr = (unsigned*)launder(args.ws) + CW_QUEUE + 512 * ((rep * 2 + LL) * 4 + 3);
          LAS unsigned* hist = (LAS unsigned*)F.lds;
          constexpr int HSTR = 257;
          if (TID == 0) MISC[17] = 0u;
          for (int uk = 0;; ++uk) {
            const int ui = unit_pick(uk, 128, qctr, MISC);
            if (ui < 0) break;
            const int qg = 63 - ((ui & 127) >> 1), b = 2 * (ui >> 7) + (ui & 1); const int lane = LANE, tid = F.wave * 64 + lane, r32 = lane & 31, hi = lane >> 5;
            const int ntiles = (qg >> 1) + 1, t = 32 * qg + r32; const size_t brow = (size_t)b * SEQ; const f16* Pg = P + (size_t)(b >> 1) * GAPP;
            unsigned* mbase = MASK + ((size_t)(b * 64 + qg) * 32) * 64 + lane;
            if (qg < 8) { for (int kt = F.wave; kt < ntiles; kt += 8) mbase[kt * 64] = 0xffffffffu; continue; }
            unsigned keys[4][32];
            {
              const f16* iqp = Pg + (brow + t) * PP + C_BIQ; const f16* iwp = Pg + (brow + t) * PP + C_BIW;
              LAS u32x4* iqL = (LAS u32x4*)(F.lds + 45056);
              const f16x8 iwv = *(const f16x8*)iwp;
              unsigned sgnbits = 0u;
#pragma unroll
              for (int h = 0; h < 8; ++h) sgnbits |= ((float)iwv[h] < 0.f) ? (1u << h) : 0u;
              { float wsel = 0.f;
#pragma unroll
                for (int h = 0; h < 8; ++h) wsel = (h == F.wave) ? (float)iwv[h] : wsel;
#pragma unroll
                for (int s2 = 0; s2 < 2; ++s2) { const f16x8 v = *(const f16x8*)(iqp + F.wave * 32 + 16 * s2 + 8 * hi);
                    u32x4 pw; pw.x = pk2h(wsel * (float)v[0], wsel * (float)v[1]); pw.y = pk2h(wsel * (float)v[2], wsel * (float)v[3]); pw.z = pk2h(wsel * (float)v[4], wsel * (float)v[5]); pw.w = pk2h(wsel * (float)v[6], wsel * (float)v[7]);
                    iqL[(F.wave * 2 + s2) * 64 + lane] = pw; } }
              if (F.wave == 0) {
#pragma unroll
                for (int s2 = 0; s2 < 2; ++s2) { float ca[8];
#pragma unroll
                    for (int e = 0; e < 8; ++e) ca[e] = 0.f;
#pragma unroll
                    for (int h = 0; h < 8; ++h) { const f16x8 v = *(const f16x8*)(iqp + h * 32 + 16 * s2 + 8 * hi); const float w = (float)iwv[h];
#pragma unroll
                        for (int e = 0; e < 8; ++e) ca[e] += w * (float)v[e]; }
                    u32x4 pw; pw.x = pk2h(ca[0], ca[1]); pw.y = pk2h(ca[2], ca[3]); pw.z = pk2h(ca[4], ca[5]); pw.w = pk2h(ca[6], ca[7]);
                    iqL[(16 + s2) * 64 + lane] = pw; } }
              __syncthreads();
#if REP_SCORE > 1
#pragma unroll 1
              for (int rs = 0; rs < launder_i(REP_SCORE); ++rs)
#endif
#pragma unroll
              for (int ti = 0; ti < 4; ++ti) { const int kt = F.wave + 8 * ti;
                if (kt < ntiles) { const int k0 = 64 * kt;
#pragma unroll
                    for (int half = 0; half < 2; ++half) { const f16* ikp = Pg + (brow + k0 + 32 * half + r32) * PP + C_BIK + 8 * hi;
                        const f16x8 kf0 = *(const f16x8*)ikp, kf1 = *(const f16x8*)(ikp + 16);
                        fa::f32x16 sc;
#pragma unroll
                        for (int r = 0; r < 16; ++r) sc[r] = 0.f;
                        sc = __builtin_amdgcn_mfma_f32_32x32x16_f16(kf0, __builtin_bit_cast(f16x8, iqL[16 * 64 + lane]), sc, 0, 0, 0);
                        sc = __builtin_amdgcn_mfma_f32_32x32x16_f16(kf1, __builtin_bit_cast(f16x8, iqL[17 * 64 + lane]), sc, 0, 0, 0);
#pragma unroll 2
                        for (int h = 0; h < 8; ++h) { fa::f32x16 a;
#pragma unroll
                            for (int r = 0; r < 16; ++r) a[r] = 0.f;
                            a = __builtin_amdgcn_mfma_f32_32x32x16_f16(kf0, __builtin_bit_cast(f16x8, iqL[(2 * h) * 64 + lane]), a, 0, 0, 0);
                            a = __builtin_amdgcn_mfma_f32_32x32x16_f16(kf1, __builtin_bit_cast(f16x8, iqL[(2 * h + 1) * 64 + lane]), a, 0, 0, 0);
                            const float sg = ((sgnbits >> h) & 1u) ? -1.f : 1.f;
#pragma unroll
                            for (int r = 0; r < 16; ++r) sc[r] = __builtin_fmaf(__builtin_fabsf(a[r]), sg, sc[r]); }
#pragma unroll
                        for (int r = 0; r < 16; ++r) keys[ti][16 * half + r] = ordkey(sc[r]);
                        if (k0 + 63 > 32 * qg) {
#pragma unroll
                            for (int r = 0; r < 16; ++r) { const int kidx = k0 + 32 * half + fa::crow(r, hi); keys[ti][16 * half + r] = (kidx <= t) ? keys[ti][16 * half + r] : 0u; } } }
                } else {
#pragma unroll
                    for (int e = 0; e < 32; ++e) keys[ti][e] = 0u; } } }
            unsigned prefix = 0u;
#if REP_RADIX > 1
#pragma unroll 1
            for (int rr = 0; rr < launder_i(REP_RADIX); ++rr)
#endif
#pragma unroll 1
            for (int pass = 0; pass < 4; ++pass) { const int shift = 24 - 8 * pass;
                LAS unsigned* qst = (LAS unsigned*)(F.lds + 40960 + (pass & 1) * 512); LAS unsigned* qstn = (LAS unsigned*)(F.lds + 40960 + ((pass & 1) ^ 1) * 512);
                for (int i2 = tid; i2 < 32 * HSTR; i2 += 512) hist[i2] = 0u;
                __syncthreads();
                if (pass > 0) prefix = qst[2 * r32];
                const int pshift = (pass == 0) ? 31 : shift + 8; const unsigned pmask = (pass == 0) ? 0u : 0xffffffffu;
#pragma unroll
                for (int ti = 0; ti < 4; ++ti)
#pragma unroll
                    for (int e = 0; e < 32; ++e) { const unsigned k = keys[ti][e];
                        const unsigned x = ((k >> pshift) ^ prefix) & pmask; const unsigned inc = 1u - __builtin_elementwise_min(x, 1u);
                        if (F.wave + 8 * ti < ntiles) __hip_atomic_fetch_add(hist + r32 * HSTR + ((k >> shift) & 255u), inc, __ATOMIC_RELAXED, __HIP_MEMORY_SCOPE_WORKGROUP);
                        if ((e & 7) == 7) __builtin_amdgcn_sched_barrier(0); }
                __syncthreads();
#pragma unroll
                for (int qq = 0; qq < 4; ++qq) { const int q = F.wave * 4 + qq; const int need = (pass == 0) ? 256 : (int)qst[2 * q + 1]; const unsigned pfx = (pass == 0) ? 0u : qst[2 * q];
                    const int c0 = (int)hist[q * HSTR + 4 * lane], c1 = (int)hist[q * HSTR + 4 * lane + 1], c2 = (int)hist[q * HSTR + 4 * lane + 2], c3 = (int)hist[q * HSTR + 4 * lane + 3];
                    const int c = c0 + c1 + c2 + c3; int S = c;
#pragma unroll
                    for (int off = 1; off < 64; off <<= 1) { const int v = __shfl_down(S, off); if (lane + off < 64) S += v; }
                    const unsigned long long bal = __ballot(S >= need); const int L = __popcll(bal) - 1;
                    if (lane == L) { int cum = S - c, d;
                        if (cum + c3 >= need) d = 3; else { cum += c3; if (cum + c2 >= need) d = 2; else { cum += c2; if (cum + c1 >= need) d = 1; else { cum += c1; d = 0; } } }
                        qstn[2 * q] = (pfx << 8) | (unsigned)(4 * L + d); qstn[2 * q + 1] = (unsigned)(need - cum); } }
                __syncthreads();
            }
            const unsigned thr = ((LAS unsigned*)(F.lds + 40960))[2 * r32];
#pragma unroll
            for (int ti = 0; ti < 4; ++ti) { const int kt = F.wave + 8 * ti;
                if (kt < ntiles) { unsigned w = 0u;
#pragma unroll
                    for (int e = 0; e < 32; ++e) { w |= (keys[ti][e] >= thr) ? (1u << e) : 0u; if ((e & 7) == 7) __builtin_amdgcn_sched_barrier(0); }
                    mbase[kt * 64] = w; } }
          } }
#endif
#endif
        SEAM_L();
        }
        for (int rep = 0; rep < REP_ATT; ++rep) {
        {
            LAS float* scl = (LAS float*)(F.lds + F.wave * 16384); LAS unsigned* keyl = (LAS unsigned*)(F.lds + F.wave * 16384 + 8192);
#ifndef NO_DIFF
            { const f16* P = WSP(f16, WS_R1); f16* OA = WSP(f16, WS_OA); const float* tabs = WSP(float, WS_MISC + 32768); const float* subln = IN(I_SUBLN) + LL * 128;
              unsigned* qctr = (unsigned*)launder(args.ws) + CW_QUEUE + 512 * ((rep * 2 + LL) * 4 + 0);
              LAS float* tabl = (LAS float*)(F.lds + fa::TAB_OFF); LAS float* subl = (LAS float*)(F.lds + fa::SUB_OFF);
              { const int tid0 = TID;
                for (int i2 = tid0; i2 < 4 * TAB2H; i2 += 512) tabl[i2] = tabs[i2];
                if (tid0 < 128) subl[tid0] = subln[tid0] * ((LL == 0) ? 0.8f : 0.6444909f); }
              if (TID == 0) MISC[17] = 0u;
              for (int uk = 0;; ++uk) {
                const int ui = unit_pick(uk, 64, qctr, MISC);
                if (ui < 0) break;
                const int qb = 7 - ((ui & 63) >> 3), bh = 8 * (ui >> 6) + (ui & 7), b = bh >> 2, h = bh & 3; const int lane = LANE, tid = F.wave * 64 + lane;
                const int qpos0 = qb * 256 + F.wave * 32, ntiles = 4 * qb + 4; const size_t brow = (size_t)b * SEQ; const f16* Pg = P + (size_t)(b >> 1) * GAPP;
                fa::f32x16 o0[4];
                fa::attn_pass_pipe<64, 128, 0, 3>(F.lds, F.wave, lane, Pg + (brow + qpos0) * PP + C_AQ + h * 128, PP, Pg + brow * PP + C_AK + h * 128, PP, Pg + brow * PP + C_AV + h * 128, PP, ntiles, qpos0, tabl + h * TAB2H, 0u, 0, nullptr, o0);
                { LAS unsigned* st = (LAS unsigned*)(F.lds + fa::STASH_OFF + F.wave * 8192) + lane;
#pragma unroll
                  for (int blk = 0; blk < 4; ++blk)
#pragma unroll
                    for (int r = 0; r < 16; r += 2) st[(blk * 8 + (r >> 1)) * 64] = pk2h(o0[blk][r], o0[blk][r + 1]); }
                fa::attn_pass_pipe<64, 128, 0, 3>(F.lds, F.wave, LANE, Pg + (brow + qpos0) * PP + C_AQ + h * 128 + 64, PP, Pg + brow * PP + C_AK + h * 128 + 64, PP, Pg + brow * PP + C_AV + h * 128, PP, ntiles, qpos0, tabl + h * TAB2H, 0u, 0, nullptr, o0);
                const int lane2 = LANE, hi = lane2 >> 5; float ss = 0.f; const float lam = WSP(float, WS_MISC)[LL];
                { const LAS unsigned* st = (const LAS unsigned*)(F.lds + fa::STASH_OFF + F.wave * 8192) + lane2;
#pragma unroll
                  for (int blk = 0; blk < 4; ++blk)
#pragma unroll
                    for (int r = 0; r < 16; r += 2) { const f16x2 v = __builtin_bit_cast(f16x2, st[(blk * 8 + (r >> 1)) * 64]);
                        const float a0 = (float)v[0] - lam * o0[blk][r], a1 = (float)v[1] - lam * o0[blk][r + 1]; o0[blk][r] = a0; o0[blk][r + 1] = a1; ss += a0 * a0 + a1 * a1; } }
                ss += __shfl_xor(ss, 32);
                const float rstd = 1.f / sqrtf(ss * (1.f / 128.f) + EPS);
#pragma unroll
                for (int blk = 0; blk < 4; ++blk)
#pragma unroll
                    for (int r = 0; r < 16; ++r) o0[blk][r] *= rstd * subl[32 * blk + fa::crow(r, hi)];
                fa::store_o<128>(o0, OA + (brow + qpos0 + (lane2 & 31)) * 512 + h * 128, hi);
              } }
#endif
#ifndef NO_MOBA
#ifdef NAIVE_MOBA
            { const f16* P = WSP(f16, WS_R1); f16* OC = WSP(f16, WS_OC); const float* tabs = WSP(float, WS_MISC + 1024); const float* kmean = WSP(float, WS_MISC + 65536);
              for (int task = GW; task < NB * 4 * SEQ; task += F.NGW) {
                const int bh = task / SEQ, b = bh >> 2, h = bh & 3, t = (task % SEQ + 37 * bh) % SEQ; const size_t row = (size_t)b * SEQ + t; const int j = t >> 8;
                const f16* q = P + row * PP + C_CQ + h * 64; const float qd = (float)q[LANE];
                float gate[8];
#pragma unroll
                for (int n = 0; n < 8; ++n) gate[n] = (n < j) ? wave_sum(qd * kmean[((size_t)bh * 8 + n) * 64 + LANE]) : -INFINITY;
                unsigned selb = 1u << j;
#pragma unroll
                for (int pick = 0; pick < 3; ++pick) { float best = -INFINITY; int bi = -1;
#pragma unroll
                    for (int n = 0; n < 8; ++n) if (!((selb >> n) & 1u) && gate[n] > best) { best = gate[n]; bi = n; }
                    if (bi >= 0) selb |= 1u << bi; }
                unsigned sel = 0u;
#pragma unroll
                for (int jj = 0; jj < 32; ++jj) sel |= ((selb >> (jj >> 2)) & 1u) << jj;
                float o[1];
                naive_attn<64, 64>(scl, q, P + (size_t)b * SEQ * PP + C_CK + h * 64, PP, P + (size_t)b * SEQ * PP + C_CV + h * 64, PP, t, sel, tabs + (8 + h) * TABN, LANE, o);
                OC[row * 256 + h * 64 + LANE] = (f16)o[0];
              } }
#else
            { const f16* P = WSP(f16, WS_R1); f16* OC = WSP(f16, WS_OC); const float* tabs2 = WSP(float, WS_MISC + 32768); const float* kmean = WSP(float, WS_MISC + 65536);
              unsigned* qctr = (unsigned*)launder(args.ws) + CW_QUEUE + 512 * ((rep * 2 + LL) * 4 + 1);
              LAS float* tabl = (LAS float*)(F.lds + fa::TAB_OFF);
              __syncthreads();
              for (int i2 = TID; i2 < 4 * TAB2H; i2 += 512) tabl[i2] = tabs2[8 * TAB2H + i2];
              if (TID == 0) MISC[17] = 0u;
              for (int uk = 0;; ++uk) {
                const int ui = unit_pick(uk, 64, qctr, MISC);
                if (ui < 0) break;
                const int qb = 7 - ((ui & 63) >> 3), bh = 8 * (ui >> 6) + (ui & 7), b = bh >> 2, h = bh & 3; const int lane = LANE, tid = F.wave * 64 + lane, r32 = lane & 31, hi = lane >> 5;
                const int qpos0 = qb * 256 + F.wave * 32, ntiles = 4 * qb + 4; const size_t brow = (size_t)b * SEQ; const f16* Pg = P + (size_t)(b >> 1) * GAPP;
                const f16* Qw = Pg + (brow + qpos0) * PP + C_CQ + h * 64;
                unsigned selb = 0u;
                { f16x8 qv[4];
#pragma unroll
                  for (int d0 = 0; d0 < 4; ++d0) qv[d0] = *(const f16x8*)(Qw + (size_t)r32 * PP + d0 * 16 + hi * 8);
                  LAS float* kmL = (LAS float*)(F.lds + 98304);
                  kmL[tid] = kmean[(size_t)bh * 512 + tid];
                  __syncthreads();
                  float gate[8];
#pragma unroll
                  for (int n = 0; n < 8; ++n) { float g = 0.f;
#pragma unroll
                    for (int d0 = 0; d0 < 4; ++d0) { const f32x4 k0 = *(const LAS f32x4*)(kmL + n * 64 + 8 * hi + 16 * d0), k1 = *(const LAS f32x4*)(kmL + n * 64 + 8 * hi + 16 * d0 + 4);
                        g += ((float)qv[d0][0] * k0.x + (float)qv[d0][1] * k0.y) + ((float)qv[d0][2] * k0.z + (float)qv[d0][3] * k0.w) + ((float)qv[d0][4] * k1.x + (float)qv[d0][5] * k1.y) + ((float)qv[d0][6] * k1.z + (float)qv[d0][7] * k1.w); }
                    g += __shfl_xor(g, 32);
                    gate[n] = (n < qb) ? g : -INFINITY; }
#pragma unroll
                  for (int pick = 0; pick < 3; ++pick) { float best = -INFINITY; int bi = -1;
#pragma unroll
                    for (int n = 0; n < 8; ++n) if (!((selb >> n) & 1u) && gate[n] > best) { best = gate[n]; bi = n; }
                    if (bi >= 0) selb |= 1u << bi; } }
                fa::f32x16 o[2];
                fa::attn_pass_pipe<64, 64, 1, 4>(F.lds, F.wave, lane, Qw, PP, Pg + brow * PP + C_CK + h * 64, PP, Pg + brow * PP + C_CV + h * 64, PP, ntiles, qpos0, tabl + h * TAB2H, selb, qb, nullptr, o);
                fa::store_o<64>(o, OC + (brow + qpos0 + r32) * 256 + h * 64, hi);
              } }
#endif
#endif
#ifndef NO_DSA
#ifdef NAIVE_DSA
            { const f16* P = WSP(f16, WS_R1); f16* OB = WSP(f16, WS_OB); const f16* KVN = WSP(f16, WS_KVN); const float* tabs = WSP(float, WS_MISC + 1024);
              for (int task = GW; task < NB * SEQ; task += F.NGW) {
                const int b = task / SEQ, t = (task % SEQ + 37 * b) % SEQ; const size_t row = (size_t)b * SEQ + t; const int lane = LANE;
                unsigned sel = 0xffffffffu;
                if (t >= 256) {
                    const int nslots = (t >> 6) + 1; const f16* iq = P + row * PP + C_BIQ; const f16* iwp = P + row * PP + C_BIW;
#pragma unroll 1
                    for (int j = 0; j < nslots; ++j) { unsigned kk = 0u; const int k = 64 * j + lane;
                        if (k <= t) { const f16* ik = P + ((size_t)b * SEQ + k) * PP + C_BIK; f16x8 kv[4];
#pragma unroll
                            for (int c = 0; c < 4; ++c) kv[c] = *(const f16x8*)(ik + 8 * c);
                            float s = 0.f;
#pragma unroll 1
                            for (int hh = 0; hh < 8; ++hh) { float d = 0.f;
#pragma unroll
                                for (int c = 0; c < 4; ++c) { const f16x8 qv = *(const f16x8*)(iq + hh * 32 + 8 * c);
#pragma unroll
                                    for (int e = 0; e < 8; ++e) d += (float)qv[e] * (float)kv[c][e]; }
                                s += fmaxf(d, 0.f) * (float)iwp[hh]; }
                            kk = ordkey(s); }
                        keyl[k] = kk; }
                    unsigned thr = 0u;
#pragma unroll 1
                    for (int bit = 31; bit >= 0; --bit) { const unsigned cand = thr | (1u << bit); int c = 0;
#pragma unroll 1
                        for (int j = 0; j < nslots; ++j) c += (keyl[64 * j + lane] >= cand) ? 1 : 0;
                        if (wave_isum(c) >= 256) thr = cand; }
                    int cgt = 0;
#pragma unroll 1
                    for (int j = 0; j < nslots; ++j) cgt += (keyl[64 * j + lane] > thr) ? 1 : 0;
                    cgt = wave_isum(cgt);
                    const int need = 256 - cgt; int run = 0; sel = 0u;
#pragma unroll 1
                    for (int j = 0; j < nslots; ++j) { const unsigned kk = keyl[64 * j + lane]; const bool tie = kk == thr; const unsigned long long bal = __ballot(tie);
                        const int pre = run + __popcll(bal & ((1ull << lane) - 1ull));
                        if (kk > thr || (tie && pre < need)) sel |= 1u << j;
                        run += __popcll(bal); }
                }
#pragma unroll 1
                for (int h = 0; h < 4; ++h) { float o[2];
                    naive_attn<128, 128>(scl, P + row * PP + C_BQ + h * 128, KVN + (size_t)b * SEQ * 128, 128, KVN + (size_t)b * SEQ * 128, 128, t, sel, tabs + (4 + h) * TABN, LANE, o);
                    OB[row * 512 + h * 128 + LANE] = (f16)o[0]; OB[row * 512 + h * 128 + 64 + LANE] = (f16)o[1]; }
              } }
#else
            { const f16* P = WSP(f16, WS_R1); f16* OB = WSP(f16, WS_OB); const f16* KVN = WSP(f16, WS_KVN); const float* tabs2 = WSP(float, WS_MISC + 32768); const unsigned* MASK = WSP(unsigned, WS_MASK);
              unsigned* qctr = (unsigned*)launder(args.ws) + CW_QUEUE + 512 * ((rep * 2 + LL) * 4 + 2);
              LAS float* tabl = (LAS float*)(F.lds + fa::TAB_OFF);
              __syncthreads();
              for (int i2 = TID; i2 < 4 * TAB2H; i2 += 512) tabl[i2] = tabs2[4 * TAB2H + i2];
              if (TID == 0) MISC[17] = 0u;
              for (int uk = 0;; ++uk) {
                const int ui = unit_pick(uk, 64, qctr, MISC);
                if (ui < 0) break;
                const int qi = 31 - ((ui & 63) >> 1), b = 2 * (ui >> 6) + (ui & 1); const int lane = LANE, tid = F.wave * 64 + lane, r32 = lane & 31, hi = lane >> 5;
                const int head = F.wave & 3, qpos0 = 64 * qi + 32 * (F.wave >> 2), ntiles = qi + 1; const size_t brow = (size_t)b * SEQ; const f16* Pg = P + (size_t)(b >> 1) * GAPP;
                fa::f32x16 o[4];
                fa::attn_pass_dma<128, 128, 2, 4>(F.lds, F.wave, lane, Pg + (brow + qpos0) * PP + C_BQ + head * 128, PP, KVN + brow * 128, 128, KVN + brow * 128, 128, ntiles, qpos0, tabl + head * TAB2H, 0u, 0,
                                           MASK + ((size_t)(b * 64 + (qpos0 >> 5)) * 32) * 64, o);
                fa::store_o<128>(o, OB + (brow + qpos0 + r32) * 512 + head * 128, hi);
              } }
#endif
#endif
        }
        SEAM_L();
        }
        for (int rep = 0; rep < REP_G2; ++rep) {
#ifndef NO_G2
        { pg8::StaticOrder S; S.init(MTOK, DM, F.G, (int)blockIdx.x);
#pragma unroll 1
          for (int yi = 0; yi < 3; ++yi) { const int y = launder_i(yi), Ky = (y == 2) ? 256 : 512;
            pg8::Gemm g{WSP(f16, WS_OA + (size_t)y * 32 * MiB), WSP(f16, WS_WA + (size_t)y * 2 * MiB) + (size_t)LL * DM * Ky, MTOK, DM, Ky}; pg8::EpiF16<0> E{WSP(f16, WS_R1) + (size_t)y * YSTR, DM, GAPY};
            pg8::gemm_phase<pg8::EpiF16<0>, pg8::StaticOrder, true, true>(F.lds, g, S, E, F.wave); } }
#endif
        SEAM_L();
        }
#ifndef NO_G3
        { pg8::Gemm g{(const f16*)((const unsigned char*)xout + (size_t)64 * MiB), (const f16*)(launder(args.ws) + WS_WQG + (size_t)LL * GCOLS * 1024), MTOK, GCOLS, DM / 2}; pg8::TripleOrder S; S.init(MTOK, F.G, (int)blockIdx.x);
          pg8::EpiGateMerge<true> E{WSP(f16, WS_R1), WSP(f16, WS_R1) + 3 * YSTR};
          pg8::fill_tabs_q((const float*)launder(args.ws) + CW_RF, WSP(float, WS_CVEC) + (size_t)(LL * 3 + 1) * 16 * 4096, IN(I_GATEB) + LL * GCOLS, WSP(float, WS_SB) + (LL * 3 + 1) * 4096, S, TID);
          pg8::gemm_phase<pg8::EpiGateMerge<true>, pg8::TripleOrder, true, true, true>(F.lds, g, S, E, F.wave); }
#endif
        SEAM_L();
#ifndef NO_G4
        { pg8::Gemm g{WSP(f16, WS_R1) + 3 * YSTR, WSP(f16, WS_WO) + (size_t)LL * DM * DM, MTOK, DM, DM, (unsigned)(GAPY * 2)}; pg8::StaticOrder S; S.init(MTOK, DM, F.G, (int)blockIdx.x);
          pg8::EpiResidual E{(const f16*)xout, (f16*)xout, WSP(float, WS_MOD) + (size_t)LL * 16 * 6144 + 2 * DM, 6144, WSP(f16, WS_U), IN(I_NMLP) + LL * DM, WSP(float, WS_MOD) + (size_t)LL * 16 * 6144 + 4 * DM, WSP(float, WS_SS)};
          pg8::gemm_phase<pg8::EpiResidual, pg8::StaticOrder, true, true>(F.lds, g, S, E, F.wave); }
#endif
        SEAM_L();
        for (int rep = 0; rep < REP_G5; ++rep) {
#ifndef NO_G5
        { pg8::Gemm g{WSP(f16, WS_U), WSP(f16, WS_W1) + (size_t)LL * DFF * DM, MTOK, DFF, DM}; pg8::StaticOrder S; S.init(MTOK, DFF, F.G, (int)blockIdx.x);
          pg8::EpiNormF16<1, false, true> E{WSP(f16, WS_R1), DFF, 0};
          pg8::fill_rstd(WSP(float, WS_SS), WSP(float, WS_CVEC) + (size_t)(LL * 3 + 2) * 16 * 4096, (const float*)nullptr, S, TID);
          pg8::gemm_phase<pg8::EpiNormF16<1, false, true>, pg8::StaticOrder, true, true>(F.lds, g, S, E, F.wave); }
#endif
        SEAM_L();
        }
#ifndef NO_G6
        { pg8::Gemm g{WSP(f16, WS_R1), WSP(f16, WS_W2) + (size_t)LL * DM * DFF, MTOK, DM, DFF}; pg8::StaticOrder S; S.init(MTOK, DM, F.G, (int)blockIdx.x);
          const bool more_layers = LL + 1 < DEPTH;
          pg8::EpiResidual E{(const f16*)xout, more_layers ? (f16*)xout : WSP(f16, WS_U), WSP(float, WS_MOD) + (size_t)LL * 16 * 6144 + 5 * DM, 6144, (f16*)nullptr, (const float*)nullptr, (const float*)nullptr, (float*)nullptr};
          pg8::gemm_phase<pg8::EpiResidual, pg8::StaticOrder, true, true, false, true>(F.lds, g, S, E, F.wave); }
#endif
        if (LL + 1 < DEPTH) SEAM_L(); else xcd_barrier(bar, F.wave);
        if (LL + 1 < DEPTH) {
            const int ln = LL + 1; const float* modl = WSP(float, WS_MOD) + (size_t)ln * 16 * 6144; const float* nw = IN(I_NMIX) + ln * DM; unsigned char* U8 = (unsigned char*)xout + (size_t)64 * MiB; float* rf = (float*)launder(args.ws) + CW_RF;
            for (int m0 = GWX * 16; m0 < MTOK; m0 += F.NGW * 16) { const int b = m0 / SEQ;
                norm_quant_rows16((const f16*)xout, nw, modl + (size_t)b * 6144 + 1 * DM, U8, rf, m0, LANE); }
            SEAM_L(); }
    }
    { const float* nf = IN(I_NFINAL); const f16* xf = WSP(f16, WS_U);
      for (int m0 = GWX * 16; m0 < MTOK; m0 += F.NGW * 16) { const int lane = LANE;
        f32x4 gn[4];
#pragma unroll
        for (int j = 0; j < 4; ++j) gn[j] = ((const GAS f32x4*)nf)[lane + 64 * j];
        u32x2 nx[4];
#pragma unroll
        for (int j = 0; j < 4; ++j) nx[j] = ((const GAS u32x2*)(xf + (size_t)m0 * DM) + lane)[64 * j];
#pragma unroll 1
        for (int r = 0; r < 16; ++r) { const int m = m0 + r;
            f32x4 v[4]; float s = 0.f;
#pragma unroll
            for (int j = 0; j < 4; ++j) { const unsigned wx = nx[j].x, wy = nx[j].y; const f16x2 a = __builtin_bit_cast(f16x2, wx), b2 = __builtin_bit_cast(f16x2, wy);
                v[j] = (f32x4){(float)a[0], (float)a[1], (float)b2[0], (float)b2[1]}; s += (v[j].x * v[j].x + v[j].y * v[j].y) + (v[j].z * v[j].z + v[j].w * v[j].w); }
            if (r + 1 < 16) {
#pragma unroll
                for (int j = 0; j < 4; ++j) nx[j] = ((const GAS u32x2*)(xf + (size_t)(m + 1) * DM) + lane)[64 * j]; }
            const float rstd = 1.f / sqrtf(wave_sum(s) * (1.f / DM) + EPS);
            GAS f32x4* orow = (GAS f32x4*)(xout + (size_t)m * DM) + lane;
#pragma unroll
            for (int j = 0; j < 4; ++j) orow[64 * j] = v[j] * rstd * gn[j]; }
      } }
#undef IN
#undef WSP
#undef LANE
#undef LL
#undef GW
#undef TID
}

extern "C" void kernel_launch(void* const* d_in, const int* in_sizes, int n_in, void* d_out, int out_size, void* d_ws, size_t ws_size, hipStream_t stream) {
    static int grid = 0;
    if (grid == 0) {
        if (n_in != 20 || in_sizes[0] != MTOK * DM || out_size != MTOK * DM || ws_size < WS_END) { fprintf(stderr, "kernel_launch: shape/workspace mismatch (n_in %d, ws %zu); nothing launched\n", n_in, ws_size); grid = -1; return; }
        int dev = 0, cus = 0, per_cu = 0;
        if (hipGetDevice(&dev) != hipSuccess || hipDeviceGetAttribute(&cus, hipDeviceAttributeMultiprocessorCount, dev) != hipSuccess) { grid = -1; return; }
        if (hipFuncSetAttribute((const void*)mega_fwd, hipFuncAttributeMaxDynamicSharedMemorySize, LDS_BYTES) != hipSuccess) { fprintf(stderr, "kernel_launch: hipFuncSetAttribute failed\n"); grid = -1; return; }
        if (hipOccupancyMaxActiveBlocksPerMultiprocessor(&per_cu, (const void*)mega_fwd, NWAVES * 64, LDS_BYTES) != hipSuccess || per_cu < 1) { fprintf(stderr, "kernel_launch: occupancy query says %d blocks per CU\n", per_cu); }
        (void)hipGetLastError();
        grid = cus;
    }
    if (grid < 0) return;
    if (hipMemsetAsync((char*)d_ws + WS_CTL, 0, CTL_ZERO_BYTES, stream) != hipSuccess) return;
    Args a{};
    for (int i = 0; i < 20; ++i) a.in[i] = (const float*)d_in[i];
    a.out = (float*)d_out; a.ws = (unsigned char*)d_ws;
    hipLaunchKernelGGL(mega_fwd, dim3(grid), dim3(NWAVES * 64), LDS_BYTES, stream, a);
}
```

```cpp
#include <hip/hip_runtime.h>
#include <cstdio>
#include <cstdint>
#ifndef REP_N1
#define REP_N1 1
#endif
#ifndef REP_G1
#define REP_G1 1
#endif
#ifndef REP_SEL
#define REP_SEL 1
#endif
#ifndef REP_ATT
#define REP_ATT 1
#endif
#ifndef REP_G2
#define REP_G2 1
#endif
#ifndef REP_G5
#define REP_G5 1
#endif
#ifndef REP_P0
#define REP_P0 1
#endif
#ifndef REP_SCORE
#define REP_SCORE 1
#endif
#ifndef REP_RADIX
#define REP_RADIX 1
#endif
#ifndef REP_DIFF
#define REP_DIFF 1
#endif
#ifndef REP_MOBA
#define REP_MOBA 1
#endif
#ifndef REP_DSA
#define REP_DSA 1
#endif

#define LAS __attribute__((address_space(3)))
#define GAS __attribute__((address_space(1)))
typedef _Float16 f16;
typedef _Float16 f16x8 __attribute__((ext_vector_type(8)));
typedef _Float16 f16x4 __attribute__((ext_vector_type(4)));
typedef _Float16 f16x2 __attribute__((ext_vector_type(2)));
typedef float f32x4 __attribute__((ext_vector_type(4)));
typedef float f32x2 __attribute__((ext_vector_type(2)));
typedef unsigned u32x4 __attribute__((ext_vector_type(4)));
typedef unsigned u32x2 __attribute__((ext_vector_type(2)));

constexpr int NB = 16, SEQ = 2048, DM = 1024, MTOK = NB * SEQ, DEPTH = 2, DFF = 4096;
constexpr int IN_COLS = 6312, PCOLS = 3240, PP = 3328  , GCOLS = 3072;
constexpr int C_AQ = 0, C_AK = 512, C_AV = 1024, C_BQ = 1536, C_BKV = 2048, C_BIQ = 2176, C_BIK = 2432, C_BIW = 2464, C_CQ = 2472, C_CK = 2728, C_CV = 2984, C_G = 3240;
constexpr float EPS = 1e-6f, LOG2E = 1.4426950408889634f;
constexpr int TABN = 384;
constexpr int TAB2 = 320, TAB2H = 2 * TAB2;

__device__ __forceinline__ unsigned pk2h(float lo, float hi) { f32x2 v = {lo, hi}; f16x2 h = __builtin_convertvector(v, f16x2); return __builtin_bit_cast(unsigned, h); }

__device__ __forceinline__ int lane_id() { int l; asm volatile("v_mbcnt_lo_u32_b32 %0, -1, 0\n\tv_mbcnt_hi_u32_b32 %0, -1, %0" : "=v"(l)); return l; }

constexpr size_t SLAB_E = 16u * 1024u * 1024u;
constexpr size_t GAPP = SLAB_E - (size_t)4096 * 3328, GAPY = SLAB_E - (size_t)4096 * 1024, YSTR = (size_t)4096 * 1024;
namespace pg8 {
#define PG8_LAS __attribute__((address_space(3)))
#ifndef PG8_GRACE
#define PG8_GRACE 1
#endif
constexpr int BM = 256, BK = 64, HALF = 128, HTB = HALF * BK * 2, STAGE_BYTES = 8 * HTB, NXCD = 8, WGM = 8;
__host__ __device__ __forceinline__ int lds_byte(int r, int c) { const int st = (r >> 4) * 2 + (c >> 5), rr = r & 15, cc = c & 31, ob = rr * 64 + cc * 2; return st * 1024 + (ob ^ (((ob >> 9) & 1) << 5)); }
__host__ __device__ __forceinline__ void stage_rc(int b, int& R, int& C) { const int st = b / 1024, sb = b % 1024, swz = sb ^ (((sb >> 9) & 1) << 5); R = (st >> 1) * 16 + swz / 64; C = (st & 1) * 32 + (swz % 64) / 2; }
__host__ __device__ __forceinline__ int perm32(int rho) { const int n = rho >> 4, i = rho & 15; return 8 * (i >> 2) + 4 * n + (i & 3); }

struct Unit { int pm, pn, idx; };
struct Gemm { const f16* A; const f16* Bt; int M, N, K; unsigned gapA = 0u; };

struct StaticOrder {
    int nM, nN, nwg, G, c;
    __host__ __device__ void init(int M, int N, int G_, int c_) { nM = M / BM; nN = N / BM; nwg = nM * nN; G = G_; c = c_; }
    __host__ __device__ bool next(int i, Unit& u) const {
        const long L = (long)i * G + c; if (L >= nwg) return false;
        int wgid = (int)L; { const int q = nwg / NXCD, r = nwg % NXCD, xcd = wgid % NXCD, off = wgid / NXCD; wgid = (xcd < r ? xcd * (q + 1) : r * (q + 1) + (xcd - r) * q) + off; }
        const int nig = WGM * nN, gid = wgid / nig, fm = gid * WGM, gsz = (nM - fm) < WGM ? (nM - fm) : WGM;
        u.pm = fm + ((wgid % nig) % gsz); u.pn = (wgid % nig) / gsz; u.idx = i; return true;
    }
    __device__ __forceinline__ void a_ready(const Unit&) const {}
    __device__ __forceinline__ void done(const Unit&) const {}
};
struct TripleOrder {
    StaticOrder so;
    __host__ __device__ void init(int M, int G_, int c_) { so.init(M, 1024, G_, c_); }
    __host__ __device__ bool next(int i, Unit& u) const { if (!so.next(i / 3, u)) return false; u.pn += 4 * (i % 3); u.idx = i; return true; }
    __device__ __forceinline__ void a_ready(const Unit&) const {}
    __device__ __forceinline__ void done(const Unit&) const {}
};

typedef int i32x4 __attribute__((ext_vector_type(4)));
typedef u32x4 __attribute__((address_space(1))) g_u32x4;
typedef u32x2 __attribute__((address_space(1))) g_u32x2;
typedef f32x4 __attribute__((address_space(1))) g_f32x4;
typedef float __attribute__((address_space(1))) g_f32;
typedef f16x8 __attribute__((address_space(1))) g_f16x8;
__device__ __forceinline__ void gst16(void* p, const u32x4 w) { *(g_u32x4*)(p) = w; }
__device__ __forceinline__ void gst8(void* p, const u32x2 w) { *(g_u32x2*)(p) = w; }
template <int ACT  > struct EpiF16 {
    static constexpr bool PERM = true, AFTER_DRAIN = false; static constexpr int NSTORE = 16;
    f16* O; int ldc; size_t gap;
    __device__ __forceinline__ void operator()(const f32x4 (&acc)[2][2][4][2], const Unit& u, int wr, int wc, int fr, int fq) const {
        const int row0 = u.pm * BM + wr * 64 + fr; const int col0 = u.pn * BM + wc * 32 + 8 * fq;
#pragma unroll
        for (int ai = 0; ai < 2; ++ai)
#pragma unroll
            for (int m = 0; m < 4; ++m) { f16* rowp = O + (size_t)(row0 + ai * HALF + m * 16) * ldc + (size_t)((row0 + ai * HALF + m * 16) >> 12) * gap + col0;
#pragma unroll
                for (int bj = 0; bj < 2; ++bj) { f32x4 v0 = acc[ai][bj][m][0], v1 = acc[ai][bj][m][1];
                    if (ACT == 1) {
#pragma unroll
                        for (int e = 0; e < 4; ++e) { const float a = fmaxf(v0[e], 0.f), b = fmaxf(v1[e], 0.f); v0[e] = a * a; v1[e] = b * b; } }
                    u32x4 w; w.x = pk2h(v0[0], v0[1]); w.y = pk2h(v0[2], v0[3]); w.z = pk2h(v1[0], v1[1]); w.w = pk2h(v1[2], v1[3]);
                    gst16(rowp + bj * HALF, w); } }
    }
};
constexpr int RSTD_LDS = 131072, CV_LDS_ = 139264 + 1024, SB_LDS = CV_LDS_ + 8192;
__device__ __forceinline__ void row_rstd(const Unit& u, int wr, int fr, float (&rs)[2][4]) {
    const PG8_LAS float* rt = (const PG8_LAS float*)(uintptr_t)(RSTD_LDS + u.idx * 1024) + wr * 64 + fr;
#pragma unroll
    for (int ai = 0; ai < 2; ++ai)
#pragma unroll
        for (int m = 0; m < 4; ++m) rs[ai][m] = rt[ai * HALF + m * 16];
}
constexpr int CV_LDS = 139264 + 1024;
template <class Sched> __device__ __forceinline__ void fill_rstd(const float* SS, const float* cvec, const float* gb, const Sched& S, int tid) {
    for (int i = 0; i < 8; ++i) { Unit u; if (!S.next(i, u)) break;
        if (tid < 256) { const f32x4* sp = (const f32x4*)(SS + (size_t)(u.pm * BM + tid) * 16);
            const f32x4 a = sp[0], b = sp[1], c = sp[2], d = sp[3]; const f32x4 t = (a + b) + (c + d);
            ((PG8_LAS float*)(uintptr_t)(RSTD_LDS + i * 1024))[tid] = __builtin_amdgcn_rsqf(((t.x + t.y) + (t.z + t.w)) * (1.f / DM) + EPS); }
        else { const int c = tid - 256; float v = cvec[(size_t)((u.pm * BM) / SEQ) * 4096 + u.pn * BM + c]; if (gb) v += gb[u.pn * BM + c];
            ((PG8_LAS float*)(uintptr_t)(CV_LDS + i * 1024))[c] = v; } }
    __syncthreads();
}
template <class Sched> __device__ __forceinline__ void fill_tabs_q(const float* rowfac, const float* cvec, const float* gb, const float* sbv, const Sched& S, int tid) {
    const int c = tid & 255;
#pragma unroll 1
    for (int i0 = 0; i0 < 8; i0 += 4) {
        float va[4], vb[4], vc[4]; bool ok[4];
#pragma unroll
        for (int j = 0; j < 4; ++j) { Unit u; ok[j] = S.next(i0 + j, u); if (!ok[j]) { u.pm = 0; u.pn = 0; }
            if (tid < 256) va[j] = *(const g_f32*)(rowfac + u.pm * BM + c);
            else { va[j] = *(const g_f32*)(cvec + (size_t)((u.pm * BM) / SEQ) * 4096 + u.pn * BM + c); vb[j] = *(const g_f32*)(sbv + u.pn * BM + c); vc[j] = gb ? *(const g_f32*)(gb + u.pn * BM + c) : 0.f; } }
#pragma unroll
        for (int j = 0; j < 4; ++j) if (ok[j]) {
            if (tid < 256) ((PG8_LAS float*)(uintptr_t)(RSTD_LDS + (i0 + j) * 1024))[c] = va[j];
            else { ((PG8_LAS float*)(uintptr_t)(CV_LDS + (i0 + j) * 1024))[c] = va[j] + vc[j]; ((PG8_LAS float*)(uintptr_t)(SB_LDS + (i0 + j) * 1024))[c] = vb[j]; } } }
    __syncthreads();
}
template <int ACT  , bool I8 = false, bool TILED = false> struct EpiNormF16 {
    static constexpr bool PERM = true, AFTER_DRAIN = false; static constexpr int NSTORE = 16;
    f16* O; int ldc; size_t gap;
    __device__ __forceinline__ void operator()(const f32x4 (&acc)[2][2][4][2], const Unit& u, int wr, int wc, int fr, int fq) const {
        const int row0 = u.pm * BM + wr * 64 + fr; const int col0 = u.pn * BM + wc * 32 + 8 * fq; const int b = (u.pm * BM) / SEQ;
        float rs[2][4]; row_rstd(u, wr, fr, rs);
        f32x4 cv[2][2];
#pragma unroll
        for (int bj = 0; bj < 2; ++bj)
#pragma unroll
            for (int n = 0; n < 2; ++n) cv[bj][n] = *(const PG8_LAS f32x4*)(uintptr_t)(CV_LDS + u.idx * 1024 + (wc * 32 + 8 * fq + bj * HALF + 4 * n) * 4);
        f32x4 sv[2][2];
        if constexpr (I8) {
#pragma unroll
            for (int bj = 0; bj < 2; ++bj)
#pragma unroll
                for (int n = 0; n < 2; ++n) sv[bj][n] = *(const PG8_LAS f32x4*)(uintptr_t)(SB_LDS + u.idx * 1024 + (wc * 32 + 8 * fq + bj * HALF + 4 * n) * 4); }
#pragma unroll
        for (int ai = 0; ai < 2; ++ai)
#pragma unroll
            for (int m = 0; m < 4; ++m) { const int rowg = row0 + ai * HALF + m * 16;
                f16* rowp = TILED ? O + ((size_t)((rowg >> 8) * (ldc >> 6) + (col0 >> 6)) * 256 + (rowg & 255)) * 64 + (col0 & 63) : O + (size_t)rowg * ldc + (size_t)(rowg >> 12) * gap + col0; const float r = rs[ai][m];
#pragma unroll
                for (int bj = 0; bj < 2; ++bj) { f32x4 a0 = acc[ai][bj][m][0], a1 = acc[ai][bj][m][1];
                    if constexpr (I8) { const i32x4 i0 = __builtin_bit_cast(i32x4, a0), i1 = __builtin_bit_cast(i32x4, a1);
                        a0 = (f32x4){(float)i0.x, (float)i0.y, (float)i0.z, (float)i0.w} * sv[bj][0]; a1 = (f32x4){(float)i1.x, (float)i1.y, (float)i1.z, (float)i1.w} * sv[bj][1]; }
                    f32x4 v0 = a0 * r + cv[bj][0], v1 = a1 * r + cv[bj][1];
                    if (ACT == 1) {
#pragma unroll
                        for (int e = 0; e < 4; ++e) { const float a = fmaxf(v0[e], 0.f), b2 = fmaxf(v1[e], 0.f); v0[e] = a * a; v1[e] = b2 * b2; } }
                    u32x4 w; w.x = pk2h(v0[0], v0[1]); w.y = pk2h(v0[2], v0[3]); w.z = pk2h(v1[0], v1[1]); w.w = pk2h(v1[2], v1[3]);
                    gst16(rowp + (TILED ? bj * 2 * 256 * 64 : bj * HALF), w); } }
    }
};
template <bool I8> struct EpiGateMerge {
    static constexpr bool PERM = true, AFTER_DRAIN = false; static constexpr int NSTORE = 28;
    f16* Y; f16* merged;
    __device__ __forceinline__ void operator()(const f32x4 (&acc)[2][2][4][2], const Unit& u, int wr, int wc, int fr, int fq) const {
        const int br = u.pn >> 2, pc = u.pn & 3;
        const int row0 = u.pm * BM + wr * 64 + fr; const int col0 = pc * BM + wc * 32 + 8 * fq;
        if (br == 2) { __builtin_amdgcn_fence(__ATOMIC_ACQUIRE, "agent"); }
        const int b = (u.pm * BM) / SEQ; float rs[2][4]; row_rstd(u, wr, fr, rs);
        f32x4 bv[2][2];
#pragma unroll
        for (int bj = 0; bj < 2; ++bj)
#pragma unroll
            for (int n = 0; n < 2; ++n) bv[bj][n] = *(const PG8_LAS f32x4*)(uintptr_t)(CV_LDS + u.idx * 1024 + (wc * 32 + 8 * fq + bj * HALF + 4 * n) * 4);
        f32x4 sv[2][2];
        if constexpr (I8) {
#pragma unroll
            for (int bj = 0; bj < 2; ++bj)
#pragma unroll
                for (int n = 0; n < 2; ++n) sv[bj][n] = *(const PG8_LAS f32x4*)(uintptr_t)(SB_LDS + u.idx * 1024 + (wc * 32 + 8 * fq + bj * HALF + 4 * n) * 4); }
        f16* Yb = Y + (size_t)br * YSTR;
#pragma unroll
        for (int ai = 0; ai < 2; ++ai) {
            const int rowa = row0 + ai * HALF; const size_t offa = (size_t)rowa * 1024 + (size_t)(rowa >> 12) * GAPY + col0;
#pragma unroll
            for (int mp = 0; mp < 2; ++mp) {
            f16x8 yv[4][2];
#pragma unroll
            for (int m = 2 * mp; m < 2 * mp + 2; ++m)
#pragma unroll
                for (int bj = 0; bj < 2; ++bj) yv[m][bj] = *(const g_f16x8*)(Yb + offa + (size_t)m * 16 * 1024 + bj * HALF);
#pragma unroll
            for (int m = 2 * mp; m < 2 * mp + 2; ++m) { const size_t off = offa + (size_t)m * 16 * 1024;
                f16x8 za[2], zb[2];
                if (br == 2) {
#pragma unroll
                    for (int bj = 0; bj < 2; ++bj) { za[bj] = *(const g_f16x8*)(Y + off + bj * HALF); zb[bj] = *(const g_f16x8*)(Y + YSTR + off + bj * HALF); } }
#pragma unroll
                for (int bj = 0; bj < 2; ++bj) {
                    f32x4 a0 = acc[ai][bj][m][0], a1 = acc[ai][bj][m][1];
                    if constexpr (I8) { const i32x4 i0 = __builtin_bit_cast(i32x4, a0), i1 = __builtin_bit_cast(i32x4, a1);
                        a0 = (f32x4){(float)i0.x, (float)i0.y, (float)i0.z, (float)i0.w} * sv[bj][0]; a1 = (f32x4){(float)i1.x, (float)i1.y, (float)i1.z, (float)i1.w} * sv[bj][1]; }
                    const f32x4 g0 = a0 * rs[ai][m] + bv[bj][0], g1 = a1 * rs[ai][m] + bv[bj][1];
                    const f16x8 yy = yv[m][bj];
                    float z[8];
#pragma unroll
                    for (int e = 0; e < 4; ++e) { z[e] = (float)yy[e] * __builtin_amdgcn_rcpf(1.f + __builtin_amdgcn_exp2f(-LOG2E * g0[e])); z[4 + e] = (float)yy[4 + e] * __builtin_amdgcn_rcpf(1.f + __builtin_amdgcn_exp2f(-LOG2E * g1[e])); }
                    if (br == 2) {
#pragma unroll
                        for (int e = 0; e < 8; ++e) z[e] += (float)za[bj][e] + (float)zb[bj][e]; }
                    u32x4 w; w.x = pk2h(z[0], z[1]); w.y = pk2h(z[2], z[3]); w.z = pk2h(z[4], z[5]); w.w = pk2h(z[6], z[7]);
                    f16* dst = (br == 2) ? merged : Yb;
                    gst16(dst + off + bj * HALF, w); } } } }
    }
};
struct EpiResidual {
    static constexpr bool PERM = true, AFTER_DRAIN = false; static constexpr int NSTORE = 32;
    const f16* xin16; f16* out; const float* gate; int gpitch; f16* U; const float* nw; const float* nsc; float* SS;
    __device__ __forceinline__ void operator()(const f32x4 (&acc)[2][2][4][2], const Unit& u, int wr, int wc, int fr, int fq) const {
        const int col0 = u.pn * BM + wc * 32 + 8 * fq; const int b = (u.pm * BM) / SEQ;
        f32x4 gv[2][2], Gv[2][2];
#pragma unroll
        for (int bj = 0; bj < 2; ++bj)
#pragma unroll
            for (int n = 0; n < 2; ++n) gv[bj][n] = *(const g_f32x4*)(gate + (size_t)b * gpitch + col0 + bj * HALF + 4 * n);
        if (U) {
#pragma unroll
            for (int bj = 0; bj < 2; ++bj)
#pragma unroll
                for (int n = 0; n < 2; ++n) Gv[bj][n] = *(const g_f32x4*)(nw + col0 + bj * HALF + 4 * n) * (*(const g_f32x4*)(nsc + (size_t)b * gpitch + col0 + bj * HALF + 4 * n) + 1.f); }
#pragma unroll
        for (int ai = 0; ai < 2; ++ai) {
            const int rowa = u.pm * BM + ai * HALF + wr * 64 + fr;
            f16x8 xh[4][2];
#pragma unroll
            for (int m = 0; m < 4; ++m)
#pragma unroll
                for (int bj = 0; bj < 2; ++bj) xh[m][bj] = *(const g_f16x8*)(xin16 + (size_t)(rowa + m * 16) * DM + col0 + bj * HALF);
#pragma unroll
            for (int m = 0; m < 4; ++m) { const int row = rowa + m * 16; const size_t off = (size_t)row * DM + col0; float ss = 0.f;
#pragma unroll
                for (int bj = 0; bj < 2; ++bj) { const f16x8 h = xh[m][bj];
                    const f32x4 xn0 = (f32x4){(float)h[0], (float)h[1], (float)h[2], (float)h[3]} + gv[bj][0] * acc[ai][bj][m][0];
                    const f32x4 xn1 = (f32x4){(float)h[4], (float)h[5], (float)h[6], (float)h[7]} + gv[bj][1] * acc[ai][bj][m][1];
                    { u32x4 w; w.x = pk2h(xn0.x, xn0.y); w.y = pk2h(xn0.z, xn0.w); w.z = pk2h(xn1.x, xn1.y); w.w = pk2h(xn1.z, xn1.w); gst16(out + off + bj * HALF, w); }
                    if (U) { ss += ((xn0.x * xn0.x + xn0.y * xn0.y) + (xn0.z * xn0.z + xn0.w * xn0.w)) + ((xn1.x * xn1.x + xn1.y * xn1.y) + (xn1.z * xn1.z + xn1.w * xn1.w));
                        const f32x4 y0 = xn0 * Gv[bj][0], y1 = xn1 * Gv[bj][1];
                        u32x4 w; w.x = pk2h(y0.x, y0.y); w.y = pk2h(y0.z, y0.w); w.z = pk2h(y1.x, y1.y); w.w = pk2h(y1.z, y1.w); gst16(U + off + bj * HALF, w); } }
                if (U) { ss += __shfl_xor(ss, 16); ss += __shfl_xor(ss, 32); if (fq == 0) *(g_f32*)(SS + (size_t)row * 16 + u.pn * 4 + wc) = ss; } } }
    }
};

__device__ __forceinline__ unsigned sgpr_opaque(unsigned x) { asm volatile("" : "+s"(x)); return x; }
template <class Epi, class Sched, bool ALIGN_EPI = false, bool SP2 = false, bool I8 = false, bool ATILED = false>
__device__ __forceinline__ void gemm_phase(PG8_LAS unsigned char* lds, const Gemm g, const Sched& S, const Epi& E, const int wid) {
    const int lane = lane_id(), tid = wid * 64 + lane, wr = wid >> 2, wc = wid & 3, fr = lane & 15, fq = lane >> 4;
    const int K = g.K, nt = K / BK;
    unsigned voffA[2], voffB[2];
#pragma unroll
    for (int i = 0; i < 2; ++i) { int R, C; stage_rc(tid * 16 + i * 8192, R, C); const int Rb = Epi::PERM ? ((R & ~31) + perm32(R & 31)) : R;
        voffA[i] = (unsigned)(R * (ATILED ? BK : K) + C) * 2u; voffB[i] = (unsigned)(Rb * K + C) * 2u; }
    const unsigned kstep = (unsigned)(BK * 2);
    const unsigned hstep = (unsigned)HALF * K * 2;
    const unsigned tstep = 2 * hstep;
    const unsigned kstepA = ATILED ? (unsigned)(BM * BK * 2) : kstep, hstepA = ATILED ? (unsigned)(HALF * BK * 2) : hstep, tstepA = ATILED ? (unsigned)nt * (unsigned)(BM * BK * 2) : tstep;
    const __amdgpu_buffer_rsrc_t rsA = __builtin_amdgcn_make_buffer_rsrc((void*)g.A, 0, 0x7fffffff, 0x00020000), rsB = __builtin_amdgcn_make_buffer_rsrc((void*)g.Bt, 0, 0x7fffffff, 0x00020000);
    const unsigned ldsw = (unsigned)wid * 1024u;
    const int aoff = lds_byte(wr * 64 + fr, fq * 8), boff = lds_byte(wc * 32 + fr, fq * 8);
#define PG8_SA(b, h) (((b) * 2 + (h)) * HTB)
#define PG8_SB(b, h) ((4 + (b) * 2 + (h)) * HTB)
#define PG8_STAGE(bufoff, RS, soff, voff) do { _Pragma("unroll") for (int _i = 0; _i < 2; ++_i) \
        __builtin_amdgcn_raw_ptr_buffer_load_lds(RS, (PG8_LAS void*)(lds + (bufoff) + sgpr_opaque(ldsw) + _i * 8192), 16, (int)(voff)[_i], (int)(soff), 0, 0); } while (0)
#define PG8_LDA(dst, b, h) do { _Pragma("unroll") for (int m = 0; m < 4; ++m) _Pragma("unroll") for (int k = 0; k < 2; ++k) dst[m][k] = *(const PG8_LAS f16x8*)(lds + PG8_SA(b, h) + aoff + m * 2048 + k * 1024); } while (0)
#define PG8_LDB(dst, b, h) do { _Pragma("unroll") for (int n = 0; n < 2; ++n) _Pragma("unroll") for (int k = 0; k < 2; ++k) dst[n][k] = *(const PG8_LAS f16x8*)(lds + PG8_SB(b, h) + boff + n * 2048 + k * 1024); } while (0)
#define PG8_MMA(ai, bj, At, Bt) do { __builtin_amdgcn_s_setprio(1); _Pragma("unroll") for (int m = 0; m < 4; ++m) _Pragma("unroll") for (int n = 0; n < 2; ++n) _Pragma("unroll") for (int k = 0; k < 2; ++k) \
        { if constexpr (I8) acc[ai][bj][m][n] = __builtin_bit_cast(f32x4, __builtin_amdgcn_mfma_i32_16x16x64_i8(__builtin_bit_cast(i32x4, Bt[n][k]), __builtin_bit_cast(i32x4, At[m][k]), __builtin_bit_cast(i32x4, acc[ai][bj][m][n]), 0, 0, 0)); \
          else acc[ai][bj][m][n] = __builtin_amdgcn_mfma_f32_16x16x32_f16(Bt[n][k], At[m][k], acc[ai][bj][m][n], 0, 0, 0); } __builtin_amdgcn_s_setprio(0); } while (0)
#define PG8_WAIT_V(n) asm volatile("s_waitcnt vmcnt(" #n ")" ::: "memory")
#define PG8_WAIT_L(n) asm volatile("s_waitcnt lgkmcnt(" #n ")" ::: "memory")
#define PG8_BAR __builtin_amdgcn_s_barrier()
#define PG8_SCHED __builtin_amdgcn_sched_barrier(0)
    Unit cur, nxt; int ui = 0;
    if (!S.next(0, cur)) return;
    f32x4 acc[2][2][4][2];
#pragma unroll
    for (int a = 0; a < 2; ++a)
#pragma unroll
        for (int b = 0; b < 2; ++b)
#pragma unroll
            for (int m = 0; m < 4; ++m)
#pragma unroll
                for (int n = 0; n < 2; ++n) acc[a][b][m][n] = (f32x4){0.f, 0.f, 0.f, 0.f};
    f16x8 At[4][2], B0[2][2], B1[2][2];
    unsigned cA = (unsigned)cur.pm * tstepA + (unsigned)(cur.pm >> 4) * g.gapA, cB = (unsigned)cur.pn * tstep;
    S.a_ready(cur);
    if constexpr (SP2) {
        PG8_STAGE(PG8_SB(0, 0), rsB, cB, voffB); PG8_STAGE(PG8_SB(0, 1), rsB, cB + hstep, voffB); PG8_STAGE(PG8_SA(0, 0), rsA, cA, voffA); PG8_STAGE(PG8_SA(0, 1), rsA, cA + hstepA, voffA);
        if (wr == 1) PG8_BAR;
        PG8_WAIT_V(2); PG8_BAR;
        PG8_STAGE(PG8_SB(1, 0), rsB, cB + kstep, voffB); PG8_STAGE(PG8_SA(1, 0), rsA, cA + kstepA, voffA); PG8_STAGE(PG8_SB(1, 1), rsB, cB + hstep + kstep, voffB);
        PG8_WAIT_V(6); PG8_BAR;
    } else {
        PG8_STAGE(PG8_SB(0, 0), rsB, cB, voffB); PG8_STAGE(PG8_SA(0, 0), rsA, cA, voffA); PG8_STAGE(PG8_SB(0, 1), rsB, cB + hstep, voffB); PG8_STAGE(PG8_SA(0, 1), rsA, cA + hstepA, voffA);
        if (wr == 1) PG8_BAR;
        PG8_WAIT_V(4); PG8_BAR;
        PG8_STAGE(PG8_SB(1, 0), rsB, cB + kstep, voffB); PG8_STAGE(PG8_SA(1, 0), rsA, cA + kstepA, voffA); PG8_STAGE(PG8_SB(1, 1), rsB, cB + hstep + kstep, voffB);
        PG8_WAIT_V(6); PG8_BAR;
    }
    for (;;) {
        const bool has_next = S.next(ui + 1, nxt);
        const unsigned nA = has_next ? (unsigned)nxt.pm * tstepA + (unsigned)(nxt.pm >> 4) * g.gapA : cA, nB = has_next ? (unsigned)nxt.pn * tstep : cB;
        for (int t = 0; t < nt; t += 2) {
            const bool last = (t == nt - 2);
            const unsigned a1 = cA + (unsigned)(t + 1) * kstepA;
            const unsigned a2 = last ? nA : cA + (unsigned)(t + 2) * kstepA, b2 = last ? nB : cB + (unsigned)(t + 2) * kstep;
            const unsigned a3 = a2 + kstepA, b3 = b2 + kstep;
            if (last && has_next) S.a_ready(nxt);
            if constexpr (SP2) {
            const int grace = __builtin_amdgcn_readfirstlane((PG8_GRACE && Epi::NSTORE > 0 && t == 0 && ui > 0) ? 1 : 0);
#define PG8_WAIT_VG do { if constexpr (PG8_GRACE && Epi::NSTORE > 0) asm volatile("s_cmp_lg_u32 %0, 0\n\ts_cbranch_scc1 .Lgr%=\n\ts_waitcnt vmcnt(8)\n.Lgr%=:\n\ts_waitcnt vmcnt(%1)" :: "s"(grace), "n"(8 + Epi::NSTORE) : "memory", "scc"); \
                         else PG8_WAIT_V(8); } while (0)
            PG8_LDB(B0, 0, 0); PG8_LDB(B1, 0, 1); PG8_SCHED; PG8_LDA(At, 0, 0); PG8_STAGE(PG8_SA(1, 1), rsA, a1 + hstepA, voffA);
            PG8_WAIT_VG; PG8_WAIT_L(0); PG8_BAR; PG8_MMA(0, 0, At, B0); PG8_MMA(0, 1, At, B1); PG8_BAR; PG8_SCHED;
            PG8_LDA(At, 0, 1); PG8_STAGE(PG8_SB(0, 0), rsB, b2, voffB); PG8_STAGE(PG8_SB(0, 1), rsB, b2 + hstep, voffB); PG8_STAGE(PG8_SA(0, 0), rsA, a2, voffA);
            PG8_WAIT_VG; PG8_WAIT_L(0); PG8_BAR; PG8_MMA(1, 0, At, B0); PG8_MMA(1, 1, At, B1); PG8_BAR; PG8_SCHED;
            PG8_LDB(B0, 1, 0); PG8_LDB(B1, 1, 1); PG8_SCHED; PG8_LDA(At, 1, 0); PG8_STAGE(PG8_SA(0, 1), rsA, a2 + hstepA, voffA);
            PG8_WAIT_VG; PG8_WAIT_L(0); PG8_BAR; PG8_MMA(0, 0, At, B0); PG8_MMA(0, 1, At, B1); PG8_BAR; PG8_SCHED;
            PG8_LDA(At, 1, 1); PG8_STAGE(PG8_SB(1, 0), rsB, b3, voffB); PG8_STAGE(PG8_SB(1, 1), rsB, b3 + hstep, voffB); PG8_STAGE(PG8_SA(1, 0), rsA, a3, voffA);
            PG8_WAIT_VG; PG8_WAIT_L(0); PG8_BAR; PG8_MMA(1, 0, At, B0); PG8_MMA(1, 1, At, B1); PG8_BAR; PG8_SCHED;
#undef PG8_WAIT_VG
            } else {
            PG8_LDB(B0, 0, 0); PG8_SCHED; PG8_LDA(At, 0, 0); PG8_STAGE(PG8_SA(1, 1), rsA, a1 + hstepA, voffA);
            PG8_WAIT_L(8); PG8_BAR; PG8_WAIT_L(0); PG8_MMA(0, 0, At, B0); PG8_BAR; PG8_SCHED;
            PG8_LDB(B1, 0, 1); PG8_STAGE(PG8_SB(0, 0), rsB, b2, voffB);
            PG8_BAR; PG8_WAIT_L(0); PG8_MMA(0, 1, At, B1); PG8_BAR;
            PG8_LDA(At, 0, 1); PG8_STAGE(PG8_SA(0, 0), rsA, a2, voffA);
            PG8_BAR; PG8_WAIT_L(0); PG8_MMA(1, 0, At, B0); PG8_BAR; PG8_SCHED;
            PG8_STAGE(PG8_SB(0, 1), rsB, b2 + hstep, voffB);
            PG8_WAIT_V(6); PG8_BAR; PG8_MMA(1, 1, At, B1); PG8_BAR;
            PG8_LDB(B0, 1, 0); PG8_SCHED; PG8_LDA(At, 1, 0); PG8_STAGE(PG8_SA(0, 1), rsA, a2 + hstepA, voffA);
            PG8_WAIT_L(8); PG8_BAR; PG8_WAIT_L(0); PG8_MMA(0, 0, At, B0); PG8_BAR; PG8_SCHED;
            PG8_LDB(B1, 1, 1); PG8_STAGE(PG8_SB(1, 0), rsB, b3, voffB);
            PG8_BAR; PG8_WAIT_L(0); PG8_MMA(0, 1, At, B1); PG8_BAR;
            PG8_LDA(At, 1, 1); PG8_STAGE(PG8_SA(1, 0), rsA, a3, voffA);
            PG8_BAR; PG8_WAIT_L(0); PG8_MMA(1, 0, At, B0); PG8_BAR; PG8_SCHED;
            PG8_STAGE(PG8_SB(1, 1), rsB, b3 + hstep, voffB);
            PG8_WAIT_V(6); PG8_BAR; PG8_MMA(1, 1, At, B1); PG8_BAR;
            }
        }
        if constexpr (ALIGN_EPI) { if (wr == 0) PG8_BAR; }
        if constexpr (!Epi::AFTER_DRAIN) { E(acc, cur, wr, wc, fr, fq); S.done(cur); }
        if (!has_next) break;
#pragma unroll
        for (int a = 0; a < 2; ++a)
#pragma unroll
            for (int b = 0; b < 2; ++b)
#pragma unroll
                for (int m = 0; m < 4; ++m)
#pragma unroll
                    for (int n = 0; n < 2; ++n) acc[a][b][m][n] = (f32x4){0.f, 0.f, 0.f, 0.f};
        cur = nxt; cA = nA; cB = nB; ++ui;
        if constexpr (ALIGN_EPI) { if (wr == 1) PG8_BAR; }
    }
    PG8_WAIT_V(0);
    if constexpr (!ALIGN_EPI) { if (wr == 0) PG8_BAR; }
    PG8_BAR;
#undef PG8_SA
#undef PG8_SB
#undef PG8_STAGE
#undef PG8_LDA
#undef PG8_LDB
#undef PG8_MMA
#undef PG8_WAIT_V
#undef PG8_WAIT_L
#undef PG8_BAR
#undef PG8_SCHED
}
}

constexpr size_t MiB = 1u << 20;
constexpr size_t WS_CTL = 0, CTL_ZERO_BYTES = 1 * MiB;
constexpr size_t WS_MOD = 1 * MiB;
constexpr size_t WS_MISC = 2 * MiB;
constexpr size_t WS_WIN = 4 * MiB;
constexpr size_t WS_WG = 18 * MiB;
constexpr size_t WS_WA = 30 * MiB;
constexpr size_t WS_WBC = 32 * MiB;
constexpr size_t WS_WC = 34 * MiB;
constexpr size_t WS_WO = 36 * MiB;
constexpr size_t WS_W1 = 40 * MiB;
constexpr size_t WS_W2 = 56 * MiB;
constexpr size_t WS_U = 72 * MiB;
constexpr size_t WS_KVN = 136 * MiB;
constexpr size_t WS_MASK = 144 * MiB;
constexpr size_t WS_OA = 152 * MiB;
constexpr size_t WS_OB = 184 * MiB;
constexpr size_t WS_OC = 216 * MiB;
constexpr size_t WS_R1 = 232 * MiB;
constexpr size_t WS_SS = 488 * MiB;
constexpr size_t WS_WQG = 490 * MiB;
constexpr size_t WS_WQIN = 496 * MiB;
constexpr size_t WS_WQ1 = 503 * MiB;
constexpr size_t WS_END = 511 * MiB;
constexpr size_t WS_CVEC = WS_MISC + 256 * 1024;
constexpr size_t WS_SB = WS_MISC + 1792 * 1024;
constexpr int CW_CMAX = 65536  , CW_RF = 131072  ;
constexpr int CW_TMO = 0, CW_BAR = 4096, CW_QUEUE = 16384;

constexpr int NWAVES = 8;
constexpr int RING_BYTES = 131072, LDSCTL_OFF = 139264, MISC_OFF = LDSCTL_OFF + 320, LDS_BYTES = LDSCTL_OFF + 24576;

#define RLX_AGENT __ATOMIC_RELAXED, __HIP_MEMORY_SCOPE_AGENT
#define LDS_WAIT() asm volatile("s_waitcnt lgkmcnt(0)" ::: "memory")

#define XB_TMO      128
#define XB_XCNT(j)  (256  + 64 * (j))
#define XB_XSUB(j)  (1280 + 64 * (j))
#define XB_XGEN(j)  (2304 + 64 * (j))
#define XB_TOP      3328
#define XB_TOPGEN   3392
#define XCD_BAR_WORDS 3456
#define XB_SPIN_CAP (1u << 22)
__device__ __forceinline__ unsigned xb_ld(unsigned* p)              { return __hip_atomic_load(p, __ATOMIC_RELAXED, __HIP_MEMORY_SCOPE_AGENT); }
__device__ __forceinline__ unsigned xb_add(unsigned* p, unsigned v) { return __hip_atomic_fetch_add(p, v, __ATOMIC_RELAXED, __HIP_MEMORY_SCOPE_AGENT); }
__device__ __forceinline__ unsigned xb_xcc_id() { return (unsigned)__builtin_amdgcn_s_getreg((3 << 11) | 20) & 0xFu; }
__device__ __forceinline__ int xq_take(unsigned* ctr, const int per, volatile LAS unsigned* misc) {
    __syncthreads();
    if (threadIdx.x == 0) { unsigned q = misc[17]; int res = -1; const unsigned x = xb_xcc_id();
        while (q < 8u) { const unsigned xx = (x + q) & 7u; const unsigned v = __hip_atomic_fetch_add(ctr + 64 * xx, 1u, __ATOMIC_RELAXED, __HIP_MEMORY_SCOPE_AGENT);
            if (v < (unsigned)per) { res = (int)(xx * (unsigned)per + v); break; } ++q; }
        misc[17] = q; misc[16] = (unsigned)res; }
    __syncthreads();
    return __builtin_amdgcn_readfirstlane((int)misc[16]);
}
__device__ __forceinline__ int unit_pick(const int k, const int per, unsigned* ctr, volatile LAS unsigned* misc) {
    if (gridDim.x == 256u) { __syncthreads(); if (k >= (per >> 5)) return -1;
        const int s_ = (int)(blockIdx.x >> 3), x_ = (int)(blockIdx.x & 7u); return x_ * per + (k >> 1) * 64 + ((k & 1) ? 63 - s_ : s_); }
    return xq_take(ctr, per, misc);
}
#define XB_SPIN(cond, bar) do { unsigned _sp = 0; while (cond) { __builtin_amdgcn_s_sleep(1); \
    if ((++_sp & 255u) == 0u) { if (xb_ld(&(bar)[XB_TMO])) break; if (_sp > XB_SPIN_CAP) { atomicAdd(&(bar)[XB_TMO], 1u); break; } } } } while (0)
struct XcdBarrier { unsigned* bar; unsigned x; volatile LAS unsigned* st; };
__device__ __forceinline__ XcdBarrier xcd_barrier_post(unsigned* bar, volatile LAS unsigned* st, int wave) {
    XcdBarrier b; b.bar = bar; b.x = xb_xcc_id(); b.st = st;
    if (wave == 0 && lane_id() == 0) (void)xb_add(&bar[XB_XCNT(b.x)], 1u);
    return b;
}
__device__ __forceinline__ void xcd_barrier_complete(unsigned* bar, unsigned x, unsigned& nloc, unsigned& nx) {
    const unsigned G = gridDim.x * gridDim.y * gridDim.z;
    unsigned sum, cnt, mine, sp = 0u;
    for (;;) {
        sum = 0u; cnt = 0u; mine = 0u;
#pragma unroll
        for (unsigned j = 0; j < 16; ++j) { const unsigned c = xb_ld(&bar[XB_XCNT(j)]); sum += c; cnt += (c > 0u) ? 1u : 0u; mine = (j == x) ? c : mine; }
        if (sum == G) break;
        __builtin_amdgcn_s_sleep(1);
        if ((++sp & 255u) == 0u) { if (xb_ld(&bar[XB_TMO])) break; if (sp > XB_SPIN_CAP) { atomicAdd(&bar[XB_TMO], 1u); break; } }
    }
    nloc = mine > 0u ? mine : 1u; nx = cnt > 0u ? cnt : 1u;
}
__device__ __forceinline__ void xcd_barrier(const XcdBarrier& b, int wave) {
    asm volatile("s_waitcnt vmcnt(0)" ::: "memory");
    __syncthreads();
    if (wave == 0 && lane_id() == 0) {
        unsigned* bar = b.bar; asm volatile("" : "+s"(bar)); unsigned bx = b.x; asm volatile("" : "+s"(bx));
        __builtin_amdgcn_s_waitcnt(0);
        unsigned nloc = b.st[0], nx = b.st[1];
        if (nloc == 0u) { xcd_barrier_complete(bar, bx, nloc, nx); b.st[0] = nloc; b.st[1] = nx; }
        const unsigned old = xb_add(&bar[XB_XSUB(bx)], 1u);
        const unsigned gen = old / nloc;
        if (old + 1u == (gen + 1u) * nloc) {
            __builtin_amdgcn_fence(__ATOMIC_RELEASE, "agent");
            asm volatile("s_waitcnt vmcnt(0)" ::: "memory");
            const unsigned og = xb_add(&bar[XB_TOP], 1u);
            const unsigned tg = og / nx;
            __builtin_amdgcn_fence(__ATOMIC_ACQUIRE, "agent");
            if (og + 1u == (tg + 1u) * nx) xb_add(&bar[XB_TOPGEN], 1u);
            else XB_SPIN(xb_ld(&bar[XB_TOPGEN]) == tg, bar);
            xb_add(&bar[XB_XGEN(bx)], 1u);
            asm volatile("s_waitcnt vmcnt(0)" ::: "memory");
        } else {
            __builtin_amdgcn_fence(__ATOMIC_ACQUIRE, "agent");
            XB_SPIN(xb_ld(&bar[XB_XGEN(bx)]) == gen, bar);
            asm volatile("s_waitcnt vmcnt(0)" ::: "memory");
        }
    }
    __syncthreads();
}

constexpr int CW_LB = 200000;
__device__ __forceinline__ void xcd_local_barrier(unsigned* lb, const XcdBarrier& b, int wave) {
    asm volatile("s_waitcnt vmcnt(0)" ::: "memory");
    __syncthreads();
    if (wave == 0 && lane_id() == 0) {
        unsigned* lbp = lb; asm volatile("" : "+s"(lbp));
        const unsigned x = blockIdx.x & 7u; unsigned* cnt = lbp + 64u * x; unsigned* gen = lbp + 64u * (8u + x);
        __builtin_amdgcn_s_waitcnt(0);
        const unsigned g = b.st[3];
        const unsigned old = xb_add(cnt, 1u);
        __builtin_amdgcn_fence(__ATOMIC_ACQUIRE, "agent");
        if (old + 1u == (g + 1u) * 32u) xb_add(gen, 1u);
        else XB_SPIN(xb_ld(gen) == g, b.bar);
        b.st[3] = g + 1u;
        asm volatile("s_waitcnt vmcnt(0)" ::: "memory");
    }
    __syncthreads();
}
__device__ __forceinline__ float wave_sum(float v) {
#pragma unroll
    for (int o = 1; o < 64; o <<= 1) v += __shfl_xor(v, o);
    return v;
}
__device__ __forceinline__ float wave_max(float v) {
#pragma unroll
    for (int o = 1; o < 64; o <<= 1) v = fmaxf(v, __shfl_xor(v, o));
    return v;
}
__device__ __forceinline__ int wave_isum(int v) {
#pragma unroll
    for (int o = 1; o < 64; o <<= 1) v += __shfl_xor(v, o);
    return v;
}

__device__ __forceinline__ int t5_bucket(int n) {
    if (n < 16) return n;
    if (n >= 113) return 31;
    const int first[16] = {16, 19, 21, 24, 27, 31, 35, 40, 46, 52, 59, 67, 77, 87, 99, 113};
    int b = 16;
#pragma unroll
    for (int i = 1; i < 16; ++i) b += (n >= first[i]) ? 1 : 0;
    return b;
}

struct Frame {
    LAS unsigned char* lds;
    int wave, gw, NGW, G;
};

template <class ScaleFn>
__device__ __forceinline__ void transpose_item(const float* W, int ldw, int col0, int nvalid, int K, f16* WT, int nblk, LAS float* scr, int item, int lane, ScaleFn sf, unsigned* cmax = nullptr) {
    const int kb = item / nblk, nb = item % nblk, k0 = 64 * kb, n0 = 32 * nb;
    const int nn = n0 + (lane & 31);
    const bool ok = nn < nvalid;
    const float sc = sf(nn);
    float wv[32];
#pragma unroll
    for (int i = 0; i < 32; ++i) { const int kk = 2 * i + (lane >> 5); wv[i] = ok ? *(const GAS float*)(W + (size_t)(k0 + kk) * ldw + col0 + nn) : 0.f; }
#pragma unroll
    for (int i = 0; i < 32; ++i) { const int kk = 2 * i + (lane >> 5); scr[kk * 33 + (lane & 31)] = wv[i] * sc; }
    if (cmax) { float mx = 0.f;
#pragma unroll
        for (int i = 0; i < 32; ++i) mx = fmaxf(mx, __builtin_fabsf(wv[i] * sc));
        mx = fmaxf(mx, __shfl_xor(mx, 32));
        if (lane < 32) __hip_atomic_fetch_max(cmax + nn, __float_as_uint(mx), __ATOMIC_RELAXED, __HIP_MEMORY_SCOPE_AGENT); }
    LDS_WAIT(); asm volatile("" ::: "memory");
    const int c = lane & 7;
#pragma unroll
    for (int j = 0; j < 4; ++j) { const int n = (lane >> 3) + 8 * j; const LAS float* s = scr + (8 * c) * 33 + n;
        u32x4 o; o.x = pk2h(s[0 * 33], s[1 * 33]); o.y = pk2h(s[2 * 33], s[3 * 33]); o.z = pk2h(s[4 * 33], s[5 * 33]); o.w = pk2h(s[6 * 33], s[7 * 33]);
        *(u32x4*)(WT + (size_t)(n0 + n) * K + k0 + 8 * c) = o; }
    LDS_WAIT(); asm volatile("" ::: "memory");
}
struct TItem { const float* W; int ldw, col0, nvalid, K; f16* WT; int nblk; unsigned* cmax; int item; bool scale_in, tiled; };
struct ScaleOne { __device__ __forceinline__ float operator()(int) const { return 1.f; } };
struct ScaleIn {
    __device__ __forceinline__ float operator()(int n) const {
        if (n < 512) return 0.125f * LOG2E;
        if (n >= C_BQ && n < C_BKV) return 0.08838834764831845f * LOG2E;
        if (n >= C_CQ && n < C_CK) return 0.125f * LOG2E;
        return 1.f; }
};
__device__ __forceinline__ void titem_load(const TItem& d, int lane, float (&wv)[32], float& sc) {
    const int kb = d.item / d.nblk, nb = d.item % d.nblk, k0 = 64 * kb, nn = 32 * nb + (lane & 31);
    const bool ok = nn < d.nvalid;
    sc = d.scale_in ? ScaleIn()(nn) : 1.f;
#pragma unroll
    for (int i = 0; i < 32; ++i) { const int kk = 2 * i + (lane >> 5); wv[i] = ok ? *(const GAS float*)(d.W + (size_t)(k0 + kk) * d.ldw + d.col0 + nn) : 0.f; }
}
__device__ __forceinline__ void titem_store(const TItem& d, int lane, const float (&wv)[32], const float sc, LAS float* scr) {
    const int kb = d.item / d.nblk, nb = d.item % d.nblk, k0 = 64 * kb, n0 = 32 * nb, nn = n0 + (lane & 31);
#pragma unroll
    for (int i = 0; i < 32; ++i) { const int kk = 2 * i + (lane >> 5); scr[kk * 33 + (lane & 31)] = wv[i] * sc; }
    if (d.cmax) { float mx = 0.f;
#pragma unroll
        for (int i = 0; i < 32; ++i) mx = fmaxf(mx, __builtin_fabsf(wv[i] * sc));
        mx = fmaxf(mx, __shfl_xor(mx, 32));
        if (lane < 32) __hip_atomic_fetch_max(d.cmax + nn, __float_as_uint(mx), __ATOMIC_RELAXED, __HIP_MEMORY_SCOPE_AGENT); }
    LDS_WAIT(); asm volatile("" ::: "memory");
    const int c = lane & 7;
#pragma unroll
    for (int j = 0; j < 4; ++j) { const int n = (lane >> 3) + 8 * j; const LAS float* sp = scr + (8 * c) * 33 + n;
        u32x4 o; o.x = pk2h(sp[0 * 33], sp[1 * 33]); o.y = pk2h(sp[2 * 33], sp[3 * 33]); o.z = pk2h(sp[4 * 33], sp[5 * 33]); o.w = pk2h(sp[6 * 33], sp[7 * 33]);
        if (d.tiled) *(u32x4*)(d.WT + ((size_t)(((n0 + n) >> 8) * (d.K >> 6) + kb) * 256 + ((n0 + n) & 255)) * 64 + 8 * c) = o;
        else *(u32x4*)(d.WT + (size_t)(n0 + n) * d.K + k0 + 8 * c) = o; }
    LDS_WAIT(); asm volatile("" ::: "memory");
}

__device__ __forceinline__ void norm_row_pre(const float* xrow, const float* g, const float* scale, f16* orow, f16* x16row, float* ssrow, int lane) {
    const f32x4* xr = (const f32x4*)xrow + lane;
    f32x4 v[4]; float s = 0.f;
#pragma unroll
    for (int j = 0; j < 4; ++j) { v[j] = xr[64 * j]; s += (v[j].x * v[j].x + v[j].y * v[j].y) + (v[j].z * v[j].z + v[j].w * v[j].w); }
    s = wave_sum(s);
#pragma unroll
    for (int j = 0; j < 4; ++j) {
        const f32x4 gv = ((const f32x4*)g)[lane + 64 * j], sc = ((const f32x4*)scale)[lane + 64 * j];
        const f32x4 y = v[j] * gv * (sc + 1.f);
        u32x2 w; w.x = pk2h(y.x, y.y); w.y = pk2h(y.z, y.w);
        ((u32x2*)orow)[lane + 64 * j] = w;
        u32x2 wx; wx.x = pk2h(v[j].x, v[j].y); wx.y = pk2h(v[j].z, v[j].w);
        ((u32x2*)x16row)[lane + 64 * j] = wx; }
    if (lane < 4) ((f32x4*)ssrow)[lane] = (f32x4){lane == 0 ? s : 0.f, 0.f, 0.f, 0.f};
}

__device__ __forceinline__ void nq_gain(const float* g, const float* scale, int lane, float (&gl)[16]) {
#pragma unroll
    for (int c = 0; c < 2; ++c)
#pragma unroll
        for (int h = 0; h < 2; ++h) { const f32x4 gv = *(const GAS f32x4*)(g + 512 * c + 8 * lane + 4 * h), sc = *(const GAS f32x4*)(scale + 512 * c + 8 * lane + 4 * h);
#pragma unroll
            for (int e = 0; e < 4; ++e) gl[8 * c + 4 * h + e] = gv[e] * (sc[e] + 1.f); }
}
__device__ __forceinline__ void nq_finish(const float (&y)[16], float ss, float am, unsigned char* qrow, float* rowfac, int lane) {
    ss = wave_sum(ss); am = wave_max(am);
    const float inv = am > 0.f ? 127.f / am : 0.f;
#pragma unroll
    for (int c = 0; c < 2; ++c) { u32x2 pk; pk.x = 0u; pk.y = 0u;
#pragma unroll
        for (int e = 0; e < 4; ++e) { pk.x |= ((unsigned)(int)__builtin_rintf(y[8 * c + e] * inv) & 255u) << (8 * e); pk.y |= ((unsigned)(int)__builtin_rintf(y[8 * c + 4 + e] * inv) & 255u) << (8 * e); }
        *(GAS u32x2*)(qrow + 512 * c + 8 * lane) = pk; }
    if (lane == 0) *rowfac = am * (1.f / 127.f) * __builtin_amdgcn_rsqf(ss * (1.f / DM) + EPS);
}
__device__ __forceinline__ void norm_quant_rows16(const f16* x16, const float* g, const float* scale, unsigned char* q8, float* rowfac, int m0, int lane) {
    float gl[16]; nq_gain(g, scale, lane, gl);
    u32x4 nx[2];
#pragma unroll
    for (int c = 0; c < 2; ++c) nx[c] = *(const GAS u32x4*)(x16 + (size_t)m0 * DM + 512 * c + 8 * lane);
#pragma unroll 1
    for (int r = 0; r < 16; ++r) { const int m = m0 + r;
        const f16x8 xa = __builtin_bit_cast(f16x8, nx[0]), xb = __builtin_bit_cast(f16x8, nx[1]);
        if (r + 1 < 16) {
#pragma unroll
            for (int c = 0; c < 2; ++c) nx[c] = *(const GAS u32x4*)(x16 + (size_t)(m + 1) * DM + 512 * c + 8 * lane); }
        float y[16]; float ss = 0.f, am = 0.f;
#pragma unroll
        for (int e = 0; e < 8; ++e) { const float x0 = (float)xa[e], x1 = (float)xb[e]; ss += x0 * x0 + x1 * x1; y[e] = x0 * gl[e]; y[8 + e] = x1 * gl[8 + e]; am = fmaxf(am, fmaxf(__builtin_fabsf(y[e]), __builtin_fabsf(y[8 + e]))); }
        nq_finish(y, ss, am, q8 + (size_t)m * DM, rowfac + m, lane); }
}
__device__ __forceinline__ void norm_quant_rows16_0(const float* x, const float* g, const float* scale, f16* x16, unsigned char* q8, float* rowfac, int m0, int lane) {
    float gl[16]; nq_gain(g, scale, lane, gl);
    f32x4 nx[4];
#pragma unroll
    for (int c = 0; c < 2; ++c)
#pragma unroll
        for (int h = 0; h < 2; ++h) nx[2 * c + h] = *(const GAS f32x4*)(x + (size_t)m0 * DM + 512 * c + 8 * lane + 4 * h);
#pragma unroll 1
    for (int r = 0; r < 16; ++r) { const int m = m0 + r;
        f32x4 xa[4];
#pragma unroll
        for (int i = 0; i < 4; ++i) xa[i] = nx[i];
        if (r + 1 < 16) {
#pragma unroll
            for (int c = 0; c < 2; ++c)
#pragma unroll
                for (int h = 0; h < 2; ++h) nx[2 * c + h] = *(const GAS f32x4*)(x + (size_t)(m + 1) * DM + 512 * c + 8 * lane + 4 * h); }
        float y[16]; float ss = 0.f, am = 0.f;
#pragma unroll
        for (int c = 0; c < 2; ++c) { u32x4 w; w.x = pk2h(xa[2 * c].x, xa[2 * c].y); w.y = pk2h(xa[2 * c].z, xa[2 * c].w); w.z = pk2h(xa[2 * c + 1].x, xa[2 * c + 1].y); w.w = pk2h(xa[2 * c + 1].z, xa[2 * c + 1].w);
            *(GAS u32x4*)(x16 + (size_t)m * DM + 512 * c + 8 * lane) = w;
#pragma unroll
            for (int h = 0; h < 2; ++h)
#pragma unroll
                for (int e = 0; e < 4; ++e) { const float xx = xa[2 * c + h][e]; ss += xx * xx; const float v = xx * gl[8 * c + 4 * h + e]; y[8 * c + 4 * h + e] = v; am = fmaxf(am, __builtin_fabsf(v)); } }
        nq_finish(y, ss, am, q8 + (size_t)m * DM, rowfac + m, lane); }
}

template <int DQK, int DV>
__device__ __forceinline__ void naive_attn(LAS float* scl  , const f16* q, const f16* Kb, int kpitch, const f16* Vb, int vpitch, int t, unsigned sel, const float* tab, int lane, float (&o)[DV / 64]) {
    const int nslots = (t >> 6) + 1;
    float mx = -INFINITY;
#pragma unroll 1
    for (int j = 0; j < nslots; ++j) {
        float s = -INFINITY; const int k = 64 * j + lane;
        if (k <= t && ((sel >> j) & 1u)) {
            const f16* kr = Kb + (size_t)k * kpitch; float a = 0.f;
#pragma unroll 4
            for (int c = 0; c < DQK / 8; ++c) { const f16x8 kv = *(const f16x8*)(kr + 8 * c); const f16x8 qv = *(const f16x8*)(q + 8 * c);
#pragma unroll
                for (int e = 0; e < 8; ++e) a += (float)kv[e] * (float)qv[e]; }
            const int dist = t - k; s = a + tab[(dist < 128 ? dist : 128) + 255];
        }
        scl[k] = s; mx = fmaxf(mx, s);
    }
    mx = wave_max(mx);
    float l = 0.f;
#pragma unroll 1
    for (int j = 0; j < nslots; ++j) { const float p = __builtin_amdgcn_exp2f(scl[64 * j + lane] - mx); scl[64 * j + lane] = p; l += p; }
    l = wave_sum(l);
    const float inv = 1.f / l;
#pragma unroll
    for (int i = 0; i < DV / 64; ++i) o[i] = 0.f;
    LDS_WAIT(); asm volatile("" ::: "memory");
#pragma unroll 1
    for (int k = 0; k < 64 * nslots; k += 4) {
        const f32x4 p = *(const LAS f32x4*)(scl + k);
        if (p.x != 0.f || p.y != 0.f || p.z != 0.f || p.w != 0.f) { const f16* vr = Vb + (size_t)k * vpitch;
            float v[4][DV / 64];
#pragma unroll
            for (int r = 0; r < 4; ++r)
#pragma unroll
                for (int i = 0; i < DV / 64; ++i) v[r][i] = (float)vr[(size_t)r * vpitch + lane + 64 * i];
#pragma unroll
            for (int i = 0; i < DV / 64; ++i) o[i] += (p.x * v[0][i] + p.y * v[1][i]) + (p.z * v[2][i] + p.w * v[3][i]); }
    }
#pragma unroll
    for (int i = 0; i < DV / 64; ++i) o[i] *= inv;
    LDS_WAIT(); asm volatile("" ::: "memory");
}

__device__ __forceinline__ unsigned char* launder(unsigned char* p) { asm volatile("" : "+s"(p)); return p; }
__device__ __forceinline__ int launder_i(int v) { asm volatile("" : "+s"(v)); return v; }
constexpr int PTAB_OFF = LDSCTL_OFF + 512;
__device__ __forceinline__ const float* inptr(LAS unsigned char* lds, int i) {
    unsigned saddr = (unsigned)(uintptr_t)(lds + PTAB_OFF) + 8u * (unsigned)i, addr;
    asm volatile("v_mov_b32 %0, %1" : "=v"(addr) : "s"(saddr));
    const unsigned long long v = *(volatile LAS unsigned long long*)(uintptr_t)addr;
    const unsigned lo = __builtin_amdgcn_readfirstlane((unsigned)v), hi = __builtin_amdgcn_readfirstlane((unsigned)(v >> 32));
    return (const float*)(((unsigned long long)hi << 32) | lo);
}
__device__ __forceinline__ unsigned ordkey(float f) { const unsigned u = __float_as_uint(f); return u ^ ((unsigned)((int)u >> 31) | 0x80000000u); }

namespace fa {
typedef float f32x16 __attribute__((ext_vector_type(16)));
typedef short v4i16_t __attribute__((ext_vector_type(4)));
__device__ __forceinline__ int crow(int r, int hi) { return (r & 3) + 8 * (r >> 2) + 4 * hi; }
constexpr int TAB_OFF = 139264 + 1024;
constexpr int SUB_OFF = TAB_OFF + 10240;
constexpr int STASH_OFF = 73728;
template <int DQK, int DV, bool KVSAME> struct Lay {
    static constexpr int RSK = DQK * 2 + 16, RSV = DV * 2 + 64;
    static constexpr int KBUF = 64 * RSK, VBUF = 64 * RSV;
    static constexpr int VOFF0 = 2 * KBUF, END = 2 * KBUF + 2 * VBUF;
    static constexpr int NKC = DQK / 64, NVC = KVSAME ? 0 : DV / 64;
    static_assert(END <= 77824, "attention LDS map");
};
__device__ __forceinline__ f16x8 pack8(const f32x16& p, int b) {
    u32x4 w; w.x = pk2h(p[b + 0], p[b + 1]); w.y = pk2h(p[b + 2], p[b + 3]); w.z = pk2h(p[b + 4], p[b + 5]); w.w = pk2h(p[b + 6], p[b + 7]);
    return __builtin_bit_cast(f16x8, w);
}
__device__ __forceinline__ float psum8(const f16x8& p, float acc) {
    typedef _Float16 h2_t __attribute__((ext_vector_type(2)));
    const u32x4 w = __builtin_bit_cast(u32x4, p); const unsigned w0 = w.x, w1 = w.y, w2 = w.z, w3 = w.w; const h2_t one = {(_Float16)1.f, (_Float16)1.f};
    acc = __builtin_amdgcn_fdot2(__builtin_bit_cast(h2_t, w0), one, acc, false); acc = __builtin_amdgcn_fdot2(__builtin_bit_cast(h2_t, w1), one, acc, false);
    acc = __builtin_amdgcn_fdot2(__builtin_bit_cast(h2_t, w2), one, acc, false); acc = __builtin_amdgcn_fdot2(__builtin_bit_cast(h2_t, w3), one, acc, false);
    return acc;
}
__device__ __forceinline__ float max3f(float a, float b, float c) { float r; asm("v_max3_f32 %0, %1, %2, %3" : "=v"(r) : "v"(a), "v"(b), "v"(c)); return r; }
__device__ __forceinline__ float rowmax32(const f32x16& a, const f32x16& b) {
    float x = max3f(a[0], a[1], b[0]), y = max3f(a[2], a[3], b[1]); x = max3f(x, b[2], b[3]);
#pragma unroll
    for (int r = 4; r < 16; r += 4) { x = max3f(x, a[r], a[r + 1]); y = max3f(y, a[r + 2], a[r + 3]); x = max3f(x, b[r], b[r + 1]); y = max3f(y, b[r + 2], b[r + 3]); }
    return max3f(x, y, y);
}
__device__ __forceinline__ float half_max(float x) { const auto rr = __builtin_amdgcn_permlane32_swap(__float_as_uint(x), __float_as_uint(x), false, false); return fmaxf(__uint_as_float(rr[0]), __uint_as_float(rr[1])); }
__device__ __forceinline__ float half_sum(float x) { const auto rr = __builtin_amdgcn_permlane32_swap(__float_as_uint(x), __float_as_uint(x), false, false); return __uint_as_float(rr[0]) + __uint_as_float(rr[1]); }
template <int DQK, int DV, int MODE>
__device__ __forceinline__ void attn_pass(LAS unsigned char* lds, const int wave, const int lane,
        const f16* Qw, const int qpitch, const f16* Kg, const int kpitch, const f16* Vg, const int vpitch,
        const int ntiles, const int qpos0, const LAS float* tab, const unsigned selb, const int jblk, const unsigned* maskw,
        f32x16 (&o)[DV / 32]) {
    typedef Lay<DQK, DV, MODE == 2> L;
    constexpr int NB_ = DV / 32;
    const int r32 = lane & 31, hi = lane >> 5, tid = wave * 64 + lane;
    f16x8 qf[DQK / 16];
#pragma unroll
    for (int d0 = 0; d0 < DQK / 16; ++d0) qf[d0] = __builtin_bit_cast(f16x8, *(const GAS u32x4*)(Qw + (size_t)r32 * qpitch + d0 * 16 + hi * 8));
#pragma unroll
    for (int blk = 0; blk < NB_; ++blk)
#pragma unroll
        for (int r = 0; r < 16; ++r) o[blk][r] = 0.f;
    float m = -INFINITY, l = 0.f;
    u32x4 kreg[L::NKC], vreg[L::NVC > 0 ? L::NVC : 1];
    unsigned wnext = 0u;
#define FA_LOAD(kt_) do { \
        _Pragma("unroll") for (int c = 0; c < L::NKC; ++c) { const int id = tid + 512 * c, row = id / (DQK / 8), ch = id % (DQK / 8); \
            kreg[c] = *(const GAS u32x4*)(Kg + (size_t)((kt_) * 64 + row) * kpitch + ch * 8); } \
        _Pragma("unroll") for (int c = 0; c < L::NVC; ++c) { const int id = tid + 512 * c, row = id / (DV / 8), ch = id % (DV / 8); \
            vreg[c] = *(const GAS u32x4*)(Vg + (size_t)((kt_) * 64 + row) * vpitch + ch * 8); } \
        if (MODE == 2) wnext = *(const GAS unsigned*)(maskw + (kt_) * 64 + lane); } while (0)
#define FA_WRITE(buf_) do { \
        _Pragma("unroll") for (int c = 0; c < L::NKC; ++c) { const int id = tid + 512 * c, row = id / (DQK / 8), ch = id % (DQK / 8); \
            *(LAS u32x4*)(lds + (buf_) * L::KBUF + row * L::RSK + ch * 16) = kreg[c]; \
            if (MODE == 2) *(LAS u32x4*)(lds + L::VOFF0 + (buf_) * L::VBUF + row * L::RSV + ch * 16) = kreg[c]; } \
        _Pragma("unroll") for (int c = 0; c < L::NVC; ++c) { const int id = tid + 512 * c, row = id / (DV / 8), ch = id % (DV / 8); \
            *(LAS u32x4*)(lds + L::VOFF0 + (buf_) * L::VBUF + row * L::RSV + ch * 16) = vreg[c]; } } while (0)
#define FA_VREAD(dst_, ks_) do { _Pragma("unroll") for (int blk = 0; blk < NB_; ++blk) { \
        const v4i16_t a_ = __builtin_amdgcn_ds_read_tr16_b64_v4i16((LAS v4i16_t*)(vb + 16 * (ks_) * L::RSV + blk * 64)); \
        const v4i16_t b_ = __builtin_amdgcn_ds_read_tr16_b64_v4i16((LAS v4i16_t*)(vb + (16 * (ks_) + 8) * L::RSV + blk * 64)); \
        const f16x4 a4_ = __builtin_bit_cast(f16x4, a_), b4_ = __builtin_bit_cast(f16x4, b_); \
        dst_[blk] = (f16x8){a4_[0], a4_[1], a4_[2], a4_[3], b4_[0], b4_[1], b4_[2], b4_[3]}; } } while (0)
#define FA_PV(src_, ks_) do { _Pragma("unroll") for (int blk = 0; blk < NB_; ++blk) o[blk] = __builtin_amdgcn_mfma_f32_32x32x16_f16(src_[blk], pf[ks_], o[blk], 0, 0, 0); } while (0)
    FA_LOAD(0);
    unsigned wcur = wnext;
    FA_WRITE(0);
    __syncthreads();
#pragma unroll 1
    for (int kt = 0; kt < ntiles; ++kt) {
        const int cur = kt & 1;
        if (kt + 1 < ntiles) FA_LOAD(kt + 1);
        const int k0 = kt * 64;
        if (k0 <= qpos0 + 31) {
            f32x16 p0, p1;
            if (MODE == 2) {
                const unsigned nw = ~wcur;
#pragma unroll
                for (int r = 0; r < 16; ++r) { p0[r] = __uint_as_float((unsigned)__builtin_amdgcn_sbfe((int)nw, r, 1) & 0xff800000u); p1[r] = __uint_as_float((unsigned)__builtin_amdgcn_sbfe((int)nw, 16 + r, 1) & 0xff800000u); }
            } else if (MODE == 1) {
                const int n = kt >> 2; const float cv = (n == jblk || ((selb >> n) & 1u)) ? 0.f : -INFINITY;
#pragma unroll
                for (int r = 0; r < 16; ++r) { p0[r] = cv; p1[r] = cv; }
            } else {
#pragma unroll
                for (int r = 0; r < 16; ++r) { p0[r] = 0.f; p1[r] = 0.f; }
            }
            const LAS unsigned char* kb = lds + cur * L::KBUF + r32 * L::RSK + hi * 16;
            const LAS unsigned char* vb = lds + L::VOFF0 + cur * L::VBUF + (4 * hi + ((lane & 15) >> 2)) * L::RSV + (16 * ((lane >> 4) & 1) + 4 * (lane & 3)) * 2;
#pragma unroll
            for (int db = 0; db < DQK / 64; ++db) {
                f16x8 kf0[4], kf1[4];
#pragma unroll
                for (int d = 0; d < 4; ++d) { kf0[d] = *(const LAS f16x8*)(kb + (4 * db + d) * 32); kf1[d] = *(const LAS f16x8*)(kb + 32 * L::RSK + (4 * db + d) * 32); }
                __builtin_amdgcn_sched_barrier(0);
#pragma unroll
                for (int d = 0; d < 4; ++d) {
                    p0 = __builtin_amdgcn_mfma_f32_32x32x16_f16(kf0[d], qf[4 * db + d], p0, 0, 0, 0);
                    p1 = __builtin_amdgcn_mfma_f32_32x32x16_f16(kf1[d], qf[4 * db + d], p1, 0, 0, 0); }
                __builtin_amdgcn_sched_barrier(0);
            }
            f16x8 vfa[NB_], vfb[NB_];
            FA_VREAD(vfa, 0);
            __builtin_amdgcn_sched_barrier(0);
            if (qpos0 - (k0 + 63) < 128) {
                const int base = qpos0 + r32 - k0 - 4 * hi + 255;
#pragma unroll
                for (int r = 0; r < 16; ++r) { const int i0 = base - ((r & 3) + 8 * (r >> 2)), i1 = i0 - 32;
                    p0[r] += tab[i0 < 383 ? i0 : 383]; p1[r] += tab[i1 < 383 ? i1 : 383]; }
            }
            float rm = fmaxf(p0[0], p1[0]);
#pragma unroll
            for (int r = 1; r < 16; ++r) rm = fmaxf(rm, fmaxf(p0[r], p1[r]));
            rm = half_max(rm);
            const float mn = fmaxf(m, rm), mu = (mn == -INFINITY) ? 0.f : mn;
            if (__any(mn > m)) { const float al = __builtin_amdgcn_exp2f(m - mu); l *= al;
#pragma unroll
                for (int blk = 0; blk < NB_; ++blk)
#pragma unroll
                    for (int r = 0; r < 16; ++r) o[blk][r] *= al; }
            m = mn;
            float ls = 0.f;
#pragma unroll
            for (int r = 0; r < 16; ++r) { p0[r] = __builtin_amdgcn_exp2f(p0[r] - mu); p1[r] = __builtin_amdgcn_exp2f(p1[r] - mu); ls += p0[r] + p1[r]; }
            l += ls;
            f16x8 pf[4]; pf[0] = pack8(p0, 0); pf[1] = pack8(p0, 8); pf[2] = pack8(p1, 0); pf[3] = pack8(p1, 8);
            __builtin_amdgcn_sched_barrier(0);
            FA_VREAD(vfb, 1); FA_PV(vfa, 0); __builtin_amdgcn_sched_barrier(0);
            FA_VREAD(vfa, 2); FA_PV(vfb, 1); __builtin_amdgcn_sched_barrier(0);
            FA_VREAD(vfb, 3); FA_PV(vfa, 2); __builtin_amdgcn_sched_barrier(0);
            FA_PV(vfb, 3);
        }
        if (kt + 1 < ntiles) FA_WRITE(cur ^ 1);
        wcur = wnext;
        __syncthreads();
    }
#undef FA_LOAD
#undef FA_WRITE
#undef FA_VREAD
#undef FA_PV
    l = half_sum(l);
    const float inv = 1.f / l;
#pragma unroll
    for (int blk = 0; blk < NB_; ++blk)
#pragma unroll
        for (int r = 0; r < 16; ++r) o[blk][r] *= inv;
}
__device__ __forceinline__ int fsw8(int row) { return (row >> 1) & 7; }
__device__ __forceinline__ int fsw16(int row) { return ((row & 3) << 2) | ((row >> 2) & 3); }
__device__ __forceinline__ int fswv8(int row) { return ((row >> 1) & 1) << 2; }
template <int DQK, int DV, int MODE, int S> struct LayD {
    static constexpr int CPRK = DQK / 8, CPRV = DV / 8;
    static constexpr int KB = 64 * DQK * 2, VB = (MODE == 2) ? 0 : 64 * DV * 2, STG = KB + VB;
    static constexpr int PK = CPRK, PV = (MODE == 2) ? 0 : CPRV, NP = (PK + PV) / 8, NPW = NP + (MODE == 2 ? 1 : 0);
    static constexpr int MASKOFF = S * STG;
    static constexpr int END = MASKOFF + (MODE == 2 ? 8 * S * 256 : 0);
    __device__ static __forceinline__ int fk(int row) { return CPRK == 8 ? fsw8(row) : fsw16(row); }
    __device__ static __forceinline__ int fv(int row) { return MODE == 2 ? fsw16(row) : (CPRV == 8 ? fswv8(row) : fsw16(row)); }
};
#define FA_WAITV(n) asm volatile("s_waitcnt vmcnt(%0)" :: "n"(n) : "memory")
template <int DQK, int DV, int MODE, int S>
__device__ __forceinline__ void attn_pass_dma(LAS unsigned char* lds, const int wave, const int lane,
        const f16* Qw, const int qpitch, const f16* Kg, const int kpitch, const f16* Vg, const int vpitch,
        const int ntiles, const int qpos0, const LAS float* tab, const unsigned selb, const int jblk, const unsigned* maskw,
        f32x16 (&o)[DV / 32]) {
    typedef LayD<DQK, DV, MODE, S> L;
    constexpr int NB_ = DV / 32;
    const int r32 = lane & 31, hi = lane >> 5;
    f16x8 qf[DQK / 16];
#pragma unroll
    for (int d0 = 0; d0 < DQK / 16; ++d0) qf[d0] = __builtin_bit_cast(f16x8, *(const GAS u32x4*)(Qw + (size_t)r32 * qpitch + d0 * 16 + hi * 8));
#pragma unroll
    for (int blk = 0; blk < NB_; ++blk)
#pragma unroll
        for (int r = 0; r < 16; ++r) o[blk][r] = 0.f;
    float m = -INFINITY, l = 0.f;
    unsigned goff[L::NP];
#pragma unroll
    for (int c = 0; c < L::NP; ++c) { const int pc = wave + 8 * c;
        if (pc < L::PK) { const int s2 = 64 * pc + lane, row = s2 / L::CPRK, ch = (s2 % L::CPRK) ^ L::fk(row); goff[c] = (unsigned)(row * kpitch + ch * 8); }
        else { const int s2 = 64 * (pc - L::PK) + lane, row = s2 / L::CPRV, ch = (s2 % L::CPRV) ^ L::fv(row); goff[c] = (unsigned)(row * vpitch + ch * 8); } }
#define FA_ISSUE(kt_, st_) do { \
        if (MODE == 2) __builtin_amdgcn_global_load_lds((const GAS unsigned*)(maskw + (kt_) * 64 + lane), (LAS unsigned*)(lds + L::MASKOFF + (wave * S + (st_)) * 256), 4, 0, 0); \
        _Pragma("unroll") for (int c = 0; c < L::NP; ++c) { const int pc = wave + 8 * c; \
            if (pc < L::PK) __builtin_amdgcn_global_load_lds((const GAS unsigned*)(Kg + (size_t)(kt_) * 64 * kpitch + goff[c]), (LAS unsigned*)(lds + (st_) * L::STG + pc * 1024), 16, 0, 0); \
            else __builtin_amdgcn_global_load_lds((const GAS unsigned*)(Vg + (size_t)(kt_) * 64 * vpitch + goff[c]), (LAS unsigned*)(lds + (st_) * L::STG + L::KB + (pc - L::PK) * 1024), 16, 0, 0); } } while (0)
    int koff[DQK / 16];
#pragma unroll
    for (int d0 = 0; d0 < DQK / 16; ++d0) koff[d0] = (r32 * L::CPRK + ((2 * d0 + hi) ^ L::fk(r32))) * 16;
    int voff[2][NB_];
    { const int q = (lane & 15) >> 2, g1 = (lane >> 4) & 1, p = lane & 3;
#pragma unroll
      for (int sec = 0; sec < 2; ++sec)
#pragma unroll
        for (int blk = 0; blk < NB_; ++blk) { const int row = 4 * hi + q + 8 * sec; voff[sec][blk] = L::KB * (MODE == 2 ? 0 : 1) + (row * L::CPRV + ((4 * blk + 2 * g1 + (p >> 1)) ^ L::fv(row))) * 16 + 8 * (p & 1); } }
#define FA_VREADD(dst_, ks_) do { _Pragma("unroll") for (int blk = 0; blk < NB_; ++blk) { \
        const v4i16_t a_ = __builtin_amdgcn_ds_read_tr16_b64_v4i16((LAS v4i16_t*)(sb + voff[0][blk] + 16 * (ks_) * L::CPRV * 16)); \
        const v4i16_t b_ = __builtin_amdgcn_ds_read_tr16_b64_v4i16((LAS v4i16_t*)(sb + voff[1][blk] + 16 * (ks_) * L::CPRV * 16)); \
        const f16x4 a4_ = __builtin_bit_cast(f16x4, a_), b4_ = __builtin_bit_cast(f16x4, b_); \
        dst_[blk] = (f16x8){a4_[0], a4_[1], a4_[2], a4_[3], b4_[0], b4_[1], b4_[2], b4_[3]}; } } while (0)
#define FA_PVD(src_, ks_) do { _Pragma("unroll") for (int blk = 0; blk < NB_; ++blk) o[blk] = __builtin_amdgcn_mfma_f32_32x32x16_f16(src_[blk], pf[ks_], o[blk], 0, 0, 0); } while (0)
#pragma unroll
    for (int t0 = 0; t0 < S - 1; ++t0) if (t0 < ntiles) FA_ISSUE(t0, t0);
    int st = 0, sti = S - 1;
#pragma unroll 1
    for (int kt = 0; kt < ntiles; ++kt) {
        if (kt + S - 2 < ntiles) FA_WAITV(L::NPW * (S - 2)); else FA_WAITV(0);
        __builtin_amdgcn_s_barrier();
        asm volatile("" ::: "memory");
        if (kt + S - 1 < ntiles) FA_ISSUE(kt + S - 1, sti);
        const int k0 = kt * 64;
        if (k0 <= qpos0 + 31) {
            const LAS unsigned char* sb = lds + st * L::STG;
            f32x16 p0, p1;
            if (MODE == 2) {
                const unsigned nw = ~*(const LAS unsigned*)(lds + L::MASKOFF + (wave * S + st) * 256 + lane * 4);
#pragma unroll
                for (int r = 0; r < 16; ++r) { p0[r] = __uint_as_float((unsigned)__builtin_amdgcn_sbfe((int)nw, r, 1) & 0xff800000u); p1[r] = __uint_as_float((unsigned)__builtin_amdgcn_sbfe((int)nw, 16 + r, 1) & 0xff800000u); }
            } else if (MODE == 1) {
                const int n = kt >> 2; const float cv = (n == jblk || ((selb >> n) & 1u)) ? 0.f : -INFINITY;
#pragma unroll
                for (int r = 0; r < 16; ++r) { p0[r] = cv; p1[r] = cv; }
            } else {
#pragma unroll
                for (int r = 0; r < 16; ++r) { p0[r] = 0.f; p1[r] = 0.f; }
            }
#pragma unroll
            for (int db = 0; db < DQK / 64; ++db) {
                f16x8 kf0[4], kf1[4];
#pragma unroll
                for (int d = 0; d < 4; ++d) { kf0[d] = *(const LAS f16x8*)(sb + koff[4 * db + d]); kf1[d] = *(const LAS f16x8*)(sb + koff[4 * db + d] + 32 * L::CPRK * 16); }
                __builtin_amdgcn_sched_barrier(0);
#pragma unroll
                for (int d = 0; d < 4; ++d) {
                    p0 = __builtin_amdgcn_mfma_f32_32x32x16_f16(kf0[d], qf[4 * db + d], p0, 0, 0, 0);
                    p1 = __builtin_amdgcn_mfma_f32_32x32x16_f16(kf1[d], qf[4 * db + d], p1, 0, 0, 0); }
                __builtin_amdgcn_sched_barrier(0);
            }
            f16x8 vfa[NB_], vfb[NB_];
            FA_VREADD(vfa, 0);
            __builtin_amdgcn_sched_barrier(0);
            if (qpos0 - (k0 + 63) < 128) {
                const int j0 = 224 - (qpos0 + r32 - k0 - 4 * hi), sf = j0 & 1; const LAS float* rp = tab + sf * TAB2 + (j0 - sf);
#pragma unroll
                for (int g = 0; g < 4; ++g) { const f32x2 x0 = *(const LAS f32x2*)(rp + 8 * g), x1 = *(const LAS f32x2*)(rp + 8 * g + 2), y0 = *(const LAS f32x2*)(rp + 32 + 8 * g), y1 = *(const LAS f32x2*)(rp + 34 + 8 * g);
                    p0[4 * g] += x0.x; p0[4 * g + 1] += x0.y; p0[4 * g + 2] += x1.x; p0[4 * g + 3] += x1.y; p1[4 * g] += y0.x; p1[4 * g + 1] += y0.y; p1[4 * g + 2] += y1.x; p1[4 * g + 3] += y1.y; }
            }
            float rm = rowmax32(p0, p1);
            rm = half_max(rm);
            if (__any(rm > m + 8.f)) { const float mn = fmaxf(m, rm), mu2 = (mn == -INFINITY) ? 0.f : mn; const float al = __builtin_amdgcn_exp2f(m - mu2); l *= al; m = mn;
#pragma unroll
                for (int blk = 0; blk < NB_; ++blk)
#pragma unroll
                    for (int r = 0; r < 16; ++r) o[blk][r] *= al; }
            const float mu = (m == -INFINITY) ? 0.f : m;
            float ls = 0.f;
#pragma unroll
            for (int r = 0; r < 16; ++r) { p0[r] = __builtin_amdgcn_exp2f(p0[r] - mu); p1[r] = __builtin_amdgcn_exp2f(p1[r] - mu); ls += p0[r] + p1[r]; }
            l += ls;
            f16x8 pf[4]; pf[0] = pack8(p0, 0); pf[1] = pack8(p0, 8); pf[2] = pack8(p1, 0); pf[3] = pack8(p1, 8);
            __builtin_amdgcn_sched_barrier(0);
            FA_VREADD(vfb, 1); FA_PVD(vfa, 0); __builtin_amdgcn_sched_barrier(0);
            FA_VREADD(vfa, 2); FA_PVD(vfb, 1); __builtin_amdgcn_sched_barrier(0);
            FA_VREADD(vfb, 3); FA_PVD(vfa, 2); __builtin_amdgcn_sched_barrier(0);
            FA_PVD(vfb, 3);
        }
        st = (st + 1 == S) ? 0 : st + 1; sti = (sti + 1 == S) ? 0 : sti + 1;
    }
    asm volatile("s_waitcnt lgkmcnt(0)" ::: "memory");
    __builtin_amdgcn_s_barrier();
    asm volatile("" ::: "memory");
#undef FA_ISSUE
#undef FA_VREADD
#undef FA_PVD
    l = half_sum(l);
    const float inv = 1.f / l;
#pragma unroll
    for (int blk = 0; blk < NB_; ++blk)
#pragma unroll
        for (int r = 0; r < 16; ++r) o[blk][r] *= inv;
}
template <int DQK, int DV, int MODE, int S>
__device__ __forceinline__ void attn_pass_pipe(LAS unsigned char* lds, const int wave, const int lane,
        const f16* Qw, const int qpitch, const f16* Kg, const int kpitch, const f16* Vg, const int vpitch,
        const int ntiles, const int qpos0, const LAS float* tab, const unsigned selb, const int jblk, const unsigned* maskw,
        f32x16 (&o)[DV / 32]) {
    typedef LayD<DQK, DV, MODE, S> L;
    constexpr int NB_ = DV / 32;
    const int r32 = lane & 31, hi = lane >> 5;
    f16x8 qf[DQK / 16];
#pragma unroll
    for (int d0 = 0; d0 < DQK / 16; ++d0) qf[d0] = __builtin_bit_cast(f16x8, *(const GAS u32x4*)(Qw + (size_t)r32 * qpitch + d0 * 16 + hi * 8));
#pragma unroll
    for (int blk = 0; blk < NB_; ++blk)
#pragma unroll
        for (int r = 0; r < 16; ++r) o[blk][r] = 0.f;
    float m = -INFINITY, l = 0.f;
    unsigned goff[L::NP];
#pragma unroll
    for (int c = 0; c < L::NP; ++c) { const int pc = wave + 8 * c;
        if (pc < L::PK) { const int s2 = 64 * pc + lane, row = s2 / L::CPRK, ch = (s2 % L::CPRK) ^ L::fk(row); goff[c] = (unsigned)(row * kpitch + ch * 8); }
        else { const int s2 = 64 * (pc - L::PK) + lane, row = s2 / L::CPRV, ch = (s2 % L::CPRV) ^ L::fv(row); goff[c] = (unsigned)(row * vpitch + ch * 8); } }
#define FP_ISSUE(kt_, st_) do { \
        if (MODE == 2) __builtin_amdgcn_global_load_lds((const GAS unsigned*)(maskw + (kt_) * 64 + lane), (LAS unsigned*)(lds + L::MASKOFF + (wave * S + (st_)) * 256), 4, 0, 0); \
        _Pragma("unroll") for (int c = 0; c < L::NP; ++c) { const int pc = wave + 8 * c; \
            if (pc < L::PK) __builtin_amdgcn_global_load_lds((const GAS unsigned*)(Kg + (size_t)(kt_) * 64 * kpitch + goff[c]), (LAS unsigned*)(lds + (st_) * L::STG + pc * 1024), 16, 0, 0); \
            else __builtin_amdgcn_global_load_lds((const GAS unsigned*)(Vg + (size_t)(kt_) * 64 * vpitch + goff[c]), (LAS unsigned*)(lds + (st_) * L::STG + L::KB + (pc - L::PK) * 1024), 16, 0, 0); } } while (0)
    int koff[DQK / 16];
#pragma unroll
    for (int d0 = 0; d0 < DQK / 16; ++d0) koff[d0] = (r32 * L::CPRK + ((2 * d0 + hi) ^ L::fk(r32))) * 16;
    int voff[2][NB_];
    { const int q = (lane & 15) >> 2, g1 = (lane >> 4) & 1, p = lane & 3;
#pragma unroll
      for (int sec = 0; sec < 2; ++sec)
#pragma unroll
        for (int blk = 0; blk < NB_; ++blk) { const int row = 4 * hi + q + 8 * sec; voff[sec][blk] = L::KB * (MODE == 2 ? 0 : 1) + (row * L::CPRV + ((4 * blk + 2 * g1 + (p >> 1)) ^ L::fv(row))) * 16 + 8 * (p & 1); } }
    const int nact = ((qpos0 + 31) >> 6) + 1 < ntiles ? ((qpos0 + 31) >> 6) + 1 : ntiles;
#define FP_QK(a0_, a1_, kt_, st_, ref_) do { \
        const LAS unsigned char* sb_ = lds + (st_) * L::STG; const float nr_ = -(ref_); \
        if (MODE == 2) { const unsigned w_ = *(const LAS unsigned*)(lds + L::MASKOFF + (wave * S + (st_)) * 256 + lane * 4); const unsigned nrb_ = __float_as_uint(nr_); \
            _Pragma("unroll") for (int r = 0; r < 16; ++r) { const unsigned s0_ = (unsigned)__builtin_amdgcn_sbfe((int)w_, r, 1), s1_ = (unsigned)__builtin_amdgcn_sbfe((int)w_, 16 + r, 1); \
                a0_[r] = __uint_as_float((s0_ & nrb_) | (~s0_ & 0xff800000u)); a1_[r] = __uint_as_float((s1_ & nrb_) | (~s1_ & 0xff800000u)); } } \
        else if (MODE == 1) { const int n_ = (kt_) >> 2; const float cv_ = (n_ == jblk || ((selb >> n_) & 1u)) ? nr_ : -INFINITY; \
            _Pragma("unroll") for (int r = 0; r < 16; ++r) { a0_[r] = cv_; a1_[r] = cv_; } } \
        else { _Pragma("unroll") for (int r = 0; r < 16; ++r) { a0_[r] = nr_; a1_[r] = nr_; } } \
        _Pragma("unroll") for (int db = 0; db < DQK / 32; ++db) { f16x8 kf0_[2], kf1_[2]; \
            _Pragma("unroll") for (int d = 0; d < 2; ++d) { kf0_[d] = *(const LAS f16x8*)(sb_ + koff[2 * db + d]); kf1_[d] = *(const LAS f16x8*)(sb_ + koff[2 * db + d] + 32 * L::CPRK * 16); } \
            _Pragma("unroll") for (int d = 0; d < 2; ++d) { \
                a0_ = __builtin_amdgcn_mfma_f32_32x32x16_f16(kf0_[d], qf[2 * db + d], a0_, 0, 0, 0); \
                a1_ = __builtin_amdgcn_mfma_f32_32x32x16_f16(kf1_[d], qf[2 * db + d], a1_, 0, 0, 0); } } } while (0)
#define FP_PREP(a0_, a1_, kt_) do { const int k0_ = (kt_) * 64; \
        if (qpos0 - (k0_ + 63) < 128) { const int j0_ = 224 - (qpos0 + r32 - k0_ - 4 * hi), sf_ = j0_ & 1; const LAS float* rp_ = tab + sf_ * TAB2 + (j0_ - sf_); \
            _Pragma("unroll") for (int g = 0; g < 4; ++g) { const f32x2 x0_ = *(const LAS f32x2*)(rp_ + 8 * g), x1_ = *(const LAS f32x2*)(rp_ + 8 * g + 2), y0_ = *(const LAS f32x2*)(rp_ + 32 + 8 * g), y1_ = *(const LAS f32x2*)(rp_ + 34 + 8 * g); \
                a0_[4 * g] += x0_.x; a0_[4 * g + 1] += x0_.y; a0_[4 * g + 2] += x1_.x; a0_[4 * g + 3] += x1_.y; a1_[4 * g] += y0_.x; a1_[4 * g + 1] += y0_.y; a1_[4 * g + 2] += y1_.x; a1_[4 * g + 3] += y1_.y; } } \
        rmrel = half_max(rowmax32(a0_, a1_)); } while (0)
#define FP_VREAD(dst_, ks_, st_) do { const LAS unsigned char* sv_ = lds + (st_) * L::STG; _Pragma("unroll") for (int blk = 0; blk < NB_; ++blk) { \
        const v4i16_t a_ = __builtin_amdgcn_ds_read_tr16_b64_v4i16((LAS v4i16_t*)(sv_ + voff[0][blk] + 16 * (ks_) * L::CPRV * 16)); \
        const v4i16_t b_ = __builtin_amdgcn_ds_read_tr16_b64_v4i16((LAS v4i16_t*)(sv_ + voff[1][blk] + 16 * (ks_) * L::CPRV * 16)); \
        const f16x4 a4_ = __builtin_bit_cast(f16x4, a_), b4_ = __builtin_bit_cast(f16x4, b_); \
        dst_[blk] = (f16x8){a4_[0], a4_[1], a4_[2], a4_[3], b4_[0], b4_[1], b4_[2], b4_[3]}; } } while (0)
#define FP_PV(src_, ks_) do { _Pragma("unroll") for (int blk = 0; blk < NB_; ++blk) o[blk] = __builtin_amdgcn_mfma_f32_32x32x16_f16(src_[blk], pf[ks_], o[blk], 0, 0, 0); } while (0)
#define FP_STEP(c0_, c1_, n0_, n1_, kt_) do { \
        if (S > 3 && (kt_) + S - 2 < ntiles) FA_WAITV(L::NPW * (S - 3)); else FA_WAITV(0); \
        __builtin_amdgcn_s_barrier(); asm volatile("" ::: "memory"); \
        if ((kt_) + S - 1 < ntiles) FP_ISSUE((kt_) + S - 1, sti); \
        if ((kt_) < nact) { \
            const float mu_ = (m == -INFINITY) ? 0.f : m; const bool more_ = (kt_) + 1 < nact; float rmrel = -INFINITY; \
            if (more_) FP_QK(n0_, n1_, (kt_) + 1, st1, mu_); \
            if (__any(dl != 0.f)) { _Pragma("unroll") for (int r = 0; r < 16; ++r) { c0_[r] -= dl; c1_[r] -= dl; } } \
            float ls_ = 0.f; \
            _Pragma("unroll") for (int r = 0; r < 16; ++r) { c0_[r] = __builtin_amdgcn_exp2f(c0_[r]); c1_[r] = __builtin_amdgcn_exp2f(c1_[r]); ls_ += c0_[r] + c1_[r]; } \
            l += ls_; \
            f16x8 pf[4]; pf[0] = pack8(c0_, 0); pf[1] = pack8(c0_, 8); pf[2] = pack8(c1_, 0); pf[3] = pack8(c1_, 8); \
            if (NB_ <= 2) { f16x8 vfa[NB_], vfb[NB_]; \
                FP_VREAD(vfa, 0, st); FP_VREAD(vfb, 1, st); \
                if (more_) FP_PREP(n0_, n1_, (kt_) + 1); \
                FP_PV(vfa, 0); FP_VREAD(vfa, 2, st); FP_PV(vfb, 1); FP_VREAD(vfb, 3, st); FP_PV(vfa, 2); FP_PV(vfb, 3); \
            } else { f16x8 vfa[NB_]; \
                FP_VREAD(vfa, 0, st); \
                if (more_) FP_PREP(n0_, n1_, (kt_) + 1); \
                FP_PV(vfa, 0); __builtin_amdgcn_sched_barrier(0); FP_VREAD(vfa, 1, st); FP_PV(vfa, 1); __builtin_amdgcn_sched_barrier(0); \
                FP_VREAD(vfa, 2, st); FP_PV(vfa, 2); __builtin_amdgcn_sched_barrier(0); FP_VREAD(vfa, 3, st); FP_PV(vfa, 3); } \
            dl = 0.f; \
              \
            if (more_ && __any(rmrel > 8.f || (m == -INFINITY && rmrel > -INFINITY))) { \
                const float mnew_ = fmaxf(m, rmrel + mu_), mun_ = (mnew_ == -INFINITY) ? 0.f : mnew_; dl = mun_ - mu_; m = mnew_; \
                const float al_ = __builtin_amdgcn_exp2f(-dl); l *= al_; \
                _Pragma("unroll") for (int blk = 0; blk < NB_; ++blk) _Pragma("unroll") for (int r = 0; r < 16; ++r) o[blk][r] *= al_; } \
        } \
        st = st1; st1 = (st1 + 1 == S) ? 0 : st1 + 1; sti = (sti + 1 == S) ? 0 : sti + 1; } while (0)
#pragma unroll
    for (int t0 = 0; t0 < S - 1; ++t0) if (t0 < ntiles) FP_ISSUE(t0, t0);
    f32x16 sa0, sa1, sb0, sb1; float dl;
    if (ntiles >= S - 1) FA_WAITV(L::NPW * (S - 2)); else FA_WAITV(0);
    __builtin_amdgcn_s_barrier(); asm volatile("" ::: "memory");
    { float rmrel; FP_QK(sa0, sa1, 0, 0, 0.f); FP_PREP(sa0, sa1, 0); m = rmrel; dl = (m == -INFINITY) ? 0.f : m; }
    int st = 0, st1 = 1, sti = S - 1;
#pragma unroll 1
    for (int kt = 0; kt < ntiles; kt += 2) {
        FP_STEP(sa0, sa1, sb0, sb1, kt);
        if (kt + 1 < ntiles) FP_STEP(sb0, sb1, sa0, sa1, kt + 1);
    }
    asm volatile("s_waitcnt lgkmcnt(0)" ::: "memory");
    __builtin_amdgcn_s_barrier(); asm volatile("" ::: "memory");
#undef FP_ISSUE
#undef FP_QK
#undef FP_PREP
#undef FP_VREAD
#undef FP_PV
#undef FP_STEP
    l = half_sum(l);
    const float inv = 1.f / l;
#pragma unroll
    for (int blk = 0; blk < NB_; ++blk)
#pragma unroll
        for (int r = 0; r < 16; ++r) o[blk][r] *= inv;
}
template <int DV> __device__ __forceinline__ void store_o(const f32x16 (&o)[DV / 32], f16* dst, int hi) {
#pragma unroll
    for (int blk = 0; blk < DV / 32; ++blk)
#pragma unroll
        for (int g = 0; g < 4; ++g) { u32x2 w; w.x = pk2h(o[blk][4 * g], o[blk][4 * g + 1]); w.y = pk2h(o[blk][4 * g + 2], o[blk][4 * g + 3]);
            *(u32x2*)(dst + 32 * blk + 8 * g + 4 * hi) = w; }
}
}

struct Args { const float* in[20]; float* out; unsigned char* ws; };

__global__ void __launch_bounds__(NWAVES * 64, 2) mega_fwd(Args args) {
    extern __shared__ __attribute__((aligned(16))) unsigned char lds_raw[];
    Frame F;
    F.lds = (LAS unsigned char*)0;
    (void)lds_raw;
    F.wave = __builtin_amdgcn_readfirstlane(threadIdx.x >> 6);
    F.G = gridDim.x; F.gw = blockIdx.x * NWAVES + F.wave; F.NGW = F.G * NWAVES;
    volatile LAS unsigned* MISC = (volatile LAS unsigned*)(F.lds + MISC_OFF);
    for (int u = threadIdx.x; u < (LDS_BYTES - LDSCTL_OFF) / 4; u += NWAVES * 64) ((LAS unsigned*)(F.lds + LDSCTL_OFF))[u] = 0u;
    __syncthreads();
    unsigned* ctl = (unsigned*)(args.ws + WS_CTL);
    XcdBarrier bar = xcd_barrier_post(ctl + CW_BAR, MISC + 8, F.wave);
    if (threadIdx.x == 0) __hip_atomic_fetch_or(ctl + CW_LB + 64 * (16 + (int)(blockIdx.x & 7u)), 1u << xb_xcc_id(), __ATOMIC_RELAXED, __HIP_MEMORY_SCOPE_AGENT);

    if (threadIdx.x < 20) ((volatile LAS unsigned long long*)(F.lds + PTAB_OFF))[threadIdx.x] = (unsigned long long)args.in[threadIdx.x];
    __syncthreads();
#define IN(i) inptr(F.lds, (i))
#define LANE lane_id()
#define LL launder_i(l)
#define GW launder_i(F.gw)
#define GWX ((gridDim.x == 256u) ? (int)((((blockIdx.x & 7u) << 5) + (blockIdx.x >> 3)) * 8u) + F.wave : GW)
#define SEAM_L() do { if (__builtin_amdgcn_readfirstlane((int)MISC[19])) xcd_local_barrier((unsigned*)launder(args.ws) + CW_LB, bar, F.wave); else xcd_barrier(bar, F.wave); } while (0)
#define TID (F.wave * 64 + lane_id())
#define WSP(T, off) ((T*)(launder(args.ws) + (off)))
    enum { I_X = 0, I_C, I_RELB, I_ADAW, I_ADAB, I_NMIX, I_WIN, I_GATEB, I_DLAM, I_SUBLN, I_KVNORM, I_WUV, I_WBRA, I_WBRB, I_WBRC, I_WO, I_NMLP, I_WFF1, I_WFF2, I_NFINAL };
    float* xout = args.out;
    for (int rp0 = 0; rp0 < launder_i(REP_P0); ++rp0) {
        LAS float* scr = (LAS float*)(F.lds + F.wave * 16384);
        { auto decode = [&](int it) -> TItem { const int l = it >> 13; int r = it & 8191;
              if (r < 1664) return TItem{IN(I_WIN) + (size_t)l * DM * IN_COLS, IN_COLS, 0, PCOLS, DM, WSP(f16, WS_WIN) + (size_t)l * PP * DM, PP / 32, (unsigned*)launder(args.ws) + CW_CMAX + (l * 3 + 0) * 4096, r, true, false}; r -= 1664;
              if (r < 1536) return TItem{IN(I_WIN) + (size_t)l * DM * IN_COLS, IN_COLS, C_G, GCOLS, DM, WSP(f16, WS_WG) + (size_t)l * GCOLS * DM, GCOLS / 32, (unsigned*)launder(args.ws) + CW_CMAX + (l * 3 + 1) * 4096, r, false, false}; r -= 1536;
              if (r < 256) return TItem{IN(I_WBRA) + (size_t)l * 512 * DM, DM, 0, DM, 512, WSP(f16, WS_WA) + (size_t)l * DM * 512, DM / 32, (unsigned*)nullptr, r, false, false}; r -= 256;
              if (r < 128) return TItem{IN(I_WBRC) + (size_t)l * 256 * DM, DM, 0, DM, 256, WSP(f16, WS_WC) + (size_t)l * DM * 256, DM / 32, (unsigned*)nullptr, r, false, false}; r -= 128;
              if (r < 512) return TItem{IN(I_WO) + (size_t)l * DM * DM, DM, 0, DM, DM, WSP(f16, WS_WO) + (size_t)l * DM * DM, DM / 32, (unsigned*)nullptr, r, false, false}; r -= 512;
              if (r < 2048) return TItem{IN(I_WFF1) + (size_t)l * DM * DFF, DFF, 0, DFF, DM, WSP(f16, WS_W1) + (size_t)l * DFF * DM, DFF / 32, (unsigned*)launder(args.ws) + CW_CMAX + (l * 3 + 2) * 4096, r, false, false}; r -= 2048;
              return TItem{IN(I_WFF2) + (size_t)l * DFF * DM, DM, 0, DM, DFF, WSP(f16, WS_W2) + (size_t)l * DM * DFF, DM / 32, (unsigned*)nullptr, r, false, false}; };
          int it = F.gw;
          if (it < 2 * 8192) { TItem cur = decode(it); float wv[32]; float sc; titem_load(cur, LANE, wv, sc);
#pragma unroll 1
            for (;;) { const int itn = it + F.NGW; const bool more = itn < 2 * 8192;
                TItem nxt = cur; float wn[32]; float scn = 1.f;
                if (more) { nxt = decode(itn); titem_load(nxt, LANE, wn, scn); }
                titem_store(cur, LANE, wv, sc, scr);
                if (!more) break;
#pragma unroll
                for (int i = 0; i < 32; ++i) wv[i] = wn[i];
                sc = scn; cur = nxt; it = itn; } } }
        for (int it = F.gw; it < 2048; it += F.NGW) {
            const int l = it >> 10, kb = (it >> 4) & 63, nb = it & 15; const int kk0 = kb * 8, h = kk0 >> 7, r0 = kk0 & 127, n = nb * 64 + LANE;
            const float* uv = IN(I_WUV) + ((size_t)(l * 4 + h) * 128 + r0) * 64; const float* wb = IN(I_WBRB) + ((size_t)l * 256 + h * 64) * DM + n;
            float a[8];
#pragma unroll
            for (int j = 0; j < 8; ++j) a[j] = 0.f;
#pragma unroll 1
            for (int e0 = 0; e0 < 64; e0 += 16) { float bw[16];
#pragma unroll
                for (int e = 0; e < 16; ++e) bw[e] = *(const GAS float*)(wb + (size_t)(e0 + e) * DM);
#pragma unroll
                for (int e = 0; e < 16; ++e)
#pragma unroll
                    for (int j = 0; j < 8; ++j) a[j] += uv[j * 64 + e0 + e] * bw[e]; }
            u32x4 o; o.x = pk2h(a[0], a[1]); o.y = pk2h(a[2], a[3]); o.z = pk2h(a[4], a[5]); o.w = pk2h(a[6], a[7]);
            *(u32x4*)(WSP(f16, WS_WBC) + ((size_t)l * DM + n) * 512 + kk0) = o;
        }
        __syncthreads();
        if (blockIdx.x < 192) {
            const int l = blockIdx.x / 96, j0 = (blockIdx.x % 96) * 64;
            LAS float* cond = (LAS float*)F.lds;
            LAS float* part = (LAS float*)(F.lds + 65536);
            const float* c_in = IN(I_C);
            for (int i = TID; i < NB * DM; i += 512) { const float v = c_in[i]; cond[i] = v / (1.f + __expf(-v)); }
            __syncthreads();
            float a[16];
#pragma unroll
            for (int b = 0; b < 16; ++b) a[b] = 0.f;
            const float* wp = IN(I_ADAW) + (size_t)l * DM * 6144 + j0 + LANE;
#pragma unroll 1
            for (int k0 = F.wave * 128; k0 < F.wave * 128 + 128; k0 += 16) { float w[16];
#pragma unroll
                for (int i = 0; i < 16; ++i) w[i] = *(const GAS float*)(wp + (size_t)(k0 + i) * 6144);
#pragma unroll
                for (int b = 0; b < 16; ++b)
#pragma unroll
                    for (int i4 = 0; i4 < 4; ++i4) { const f32x4 cvv = *(const LAS f32x4*)(cond + b * 1024 + k0 + 4 * i4);
                        a[b] += (cvv.x * w[4 * i4] + cvv.y * w[4 * i4 + 1]) + (cvv.z * w[4 * i4 + 2] + cvv.w * w[4 * i4 + 3]); } }
#pragma unroll
            for (int b = 0; b < 16; ++b) part[(F.wave * 16 + b) * 64 + LANE] = a[b];
            __syncthreads();
            const float* ada_b = IN(I_ADAB); float* mod = WSP(float, WS_MOD);
            for (int i = TID; i < 1024; i += 512) { const int b = i >> 6, j = i & 63; float s = ada_b[l * 6144 + j0 + j];
#pragma unroll
                for (int w = 0; w < 8; ++w) s += part[(w * 16 + b) * 64 + j];
                mod[((size_t)l * 16 + b) * 6144 + j0 + j] = s; }
            __syncthreads();
        } else if (blockIdx.x == 192) {
            const float* rel_bias = IN(I_RELB); float* tabs = WSP(float, WS_MISC + 1024); float* lamv = WSP(float, WS_MISC);
            for (int i = TID; i < 12 * TABN; i += 512) { const int hh = i / TABN, idx = i % TABN, dist = idx - 255;
                float v; if (dist < 0) v = -INFINITY; else if (dist >= 128) v = 0.f; else v = (rel_bias[t5_bucket(dist) * 12 + hh] - rel_bias[31 * 12 + hh]) * LOG2E;
                tabs[i] = v; }
            float* tabs2 = WSP(float, WS_MISC + 32768);
            for (int i = TID; i < 12 * TAB2H; i += 512) { const int hh = i / TAB2H, sft = (i % TAB2H) / TAB2, j = (i % TAB2) + sft, dist = 224 - j;
                float v; if (dist < 0) v = -INFINITY; else if (dist >= 128) v = 0.f; else v = (rel_bias[t5_bucket(dist) * 12 + hh] - rel_bias[31 * 12 + hh]) * LOG2E;
                tabs2[i] = v; }
            if (F.wave < 2) { const int l = F.wave; const float* dl = IN(I_DLAM) + l * 256;
                const float s1 = wave_sum(dl[LANE] * dl[64 + LANE]), s2 = wave_sum(dl[128 + LANE] * dl[192 + LANE]);
                const float lam_init = 0.8f - 0.6f * expf(-0.3f * (float)l);
                if (LANE == 0) lamv[l] = expf(s1) - expf(s2) + lam_init; }
        }
    }
    xcd_barrier(bar, F.wave);
    if (threadIdx.x == 0) { unsigned ok = (gridDim.x == 256u) ? 1u : 0u, seen = 0u;
#pragma unroll 1
        for (int r = 0; r < 8; ++r) { const unsigned mk = xb_ld((unsigned*)launder(args.ws) + CW_LB + 64 * (16 + r)); if (__builtin_popcount(mk) != 1 || (seen & mk)) ok = 0u; seen |= mk; }
        MISC[19] = ok; }
    __syncthreads();
    { const int grp = blockIdx.x % 6, bi = blockIdx.x / 6, nbl = (F.G - grp + 5) / 6, l = grp / 3, which = grp % 3; const int lane = LANE;
      const float* modl = WSP(float, WS_MOD) + (size_t)l * 16 * 6144 + (which == 2 ? 3 : 0) * DM;
      LAS float* sh = (LAS float*)F.lds;
      for (int i2 = F.wave * 64 + lane; i2 < 16 * 1024; i2 += 512) sh[i2] = modl[(size_t)(i2 >> 10) * 6144 + (i2 & 1023)];
      __syncthreads();
      const f16* Bt = which == 0 ? WSP(f16, WS_WIN) + (size_t)l * PP * DM : (which == 1 ? WSP(f16, WS_WG) + (size_t)l * GCOLS * DM : WSP(f16, WS_W1) + (size_t)l * DFF * DM);
      const int nrows = which == 0 ? PP : (which == 1 ? GCOLS : DFF);
      float* cv = WSP(float, WS_CVEC) + (size_t)grp * 16 * 4096;
      u32x2 nxw[4]; unsigned nxc = 0u;
      { const int n = bi * 8 + F.wave;
        if (n < nrows) { nxc = ((const GAS unsigned*)launder(args.ws))[CW_CMAX + grp * 4096 + n];
#pragma unroll
          for (int j = 0; j < 4; ++j) nxw[j] = *(const GAS u32x2*)(Bt + (size_t)n * DM + 256 * j + lane * 4); } }
      for (int n = bi * 8 + F.wave; n < nrows; n += nbl * 8) {
          float w[16]; const unsigned cmb = nxc;
#pragma unroll
          for (int j = 0; j < 4; ++j) { const unsigned wx = nxw[j].x, wy = nxw[j].y; const f16x2 a = __builtin_bit_cast(f16x2, wx), b2 = __builtin_bit_cast(f16x2, wy);
              w[4 * j] = (float)a[0]; w[4 * j + 1] = (float)a[1]; w[4 * j + 2] = (float)b2[0]; w[4 * j + 3] = (float)b2[1]; }
          { const int n2 = n + nbl * 8;
            if (n2 < nrows) { nxc = ((const GAS unsigned*)launder(args.ws))[CW_CMAX + grp * 4096 + n2];
#pragma unroll
              for (int j = 0; j < 4; ++j) nxw[j] = *(const GAS u32x2*)(Bt + (size_t)n2 * DM + 256 * j + lane * 4); } }
          {
              const float cm = __uint_as_float(cmb), inv = cm > 0.f ? 127.f / cm : 0.f;
              unsigned char* wq = launder(args.ws) + (which == 0 ? WS_WQIN : (which == 1 ? WS_WQG : WS_WQ1)) + ((size_t)l * nrows + n) * 1024;
#pragma unroll
              for (int j = 0; j < 4; ++j) { unsigned pk = 0u;
#pragma unroll
                  for (int e = 0; e < 4; ++e) pk |= ((unsigned)(int)__builtin_rintf(w[4 * j + e] * inv) & 255u) << (8 * e);
                  *(unsigned*)(wq + 256 * j + lane * 4) = pk; }
              if (lane == 0) WSP(float, WS_SB)[grp * 4096 + n] = cm * (1.f / 127.f); }
          float a[16];
#pragma unroll
          for (int b = 0; b < 16; ++b) { a[b] = 0.f;
#pragma unroll
              for (int j = 0; j < 4; ++j) { const f32x4 sv = *(const LAS f32x4*)(sh + b * 1024 + 256 * j + lane * 4); a[b] += (w[4 * j] * sv.x + w[4 * j + 1] * sv.y) + (w[4 * j + 2] * sv.z + w[4 * j + 3] * sv.w); } }
#pragma unroll
          for (int st = 0; st < 4; ++st) { const int msk = 32 >> st, nh = 8 >> st; const bool up = (lane & msk) != 0;
#pragma unroll
              for (int i3 = 0; i3 < nh; ++i3) { const float send = up ? a[i3] : a[i3 + nh], keep = up ? a[i3 + nh] : a[i3]; a[i3] = keep + __shfl_xor(send, msk); } }
          a[0] += __shfl_xor(a[0], 1); a[0] += __shfl_xor(a[0], 2);
          if ((lane & 3) == 0) cv[(size_t)(((lane >> 5) & 1) * 8 + ((lane >> 4) & 1) * 4 + ((lane >> 3) & 1) * 2 + ((lane >> 2) & 1)) * 4096 + n] = a[0];
      }
      __syncthreads();
    }

#pragma unroll 1
    for (int l = 0; l < DEPTH; ++l) {
        if (LL == 0) for (int rep = 0; rep < REP_N1; ++rep) {
        { const float* xcur = IN(I_X); const float* modl = WSP(float, WS_MOD); const float* nw = IN(I_NMIX); unsigned char* U8 = (unsigned char*)xout + (size_t)64 * MiB; float* rf = (float*)launder(args.ws) + CW_RF;
          for (int m0 = GWX * 16; m0 < MTOK; m0 += F.NGW * 16) { const int b = m0 / SEQ;
            norm_quant_rows16_0(xcur, nw, modl + (size_t)b * 6144 + 1 * DM, (f16*)xout, U8, rf, m0, LANE); } }
        xcd_barrier(bar, F.wave);
        if (__builtin_amdgcn_readfirstlane((int)MISC[19])) { for (unsigned i = 0; i < (blockIdx.x & 7u); ++i) __builtin_amdgcn_s_sleep(40); }
        }
        for (int rep = 0; rep < REP_G1; ++rep) {
#ifndef NO_G1
        { pg8::Gemm g{(const f16*)((const unsigned char*)xout + (size_t)64 * MiB), (const f16*)(launder(args.ws) + WS_WQIN + (size_t)LL * PP * 1024), MTOK, PP, DM / 2}; pg8::StaticOrder S; S.init(MTOK, PP, F.G, (int)blockIdx.x);
          pg8::EpiNormF16<0, true> E{WSP(f16, WS_R1), PP, GAPP};
          pg8::fill_tabs_q((const float*)launder(args.ws) + CW_RF, WSP(float, WS_CVEC) + (size_t)(LL * 3 + 0) * 16 * 4096, (const float*)nullptr, WSP(float, WS_SB) + (LL * 3 + 0) * 4096, S, TID);
          pg8::gemm_phase<pg8::EpiNormF16<0, true>, pg8::StaticOrder, true, true, true>(F.lds, g, S, E, F.wave); }
#endif
        SEAM_L();
        }
        for (int rep = 0; rep < launder_i(REP_SEL); ++rep) {
        { const f16* P = WSP(f16, WS_R1); f16* KVN = WSP(f16, WS_KVN); const float* kvw = IN(I_KVNORM) + LL * 128; float* kmean = WSP(float, WS_MISC + 65536);
          { const int lane = LANE, sub = lane >> 4, cl = lane & 15;
            float kw[8];
#pragma unroll
            for (int e = 0; e < 8; ++e) kw[e] = kvw[cl * 8 + e];
            for (int m0 = GWX * 16; m0 < MTOK; m0 += 16 * F.NGW) {
                f16x8 v[4]; float ss[4];
#pragma unroll
                for (int j = 0; j < 4; ++j) v[j] = __builtin_bit_cast(f16x8, *(const GAS u32x4*)(P + (size_t)(m0 + j * 4 + sub) * PP + (size_t)((m0 + j * 4 + sub) >> 12) * GAPP + C_BKV + cl * 8));
#pragma unroll
                for (int j = 0; j < 4; ++j) { ss[j] = 0.f;
#pragma unroll
                    for (int e = 0; e < 8; ++e) ss[j] += (float)v[j][e] * (float)v[j][e]; }
#pragma unroll
                for (int o = 1; o < 16; o <<= 1)
#pragma unroll
                    for (int j = 0; j < 4; ++j) ss[j] += __shfl_xor(ss[j], o);
#pragma unroll
                for (int j = 0; j < 4; ++j) { const float r = __builtin_amdgcn_rsqf(ss[j] * (1.f / 128.f) + EPS);
                    u32x4 w; w.x = pk2h((float)v[j][0] * r * kw[0], (float)v[j][1] * r * kw[1]); w.y = pk2h((float)v[j][2] * r * kw[2], (float)v[j][3] * r * kw[3]);
                    w.z = pk2h((float)v[j][4] * r * kw[4], (float)v[j][5] * r * kw[5]); w.w = pk2h((float)v[j][6] * r * kw[6], (float)v[j][7] * r * kw[7]);
                    *(GAS u32x4*)(KVN + (size_t)(m0 + j * 4 + sub) * 128 + cl * 8) = w; }
            } }
          for (int it = (gridDim.x == 256u) ? (((int)(blockIdx.x >> 3) * 8 + F.wave < 64) ? (int)(blockIdx.x & 7u) * 64 + (int)(blockIdx.x >> 3) * 8 + F.wave : NB * 4 * 8) : GW; it < NB * 4 * 8; it += F.NGW) {
            const int b = it >> 5, h = (it >> 3) & 3, blk = it & 7; const int lane = LANE, rg = lane >> 3, ch = lane & 7;
            const f16* src = P + ((size_t)b * SEQ + blk * 256 + rg) * PP + (size_t)(b >> 1) * GAPP + C_CK + h * 64 + ch * 8; float a8[8];
#pragma unroll
            for (int e = 0; e < 8; ++e) a8[e] = 0.f;
#pragma unroll 8
            for (int r = 0; r < 32; ++r) { const f16x8 v = __builtin_bit_cast(f16x8, *(const GAS u32x4*)(src + (size_t)(8 * r) * PP));
#pragma unroll
                for (int e = 0; e < 8; ++e) a8[e] += (float)v[e]; }
#pragma unroll
            for (int e = 0; e < 8; ++e) { a8[e] += __shfl_xor(a8[e], 8); a8[e] += __shfl_xor(a8[e], 16); a8[e] += __shfl_xor(a8[e], 32); }
            if (rg == 0) { f32x4 o0 = {a8[0], a8[1], a8[2], a8[3]}, o1 = {a8[4], a8[5], a8[6], a8[7]};
                *(f32x4*)(kmean + (size_t)it * 64 + ch * 8) = o0 * (1.f / 256.f); *(f32x4*)(kmean + (size_t)it * 64 + ch * 8 + 4) = o1 * (1.f / 256.f); } } }
#ifndef NAIVE_DSA
#ifdef NAIVE_SELECT
        { const f16* P = WSP(f16, WS_R1); unsigned* MASK = WSP(unsigned, WS_MASK); LAS unsigned* keyl = (LAS unsigned*)(F.lds + F.wave * 16384 + 8192);
          for (int task = GW; task < NB * SEQ; task += F.NGW) {
            const int b = task / SEQ, t = (task % SEQ + 37 * b) % SEQ; const size_t row = (size_t)b * SEQ + t; const int lane = LANE;
            const int nslots = (t >> 6) + 1;
            unsigned sel = 0xffffffffu;
            if (t >= 256) {
                const f16* iq = P + row * PP + C_BIQ; const f16* iwp = P + row * PP + C_BIW;
#pragma unroll 1
                for (int j = 0; j < nslots; ++j) { unsigned kk = 0u; const int k = 64 * j + lane;
                    if (k <= t) { const f16* ik = P + ((size_t)b * SEQ + k) * PP + C_BIK; f16x8 kv[4];
#pragma unroll
                        for (int c = 0; c < 4; ++c) kv[c] = *(const f16x8*)(ik + 8 * c);
                        float sc = 0.f;
#pragma unroll 1
                        for (int hh = 0; hh < 8; ++hh) { float d = 0.f;
#pragma unroll
                            for (int c = 0; c < 4; ++c) { const f16x8 qv = *(const f16x8*)(iq + hh * 32 + 8 * c);
#pragma unroll
                                for (int e = 0; e < 8; ++e) d += (float)qv[e] * (float)kv[c][e]; }
                            sc += fmaxf(d, 0.f) * (float)iwp[hh]; }
                        kk = ordkey(sc); }
                    keyl[k] = kk; }
                unsigned thr = 0u;
#pragma unroll 1
                for (int bit = 31; bit >= 0; --bit) { const unsigned cand = thr | (1u << bit); int c = 0;
#pragma unroll 1
                    for (int j = 0; j < nslots; ++j) c += (keyl[64 * j + lane] >= cand) ? 1 : 0;
                    if (wave_isum(c) >= 256) thr = cand; }
                int cgt = 0;
#pragma unroll 1
                for (int j = 0; j < nslots; ++j) cgt += (keyl[64 * j + lane] > thr) ? 1 : 0;
                cgt = wave_isum(cgt);
                const int need = 256 - cgt; int run = 0; sel = 0u;
#pragma unroll 1
                for (int j = 0; j < nslots; ++j) { const unsigned kk = keyl[64 * j + lane]; const bool tie = kk == thr; const unsigned long long bal = __ballot(tie);
                    const int pre = run + __popcll(bal & ((1ull << lane) - 1ull));
                    if (kk > thr || (tie && pre < need)) sel |= 1u << j;
                    run += __popcll(bal); }
            }
            const int bb = lane & 31, kkq = 32 * (bb >> 4) + (bb & 3) + 8 * ((bb & 15) >> 2) + 4 * (lane >> 5);
            unsigned* mrow = MASK + ((size_t)(b * 64 + (t >> 5)) * 32) * 64 + (t & 31);
#pragma unroll 1
            for (int j = 0; j < nslots; ++j) { const unsigned long long bal = __ballot((sel >> j) & 1u);
                const unsigned long long w64 = __ballot((bal >> kkq) & 1ull);
                if (lane == 0) { mrow[j * 64] = (unsigned)w64; mrow[j * 64 + 32] = (unsigned)(w64 >> 32); } }
          } }
#else
        { const f16* P = WSP(f16, WS_R1); unsigned* MASK = WSP(unsigned, WS_MASK);
          unsigned* qctr = (unsigned*)launder(args.ws) + CW_QUEUE + 512 * ((rep * 2 + LL) * 4 + 3);
          LAS unsigned* hist = (LAS unsigned*)F.lds;
          constexpr int HSTR = 257;
          if (TID == 0) MISC[17] = 0u;
          for (int uk = 0;; ++uk) {
            const int ui = unit_pick(uk, 128, qctr, MISC);
            if (ui < 0) break;
            const int qg = 63 - ((ui & 127) >> 1), b = 2 * (ui >> 7) + (ui & 1); const int lane = LANE, tid = F.wave * 64 + lane, r32 = lane & 31, hi = lane >> 5;
            const int ntiles = (qg >> 1) + 1, t = 32 * qg + r32; const size_t brow = (size_t)b * SEQ; const f16* Pg = P + (size_t)(b >> 1) * GAPP;
            unsigned* mbase = MASK + ((size_t)(b * 64 + qg) * 32) * 64 + lane;
            if (qg < 8) { for (int kt = F.wave; kt < ntiles; kt += 8) mbase[kt * 64] = 0xffffffffu; continue; }
            unsigned keys[4][32];
            {
              const f16* iqp = Pg + (brow + t) * PP + C_BIQ; const f16* iwp = Pg + (brow + t) * PP + C_BIW;
              LAS u32x4* iqL = (LAS u32x4*)(F.lds + 45056);
              const f16x8 iwv = *(const f16x8*)iwp;
              unsigned sgnbits = 0u;
#pragma unroll
              for (int h = 0; h < 8; ++h) sgnbits |= ((float)iwv[h] < 0.f) ? (1u << h) : 0u;
              { float wsel = 0.f;
#pragma unroll
                for (int h = 0; h < 8; ++h) wsel = (h == F.wave) ? (float)iwv[h] : wsel;
#pragma unroll
                for (int s2 = 0; s2 < 2; ++s2) { const f16x8 v = *(const f16x8*)(iqp + F.wave * 32 + 16 * s2 + 8 * hi);
                    u32x4 pw; pw.x = pk2h(wsel * (float)v[0], wsel * (float)v[1]); pw.y = pk2h(wsel * (float)v[2], wsel * (float)v[3]); pw.z = pk2h(wsel * (float)v[4], wsel * (float)v[5]); pw.w = pk2h(wsel * (float)v[6], wsel * (float)v[7]);
                    iqL[(F.wave * 2 + s2) * 64 + lane] = pw; } }
              if (F.wave == 0) {
#pragma unroll
                for (int s2 = 0; s2 < 2; ++s2) { float ca[8];
#pragma unroll
                    for (int e = 0; e < 8; ++e) ca[e] = 0.f;
#pragma unroll
                    for (int h = 0; h < 8; ++h) { const f16x8 v = *(const f16x8*)(iqp + h * 32 + 16 * s2 + 8 * hi); const float w = (float)iwv[h];
#pragma unroll
                        for (int e = 0; e < 8; ++e) ca[e] += w * (float)v[e]; }
                    u32x4 pw; pw.x = pk2h(ca[0], ca[1]); pw.y = pk2h(ca[2], ca[3]); pw.z = pk2h(ca[4], ca[5]); pw.w = pk2h(ca[6], ca[7]);
                    iqL[(16 + s2) * 64 + lane] = pw; } }
              __syncthreads();
#if REP_SCORE > 1
#pragma unroll 1
              for (int rs = 0; rs < launder_i(REP_SCORE); ++rs)
#endif
#pragma unroll
              for (int ti = 0; ti < 4; ++ti) { const int kt = F.wave + 8 * ti;
                if (kt < ntiles) { const int k0 = 64 * kt;
#pragma unroll
                    for (int half = 0; half < 2; ++half) { const f16* ikp = Pg + (brow + k0 + 32 * half + r32) * PP + C_BIK + 8 * hi;
                        const f16x8 kf0 = *(const f16x8*)ikp, kf1 = *(const f16x8*)(ikp + 16);
                        fa::f32x16 sc;
#pragma unroll
                        for (int r = 0; r < 16; ++r) sc[r] = 0.f;
                        sc = __builtin_amdgcn_mfma_f32_32x32x16_f16(kf0, __builtin_bit_cast(f16x8, iqL[16 * 64 + lane]), sc, 0, 0, 0);
                        sc = __builtin_amdgcn_mfma_f32_32x32x16_f16(kf1, __builtin_bit_cast(f16x8, iqL[17 * 64 + lane]), sc, 0, 0, 0);
#pragma unroll 2
                        for (int h = 0; h < 8; ++h) { fa::f32x16 a;
#pragma unroll
                            for (int r = 0; r < 16; ++r) a[r] = 0.f;
                            a = __builtin_amdgcn_mfma_f32_32x32x16_f16(kf0, __builtin_bit_cast(f16x8, iqL[(2 * h) * 64 + lane]), a, 0, 0, 0);
                            a = __builtin_amdgcn_mfma_f32_32x32x16_f16(kf1, __builtin_bit_cast(f16x8, iqL[(2 * h + 1) * 64 + lane]), a, 0, 0, 0);
                            const float sg = ((sgnbits >> h) & 1u) ? -1.f : 1.f;
#pragma unroll
                            for (int r = 0; r < 16; ++r) sc[r] = __builtin_fmaf(__builtin_fabsf(a[r]), sg, sc[r]); }
#pragma unroll
                        for (int r = 0; r < 16; ++r) keys[ti][16 * half + r] = ordkey(sc[r]);
                        if (k0 + 63 > 32 * qg) {
#pragma unroll
                            for (int r = 0; r < 16; ++r) { const int kidx = k0 + 32 * half + fa::crow(r, hi); keys[ti][16 * half + r] = (kidx <= t) ? keys[ti][16 * half + r] : 0u; } } }
                } else {
#pragma unroll
                    for (int e = 0; e < 32; ++e) keys[ti][e] = 0u; } } }
            unsigned prefix = 0u;
#if REP_RADIX > 1
#pragma unroll 1
            for (int rr = 0; rr < launder_i(REP_RADIX); ++rr)
#endif
#pragma unroll 1
            for (int pass = 0; pass < 4; ++pass) { const int shift = 24 - 8 * pass;
                LAS unsigned* qst = (LAS unsigned*)(F.lds + 40960 + (pass & 1) * 512); LAS unsigned* qstn = (LAS unsigned*)(F.lds + 40960 + ((pass & 1) ^ 1) * 512);
                for (int i2 = tid; i2 < 32 * HSTR; i2 += 512) hist[i2] = 0u;
                __syncthreads();
                if (pass > 0) prefix = qst[2 * r32];
                const int pshift = (pass == 0) ? 31 : shift + 8; const unsigned pmask = (pass == 0) ? 0u : 0xffffffffu;
#pragma unroll
                for (int ti = 0; ti < 4; ++ti)
#pragma unroll
                    for (int e = 0; e < 32; ++e) { const unsigned k = keys[ti][e];
                        const unsigned x = ((k >> pshift) ^ prefix) & pmask; const unsigned inc = 1u - __builtin_elementwise_min(x, 1u);
                        if (F.wave + 8 * ti < ntiles) __hip_atomic_fetch_add(hist + r32 * HSTR + ((k >> shift) & 255u), inc, __ATOMIC_RELAXED, __HIP_MEMORY_SCOPE_WORKGROUP);
                        if ((e & 7) == 7) __builtin_amdgcn_sched_barrier(0); }
                __syncthreads();
#pragma unroll
                for (int qq = 0; qq < 4; ++qq) { const int q = F.wave * 4 + qq; const int need = (pass == 0) ? 256 : (int)qst[2 * q + 1]; const unsigned pfx = (pass == 0) ? 0u : qst[2 * q];
                    const int c0 = (int)hist[q * HSTR + 4 * lane], c1 = (int)hist[q * HSTR + 4 * lane + 1], c2 = (int)hist[q * HSTR + 4 * lane + 2], c3 = (int)hist[q * HSTR + 4 * lane + 3];
                    const int c = c0 + c1 + c2 + c3; int S = c;
#pragma unroll
                    for (int off = 1; off < 64; off <<= 1) { const int v = __shfl_down(S, off); if (lane + off < 64) S += v; }
                    const unsigned long long bal = __ballot(S >= need); const int L = __popcll(bal) - 1;
                    if (lane == L) { int cum = S - c, d;
                        if (cum + c3 >= need) d = 3; else { cum += c3; if (cum + c2 >= need) d = 2; else { cum += c2; if (cum + c1 >= need) d = 1; else { cum += c1; d = 0; } } }
                        qstn[2 * q] = (pfx << 8) | (unsigned)(4 * L + d); qstn[2 * q + 1] = (unsigned)(need - cum); } }
                __syncthreads();
            }
            const unsigned thr = ((LAS unsigned*)(F.lds + 40960))[2 * r32];
#pragma unroll
            for (int ti = 0; ti < 4; ++ti) { const int kt = F.wave + 8 * ti;
                if (kt < ntiles) { unsigned w = 0u;
#pragma unroll
                    for (int e = 0; e < 32; ++e) { w |= (keys[ti][e] >= thr) ? (1u << e) : 0u; if ((e & 7) == 7) __builtin_amdgcn_sched_barrier(0); }
                    mbase[kt * 64] = w; } }
          } }
#endif
#endif
        SEAM_L();
        }
        for (int rep = 0; rep < REP_ATT; ++rep) {
        {
            LAS float* scl = (LAS float*)(F.lds + F.wave * 16384); LAS unsigned* keyl = (LAS unsigned*)(F.lds + F.wave * 16384 + 8192);
#ifndef NO_DIFF
            { const f16* P = WSP(f16, WS_R1); f16* OA = WSP(f16, WS_OA); const float* tabs = WSP(float, WS_MISC + 32768); const float* subln = IN(I_SUBLN) + LL * 128;
              unsigned* qctr = (unsigned*)launder(args.ws) + CW_QUEUE + 512 * ((rep * 2 + LL) * 4 + 0);
              LAS float* tabl = (LAS float*)(F.lds + fa::TAB_OFF); LAS float* subl = (LAS float*)(F.lds + fa::SUB_OFF);
              { const int tid0 = TID;
                for (int i2 = tid0; i2 < 4 * TAB2H; i2 += 512) tabl[i2] = tabs[i2];
                if (tid0 < 128) subl[tid0] = subln[tid0] * ((LL == 0) ? 0.8f : 0.6444909f); }
              if (TID == 0) MISC[17] = 0u;
              for (int uk = 0;; ++uk) {
                const int ui = unit_pick(uk, 64, qctr, MISC);
                if (ui < 0) break;
                const int qb = 7 - ((ui & 63) >> 3), bh = 8 * (ui >> 6) + (ui & 7), b = bh >> 2, h = bh & 3; const int lane = LANE, tid = F.wave * 64 + lane;
                const int qpos0 = qb * 256 + F.wave * 32, ntiles = 4 * qb + 4; const size_t brow = (size_t)b * SEQ; const f16* Pg = P + (size_t)(b >> 1) * GAPP;
                fa::f32x16 o0[4];
                fa::attn_pass_pipe<64, 128, 0, 3>(F.lds, F.wave, lane, Pg + (brow + qpos0) * PP + C_AQ + h * 128, PP, Pg + brow * PP + C_AK + h * 128, PP, Pg + brow * PP + C_AV + h * 128, PP, ntiles, qpos0, tabl + h * TAB2H, 0u, 0, nullptr, o0);
                { LAS unsigned* st = (LAS unsigned*)(F.lds + fa::STASH_OFF + F.wave * 8192) + lane;
#pragma unroll
                  for (int blk = 0; blk < 4; ++blk)
#pragma unroll
                    for (int r = 0; r < 16; r += 2) st[(blk * 8 + (r >> 1)) * 64] = pk2h(o0[blk][r], o0[blk][r + 1]); }
                fa::attn_pass_pipe<64, 128, 0, 3>(F.lds, F.wave, LANE, Pg + (brow + qpos0) * PP + C_AQ + h * 128 + 64, PP, Pg + brow * PP + C_AK + h * 128 + 64, PP, Pg + brow * PP + C_AV + h * 128, PP, ntiles, qpos0, tabl + h * TAB2H, 0u, 0, nullptr, o0);
                const int lane2 = LANE, hi = lane2 >> 5; float ss = 0.f; const float lam = WSP(float, WS_MISC)[LL];
                { const LAS unsigned* st = (const LAS unsigned*)(F.lds + fa::STASH_OFF + F.wave * 8192) + lane2;
#pragma unroll
                  for (int blk = 0; blk < 4; ++blk)
#pragma unroll
                    for (int r = 0; r < 16; r += 2) { const f16x2 v = __builtin_bit_cast(f16x2, st[(blk * 8 + (r >> 1)) * 64]);
                        const float a0 = (float)v[0] - lam * o0[blk][r], a1 = (float)v[1] - lam * o0[blk][r + 1]; o0[blk][r] = a0; o0[blk][r + 1] = a1; ss += a0 * a0 + a1 * a1; } }
                ss += __shfl_xor(ss, 32);
                const float rstd = 1.f / sqrtf(ss * (1.f / 128.f) + EPS);
#pragma unroll
                for (int blk = 0; blk < 4; ++blk)
#pragma unroll
                    for (int r = 0; r < 16; ++r) o0[blk][r] *= rstd * subl[32 * blk + fa::crow(r, hi)];
                fa::store_o<128>(o0, OA + (brow + qpos0 + (lane2 & 31)) * 512 + h * 128, hi);
              } }
#endif
#ifndef NO_MOBA
#ifdef NAIVE_MOBA
            { const f16* P = WSP(f16, WS_R1); f16* OC = WSP(f16, WS_OC); const float* tabs = WSP(float, WS_MISC + 1024); const float* kmean = WSP(float, WS_MISC + 65536);
              for (int task = GW; task < NB * 4 * SEQ; task += F.NGW) {
                const int bh = task / SEQ, b = bh >> 2, h = bh & 3, t = (task % SEQ + 37 * bh) % SEQ; const size_t row = (size_t)b * SEQ + t; const int j = t >> 8;
                const f16* q = P + row * PP + C_CQ + h * 64; const float qd = (float)q[LANE];
                float gate[8];
#pragma unroll
                for (int n = 0; n < 8; ++n) gate[n] = (n < j) ? wave_sum(qd * kmean[((size_t)bh * 8 + n) * 64 + LANE]) : -INFINITY;
                unsigned selb = 1u << j;
#pragma unroll
                for (int pick = 0; pick < 3; ++pick) { float best = -INFINITY; int bi = -1;
#pragma unroll
                    for (int n = 0; n < 8; ++n) if (!((selb >> n) & 1u) && gate[n] > best) { best = gate[n]; bi = n; }
                    if (bi >= 0) selb |= 1u << bi; }
                unsigned sel = 0u;
#pragma unroll
                for (int jj = 0; jj < 32; ++jj) sel |= ((selb >> (jj >> 2)) & 1u) << jj;
                float o[1];
                naive_attn<64, 64>(scl, q, P + (size_t)b * SEQ * PP + C_CK + h * 64, PP, P + (size_t)b * SEQ * PP + C_CV + h * 64, PP, t, sel, tabs + (8 + h) * TABN, LANE, o);
                OC[row * 256 + h * 64 + LANE] = (f16)o[0];
              } }
#else
            { const f16* P = WSP(f16, WS_R1); f16* OC = WSP(f16, WS_OC); const float* tabs2 = WSP(float, WS_MISC + 32768); const float* kmean = WSP(float, WS_MISC + 65536);
              unsigned* qctr = (unsigned*)launder(args.ws) + CW_QUEUE + 512 * ((rep * 2 + LL) * 4 + 1);
              LAS float* tabl = (LAS float*)(F.lds + fa::TAB_OFF);
              __syncthreads();
              for (int i2 = TID; i2 < 4 * TAB2H; i2 += 512) tabl[i2] = tabs2[8 * TAB2H + i2];
              if (TID == 0) MISC[17] = 0u;
              for (int uk = 0;; ++uk) {
                const int ui = unit_pick(uk, 64, qctr, MISC);
                if (ui < 0) break;
                const int qb = 7 - ((ui & 63) >> 3), bh = 8 * (ui >> 6) + (ui & 7), b = bh >> 2, h = bh & 3; const int lane = LANE, tid = F.wave * 64 + lane, r32 = lane & 31, hi = lane >> 5;
                const int qpos0 = qb * 256 + F.wave * 32, ntiles = 4 * qb + 4; const size_t brow = (size_t)b * SEQ; const f16* Pg = P + (size_t)(b >> 1) * GAPP;
                const f16* Qw = Pg + (brow + qpos0) * PP + C_CQ + h * 64;
                unsigned selb = 0u;
                { f16x8 qv[4];
#pragma unroll
                  for (int d0 = 0; d0 < 4; ++d0) qv[d0] = *(const f16x8*)(Qw + (size_t)r32 * PP + d0 * 16 + hi * 8);
                  LAS float* kmL = (LAS float*)(F.lds + 98304);
                  kmL[tid] = kmean[(size_t)bh * 512 + tid];
                  __syncthreads();
                  float gate[8];
#pragma unroll
                  for (int n = 0; n < 8; ++n) { float g = 0.f;
#pragma unroll
                    for (int d0 = 0; d0 < 4; ++d0) { const f32x4 k0 = *(const LAS f32x4*)(kmL + n * 64 + 8 * hi + 16 * d0), k1 = *(const LAS f32x4*)(kmL + n * 64 + 8 * hi + 16 * d0 + 4);
                        g += ((float)qv[d0][0] * k0.x + (float)qv[d0][1] * k0.y) + ((float)qv[d0][2] * k0.z + (float)qv[d0][3] * k0.w) + ((float)qv[d0][4] * k1.x + (float)qv[d0][5] * k1.y) + ((float)qv[d0][6] * k1.z + (float)qv[d0][7] * k1.w); }
                    g += __shfl_xor(g, 32);
                    gate[n] = (n < qb) ? g : -INFINITY; }
#pragma unroll
                  for (int pick = 0; pick < 3; ++pick) { float best = -INFINITY; int bi = -1;
#pragma unroll
                    for (int n = 0; n < 8; ++n) if (!((selb >> n) & 1u) && gate[n] > best) { best = gate[n]; bi = n; }
                    if (bi >= 0) selb |= 1u << bi; } }
                fa::f32x16 o[2];
                fa::attn_pass_pipe<64, 64, 1, 4>(F.lds, F.wave, lane, Qw, PP, Pg + brow * PP + C_CK + h * 64, PP, Pg + brow * PP + C_CV + h * 64, PP, ntiles, qpos0, tabl + h * TAB2H, selb, qb, nullptr, o);
                fa::store_o<64>(o, OC + (brow + qpos0 + r32) * 256 + h * 64, hi);
              } }
#endif
#endif
#ifndef NO_DSA
#ifdef NAIVE_DSA
            { const f16* P = WSP(f16, WS_R1); f16* OB = WSP(f16, WS_OB); const f16* KVN = WSP(f16, WS_KVN); const float* tabs = WSP(float, WS_MISC + 1024);
              for (int task = GW; task < NB * SEQ; task += F.NGW) {
                const int b = task / SEQ, t = (task % SEQ + 37 * b) % SEQ; const size_t row = (size_t)b * SEQ + t; const int lane = LANE;
                unsigned sel = 0xffffffffu;
                if (t >= 256) {
                    const int nslots = (t >> 6) + 1; const f16* iq = P + row * PP + C_BIQ; const f16* iwp = P + row * PP + C_BIW;
#pragma unroll 1
                    for (int j = 0; j < nslots; ++j) { unsigned kk = 0u; const int k = 64 * j + lane;
                        if (k <= t) { const f16* ik = P + ((size_t)b * SEQ + k) * PP + C_BIK; f16x8 kv[4];
#pragma unroll
                            for (int c = 0; c < 4; ++c) kv[c] = *(const f16x8*)(ik + 8 * c);
                            float s = 0.f;
#pragma unroll 1
                            for (int hh = 0; hh < 8; ++hh) { float d = 0.f;
#pragma unroll
                                for (int c = 0; c < 4; ++c) { const f16x8 qv = *(const f16x8*)(iq + hh * 32 + 8 * c);
#pragma unroll
                                    for (int e = 0; e < 8; ++e) d += (float)qv[e] * (float)kv[c][e]; }
                                s += fmaxf(d, 0.f) * (float)iwp[hh]; }
                            kk = ordkey(s); }
                        keyl[k] = kk; }
                    unsigned thr = 0u;
#pragma unroll 1
                    for (int bit = 31; bit >= 0; --bit) { const unsigned cand = thr | (1u << bit); int c = 0;
#pragma unroll 1
                        for (int j = 0; j < nslots; ++j) c += (keyl[64 * j + lane] >= cand) ? 1 : 0;
                        if (wave_isum(c) >= 256) thr = cand; }
                    int cgt = 0;
#pragma unroll 1
                    for (int j = 0; j < nslots; ++j) cgt += (keyl[64 * j + lane] > thr) ? 1 : 0;
                    cgt = wave_isum(cgt);
                    const int need = 256 - cgt; int run = 0; sel = 0u;
#pragma unroll 1
                    for (int j = 0; j < nslots; ++j) { const unsigned kk = keyl[64 * j + lane]; const bool tie = kk == thr; const unsigned long long bal = __ballot(tie);
                        const int pre = run + __popcll(bal & ((1ull << lane) - 1ull));
                        if (kk > thr || (tie && pre < need)) sel |= 1u << j;
                        run += __popcll(bal); }
                }
#pragma unroll 1
                for (int h = 0; h < 4; ++h) { float o[2];
                    naive_attn<128, 128>(scl, P + row * PP + C_BQ + h * 128, KVN + (size_t)b * SEQ * 128, 128, KVN + (size_t)b * SEQ * 128, 128, t, sel, tabs + (4 + h) * TABN, LANE, o);
                    OB[row * 512 + h * 128 + LANE] = (f16)o[0]; OB[row * 512 + h * 128 + 64 + LANE] = (f16)o[1]; }
              } }
#else
            { const f16* P = WSP(f16, WS_R1); f16* OB = WSP(f16, WS_OB); const f16* KVN = WSP(f16, WS_KVN); const float* tabs2 = WSP(float, WS_MISC + 32768); const unsigned* MASK = WSP(unsigned, WS_MASK);
              unsigned* qctr = (unsigned*)launder(args.ws) + CW_QUEUE + 512 * ((rep * 2 + LL) * 4 + 2);
              LAS float* tabl = (LAS float*)(F.lds + fa::TAB_OFF);
              __syncthreads();
              for (int i2 = TID; i2 < 4 * TAB2H; i2 += 512) tabl[i2] = tabs2[4 * TAB2H + i2];
              if (TID == 0) MISC[17] = 0u;
              for (int uk = 0;; ++uk) {
                const int ui = unit_pick(uk, 64, qctr, MISC);
                if (ui < 0) break;
                const int qi = 31 - ((ui & 63) >> 1), b = 2 * (ui >> 6) + (ui & 1); const int lane = LANE, tid = F.wave * 64 + lane, r32 = lane & 31, hi = lane >> 5;
                const int head = F.wave & 3, qpos0 = 64 * qi + 32 * (F.wave >> 2), ntiles = qi + 1; const size_t brow = (size_t)b * SEQ; const f16* Pg = P + (size_t)(b >> 1) * GAPP;
                fa::f32x16 o[4];
                fa::attn_pass_dma<128, 128, 2, 4>(F.lds, F.wave, lane, Pg + (brow + qpos0) * PP + C_BQ + head * 128, PP, KVN + brow * 128, 128, KVN + brow * 128, 128, ntiles, qpos0, tabl + head * TAB2H, 0u, 0,
                                           MASK + ((size_t)(b * 64 + (qpos0 >> 5)) * 32) * 64, o);
                fa::store_o<128>(o, OB + (brow + qpos0 + r32) * 512 + head * 128, hi);
              } }
#endif
#endif
        }
        SEAM_L();
        }
        for (int rep = 0; rep < REP_G2; ++rep) {
#ifndef NO_G2
        { pg8::StaticOrder S; S.init(MTOK, DM, F.G, (int)blockIdx.x);
#pragma unroll 1
          for (int yi = 0; yi < 3; ++yi) { const int y = launder_i(yi), Ky = (y == 2) ? 256 : 512;
            pg8::Gemm g{WSP(f16, WS_OA + (size_t)y * 32 * MiB), WSP(f16, WS_WA + (size_t)y * 2 * MiB) + (size_t)LL * DM * Ky, MTOK, DM, Ky}; pg8::EpiF16<0> E{WSP(f16, WS_R1) + (size_t)y * YSTR, DM, GAPY};
            pg8::gemm_phase<pg8::EpiF16<0>, pg8::StaticOrder, true, true>(F.lds, g, S, E, F.wave); } }
#endif
        SEAM_L();
        }
#ifndef NO_G3
        { pg8::Gemm g{(const f16*)((const unsigned char*)xout + (size_t)64 * MiB), (const f16*)(launder(args.ws) + WS_WQG + (size_t)LL * GCOLS * 1024), MTOK, GCOLS, DM / 2}; pg8::TripleOrder S; S.init(MTOK, F.G, (int)blockIdx.x);
          pg8::EpiGateMerge<true> E{WSP(f16, WS_R1), WSP(f16, WS_R1) + 3 * YSTR};
          pg8::fill_tabs_q((const float*)launder(args.ws) + CW_RF, WSP(float, WS_CVEC) + (size_t)(LL * 3 + 1) * 16 * 4096, IN(I_GATEB) + LL * GCOLS, WSP(float, WS_SB) + (LL * 3 + 1) * 4096, S, TID);
          pg8::gemm_phase<pg8::EpiGateMerge<true>, pg8::TripleOrder, true, true, true>(F.lds, g, S, E, F.wave); }
#endif
        SEAM_L();
#ifndef NO_G4
        { pg8::Gemm g{WSP(f16, WS_R1) + 3 * YSTR, WSP(f16, WS_WO) + (size_t)LL * DM * DM, MTOK, DM, DM, (unsigned)(GAPY * 2)}; pg8::StaticOrder S; S.init(MTOK, DM, F.G, (int)blockIdx.x);
          pg8::EpiResidual E{(const f16*)xout, (f16*)xout, WSP(float, WS_MOD) + (size_t)LL * 16 * 6144 + 2 * DM, 6144, (f16*)nullptr, (const float*)nullptr, (const float*)nullptr, (float*)nullptr};
          pg8::gemm_phase<pg8::EpiResidual, pg8::StaticOrder, true, true>(F.lds, g, S, E, F.wave); }
#endif
        SEAM_L();
        for (int rep = 0; rep < REP_G5; ++rep) {
#ifndef NO_G5
        { const float* modl = WSP(float, WS_MOD) + (size_t)LL * 16 * 6144; const float* nw = IN(I_NMLP) + LL * DM; unsigned char* U8 = (unsigned char*)xout + (size_t)64 * MiB; float* rf = (float*)launder(args.ws) + CW_RF;
          for (int m0 = GWX * 16; m0 < MTOK; m0 += F.NGW * 16) { const int b = m0 / SEQ;
            norm_quant_rows16((const f16*)xout, nw, modl + (size_t)b * 6144 + 4 * DM, U8, rf, m0, LANE); } }
        SEAM_L();
        { pg8::Gemm g{(const f16*)((const unsigned char*)xout + (size_t)64 * MiB), (const f16*)(launder(args.ws) + WS_WQ1 + (size_t)LL * DFF * 1024), MTOK, DFF, DM / 2}; pg8::StaticOrder S; S.init(MTOK, DFF, F.G, (int)blockIdx.x);
          pg8::EpiNormF16<1, true, true> E{WSP(f16, WS_R1), DFF, 0};
          pg8::fill_tabs_q((const float*)launder(args.ws) + CW_RF, WSP(float, WS_CVEC) + (size_t)(LL * 3 + 2) * 16 * 4096, (const float*)nullptr, WSP(float, WS_SB) + (LL * 3 + 2) * 4096, S, TID);
          pg8::gemm_phase<pg8::EpiNormF16<1, true, true>, pg8::StaticOrder, true, true, true>(F.lds, g, S, E, F.wave); }
#endif
        SEAM_L();
        }
#ifndef NO_G6
        { pg8::Gemm g{WSP(f16, WS_R1), WSP(f16, WS_W2) + (size_t)LL * DM * DFF, MTOK, DM, DFF}; pg8::StaticOrder S; S.init(MTOK, DM, F.G, (int)blockIdx.x);
          const bool more_layers = LL + 1 < DEPTH;
          pg8::EpiResidual E{(const f16*)xout, more_layers ? (f16*)xout : WSP(f16, WS_U), WSP(float, WS_MOD) + (size_t)LL * 16 * 6144 + 5 * DM, 6144, (f16*)nullptr, (const float*)nullptr, (const float*)nullptr, (float*)nullptr};
          pg8::gemm_phase<pg8::EpiResidual, pg8::StaticOrder, true, true, false, true>(F.lds, g, S, E, F.wave); }
#endif
        if (LL + 1 < DEPTH) SEAM_L(); else xcd_barrier(bar, F.wave);
        if (LL + 1 < DEPTH) {
            const int ln = LL + 1; const float* modl = WSP(float, WS_MOD) + (size_t)ln * 16 * 6144; const float* nw = IN(I_NMIX) + ln * DM; unsigned char* U8 = (unsigned char*)xout + (size_t)64 * MiB; float* rf = (float*)launder(args.ws) + CW_RF;
            for (int m0 = GWX * 16; m0 < MTOK; m0 += F.NGW * 16) { const int b = m0 / SEQ;
                norm_quant_rows16((const f16*)xout, nw, modl + (size_t)b * 6144 + 1 * DM, U8, rf, m0, LANE); }
            SEAM_L(); }
    }
    { const float* nf = IN(I_NFINAL); const f16* xf = WSP(f16, WS_U);
      for (int m0 = GWX * 16; m0 < MTOK; m0 += F.NGW * 16) { const int lane = LANE;
        f32x4 gn[4];
#pragma unroll
        for (int j = 0; j < 4; ++j) gn[j] = ((const GAS f32x4*)nf)[lane + 64 * j];
        u32x2 nx[4];
#pragma unroll
        for (int j = 0; j < 4; ++j) nx[j] = ((const GAS u32x2*)(xf + (size_t)m0 * DM) + lane)[64 * j];
#pragma unroll 1
        for (int r = 0; r < 16; ++r) { const int m = m0 + r;
            f32x4 v[4]; float s = 0.f;
#pragma unroll
            for (int j = 0; j < 4; ++j) { const unsigned wx = nx[j].x, wy = nx[j].y; const f16x2 a = __builtin_bit_cast(f16x2, wx), b2 = __builtin_bit_cast(f16x2, wy);
                v[j] = (f32x4){(float)a[0], (float)a[1], (float)b2[0], (float)b2[1]}; s += (v[j].x * v[j].x + v[j].y * v[j].y) + (v[j].z * v[j].z + v[j].w * v[j].w); }
            if (r + 1 < 16) {
#pragma unroll
                for (int j = 0; j < 4; ++j) nx[j] = ((const GAS u32x2*)(xf + (size_t)(m + 1) * DM) + lane)[64 * j]; }
            const float rstd = 1.f / sqrtf(wave_sum(s) * (1.f / DM) + EPS);
            GAS f32x4* orow = (GAS f32x4*)(xout + (size_t)m * DM) + lane;
#pragma unroll
            for (int j = 0; j < 4; ++j) orow[64 * j] = v[j] * rstd * gn[j]; }
      } }
#undef IN
#undef WSP
#undef LANE
#undef LL
#undef GW
#undef TID
}

extern "C" void kernel_launch(void* const* d_in, const int* in_sizes, int n_in, void* d_out, int out_size, void* d_ws, size_t ws_size, hipStream_t stream) {
    static int grid = 0;
    if (grid == 0) {
        if (n_in != 20 || in_sizes[0] != MTOK * DM || out_size != MTOK * DM || ws_size < WS_END) { fprintf(stderr, "kernel_launch: shape/workspace mismatch (n_in %d, ws %zu); nothing launched\n", n_in, ws_size); grid = -1; return; }
        int dev = 0, cus = 0, per_cu = 0;
        if (hipGetDevice(&dev) != hipSuccess || hipDeviceGetAttribute(&cus, hipDeviceAttributeMultiprocessorCount, dev) != hipSuccess) { grid = -1; return; }
        if (hipFuncSetAttribute((const void*)mega_fwd, hipFuncAttributeMaxDynamicSharedMemorySize, LDS_BYTES) != hipSuccess) { fprintf(stderr, "kernel_launch: hipFuncSetAttribute failed\n"); grid = -1; return; }
        if (hipOccupancyMaxActiveBlocksPerMultiprocessor(&per_cu, (const void*)mega_fwd, NWAVES * 64, LDS_BYTES) != hipSuccess || per_cu < 1) { fprintf(stderr, "kernel_launch: occupancy query says %d blocks per CU\n", per_cu); }
        (void)hipGetLastError();
        grid = cus;
    }
    if (grid < 0) return;
    if (hipMemsetAsync((char*)d_ws + WS_CTL, 0, CTL_ZERO_BYTES, stream) != hipSuccess) return;
    Args a{};
    for (int i = 0; i < 20; ++i) a.in[i] = (const float*)d_in[i];
    a.out = (float*)d_out; a.ws = (unsigned char*)d_ws;
    hipLaunchKernelGGL(mega_fwd, dim3(grid), dim3(NWAVES * 64), LDS_BYTES, stream, a);
}
```

```cpp
#include <hip/hip_runtime.h>
#include <cstdio>
#include <cstdint>
#ifndef REP_N1
#define REP_N1 1
#endif
#ifndef REP_G1
#define REP_G1 1
#endif
#ifndef REP_SEL
#define REP_SEL 1
#endif
#ifndef REP_ATT
#define REP_ATT 1
#endif
#ifndef REP_G2
#define REP_G2 1
#endif
#ifndef REP_G5
#define REP_G5 1
#endif
#ifndef REP_P0
#define REP_P0 1
#endif
#ifndef REP_SCORE
#define REP_SCORE 1
#endif
#ifndef REP_RADIX
#define REP_RADIX 1
#endif
#ifndef REP_DIFF
#define REP_DIFF 1
#endif
#ifndef REP_MOBA
#define REP_MOBA 1
#endif
#ifndef REP_DSA
#define REP_DSA 1
#endif

#define LAS __attribute__((address_space(3)))
#define GAS __attribute__((address_space(1)))
typedef _Float16 f16;
typedef _Float16 f16x8 __attribute__((ext_vector_type(8)));
typedef _Float16 f16x4 __attribute__((ext_vector_type(4)));
typedef _Float16 f16x2 __attribute__((ext_vector_type(2)));
typedef float f32x4 __attribute__((ext_vector_type(4)));
typedef float f32x2 __attribute__((ext_vector_type(2)));
typedef unsigned u32x4 __attribute__((ext_vector_type(4)));
typedef unsigned u32x2 __attribute__((ext_vector_type(2)));

constexpr int NB = 16, SEQ = 2048, DM = 1024, MTOK = NB * SEQ, DEPTH = 2, DFF = 4096;
constexpr int IN_COLS = 6312, PCOLS = 3240, PP = 3328  , GCOLS = 3072;
constexpr int C_AQ = 0, C_AK = 512, C_AV = 1024, C_BQ = 1536, C_BKV = 2048, C_BIQ = 2176, C_BIK = 2432, C_BIW = 2464, C_CQ = 2472, C_CK = 2728, C_CV = 2984, C_G = 3240;
constexpr float EPS = 1e-6f, LOG2E = 1.4426950408889634f;
constexpr int TABN = 384;
constexpr int TAB2 = 320, TAB2H = 2 * TAB2;

__device__ __forceinline__ unsigned pk2h(float lo, float hi) { f32x2 v = {lo, hi}; f16x2 h = __builtin_convertvector(v, f16x2); return __builtin_bit_cast(unsigned, h); }

__device__ __forceinline__ int lane_id() { int l; asm volatile("v_mbcnt_lo_u32_b32 %0, -1, 0\n\tv_mbcnt_hi_u32_b32 %0, -1, %0" : "=v"(l)); return l; }

constexpr size_t SLAB_E = 16u * 1024u * 1024u;
constexpr size_t GAPP = SLAB_E - (size_t)4096 * 3328, GAPY = SLAB_E - (size_t)4096 * 1024, YSTR = (size_t)4096 * 1024;
namespace pg8 {
#define PG8_LAS __attribute__((address_space(3)))
#ifndef PG8_GRACE
#define PG8_GRACE 1
#endif
constexpr int BM = 256, BK = 64, HALF = 128, HTB = HALF * BK * 2, STAGE_BYTES = 8 * HTB, NXCD = 8, WGM = 8;
__host__ __device__ __forceinline__ int lds_byte(int r, int c) { const int st = (r >> 4) * 2 + (c >> 5), rr = r & 15, cc = c & 31, ob = rr * 64 + cc * 2; return st * 1024 + (ob ^ (((ob >> 9) & 1) << 5)); }
__host__ __device__ __forceinline__ void stage_rc(int b, int& R, int& C) { const int st = b / 1024, sb = b % 1024, swz = sb ^ (((sb >> 9) & 1) << 5); R = (st >> 1) * 16 + swz / 64; C = (st & 1) * 32 + (swz % 64) / 2; }
__host__ __device__ __forceinline__ int perm32(int rho) { const int n = rho >> 4, i = rho & 15; return 8 * (i >> 2) + 4 * n + (i & 3); }

struct Unit { int pm, pn, idx; };
struct Gemm { const f16* A; const f16* Bt; int M, N, K; unsigned gapA = 0u; };

struct StaticOrder {
    int nM, nN, nwg, G, c;
    __host__ __device__ void init(int M, int N, int G_, int c_) { nM = M / BM; nN = N / BM; nwg = nM * nN; G = G_; c = c_; }
    __host__ __device__ bool next(int i, Unit& u) const {
        const long L = (long)i * G + c; if (L >= nwg) return false;
        int wgid = (int)L; { const int q = nwg / NXCD, r = nwg % NXCD, xcd = wgid % NXCD, off = wgid / NXCD; wgid = (xcd < r ? xcd * (q + 1) : r * (q + 1) + (xcd - r) * q) + off; }
        const int nig = WGM * nN, gid = wgid / nig, fm = gid * WGM, gsz = (nM - fm) < WGM ? (nM - fm) : WGM;
        u.pm = fm + ((wgid % nig) % gsz); u.pn = (wgid % nig) / gsz; u.idx = i; return true;
    }
    __device__ __forceinline__ void a_ready(const Unit&) const {}
    __device__ __forceinline__ void done(const Unit&) const {}
};
struct TripleOrder {
    StaticOrder so;
    __host__ __device__ void init(int M, int G_, int c_) { so.init(M, 1024, G_, c_); }
    __host__ __device__ bool next(int i, Unit& u) const { if (!so.next(i / 3, u)) return false; u.pn += 4 * (i % 3); u.idx = i; return true; }
    __device__ __forceinline__ void a_ready(const Unit&) const {}
    __device__ __forceinline__ void done(const Unit&) const {}
};

typedef int i32x4 __attribute__((ext_vector_type(4)));
typedef u32x4 __attribute__((address_space(1))) g_u32x4;
typedef u32x2 __attribute__((address_space(1))) g_u32x2;
typedef f32x4 __attribute__((address_space(1))) g_f32x4;
typedef float __attribute__((address_space(1))) g_f32;
typedef f16x8 __attribute__((address_space(1))) g_f16x8;
__device__ __forceinline__ void gst16(void* p, const u32x4 w) { *(g_u32x4*)(p) = w; }
__device__ __forceinline__ void gst8(void* p, const u32x2 w) { *(g_u32x2*)(p) = w; }
template <int ACT  > struct EpiF16 {
    static constexpr bool PERM = true, AFTER_DRAIN = false; static constexpr int NSTORE = 16;
    f16* O; int ldc; size_t gap;
    __device__ __forceinline__ void operator()(const f32x4 (&acc)[2][2][4][2], const Unit& u, int wr, int wc, int fr, int fq) const {
        const int row0 = u.pm * BM + wr * 64 + fr; const int col0 = u.pn * BM + wc * 32 + 8 * fq;
#pragma unroll
        for (int ai = 0; ai < 2; ++ai)
#pragma unroll
            for (int m = 0; m < 4; ++m) { f16* rowp = O + (size_t)(row0 + ai * HALF + m * 16) * ldc + (size_t)((row0 + ai * HALF + m * 16) >> 12) * gap + col0;
#pragma unroll
                for (int bj = 0; bj < 2; ++bj) { f32x4 v0 = acc[ai][bj][m][0], v1 = acc[ai][bj][m][1];
                    if (ACT == 1) {
#pragma unroll
                        for (int e = 0; e < 4; ++e) { const float a = fmaxf(v0[e], 0.f), b = fmaxf(v1[e], 0.f); v0[e] = a * a; v1[e] = b * b; } }
                    u32x4 w; w.x = pk2h(v0[0], v0[1]); w.y = pk2h(v0[2], v0[3]); w.z = pk2h(v1[0], v1[1]); w.w = pk2h(v1[2], v1[3]);
                    gst16(rowp + bj * HALF, w); } }
    }
};
constexpr int RSTD_LDS = 131072, CV_LDS_ = 139264 + 1024, SB_LDS = CV_LDS_ + 8192;
__device__ __forceinline__ void row_rstd(const Unit& u, int wr, int fr, float (&rs)[2][4]) {
    const PG8_LAS float* rt = (const PG8_LAS float*)(uintptr_t)(RSTD_LDS + u.idx * 1024) + wr * 64 + fr;
#pragma unroll
    for (int ai = 0; ai < 2; ++ai)
#pragma unroll
        for (int m = 0; m < 4; ++m) rs[ai][m] = rt[ai * HALF + m * 16];
}
constexpr int CV_LDS = 139264 + 1024;
template <class Sched> __device__ __forceinline__ void fill_rstd(const float* SS, const float* cvec, const float* gb, const Sched& S, int tid) {
    for (int i = 0; i < 8; ++i) { Unit u; if (!S.next(i, u)) break;
        if (tid < 256) { const f32x4* sp = (const f32x4*)(SS + (size_t)(u.pm * BM + tid) * 16);
            const f32x4 a = sp[0], b = sp[1], c = sp[2], d = sp[3]; const f32x4 t = (a + b) + (c + d);
            ((PG8_LAS float*)(uintptr_t)(RSTD_LDS + i * 1024))[tid] = __builtin_amdgcn_rsqf(((t.x + t.y) + (t.z + t.w)) * (1.f / DM) + EPS); }
        else { const int c = tid - 256; float v = cvec[(size_t)((u.pm * BM) / SEQ) * 4096 + u.pn * BM + c]; if (gb) v += gb[u.pn * BM + c];
            ((PG8_LAS float*)(uintptr_t)(CV_LDS + i * 1024))[c] = v; } }
    __syncthreads();
}
template <class Sched> __device__ __forceinline__ void fill_tabs_q(const float* rowfac, const float* cvec, const float* gb, const float* sbv, const Sched& S, int tid) {
    const int c = tid & 255;
#pragma unroll 1
    for (int i0 = 0; i0 < 8; i0 += 4) {
        float va[4], vb[4], vc[4]; bool ok[4];
#pragma unroll
        for (int j = 0; j < 4; ++j) { Unit u; ok[j] = S.next(i0 + j, u); if (!ok[j]) { u.pm = 0; u.pn = 0; }
            if (tid < 256) va[j] = *(const g_f32*)(rowfac + u.pm * BM + c);
            else { va[j] = *(const g_f32*)(cvec + (size_t)((u.pm * BM) / SEQ) * 4096 + u.pn * BM + c); vb[j] = *(const g_f32*)(sbv + u.pn * BM + c); vc[j] = gb ? *(const g_f32*)(gb + u.pn * BM + c) : 0.f; } }
#pragma unroll
        for (int j = 0; j < 4; ++j) if (ok[j]) {
            if (tid < 256) ((PG8_LAS float*)(uintptr_t)(RSTD_LDS + (i0 + j) * 1024))[c] = va[j];
            else { ((PG8_LAS float*)(uintptr_t)(CV_LDS + (i0 + j) * 1024))[c] = va[j] + vc[j]; ((PG8_LAS float*)(uintptr_t)(SB_LDS + (i0 + j) * 1024))[c] = vb[j]; } } }
    __syncthreads();
}
template <int ACT  , bool I8 = false, bool TILED = false> struct EpiNormF16 {
    static constexpr bool PERM = true, AFTER_DRAIN = false; static constexpr int NSTORE = 16;
    f16* O; int ldc; size_t gap;
    __device__ __forceinline__ void operator()(const f32x4 (&acc)[2][2][4][2], const Unit& u, int wr, int wc, int fr, int fq) const {
        const int row0 = u.pm * BM + wr * 64 + fr; const int col0 = u.pn * BM + wc * 32 + 8 * fq; const int b = (u.pm * BM) / SEQ;
        float rs[2][4]; row_rstd(u, wr, fr, rs);
        f32x4 cv[2][2];
#pragma unroll
        for (int bj = 0; bj < 2; ++bj)
#pragma unroll
            for (int n = 0; n < 2; ++n) cv[bj][n] = *(const PG8_LAS f32x4*)(uintptr_t)(CV_LDS + u.idx * 1024 + (wc * 32 + 8 * fq + bj * HALF + 4 * n) * 4);
        f32x4 sv[2][2];
        if constexpr (I8) {
#pragma unroll
            for (int bj = 0; bj < 2; ++bj)
#pragma unroll
                for (int n = 0; n < 2; ++n) sv[bj][n] = *(const PG8_LAS f32x4*)(uintptr_t)(SB_LDS + u.idx * 1024 + (wc * 32 + 8 * fq + bj * HALF + 4 * n) * 4); }
#pragma unroll
        for (int ai = 0; ai < 2; ++ai)
#pragma unroll
            for (int m = 0; m < 4; ++m) { const int rowg = row0 + ai * HALF + m * 16;
                f16* rowp = TILED ? O + ((size_t)((rowg >> 8) * (ldc >> 6) + (col0 >> 6)) * 256 + (rowg & 255)) * 64 + (col0 & 63) : O + (size_t)rowg * ldc + (size_t)(rowg >> 12) * gap + col0; const float r = rs[ai][m];
#pragma unroll
                for (int bj = 0; bj < 2; ++bj) { f32x4 a0 = acc[ai][bj][m][0], a1 = acc[ai][bj][m][1];
                    if constexpr (I8) { const i32x4 i0 = __builtin_bit_cast(i32x4, a0), i1 = __builtin_bit_cast(i32x4, a1);
                        a0 = (f32x4){(float)i0.x, (float)i0.y, (float)i0.z, (float)i0.w} * sv[bj][0]; a1 = (f32x4){(float)i1.x, (float)i1.y, (float)i1.z, (float)i1.w} * sv[bj][1]; }
                    f32x4 v0 = a0 * r + cv[bj][0], v1 = a1 * r + cv[bj][1];
                    if (ACT == 1) {
#pragma unroll
                        for (int e = 0; e < 4; ++e) { const float a = fmaxf(v0[e], 0.f), b2 = fmaxf(v1[e], 0.f); v0[e] = a * a; v1[e] = b2 * b2; } }
                    u32x4 w; w.x = pk2h(v0[0], v0[1]); w.y = pk2h(v0[2], v0[3]); w.z = pk2h(v1[0], v1[1]); w.w = pk2h(v1[2], v1[3]);
                    gst16(rowp + (TILED ? bj * 2 * 256 * 64 : bj * HALF), w); } }
    }
};
template <bool I8> struct EpiGateMerge {
    static constexpr bool PERM = true, AFTER_DRAIN = false; static constexpr int NSTORE = 28;
    f16* Y; f16* merged;
    __device__ __forceinline__ void operator()(const f32x4 (&acc)[2][2][4][2], const Unit& u, int wr, int wc, int fr, int fq) const {
        const int br = u.pn >> 2, pc = u.pn & 3;
        const int row0 = u.pm * BM + wr * 64 + fr; const int col0 = pc * BM + wc * 32 + 8 * fq;
        if (br == 2) { __builtin_amdgcn_fence(__ATOMIC_ACQUIRE, "agent"); }
        const int b = (u.pm * BM) / SEQ; float rs[2][4]; row_rstd(u, wr, fr, rs);
        f32x4 bv[2][2];
#pragma unroll
        for (int bj = 0; bj < 2; ++bj)
#pragma unroll
            for (int n = 0; n < 2; ++n) bv[bj][n] = *(const PG8_LAS f32x4*)(uintptr_t)(CV_LDS + u.idx * 1024 + (wc * 32 + 8 * fq + bj * HALF + 4 * n) * 4);
        f32x4 sv[2][2];
        if constexpr (I8) {
#pragma unroll
            for (int bj = 0; bj < 2; ++bj)
#pragma unroll
                for (int n = 0; n < 2; ++n) sv[bj][n] = *(const PG8_LAS f32x4*)(uintptr_t)(SB_LDS + u.idx * 1024 + (wc * 32 + 8 * fq + bj * HALF + 4 * n) * 4); }
        f16* Yb = Y + (size_t)br * YSTR;
#pragma unroll
        for (int ai = 0; ai < 2; ++ai) {
            const int rowa = row0 + ai * HALF; const size_t offa = (size_t)rowa * 1024 + (size_t)(rowa >> 12) * GAPY + col0;
#pragma unroll
            for (int mp = 0; mp < 2; ++mp) {
            f16x8 yv[4][2];
#pragma unroll
            for (int m = 2 * mp; m < 2 * mp + 2; ++m)
#pragma unroll
                for (int bj = 0; bj < 2; ++bj) yv[m][bj] = *(const g_f16x8*)(Yb + offa + (size_t)m * 16 * 1024 + bj * HALF);
#pragma unroll
            for (int m = 2 * mp; m < 2 * mp + 2; ++m) { const size_t off = offa + (size_t)m * 16 * 1024;
                f16x8 za[2], zb[2];
                if (br == 2) {
#pragma unroll
                    for (int bj = 0; bj < 2; ++bj) { za[bj] = *(const g_f16x8*)(Y + off + bj * HALF); zb[bj] = *(const g_f16x8*)(Y + YSTR + off + bj * HALF); } }
#pragma unroll
                for (int bj = 0; bj < 2; ++bj) {
                    f32x4 a0 = acc[ai][bj][m][0], a1 = acc[ai][bj][m][1];
                    if constexpr (I8) { const i32x4 i0 = __builtin_bit_cast(i32x4, a0), i1 = __builtin_bit_cast(i32x4, a1);
                        a0 = (f32x4){(float)i0.x, (float)i0.y, (float)i0.z, (float)i0.w} * sv[bj][0]; a1 = (f32x4){(float)i1.x, (float)i1.y, (float)i1.z, (float)i1.w} * sv[bj][1]; }
                    const f32x4 g0 = a0 * rs[ai][m] + bv[bj][0], g1 = a1 * rs[ai][m] + bv[bj][1];
                    const f16x8 yy = yv[m][bj];
                    float z[8];
#pragma unroll
                    for (int e = 0; e < 4; ++e) { z[e] = (float)yy[e] * __builtin_amdgcn_rcpf(1.f + __builtin_amdgcn_exp2f(-LOG2E * g0[e])); z[4 + e] = (float)yy[4 + e] * __builtin_amdgcn_rcpf(1.f + __builtin_amdgcn_exp2f(-LOG2E * g1[e])); }
                    if (br == 2) {
#pragma unroll
                        for (int e = 0; e < 8; ++e) z[e] += (float)za[bj][e] + (float)zb[bj][e]; }
                    u32x4 w; w.x = pk2h(z[0], z[1]); w.y = pk2h(z[2], z[3]); w.z = pk2h(z[4], z[5]); w.w = pk2h(z[6], z[7]);
                    f16* dst = (br == 2) ? merged : Yb;
                    gst16(dst + off + bj * HALF, w); } } } }
    }
};
struct EpiResidual {
    static constexpr bool PERM = true, AFTER_DRAIN = false; static constexpr int NSTORE = 32;
    const f16* xin16; f16* out; const float* gate; int gpitch; f16* U; const float* nw; const float* nsc; float* SS;
    __device__ __forceinline__ void operator()(const f32x4 (&acc)[2][2][4][2], const Unit& u, int wr, int wc, int fr, int fq) const {
        const int col0 = u.pn * BM + wc * 32 + 8 * fq; const int b = (u.pm * BM) / SEQ;
        f32x4 gv[2][2], Gv[2][2];
#pragma unroll
        for (int bj = 0; bj < 2; ++bj)
#pragma unroll
            for (int n = 0; n < 2; ++n) gv[bj][n] = *(const g_f32x4*)(gate + (size_t)b * gpitch + col0 + bj * HALF + 4 * n);
        if (U) {
#pragma unroll
            for (int bj = 0; bj < 2; ++bj)
#pragma unroll
                for (int n = 0; n < 2; ++n) Gv[bj][n] = *(const g_f32x4*)(nw + col0 + bj * HALF + 4 * n) * (*(const g_f32x4*)(nsc + (size_t)b * gpitch + col0 + bj * HALF + 4 * n) + 1.f); }
#pragma unroll
        for (int ai = 0; ai < 2; ++ai) {
            const int rowa = u.pm * BM + ai * HALF + wr * 64 + fr;
            f16x8 xh[4][2];
#pragma unroll
            for (int m = 0; m < 4; ++m)
#pragma unroll
                for (int bj = 0; bj < 2; ++bj) xh[m][bj] = *(const g_f16x8*)(xin16 + (size_t)(rowa + m * 16) * DM + col0 + bj * HALF);
#pragma unroll
            for (int m = 0; m < 4; ++m) { const int row = rowa + m * 16; const size_t off = (size_t)row * DM + col0; float ss = 0.f;
#pragma unroll
                for (int bj = 0; bj < 2; ++bj) { const f16x8 h = xh[m][bj];
                    const f32x4 xn0 = (f32x4){(float)h[0], (float)h[1], (float)h[2], (float)h[3]} + gv[bj][0] * acc[ai][bj][m][0];
                    const f32x4 xn1 = (f32x4){(float)h[4], (float)h[5], (float)h[6], (float)h[7]} + gv[bj][1] * acc[ai][bj][m][1];
                    { u32x4 w; w.x = pk2h(xn0.x, xn0.y); w.y = pk2h(xn0.z, xn0.w); w.z = pk2h(xn1.x, xn1.y); w.w = pk2h(xn1.z, xn1.w); gst16(out + off + bj * HALF, w); }
                    if (U) { ss += ((xn0.x * xn0.x + xn0.y * xn0.y) + (xn0.z * xn0.z + xn0.w * xn0.w)) + ((xn1.x * xn1.x + xn1.y * xn1.y) + (xn1.z * xn1.z + xn1.w * xn1.w));
                        const f32x4 y0 = xn0 * Gv[bj][0], y1 = xn1 * Gv[bj][1];
                        u32x4 w; w.x = pk2h(y0.x, y0.y); w.y = pk2h(y0.z, y0.w); w.z = pk2h(y1.x, y1.y); w.w = pk2h(y1.z, y1.w); gst16(U + off + bj * HALF, w); } }
                if (U) { ss += __shfl_xor(ss, 16); ss += __shfl_xor(ss, 32); if (fq == 0) *(g_f32*)(SS + (size_t)row * 16 + u.pn * 4 + wc) = ss; } } }
    }
};

__device__ __forceinline__ unsigned sgpr_opaque(unsigned x) { asm volatile("" : "+s"(x)); return x; }
template <class Epi, class Sched, bool ALIGN_EPI = false, bool SP2 = false, bool I8 = false, bool ATILED = false>
__device__ __forceinline__ void gemm_phase(PG8_LAS unsigned char* lds, const Gemm g, const Sched& S, const Epi& E, const int wid) {
    const int lane = lane_id(), tid = wid * 64 + lane, wr = wid >> 2, wc = wid & 3, fr = lane & 15, fq = lane >> 4;
    const int K = g.K, nt = K / BK;
    unsigned voffA[2], voffB[2];
#pragma unroll
    for (int i = 0; i < 2; ++i) { int R, C; stage_rc(tid * 16 + i * 8192, R, C); const int Rb = Epi::PERM ? ((R & ~31) + perm32(R & 31)) : R;
        voffA[i] = (unsigned)(R * (ATILED ? BK : K) + C) * 2u; voffB[i] = (unsigned)(Rb * K + C) * 2u; }
    const unsigned kstep = (unsigned)(BK * 2);
    const unsigned hstep = (unsigned)HALF * K * 2;
    const unsigned tstep = 2 * hstep;
    const unsigned kstepA = ATILED ? (unsigned)(BM * BK * 2) : kstep, hstepA = ATILED ? (unsigned)(HALF * BK * 2) : hstep, tstepA = ATILED ? (unsigned)nt * (unsigned)(BM * BK * 2) : tstep;
    const __amdgpu_buffer_rsrc_t rsA = __builtin_amdgcn_make_buffer_rsrc((void*)g.A, 0, 0x7fffffff, 0x00020000), rsB = __builtin_amdgcn_make_buffer_rsrc((void*)g.Bt, 0, 0x7fffffff, 0x00020000);
    const unsigned ldsw = (unsigned)wid * 1024u;
    const int aoff = lds_byte(wr * 64 + fr, fq * 8), boff = lds_byte(wc * 32 + fr, fq * 8);
#define PG8_SA(b, h) (((b) * 2 + (h)) * HTB)
#define PG8_SB(b, h) ((4 + (b) * 2 + (h)) * HTB)
#define PG8_STAGE(bufoff, RS, soff, voff) do { _Pragma("unroll") for (int _i = 0; _i < 2; ++_i) \
        __builtin_amdgcn_raw_ptr_buffer_load_lds(RS, (PG8_LAS void*)(lds + (bufoff) + sgpr_opaque(ldsw) + _i * 8192), 16, (int)(voff)[_i], (int)(soff), 0, 0); } while (0)
#define PG8_LDA(dst, b, h) do { _Pragma("unroll") for (int m = 0; m < 4; ++m) _Pragma("unroll") for (int k = 0; k < 2; ++k) dst[m][k] = *(const PG8_LAS f16x8*)(lds + PG8_SA(b, h) + aoff + m * 2048 + k * 1024); } while (0)
#define PG8_LDB(dst, b, h) do { _Pragma("unroll") for (int n = 0; n < 2; ++n) _Pragma("unroll") for (int k = 0; k < 2; ++k) dst[n][k] = *(const PG8_LAS f16x8*)(lds + PG8_SB(b, h) + boff + n * 2048 + k * 1024); } while (0)
#define PG8_MMA(ai, bj, At, Bt) do { __builtin_amdgcn_s_setprio(1); _Pragma("unroll") for (int m = 0; m < 4; ++m) _Pragma("unroll") for (int n = 0; n < 2; ++n) _Pragma("unroll") for (int k = 0; k < 2; ++k) \
        { if constexpr (I8) acc[ai][bj][m][n] = __builtin_bit_cast(f32x4, __builtin_amdgcn_mfma_i32_16x16x64_i8(__builtin_bit_cast(i32x4, Bt[n][k]), __builtin_bit_cast(i32x4, At[m][k]), __builtin_bit_cast(i32x4, acc[ai][bj][m][n]), 0, 0, 0)); \
          else acc[ai][bj][m][n] = __builtin_amdgcn_mfma_f32_16x16x32_f16(Bt[n][k], At[m][k], acc[ai][bj][m][n], 0, 0, 0); } __builtin_amdgcn_s_setprio(0); } while (0)
#define PG8_WAIT_V(n) asm volatile("s_waitcnt vmcnt(" #n ")" ::: "memory")
#define PG8_WAIT_L(n) asm volatile("s_waitcnt lgkmcnt(" #n ")" ::: "memory")
#define PG8_BAR __builtin_amdgcn_s_barrier()
#define PG8_SCHED __builtin_amdgcn_sched_barrier(0)
    Unit cur, nxt; int ui = 0;
    if (!S.next(0, cur)) return;
    f32x4 acc[2][2][4][2];
#pragma unroll
    for (int a = 0; a < 2; ++a)
#pragma unroll
        for (int b = 0; b < 2; ++b)
#pragma unroll
            for (int m = 0; m < 4; ++m)
#pragma unroll
                for (int n = 0; n < 2; ++n) acc[a][b][m][n] = (f32x4){0.f, 0.f, 0.f, 0.f};
    f16x8 At[4][2], B0[2][2], B1[2][2];
    unsigned cA = (unsigned)cur.pm * tstepA + (unsigned)(cur.pm >> 4) * g.gapA, cB = (unsigned)cur.pn * tstep;
    S.a_ready(cur);
    if constexpr (SP2) {
        PG8_STAGE(PG8_SB(0, 0), rsB, cB, voffB); PG8_STAGE(PG8_SB(0, 1), rsB, cB + hstep, voffB); PG8_STAGE(PG8_SA(0, 0), rsA, cA, voffA); PG8_STAGE(PG8_SA(0, 1), rsA, cA + hstepA, voffA);
        if (wr == 1) PG8_BAR;
        PG8_WAIT_V(2); PG8_BAR;
        PG8_STAGE(PG8_SB(1, 0), rsB, cB + kstep, voffB); PG8_STAGE(PG8_SA(1, 0), rsA, cA + kstepA, voffA); PG8_STAGE(PG8_SB(1, 1), rsB, cB + hstep + kstep, voffB);
        PG8_WAIT_V(6); PG8_BAR;
    } else {
        PG8_STAGE(PG8_SB(0, 0), rsB, cB, voffB); PG8_STAGE(PG8_SA(0, 0), rsA, cA, voffA); PG8_STAGE(PG8_SB(0, 1), rsB, cB + hstep, voffB); PG8_STAGE(PG8_SA(0, 1), rsA, cA + hstepA, voffA);
        if (wr == 1) PG8_BAR;
        PG8_WAIT_V(4); PG8_BAR;
        PG8_STAGE(PG8_SB(1, 0), rsB, cB + kstep, voffB); PG8_STAGE(PG8_SA(1, 0), rsA, cA + kstepA, voffA); PG8_STAGE(PG8_SB(1, 1), rsB, cB + hstep + kstep, voffB);
        PG8_WAIT_V(6); PG8_BAR;
    }
    for (;;) {
        const bool has_next = S.next(ui + 1, nxt);
        const unsigned nA = has_next ? (unsigned)nxt.pm * tstepA + (unsigned)(nxt.pm >> 4) * g.gapA : cA, nB = has_next ? (unsigned)nxt.pn * tstep : cB;
        for (int t = 0; t < nt; t += 2) {
            const bool last = (t == nt - 2);
            const unsigned a1 = cA + (unsigned)(t + 1) * kstepA;
            const unsigned a2 = last ? nA : cA + (unsigned)(t + 2) * kstepA, b2 = last ? nB : cB + (unsigned)(t + 2) * kstep;
            const unsigned a3 = a2 + kstepA, b3 = b2 + kstep;
            if (last && has_next) S.a_ready(nxt);
            if constexpr (SP2) {
            const int grace = __builtin_amdgcn_readfirstlane((PG8_GRACE && Epi::NSTORE > 0 && t == 0 && ui > 0) ? 1 : 0);
#define PG8_WAIT_VG do { if constexpr (PG8_GRACE && Epi::NSTORE > 0) asm volatile("s_cmp_lg_u32 %0, 0\n\ts_cbranch_scc1 .Lgr%=\n\ts_waitcnt vmcnt(8)\n.Lgr%=:\n\ts_waitcnt vmcnt(%1)" :: "s"(grace), "n"(8 + Epi::NSTORE) : "memory", "scc"); \
                         else PG8_WAIT_V(8); } while (0)
            PG8_LDB(B0, 0, 0); PG8_LDB(B1, 0, 1); PG8_SCHED; PG8_LDA(At, 0, 0); PG8_STAGE(PG8_SA(1, 1), rsA, a1 + hstepA, voffA);
            PG8_WAIT_VG; PG8_WAIT_L(0); PG8_BAR; PG8_MMA(0, 0, At, B0); PG8_MMA(0, 1, At, B1); PG8_BAR; PG8_SCHED;
            PG8_LDA(At, 0, 1); PG8_STAGE(PG8_SB(0, 0), rsB, b2, voffB); PG8_STAGE(PG8_SB(0, 1), rsB, b2 + hstep, voffB); PG8_STAGE(PG8_SA(0, 0), rsA, a2, voffA);
            PG8_WAIT_VG; PG8_WAIT_L(0); PG8_BAR; PG8_MMA(1, 0, At, B0); PG8_MMA(1, 1, At, B1); PG8_BAR; PG8_SCHED;
            PG8_LDB(B0, 1, 0); PG8_LDB(B1, 1, 1); PG8_SCHED; PG8_LDA(At, 1, 0); PG8_STAGE(PG8_SA(0, 1), rsA, a2 + hstepA, voffA);
            PG8_WAIT_VG; PG8_WAIT_L(0); PG8_BAR; PG8_MMA(0, 0, At, B0); PG8_MMA(0, 1, At, B1); PG8_BAR; PG8_SCHED;
            PG8_LDA(At, 1, 1); PG8_STAGE(PG8_SB(1, 0), rsB, b3, voffB); PG8_STAGE(PG8_SB(1, 1), rsB, b3 + hstep, voffB); PG8_STAGE(PG8_SA(1, 0), rsA, a3, voffA);
            PG8_WAIT_VG; PG8_WAIT_L(0); PG8_BAR; PG8_MMA(1, 0, At, B0); PG8_MMA(1, 1, At, B1); PG8_BAR; PG8_SCHED;
#undef PG8_WAIT_VG
            } else {
            PG8_LDB(B0, 0, 0); PG8_SCHED; PG8_LDA(At, 0, 0); PG8_STAGE(PG8_SA(1, 1), rsA, a1 + hstepA, voffA);
            PG8_WAIT_L(8); PG8_BAR; PG8_WAIT_L(0); PG8_MMA(0, 0, At, B0); PG8_BAR; PG8_SCHED;
            PG8_LDB(B1, 0, 1); PG8_STAGE(PG8_SB(0, 0), rsB, b2, voffB);
            PG8_BAR; PG8_WAIT_L(0); PG8_MMA(0, 1, At, B1); PG8_BAR;
            PG8_LDA(At, 0, 1); PG8_STAGE(PG8_SA(0, 0), rsA, a2, voffA);
            PG8_BAR; PG8_WAIT_L(0); PG8_MMA(1, 0, At, B0); PG8_BAR; PG8_SCHED;
            PG8_STAGE(PG8_SB(0, 1), rsB, b2 + hstep, voffB);
            PG8_WAIT_V(6); PG8_BAR; PG8_MMA(1, 1, At, B1); PG8_BAR;
            PG8_LDB(B0, 1, 0); PG8_SCHED; PG8_LDA(At, 1, 0); PG8_STAGE(PG8_SA(0, 1), rsA, a2 + hstepA, voffA);
            PG8_WAIT_L(8); PG8_BAR; PG8_WAIT_L(0); PG8_MMA(0, 0, At, B0); PG8_BAR; PG8_SCHED;
            PG8_LDB(B1, 1, 1); PG8_STAGE(PG8_SB(1, 0), rsB, b3, voffB);
            PG8_BAR; PG8_WAIT_L(0); PG8_MMA(0, 1, At, B1); PG8_BAR;
            PG8_LDA(At, 1, 1); PG8_STAGE(PG8_SA(1, 0), rsA, a3, voffA);
            PG8_BAR; PG8_WAIT_L(0); PG8_MMA(1, 0, At, B0); PG8_BAR; PG8_SCHED;
            PG8_STAGE(PG8_SB(1, 1), rsB, b3 + hstep, voffB);
            PG8_WAIT_V(6); PG8_BAR; PG8_MMA(1, 1, At, B1); PG8_BAR;
            }
        }
        if constexpr (ALIGN_EPI) { if (wr == 0) PG8_BAR; }
        if constexpr (!Epi::AFTER_DRAIN) { E(acc, cur, wr, wc, fr, fq); S.done(cur); }
        if (!has_next) break;
#pragma unroll
        for (int a = 0; a < 2; ++a)
#pragma unroll
            for (int b = 0; b < 2; ++b)
#pragma unroll
                for (int m = 0; m < 4; ++m)
#pragma unroll
                    for (int n = 0; n < 2; ++n) acc[a][b][m][n] = (f32x4){0.f, 0.f, 0.f, 0.f};
        cur = nxt; cA = nA; cB = nB; ++ui;
        if constexpr (ALIGN_EPI) { if (wr == 1) PG8_BAR; }
    }
    PG8_WAIT_V(0);
    if constexpr (!ALIGN_EPI) { if (wr == 0) PG8_BAR; }
    PG8_BAR;
#undef PG8_SA
#undef PG8_SB
#undef PG8_STAGE
#undef PG8_LDA
#undef PG8_LDB
#undef PG8_MMA
#undef PG8_WAIT_V
#undef PG8_WAIT_L
#undef PG8_BAR
#undef PG8_SCHED
}
}

constexpr size_t MiB = 1u << 20;
constexpr size_t WS_CTL = 0, CTL_ZERO_BYTES = 1 * MiB;
constexpr size_t WS_MOD = 1 * MiB;
constexpr size_t WS_MISC = 2 * MiB;
constexpr size_t WS_WIN = 4 * MiB;
constexpr size_t WS_WG = 18 * MiB;
constexpr size_t WS_WA = 30 * MiB;
constexpr size_t WS_WBC = 32 * MiB;
constexpr size_t WS_WC = 34 * MiB;
constexpr size_t WS_WO = 36 * MiB;
constexpr size_t WS_W1 = 40 * MiB;
constexpr size_t WS_W2 = 56 * MiB;
constexpr size_t WS_U = 72 * MiB;
constexpr size_t WS_KVN = 136 * MiB;
constexpr size_t WS_MASK = 144 * MiB;
constexpr size_t WS_OA = 152 * MiB;
constexpr size_t WS_OB = 184 * MiB;
constexpr size_t WS_OC = 216 * MiB;
constexpr size_t WS_R1 = 232 * MiB;
constexpr size_t WS_SS = 488 * MiB;
constexpr size_t WS_WQG = 490 * MiB;
constexpr size_t WS_WQIN = 496 * MiB;
constexpr size_t WS_WQ1 = 503 * MiB;
constexpr size_t WS_END = 511 * MiB;
constexpr size_t WS_CVEC = WS_MISC + 256 * 1024;
constexpr size_t WS_SB = WS_MISC + 1792 * 1024;
constexpr int CW_CMAX = 65536  , CW_RF = 131072  ;
constexpr int CW_TMO = 0, CW_BAR = 4096, CW_QUEUE = 16384;

constexpr int NWAVES = 8;
constexpr int RING_BYTES = 131072, LDSCTL_OFF = 139264, MISC_OFF = LDSCTL_OFF + 320, LDS_BYTES = LDSCTL_OFF + 24576;

#define RLX_AGENT __ATOMIC_RELAXED, __HIP_MEMORY_SCOPE_AGENT
#define LDS_WAIT() asm volatile("s_waitcnt lgkmcnt(0)" ::: "memory")

#define XB_TMO      128
#define XB_XCNT(j)  (256  + 64 * (j))
#define XB_XSUB(j)  (1280 + 64 * (j))
#define XB_XGEN(j)  (2304 + 64 * (j))
#define XB_TOP      3328
#define XB_TOPGEN   3392
#define XCD_BAR_WORDS 3456
#define XB_SPIN_CAP (1u << 22)
__device__ __forceinline__ unsigned xb_ld(unsigned* p)              { return __hip_atomic_load(p, __ATOMIC_RELAXED, __HIP_MEMORY_SCOPE_AGENT); }
__device__ __forceinline__ unsigned xb_add(unsigned* p, unsigned v) { return __hip_atomic_fetch_add(p, v, __ATOMIC_RELAXED, __HIP_MEMORY_SCOPE_AGENT); }
__device__ __forceinline__ unsigned xb_xcc_id() { return (unsigned)__builtin_amdgcn_s_getreg((3 << 11) | 20) & 0xFu; }
__device__ __forceinline__ int xq_take(unsigned* ctr, const int per, volatile LAS unsigned* misc) {
    __syncthreads();
    if (threadIdx.x == 0) { unsigned q = misc[17]; int res = -1; const unsigned x = xb_xcc_id();
        while (q < 8u) { const unsigned xx = (x + q) & 7u; const unsigned v = __hip_atomic_fetch_add(ctr + 64 * xx, 1u, __ATOMIC_RELAXED, __HIP_MEMORY_SCOPE_AGENT);
            if (v < (unsigned)per) { res = (int)(xx * (unsigned)per + v); break; } ++q; }
        misc[17] = q; misc[16] = (unsigned)res; }
    __syncthreads();
    return __builtin_amdgcn_readfirstlane((int)misc[16]);
}
__device__ __forceinline__ int unit_pick(const int k, const int per, unsigned* ctr, volatile LAS unsigned* misc) {
    if (gridDim.x == 256u) { __syncthreads(); if (k >= (per >> 5)) return -1;
        const int s_ = (int)(blockIdx.x >> 3), x_ = (int)(blockIdx.x & 7u); return x_ * per + (k >> 1) * 64 + ((k & 1) ? 63 - s_ : s_); }
    return xq_take(ctr, per, misc);
}
#define XB_SPIN(cond, bar) do { unsigned _sp = 0; while (cond) { __builtin_amdgcn_s_sleep(1); \
    if ((++_sp & 255u) == 0u) { if (xb_ld(&(bar)[XB_TMO])) break; if (_sp > XB_SPIN_CAP) { atomicAdd(&(bar)[XB_TMO], 1u); break; } } } } while (0)
struct XcdBarrier { unsigned* bar; unsigned x; volatile LAS unsigned* st; };
__device__ __forceinline__ XcdBarrier xcd_barrier_post(unsigned* bar, volatile LAS unsigned* st, int wave) {
    XcdBarrier b; b.bar = bar; b.x = xb_xcc_id(); b.st = st;
    if (wave == 0 && lane_id() == 0) (void)xb_add(&bar[XB_XCNT(b.x)], 1u);
    return b;
}
__device__ __forceinline__ void xcd_barrier_complete(unsigned* bar, unsigned x, unsigned& nloc, unsigned& nx) {
    const unsigned G = gridDim.x * gridDim.y * gridDim.z;
    unsigned sum, cnt, mine, sp = 0u;
    for (;;) {
        sum = 0u; cnt = 0u; mine = 0u;
#pragma unroll
        for (unsigned j = 0; j < 16; ++j) { const unsigned c = xb_ld(&bar[XB_XCNT(j)]); sum += c; cnt += (c > 0u) ? 1u : 0u; mine = (j == x) ? c : mine; }
        if (sum == G) break;
        __builtin_amdgcn_s_sleep(1);
        if ((++sp & 255u) == 0u) { if (xb_ld(&bar[XB_TMO])) break; if (sp > XB_SPIN_CAP) { atomicAdd(&bar[XB_TMO], 1u); break; } }
    }
    nloc = mine > 0u ? mine : 1u; nx = cnt > 0u ? cnt : 1u;
}
__device__ __forceinline__ void xcd_barrier(const XcdBarrier& b, int wave) {
    asm volatile("s_waitcnt vmcnt(0)" ::: "memory");
    __syncthreads();
    if (wave == 0 && lane_id() == 0) {
        unsigned* bar = b.bar; asm volatile("" : "+s"(bar)); unsigned bx = b.x; asm volatile("" : "+s"(bx));
        __builtin_amdgcn_s_waitcnt(0);
        unsigned nloc = b.st[0], nx = b.st[1];
        if (nloc == 0u) { xcd_barrier_complete(bar, bx, nloc, nx); b.st[0] = nloc; b.st[1] = nx; }
        const unsigned old = xb_add(&bar[XB_XSUB(bx)], 1u);
        const unsigned gen = old / nloc;
        if (old + 1u == (gen + 1u) * nloc) {
            __builtin_amdgcn_fence(__ATOMIC_RELEASE, "agent");
            asm volatile("s_waitcnt vmcnt(0)" ::: "memory");
            const unsigned og = xb_add(&bar[XB_TOP], 1u);
            const unsigned tg = og / nx;
            __builtin_amdgcn_fence(__ATOMIC_ACQUIRE, "agent");
            if (og + 1u == (tg + 1u) * nx) xb_add(&bar[XB_TOPGEN], 1u);
            else XB_SPIN(xb_ld(&bar[XB_TOPGEN]) == tg, bar);
            xb_add(&bar[XB_XGEN(bx)], 1u);
            asm volatile("s_waitcnt vmcnt(0)" ::: "memory");
        } else {
            __builtin_amdgcn_fence(__ATOMIC_ACQUIRE, "agent");
            XB_SPIN(xb_ld(&bar[XB_XGEN(bx)]) == gen, bar);
            asm volatile("s_waitcnt vmcnt(0)" ::: "memory");
        }
    }
    __syncthreads();
}

constexpr int CW_LB = 200000;
__device__ __forceinline__ void xcd_local_barrier(unsigned* lb, const XcdBarrier& b, int wave) {
    asm volatile("s_waitcnt vmcnt(0)" ::: "memory");
    __syncthreads();
    if (wave == 0 && lane_id() == 0) {
        unsigned* lbp = lb; asm volatile("" : "+s"(lbp));
        const unsigned x = blockIdx.x & 7u; unsigned* cnt = lbp + 64u * x; unsigned* gen = lbp + 64u * (8u + x);
        __builtin_amdgcn_s_waitcnt(0);
        const unsigned g = b.st[3];
        const unsigned old = xb_add(cnt, 1u);
        __builtin_amdgcn_fence(__ATOMIC_ACQUIRE, "agent");
        if (old + 1u == (g + 1u) * 32u) xb_add(gen, 1u);
        else XB_SPIN(xb_ld(gen) == g, b.bar);
        b.st[3] = g + 1u;
        asm volatile("s_waitcnt vmcnt(0)" ::: "memory");
    }
    __syncthreads();
}
#define DPP_F(v, ctrl) __builtin_bit_cast(float, __builtin_amdgcn_update_dpp(0, __builtin_bit_cast(int, (v)), (ctrl), 0xf, 0xf, false))
__device__ __forceinline__ float row16_sum(float v) { v += DPP_F(v, 0xB1); v += DPP_F(v, 0x4E); v += DPP_F(v, 0x141); v += DPP_F(v, 0x140); return v; }
__device__ __forceinline__ float row16_max(float v) { v = fmaxf(v, DPP_F(v, 0xB1)); v = fmaxf(v, DPP_F(v, 0x4E)); v = fmaxf(v, DPP_F(v, 0x141)); v = fmaxf(v, DPP_F(v, 0x140)); return v; }
__device__ __forceinline__ float wave_sum(float v) {
    v = row16_sum(v); const int b = __builtin_bit_cast(int, v);
    const float r0 = __builtin_bit_cast(float, __builtin_amdgcn_readlane(b, 0)), r1 = __builtin_bit_cast(float, __builtin_amdgcn_readlane(b, 16)), r2 = __builtin_bit_cast(float, __builtin_amdgcn_readlane(b, 32)), r3 = __builtin_bit_cast(float, __builtin_amdgcn_readlane(b, 48));
    return (r0 + r1) + (r2 + r3);
}
__device__ __forceinline__ float wave_max(float v) {
    v = row16_max(v); const int b = __builtin_bit_cast(int, v);
    const float r0 = __builtin_bit_cast(float, __builtin_amdgcn_readlane(b, 0)), r1 = __builtin_bit_cast(float, __builtin_amdgcn_readlane(b, 16)), r2 = __builtin_bit_cast(float, __builtin_amdgcn_readlane(b, 32)), r3 = __builtin_bit_cast(float, __builtin_amdgcn_readlane(b, 48));
    return fmaxf(fmaxf(r0, r1), fmaxf(r2, r3));
}
__device__ __forceinline__ int wave_isum(int v) {
#pragma unroll
    for (int o = 1; o < 64; o <<= 1) v += __shfl_xor(v, o);
    return v;
}

__device__ __forceinline__ int t5_bucket(int n) {
    if (n < 16) return n;
    if (n >= 113) return 31;
    const int first[16] = {16, 19, 21, 24, 27, 31, 35, 40, 46, 52, 59, 67, 77, 87, 99, 113};
    int b = 16;
#pragma unroll
    for (int i = 1; i < 16; ++i) b += (n >= first[i]) ? 1 : 0;
    return b;
}

struct Frame {
    LAS unsigned char* lds;
    int wave, gw, NGW, G;
};

template <class ScaleFn>
__device__ __forceinline__ void transpose_item(const float* W, int ldw, int col0, int nvalid, int K, f16* WT, int nblk, LAS float* scr, int item, int lane, ScaleFn sf, unsigned* cmax = nullptr) {
    const int kb = item / nblk, nb = item % nblk, k0 = 64 * kb, n0 = 32 * nb;
    const int nn = n0 + (lane & 31);
    const bool ok = nn < nvalid;
    const float sc = sf(nn);
    float wv[32];
#pragma unroll
    for (int i = 0; i < 32; ++i) { const int kk = 2 * i + (lane >> 5); wv[i] = ok ? *(const GAS float*)(W + (size_t)(k0 + kk) * ldw + col0 + nn) : 0.f; }
#pragma unroll
    for (int i = 0; i < 32; ++i) { const int kk = 2 * i + (lane >> 5); scr[kk * 33 + (lane & 31)] = wv[i] * sc; }
    if (cmax) { float mx = 0.f;
#pragma unroll
        for (int i = 0; i < 32; ++i) mx = fmaxf(mx, __builtin_fabsf(wv[i] * sc));
        mx = fmaxf(mx, __shfl_xor(mx, 32));
        if (lane < 32) __hip_atomic_fetch_max(cmax + nn, __float_as_uint(mx), __ATOMIC_RELAXED, __HIP_MEMORY_SCOPE_AGENT); }
    LDS_WAIT(); asm volatile("" ::: "memory");
    const int c = lane & 7;
#pragma unroll
    for (int j = 0; j < 4; ++j) { const int n = (lane >> 3) + 8 * j; const LAS float* s = scr + (8 * c) * 33 + n;
        u32x4 o; o.x = pk2h(s[0 * 33], s[1 * 33]); o.y = pk2h(s[2 * 33], s[3 * 33]); o.z = pk2h(s[4 * 33], s[5 * 33]); o.w = pk2h(s[6 * 33], s[7 * 33]);
        *(u32x4*)(WT + (size_t)(n0 + n) * K + k0 + 8 * c) = o; }
    LDS_WAIT(); asm volatile("" ::: "memory");
}
struct TItem { const float* W; int ldw, col0, nvalid, K; f16* WT; int nblk; unsigned* cmax; int item; bool scale_in, tiled; };
struct ScaleOne { __device__ __forceinline__ float operator()(int) const { return 1.f; } };
struct ScaleIn {
    __device__ __forceinline__ float operator()(int n) const {
        if (n < 512) return 0.125f * LOG2E;
        if (n >= C_BQ && n < C_BKV) return 0.08838834764831845f * LOG2E;
        if (n >= C_CQ && n < C_CK) return 0.125f * LOG2E;
        return 1.f; }
};
__device__ __forceinline__ void titem_load(const TItem& d, int lane, float (&wv)[32], float& sc) {
    const int kb = d.item / d.nblk, nb = d.item % d.nblk, k0 = 64 * kb, nn = 32 * nb + (lane & 31);
    const bool ok = nn < d.nvalid;
    sc = d.scale_in ? ScaleIn()(nn) : 1.f;
#pragma unroll
    for (int i = 0; i < 32; ++i) { const int kk = 2 * i + (lane >> 5); wv[i] = ok ? *(const GAS float*)(d.W + (size_t)(k0 + kk) * d.ldw + d.col0 + nn) : 0.f; }
}
__device__ __forceinline__ void titem_store(const TItem& d, int lane, const float (&wv)[32], const float sc, LAS float* scr) {
    const int kb = d.item / d.nblk, nb = d.item % d.nblk, k0 = 64 * kb, n0 = 32 * nb, nn = n0 + (lane & 31);
#pragma unroll
    for (int i = 0; i < 32; ++i) { const int kk = 2 * i + (lane >> 5); scr[kk * 33 + (lane & 31)] = wv[i] * sc; }
    if (d.cmax) { float mx = 0.f;
#pragma unroll
        for (int i = 0; i < 32; ++i) mx = fmaxf(mx, __builtin_fabsf(wv[i] * sc));
        mx = fmaxf(mx, __shfl_xor(mx, 32));
        if (lane < 32) __hip_atomic_fetch_max(d.cmax + nn, __float_as_uint(mx), __ATOMIC_RELAXED, __HIP_MEMORY_SCOPE_AGENT); }
    LDS_WAIT(); asm volatile("" ::: "memory");
    const int c = lane & 7;
#pragma unroll
    for (int j = 0; j < 4; ++j) { const int n = (lane >> 3) + 8 * j; const LAS float* sp = scr + (8 * c) * 33 + n;
        u32x4 o; o.x = pk2h(sp[0 * 33], sp[1 * 33]); o.y = pk2h(sp[2 * 33], sp[3 * 33]); o.z = pk2h(sp[4 * 33], sp[5 * 33]); o.w = pk2h(sp[6 * 33], sp[7 * 33]);
        if (d.tiled) *(u32x4*)(d.WT + ((size_t)(((n0 + n) >> 8) * (d.K >> 6) + kb) * 256 + ((n0 + n) & 255)) * 64 + 8 * c) = o;
        else *(u32x4*)(d.WT + (size_t)(n0 + n) * d.K + k0 + 8 * c) = o; }
    LDS_WAIT(); asm volatile("" ::: "memory");
}

__device__ __forceinline__ void norm_row_pre(const float* xrow, const float* g, const float* scale, f16* orow, f16* x16row, float* ssrow, int lane) {
    const f32x4* xr = (const f32x4*)xrow + lane;
    f32x4 v[4]; float s = 0.f;
#pragma unroll
    for (int j = 0; j < 4; ++j) { v[j] = xr[64 * j]; s += (v[j].x * v[j].x + v[j].y * v[j].y) + (v[j].z * v[j].z + v[j].w * v[j].w); }
    s = wave_sum(s);
#pragma unroll
    for (int j = 0; j < 4; ++j) {
        const f32x4 gv = ((const f32x4*)g)[lane + 64 * j], sc = ((const f32x4*)scale)[lane + 64 * j];
        const f32x4 y = v[j] * gv * (sc + 1.f);
        u32x2 w; w.x = pk2h(y.x, y.y); w.y = pk2h(y.z, y.w);
        ((u32x2*)orow)[lane + 64 * j] = w;
        u32x2 wx; wx.x = pk2h(v[j].x, v[j].y); wx.y = pk2h(v[j].z, v[j].w);
        ((u32x2*)x16row)[lane + 64 * j] = wx; }
    if (lane < 4) ((f32x4*)ssrow)[lane] = (f32x4){lane == 0 ? s : 0.f, 0.f, 0.f, 0.f};
}

__device__ __forceinline__ void nq_gain(const float* g, const float* scale, int lane, float (&gl)[16]) {
#pragma unroll
    for (int c = 0; c < 2; ++c)
#pragma unroll
        for (int h = 0; h < 2; ++h) { const f32x4 gv = *(const GAS f32x4*)(g + 512 * c + 8 * lane + 4 * h), sc = *(const GAS f32x4*)(scale + 512 * c + 8 * lane + 4 * h);
#pragma unroll
            for (int e = 0; e < 4; ++e) gl[8 * c + 4 * h + e] = gv[e] * (sc[e] + 1.f); }
}
__device__ __forceinline__ void nq_finish(const float (&y)[16], float ss, float am, unsigned char* qrow, float* rowfac, int lane) {
    ss = wave_sum(ss); am = wave_max(am);
    const float inv = am > 0.f ? 127.f / am : 0.f;
#pragma unroll
    for (int c = 0; c < 2; ++c) { u32x2 pk; pk.x = 0u; pk.y = 0u;
#pragma unroll
        for (int e = 0; e < 4; ++e) { pk.x |= ((unsigned)(int)__builtin_rintf(y[8 * c + e] * inv) & 255u) << (8 * e); pk.y |= ((unsigned)(int)__builtin_rintf(y[8 * c + 4 + e] * inv) & 255u) << (8 * e); }
        *(GAS u32x2*)(qrow + 512 * c + 8 * lane) = pk; }
    if (lane == 0) *rowfac = am * (1.f / 127.f) * __builtin_amdgcn_rsqf(ss * (1.f / DM) + EPS);
}
__device__ __forceinline__ void norm_quant_rows16(const f16* x16, const float* g, const float* scale, unsigned char* q8, float* rowfac, int m0, int lane) {
    float gl[16]; nq_gain(g, scale, lane, gl);
    u32x4 nx[2];
#pragma unroll
    for (int c = 0; c < 2; ++c) nx[c] = *(const GAS u32x4*)(x16 + (size_t)m0 * DM + 512 * c + 8 * lane);
#pragma unroll 1
    for (int r = 0; r < 16; ++r) { const int m = m0 + r;
        const f16x8 xa = __builtin_bit_cast(f16x8, nx[0]), xb = __builtin_bit_cast(f16x8, nx[1]);
        if (r + 1 < 16) {
#pragma unroll
            for (int c = 0; c < 2; ++c) nx[c] = *(const GAS u32x4*)(x16 + (size_t)(m + 1) * DM + 512 * c + 8 * lane); }
        float y[16]; float ss = 0.f, am = 0.f;
#pragma unroll
        for (int e = 0; e < 8; ++e) { const float x0 = (float)xa[e], x1 = (float)xb[e]; ss += x0 * x0 + x1 * x1; y[e] = x0 * gl[e]; y[8 + e] = x1 * gl[8 + e]; am = fmaxf(am, fmaxf(__builtin_fabsf(y[e]), __builtin_fabsf(y[8 + e]))); }
        nq_finish(y, ss, am, q8 + (size_t)m * DM, rowfac + m, lane); }
}
__device__ __forceinline__ void norm_quant_rows16_0(const float* x, const float* g, const float* scale, f16* x16, unsigned char* q8, float* rowfac, int m0, int lane) {
    float gl[16]; nq_gain(g, scale, lane, gl);
    f32x4 nx[4];
#pragma unroll
    for (int c = 0; c < 2; ++c)
#pragma unroll
        for (int h = 0; h < 2; ++h) nx[2 * c + h] = *(const GAS f32x4*)(x + (size_t)m0 * DM + 512 * c + 8 * lane + 4 * h);
#pragma unroll 1
    for (int r = 0; r < 16; ++r) { const int m = m0 + r;
        f32x4 xa[4];
#pragma unroll
        for (int i = 0; i < 4; ++i) xa[i] = nx[i];
        if (r + 1 < 16) {
#pragma unroll
            for (int c = 0; c < 2; ++c)
#pragma unroll
                for (int h = 0; h < 2; ++h) nx[2 * c + h] = *(const GAS f32x4*)(x + (size_t)(m + 1) * DM + 512 * c + 8 * lane + 4 * h); }
        float y[16]; float ss = 0.f, am = 0.f;
#pragma unroll
        for (int c = 0; c < 2; ++c) { u32x4 w; w.x = pk2h(xa[2 * c].x, xa[2 * c].y); w.y = pk2h(xa[2 * c].z, xa[2 * c].w); w.z = pk2h(xa[2 * c + 1].x, xa[2 * c + 1].y); w.w = pk2h(xa[2 * c + 1].z, xa[2 * c + 1].w);
            *(GAS u32x4*)(x16 + (size_t)m * DM + 512 * c + 8 * lane) = w;
#pragma unroll
            for (int h = 0; h < 2; ++h)
#pragma unroll
                for (int e = 0; e < 4; ++e) { const float xx = xa[2 * c + h][e]; ss += xx * xx; const float v = xx * gl[8 * c + 4 * h + e]; y[8 * c + 4 * h + e] = v; am = fmaxf(am, __builtin_fabsf(v)); } }
        nq_finish(y, ss, am, q8 + (size_t)m * DM, rowfac + m, lane); }
}

template <int DQK, int DV>
__device__ __forceinline__ void naive_attn(LAS float* scl  , const f16* q, const f16* Kb, int kpitch, const f16* Vb, int vpitch, int t, unsigned sel, const float* tab, int lane, float (&o)[DV / 64]) {
    const int nslots = (t >> 6) + 1;
    float mx = -INFINITY;
#pragma unroll 1
    for (int j = 0; j < nslots; ++j) {
        float s = -INFINITY; const int k = 64 * j + lane;
        if (k <= t && ((sel >> j) & 1u)) {
            const f16* kr = Kb + (size_t)k * kpitch; float a = 0.f;
#pragma unroll 4
            for (int c = 0; c < DQK / 8; ++c) { const f16x8 kv = *(const f16x8*)(kr + 8 * c); const f16x8 qv = *(const f16x8*)(q + 8 * c);
#pragma unroll
                for (int e = 0; e < 8; ++e) a += (float)kv[e] * (float)qv[e]; }
            const int dist = t - k; s = a + tab[(dist < 128 ? dist : 128) + 255];
        }
        scl[k] = s; mx = fmaxf(mx, s);
    }
    mx = wave_max(mx);
    float l = 0.f;
#pragma unroll 1
    for (int j = 0; j < nslots; ++j) { const float p = __builtin_amdgcn_exp2f(scl[64 * j + lane] - mx); scl[64 * j + lane] = p; l += p; }
    l = wave_sum(l);
    const float inv = 1.f / l;
#pragma unroll
    for (int i = 0; i < DV / 64; ++i) o[i] = 0.f;
    LDS_WAIT(); asm volatile("" ::: "memory");
#pragma unroll 1
    for (int k = 0; k < 64 * nslots; k += 4) {
        const f32x4 p = *(const LAS f32x4*)(scl + k);
        if (p.x != 0.f || p.y != 0.f || p.z != 0.f || p.w != 0.f) { const f16* vr = Vb + (size_t)k * vpitch;
            float v[4][DV / 64];
#pragma unroll
            for (int r = 0; r < 4; ++r)
#pragma unroll
                for (int i = 0; i < DV / 64; ++i) v[r][i] = (float)vr[(size_t)r * vpitch + lane + 64 * i];
#pragma unroll
            for (int i = 0; i < DV / 64; ++i) o[i] += (p.x * v[0][i] + p.y * v[1][i]) + (p.z * v[2][i] + p.w * v[3][i]); }
    }
#pragma unroll
    for (int i = 0; i < DV / 64; ++i) o[i] *= inv;
    LDS_WAIT(); asm volatile("" ::: "memory");
}

__device__ __forceinline__ unsigned char* launder(unsigned char* p) { asm volatile("" : "+s"(p)); return p; }
__device__ __forceinline__ int launder_i(int v) { asm volatile("" : "+s"(v)); return v; }
constexpr int PTAB_OFF = LDSCTL_OFF + 512;
__device__ __forceinline__ const float* inptr(LAS unsigned char* lds, int i) {
    unsigned saddr = (unsigned)(uintptr_t)(lds + PTAB_OFF) + 8u * (unsigned)i, addr;
    asm volatile("v_mov_b32 %0, %1" : "=v"(addr) : "s"(saddr));
    const unsigned long long v = *(volatile LAS unsigned long long*)(uintptr_t)addr;
    const unsigned lo = __builtin_amdgcn_readfirstlane((unsigned)v), hi = __builtin_amdgcn_readfirstlane((unsigned)(v >> 32));
    return (const float*)(((unsigned long long)hi << 32) | lo);
}
__device__ __forceinline__ unsigned ordkey(float f) { const unsigned u = __float_as_uint(f); return u ^ ((unsigned)((int)u >> 31) | 0x80000000u); }

namespace fa {
typedef float f32x16 __attribute__((ext_vector_type(16)));
typedef short v4i16_t __attribute__((ext_vector_type(4)));
__device__ __forceinline__ int crow(int r, int hi) { return (r & 3) + 8 * (r >> 2) + 4 * hi; }
constexpr int TAB_OFF = 139264 + 1024;
constexpr int SUB_OFF = TAB_OFF + 10240;
constexpr int STASH_OFF = 73728;
template <int DQK, int DV, bool KVSAME> struct Lay {
    static constexpr int RSK = DQK * 2 + 16, RSV = DV * 2 + 64;
    static constexpr int KBUF = 64 * RSK, VBUF = 64 * RSV;
    static constexpr int VOFF0 = 2 * KBUF, END = 2 * KBUF + 2 * VBUF;
    static constexpr int NKC = DQK / 64, NVC = KVSAME ? 0 : DV / 64;
    static_assert(END <= 77824, "attention LDS map");
};
__device__ __forceinline__ f16x8 pack8(const f32x16& p, int b) {
    u32x4 w; w.x = pk2h(p[b + 0], p[b + 1]); w.y = pk2h(p[b + 2], p[b + 3]); w.z = pk2h(p[b + 4], p[b + 5]); w.w = pk2h(p[b + 6], p[b + 7]);
    return __builtin_bit_cast(f16x8, w);
}
__device__ __forceinline__ float psum8(const f16x8& p, float acc) {
    typedef _Float16 h2_t __attribute__((ext_vector_type(2)));
    const u32x4 w = __builtin_bit_cast(u32x4, p); const unsigned w0 = w.x, w1 = w.y, w2 = w.z, w3 = w.w; const h2_t one = {(_Float16)1.f, (_Float16)1.f};
    acc = __builtin_amdgcn_fdot2(__builtin_bit_cast(h2_t, w0), one, acc, false); acc = __builtin_amdgcn_fdot2(__builtin_bit_cast(h2_t, w1), one, acc, false);
    acc = __builtin_amdgcn_fdot2(__builtin_bit_cast(h2_t, w2), one, acc, false); acc = __builtin_amdgcn_fdot2(__builtin_bit_cast(h2_t, w3), one, acc, false);
    return acc;
}
__device__ __forceinline__ float max3f(float a, float b, float c) { float r; asm("v_max3_f32 %0, %1, %2, %3" : "=v"(r) : "v"(a), "v"(b), "v"(c)); return r; }
__device__ __forceinline__ float rowmax32(const f32x16& a, const f32x16& b) {
    float x = max3f(a[0], a[1], b[0]), y = max3f(a[2], a[3], b[1]); x = max3f(x, b[2], b[3]);
#pragma unroll
    for (int r = 4; r < 16; r += 4) { x = max3f(x, a[r], a[r + 1]); y = max3f(y, a[r + 2], a[r + 3]); x = max3f(x, b[r], b[r + 1]); y = max3f(y, b[r + 2], b[r + 3]); }
    return max3f(x, y, y);
}
__device__ __forceinline__ float half_max(float x) { const auto rr = __builtin_amdgcn_permlane32_swap(__float_as_uint(x), __float_as_uint(x), false, false); return fmaxf(__uint_as_float(rr[0]), __uint_as_float(rr[1])); }
__device__ __forceinline__ float half_sum(float x) { const auto rr = __builtin_amdgcn_permlane32_swap(__float_as_uint(x), __float_as_uint(x), false, false); return __uint_as_float(rr[0]) + __uint_as_float(rr[1]); }
template <int DQK, int DV, int MODE>
__device__ __forceinline__ void attn_pass(LAS unsigned char* lds, const int wave, const int lane,
        const f16* Qw, const int qpitch, const f16* Kg, const int kpitch, const f16* Vg, const int vpitch,
        const int ntiles, const int qpos0, const LAS float* tab, const unsigned selb, const int jblk, const unsigned* maskw,
        f32x16 (&o)[DV / 32]) {
    typedef Lay<DQK, DV, MODE == 2> L;
    constexpr int NB_ = DV / 32;
    const int r32 = lane & 31, hi = lane >> 5, tid = wave * 64 + lane;
    f16x8 qf[DQK / 16];
#pragma unroll
    for (int d0 = 0; d0 < DQK / 16; ++d0) qf[d0] = __builtin_bit_cast(f16x8, *(const GAS u32x4*)(Qw + (size_t)r32 * qpitch + d0 * 16 + hi * 8));
#pragma unroll
    for (int blk = 0; blk < NB_; ++blk)
#pragma unroll
        for (int r = 0; r < 16; ++r) o[blk][r] = 0.f;
    float m = -INFINITY, l = 0.f;
    u32x4 kreg[L::NKC], vreg[L::NVC > 0 ? L::NVC : 1];
    unsigned wnext = 0u;
#define FA_LOAD(kt_) do { \
        _Pragma("unroll") for (int c = 0; c < L::NKC; ++c) { const int id = tid + 512 * c, row = id / (DQK / 8), ch = id % (DQK / 8); \
            kreg[c] = *(const GAS u32x4*)(Kg + (size_t)((kt_) * 64 + row) * kpitch + ch * 8); } \
        _Pragma("unroll") for (int c = 0; c < L::NVC; ++c) { const int id = tid + 512 * c, row = id / (DV / 8), ch = id % (DV / 8); \
            vreg[c] = *(const GAS u32x4*)(Vg + (size_t)((kt_) * 64 + row) * vpitch + ch * 8); } \
        if (MODE == 2) wnext = *(const GAS unsigned*)(maskw + (kt_) * 64 + lane); } while (0)
#define FA_WRITE(buf_) do { \
        _Pragma("unroll") for (int c = 0; c < L::NKC; ++c) { const int id = tid + 512 * c, row = id / (DQK / 8), ch = id % (DQK / 8); \
            *(LAS u32x4*)(lds + (buf_) * L::KBUF + row * L::RSK + ch * 16) = kreg[c]; \
            if (MODE == 2) *(LAS u32x4*)(lds + L::VOFF0 + (buf_) * L::VBUF + row * L::RSV + ch * 16) = kreg[c]; } \
        _Pragma("unroll") for (int c = 0; c < L::NVC; ++c) { const int id = tid + 512 * c, row = id / (DV / 8), ch = id % (DV / 8); \
            *(LAS u32x4*)(lds + L::VOFF0 + (buf_) * L::VBUF + row * L::RSV + ch * 16) = vreg[c]; } } while (0)
#define FA_VREAD(dst_, ks_) do { _Pragma("unroll") for (int blk = 0; blk < NB_; ++blk) { \
        const v4i16_t a_ = __builtin_amdgcn_ds_read_tr16_b64_v4i16((LAS v4i16_t*)(vb + 16 * (ks_) * L::RSV + blk * 64)); \
        const v4i16_t b_ = __builtin_amdgcn_ds_read_tr16_b64_v4i16((LAS v4i16_t*)(vb + (16 * (ks_) + 8) * L::RSV + blk * 64)); \
        const f16x4 a4_ = __builtin_bit_cast(f16x4, a_), b4_ = __builtin_bit_cast(f16x4, b_); \
        dst_[blk] = (f16x8){a4_[0], a4_[1], a4_[2], a4_[3], b4_[0], b4_[1], b4_[2], b4_[3]}; } } while (0)
#define FA_PV(src_, ks_) do { _Pragma("unroll") for (int blk = 0; blk < NB_; ++blk) o[blk] = __builtin_amdgcn_mfma_f32_32x32x16_f16(src_[blk], pf[ks_], o[blk], 0, 0, 0); } while (0)
    FA_LOAD(0);
    unsigned wcur = wnext;
    FA_WRITE(0);
    __syncthreads();
#pragma unroll 1
    for (int kt = 0; kt < ntiles; ++kt) {
        const int cur = kt & 1;
        if (kt + 1 < ntiles) FA_LOAD(kt + 1);
        const int k0 = kt * 64;
        if (k0 <= qpos0 + 31) {
            f32x16 p0, p1;
            if (MODE == 2) {
                const unsigned nw = ~wcur;
#pragma unroll
                for (int r = 0; r < 16; ++r) { p0[r] = __uint_as_float((unsigned)__builtin_amdgcn_sbfe((int)nw, r, 1) & 0xff800000u); p1[r] = __uint_as_float((unsigned)__builtin_amdgcn_sbfe((int)nw, 16 + r, 1) & 0xff800000u); }
            } else if (MODE == 1) {
                const int n = kt >> 2; const float cv = (n == jblk || ((selb >> n) & 1u)) ? 0.f : -INFINITY;
#pragma unroll
                for (int r = 0; r < 16; ++r) { p0[r] = cv; p1[r] = cv; }
            } else {
#pragma unroll
                for (int r = 0; r < 16; ++r) { p0[r] = 0.f; p1[r] = 0.f; }
            }
            const LAS unsigned char* kb = lds + cur * L::KBUF + r32 * L::RSK + hi * 16;
            const LAS unsigned char* vb = lds + L::VOFF0 + cur * L::VBUF + (4 * hi + ((lane & 15) >> 2)) * L::RSV + (16 * ((lane >> 4) & 1) + 4 * (lane & 3)) * 2;
#pragma unroll
            for (int db = 0; db < DQK / 64; ++db) {
                f16x8 kf0[4], kf1[4];
#pragma unroll
                for (int d = 0; d < 4; ++d) { kf0[d] = *(const LAS f16x8*)(kb + (4 * db + d) * 32); kf1[d] = *(const LAS f16x8*)(kb + 32 * L::RSK + (4 * db + d) * 32); }
                __builtin_amdgcn_sched_barrier(0);
#pragma unroll
                for (int d = 0; d < 4; ++d) {
                    p0 = __builtin_amdgcn_mfma_f32_32x32x16_f16(kf0[d], qf[4 * db + d], p0, 0, 0, 0);
                    p1 = __builtin_amdgcn_mfma_f32_32x32x16_f16(kf1[d], qf[4 * db + d], p1, 0, 0, 0); }
                __builtin_amdgcn_sched_barrier(0);
            }
            f16x8 vfa[NB_], vfb[NB_];
            FA_VREAD(vfa, 0);
            __builtin_amdgcn_sched_barrier(0);
            if (qpos0 - (k0 + 63) < 128) {
                const int base = qpos0 + r32 - k0 - 4 * hi + 255;
#pragma unroll
                for (int r = 0; r < 16; ++r) { const int i0 = base - ((r & 3) + 8 * (r >> 2)), i1 = i0 - 32;
                    p0[r] += tab[i0 < 383 ? i0 : 383]; p1[r] += tab[i1 < 383 ? i1 : 383]; }
            }
            float rm = fmaxf(p0[0], p1[0]);
#pragma unroll
            for (int r = 1; r < 16; ++r) rm = fmaxf(rm, fmaxf(p0[r], p1[r]));
            rm = half_max(rm);
            const float mn = fmaxf(m, rm), mu = (mn == -INFINITY) ? 0.f : mn;
            if (__any(mn > m)) { const float al = __builtin_amdgcn_exp2f(m - mu); l *= al;
#pragma unroll
                for (int blk = 0; blk < NB_; ++blk)
#pragma unroll
                    for (int r = 0; r < 16; ++r) o[blk][r] *= al; }
            m = mn;
            float ls = 0.f;
#pragma unroll
            for (int r = 0; r < 16; ++r) { p0[r] = __builtin_amdgcn_exp2f(p0[r] - mu); p1[r] = __builtin_amdgcn_exp2f(p1[r] - mu); ls += p0[r] + p1[r]; }
            l += ls;
            f16x8 pf[4]; pf[0] = pack8(p0, 0); pf[1] = pack8(p0, 8); pf[2] = pack8(p1, 0); pf[3] = pack8(p1, 8);
            __builtin_amdgcn_sched_barrier(0);
            FA_VREAD(vfb, 1); FA_PV(vfa, 0); __builtin_amdgcn_sched_barrier(0);
            FA_VREAD(vfa, 2); FA_PV(vfb, 1); __builtin_amdgcn_sched_barrier(0);
            FA_VREAD(vfb, 3); FA_PV(vfa, 2); __builtin_amdgcn_sched_barrier(0);
            FA_PV(vfb, 3);
        }
        if (kt + 1 < ntiles) FA_WRITE(cur ^ 1);
        wcur = wnext;
        __syncthreads();
    }
#undef FA_LOAD
#undef FA_WRITE
#undef FA_VREAD
#undef FA_PV
    l = half_sum(l);
    const float inv = 1.f / l;
#pragma unroll
    for (int blk = 0; blk < NB_; ++blk)
#pragma unroll
        for (int r = 0; r < 16; ++r) o[blk][r] *= inv;
}
__device__ __forceinline__ int fsw8(int row) { return (row >> 1) & 7; }
__device__ __forceinline__ int fsw16(int row) { return ((row & 3) << 2) | ((row >> 2) & 3); }
__device__ __forceinline__ int fswv8(int row) { return ((row >> 1) & 1) << 2; }
template <int DQK, int DV, int MODE, int S> struct LayD {
    static constexpr int CPRK = DQK / 8, CPRV = DV / 8;
    static constexpr int KB = 64 * DQK * 2, VB = (MODE == 2) ? 0 : 64 * DV * 2, STG = KB + VB;
    static constexpr int PK = CPRK, PV = (MODE == 2) ? 0 : CPRV, NP = (PK + PV) / 8, NPW = NP + (MODE == 2 ? 1 : 0);
    static constexpr int MASKOFF = S * STG;
    static constexpr int END = MASKOFF + (MODE == 2 ? 8 * S * 256 : 0);
    __device__ static __forceinline__ int fk(int row) { return CPRK == 8 ? fsw8(row) : fsw16(row); }
    __device__ static __forceinline__ int fv(int row) { return MODE == 2 ? fsw16(row) : (CPRV == 8 ? fswv8(row) : fsw16(row)); }
};
#define FA_WAITV(n) asm volatile("s_waitcnt vmcnt(%0)" :: "n"(n) : "memory")
template <int DQK, int DV, int MODE, int S>
__device__ __forceinline__ void attn_pass_dma(LAS unsigned char* lds, const int wave, const int lane,
        const f16* Qw, const int qpitch, const f16* Kg, const int kpitch, const f16* Vg, const int vpitch,
        const int ntiles, const int qpos0, const LAS float* tab, const unsigned selb, const int jblk, const unsigned* maskw,
        f32x16 (&o)[DV / 32]) {
    typedef LayD<DQK, DV, MODE, S> L;
    constexpr int NB_ = DV / 32;
    const int r32 = lane & 31, hi = lane >> 5;
    f16x8 qf[DQK / 16];
#pragma unroll
    for (int d0 = 0; d0 < DQK / 16; ++d0) qf[d0] = __builtin_bit_cast(f16x8, *(const GAS u32x4*)(Qw + (size_t)r32 * qpitch + d0 * 16 + hi * 8));
#pragma unroll
    for (int blk = 0; blk < NB_; ++blk)
#pragma unroll
        for (int r = 0; r < 16; ++r) o[blk][r] = 0.f;
    float m = -INFINITY, l = 0.f;
    unsigned goff[L::NP];
#pragma unroll
    for (int c = 0; c < L::NP; ++c) { const int pc = wave + 8 * c;
        if (pc < L::PK) { const int s2 = 64 * pc + lane, row = s2 / L::CPRK, ch = (s2 % L::CPRK) ^ L::fk(row); goff[c] = (unsigned)(row * kpitch + ch * 8); }
        else { const int s2 = 64 * (pc - L::PK) + lane, row = s2 / L::CPRV, ch = (s2 % L::CPRV) ^ L::fv(row); goff[c] = (unsigned)(row * vpitch + ch * 8); } }
#define FA_ISSUE(kt_, st_) do { \
        if (MODE == 2) __builtin_amdgcn_global_load_lds((const GAS unsigned*)(maskw + (kt_) * 64 + lane), (LAS unsigned*)(lds + L::MASKOFF + (wave * S + (st_)) * 256), 4, 0, 0); \
        _Pragma("unroll") for (int c = 0; c < L::NP; ++c) { const int pc = wave + 8 * c; \
            if (pc < L::PK) __builtin_amdgcn_global_load_lds((const GAS unsigned*)(Kg + (size_t)(kt_) * 64 * kpitch + goff[c]), (LAS unsigned*)(lds + (st_) * L::STG + pc * 1024), 16, 0, 0); \
            else __builtin_amdgcn_global_load_lds((const GAS unsigned*)(Vg + (size_t)(kt_) * 64 * vpitch + goff[c]), (LAS unsigned*)(lds + (st_) * L::STG + L::KB + (pc - L::PK) * 1024), 16, 0, 0); } } while (0)
    int koff[DQK / 16];
#pragma unroll
    for (int d0 = 0; d0 < DQK / 16; ++d0) koff[d0] = (r32 * L::CPRK + ((2 * d0 + hi) ^ L::fk(r32))) * 16;
    int voff[2][NB_];
    { const int q = (lane & 15) >> 2, g1 = (lane >> 4) & 1, p = lane & 3;
#pragma unroll
      for (int sec = 0; sec < 2; ++sec)
#pragma unroll
        for (int blk = 0; blk < NB_; ++blk) { const int row = 4 * hi + q + 8 * sec; voff[sec][blk] = L::KB * (MODE == 2 ? 0 : 1) + (row * L::CPRV + ((4 * blk + 2 * g1 + (p >> 1)) ^ L::fv(row))) * 16 + 8 * (p & 1); } }
#define FA_VREADD(dst_, ks_) do { _Pragma("unroll") for (int blk = 0; blk < NB_; ++blk) { \
        const v4i16_t a_ = __builtin_amdgcn_ds_read_tr16_b64_v4i16((LAS v4i16_t*)(sb + voff[0][blk] + 16 * (ks_) * L::CPRV * 16)); \
        const v4i16_t b_ = __builtin_amdgcn_ds_read_tr16_b64_v4i16((LAS v4i16_t*)(sb + voff[1][blk] + 16 * (ks_) * L::CPRV * 16)); \
        const f16x4 a4_ = __builtin_bit_cast(f16x4, a_), b4_ = __builtin_bit_cast(f16x4, b_); \
        dst_[blk] = (f16x8){a4_[0], a4_[1], a4_[2], a4_[3], b4_[0], b4_[1], b4_[2], b4_[3]}; } } while (0)
#define FA_PVD(src_, ks_) do { _Pragma("unroll") for (int blk = 0; blk < NB_; ++blk) o[blk] = __builtin_amdgcn_mfma_f32_32x32x16_f16(src_[blk], pf[ks_], o[blk], 0, 0, 0); } while (0)
#pragma unroll
    for (int t0 = 0; t0 < S - 1; ++t0) if (t0 < ntiles) FA_ISSUE(t0, t0);
    int st = 0, sti = S - 1;
#pragma unroll 1
    for (int kt = 0; kt < ntiles; ++kt) {
        if (kt + S - 2 < ntiles) FA_WAITV(L::NPW * (S - 2)); else FA_WAITV(0);
        __builtin_amdgcn_s_barrier();
        asm volatile("" ::: "memory");
        if (kt + S - 1 < ntiles) FA_ISSUE(kt + S - 1, sti);
        const int k0 = kt * 64;
        if (k0 <= qpos0 + 31) {
            const LAS unsigned char* sb = lds + st * L::STG;
            f32x16 p0, p1;
            if (MODE == 2) {
                const unsigned nw = ~*(const LAS unsigned*)(lds + L::MASKOFF + (wave * S + st) * 256 + lane * 4);
#pragma unroll
                for (int r = 0; r < 16; ++r) { p0[r] = __uint_as_float((unsigned)__builtin_amdgcn_sbfe((int)nw, r, 1) & 0xff800000u); p1[r] = __uint_as_float((unsigned)__builtin_amdgcn_sbfe((int)nw, 16 + r, 1) & 0xff800000u); }
            } else if (MODE == 1) {
                const int n = kt >> 2; const float cv = (n == jblk || ((selb >> n) & 1u)) ? 0.f : -INFINITY;
#pragma unroll
                for (int r = 0; r < 16; ++r) { p0[r] = cv; p1[r] = cv; }
            } else {
#pragma unroll
                for (int r = 0; r < 16; ++r) { p0[r] = 0.f; p1[r] = 0.f; }
            }
#pragma unroll
            for (int db = 0; db < DQK / 64; ++db) {
                f16x8 kf0[4], kf1[4];
#pragma unroll
                for (int d = 0; d < 4; ++d) { kf0[d] = *(const LAS f16x8*)(sb + koff[4 * db + d]); kf1[d] = *(const LAS f16x8*)(sb + koff[4 * db + d] + 32 * L::CPRK * 16); }
                __builtin_amdgcn_sched_barrier(0);
#pragma unroll
                for (int d = 0; d < 4; ++d) {
                    p0 = __builtin_amdgcn_mfma_f32_32x32x16_f16(kf0[d], qf[4 * db + d], p0, 0, 0, 0);
                    p1 = __builtin_amdgcn_mfma_f32_32x32x16_f16(kf1[d], qf[4 * db + d], p1, 0, 0, 0); }
                __builtin_amdgcn_sched_barrier(0);
            }
            f16x8 vfa[NB_], vfb[NB_];
            FA_VREADD(vfa, 0);
            __builtin_amdgcn_sched_barrier(0);
            if (qpos0 - (k0 + 63) < 128) {
                const int j0 = 224 - (qpos0 + r32 - k0 - 4 * hi), sf = j0 & 1; const LAS float* rp = tab + sf * TAB2 + (j0 - sf);
#pragma unroll
                for (int g = 0; g < 4; ++g) { const f32x2 x0 = *(const LAS f32x2*)(rp + 8 * g), x1 = *(const LAS f32x2*)(rp + 8 * g + 2), y0 = *(const LAS f32x2*)(rp + 32 + 8 * g), y1 = *(const LAS f32x2*)(rp + 34 + 8 * g);
                    p0[4 * g] += x0.x; p0[4 * g + 1] += x0.y; p0[4 * g + 2] += x1.x; p0[4 * g + 3] += x1.y; p1[4 * g] += y0.x; p1[4 * g + 1] += y0.y; p1[4 * g + 2] += y1.x; p1[4 * g + 3] += y1.y; }
            }
            float rm = rowmax32(p0, p1);
            rm = half_max(rm);
            if (__any(rm > m + 8.f)) { const float mn = fmaxf(m, rm), mu2 = (mn == -INFINITY) ? 0.f : mn; const float al = __builtin_amdgcn_exp2f(m - mu2); l *= al; m = mn;
#pragma unroll
                for (int blk = 0; blk < NB_; ++blk)
#pragma unroll
                    for (int r = 0; r < 16; ++r) o[blk][r] *= al; }
            const float mu = (m == -INFINITY) ? 0.f : m;
            float ls = 0.f;
#pragma unroll
            for (int r = 0; r < 16; ++r) { p0[r] = __builtin_amdgcn_exp2f(p0[r] - mu); p1[r] = __builtin_amdgcn_exp2f(p1[r] - mu); ls += p0[r] + p1[r]; }
            l += ls;
            f16x8 pf[4]; pf[0] = pack8(p0, 0); pf[1] = pack8(p0, 8); pf[2] = pack8(p1, 0); pf[3] = pack8(p1, 8);
            __builtin_amdgcn_sched_barrier(0);
            FA_VREADD(vfb, 1); FA_PVD(vfa, 0); __builtin_amdgcn_sched_barrier(0);
            FA_VREADD(vfa, 2); FA_PVD(vfb, 1); __builtin_amdgcn_sched_barrier(0);
            FA_VREADD(vfb, 3); FA_PVD(vfa, 2); __builtin_amdgcn_sched_barrier(0);
            FA_PVD(vfb, 3);
        }
        st = (st + 1 == S) ? 0 : st + 1; sti = (sti + 1 == S) ? 0 : sti + 1;
    }
    asm volatile("s_waitcnt lgkmcnt(0)" ::: "memory");
    __builtin_amdgcn_s_barrier();
    asm volatile("" ::: "memory");
#undef FA_ISSUE
#undef FA_VREADD
#undef FA_PVD
    l = half_sum(l);
    const float inv = 1.f / l;
#pragma unroll
    for (int blk = 0; blk < NB_; ++blk)
#pragma unroll
        for (int r = 0; r < 16; ++r) o[blk][r] *= inv;
}
template <int DQK, int DV, int MODE, int S>
__device__ __forceinline__ void attn_pass_pipe(LAS unsigned char* lds, const int wave, const int lane,
        const f16* Qw, const int qpitch, const f16* Kg, const int kpitch, const f16* Vg, const int vpitch,
        const int ntiles, const int qpos0, const LAS float* tab, const unsigned selb, const int jblk, const unsigned* maskw,
        f32x16 (&o)[DV / 32]) {
    typedef LayD<DQK, DV, MODE, S> L;
    constexpr int NB_ = DV / 32;
    const int r32 = lane & 31, hi = lane >> 5;
    f16x8 qf[DQK / 16];
#pragma unroll
    for (int d0 = 0; d0 < DQK / 16; ++d0) qf[d0] = __builtin_bit_cast(f16x8, *(const GAS u32x4*)(Qw + (size_t)r32 * qpitch + d0 * 16 + hi * 8));
#pragma unroll
    for (int blk = 0; blk < NB_; ++blk)
#pragma unroll
        for (int r = 0; r < 16; ++r) o[blk][r] = 0.f;
    float m = -INFINITY, l = 0.f;
    unsigned goff[L::NP];
#pragma unroll
    for (int c = 0; c < L::NP; ++c) { const int pc = wave + 8 * c;
        if (pc < L::PK) { const int s2 = 64 * pc + lane, row = s2 / L::CPRK, ch = (s2 % L::CPRK) ^ L::fk(row); goff[c] = (unsigned)(row * kpitch + ch * 8); }
        else { const int s2 = 64 * (pc - L::PK) + lane, row = s2 / L::CPRV, ch = (s2 % L::CPRV) ^ L::fv(row); goff[c] = (unsigned)(row * vpitch + ch * 8); } }
#define FP_ISSUE(kt_, st_) do { \
        if (MODE == 2) __builtin_amdgcn_global_load_lds((const GAS unsigned*)(maskw + (kt_) * 64 + lane), (LAS unsigned*)(lds + L::MASKOFF + (wave * S + (st_)) * 256), 4, 0, 0); \
        _Pragma("unroll") for (int c = 0; c < L::NP; ++c) { const int pc = wave + 8 * c; \
            if (pc < L::PK) __builtin_amdgcn_global_load_lds((const GAS unsigned*)(Kg + (size_t)(kt_) * 64 * kpitch + goff[c]), (LAS unsigned*)(lds + (st_) * L::STG + pc * 1024), 16, 0, 0); \
            else __builtin_amdgcn_global_load_lds((const GAS unsigned*)(Vg + (size_t)(kt_) * 64 * vpitch + goff[c]), (LAS unsigned*)(lds + (st_) * L::STG + L::KB + (pc - L::PK) * 1024), 16, 0, 0); } } while (0)
    int koff[DQK / 16];
#pragma unroll
    for (int d0 = 0; d0 < DQK / 16; ++d0) koff[d0] = (r32 * L::CPRK + ((2 * d0 + hi) ^ L::fk(r32))) * 16;
    int voff[2][NB_];
    { const int q = (lane & 15) >> 2, g1 = (lane >> 4) & 1, p = lane & 3;
#pragma unroll
      for (int sec = 0; sec < 2; ++sec)
#pragma unroll
        for (int blk = 0; blk < NB_; ++blk) { const int row = 4 * hi + q + 8 * sec; voff[sec][blk] = L::KB * (MODE == 2 ? 0 : 1) + (row * L::CPRV + ((4 * blk + 2 * g1 + (p >> 1)) ^ L::fv(row))) * 16 + 8 * (p & 1); } }
    const int nact = ((qpos0 + 31) >> 6) + 1 < ntiles ? ((qpos0 + 31) >> 6) + 1 : ntiles;
#define FP_QK(a0_, a1_, kt_, st_, ref_) do { \
        const LAS unsigned char* sb_ = lds + (st_) * L::STG; const float nr_ = -(ref_); \
        if (MODE == 2) { const unsigned w_ = *(const LAS unsigned*)(lds + L::MASKOFF + (wave * S + (st_)) * 256 + lane * 4); const unsigned nrb_ = __float_as_uint(nr_); \
            _Pragma("unroll") for (int r = 0; r < 16; ++r) { const unsigned s0_ = (unsigned)__builtin_amdgcn_sbfe((int)w_, r, 1), s1_ = (unsigned)__builtin_amdgcn_sbfe((int)w_, 16 + r, 1); \
                a0_[r] = __uint_as_float((s0_ & nrb_) | (~s0_ & 0xff800000u)); a1_[r] = __uint_as_float((s1_ & nrb_) | (~s1_ & 0xff800000u)); } } \
        else if (MODE == 1) { const int n_ = (kt_) >> 2; const float cv_ = (n_ == jblk || ((selb >> n_) & 1u)) ? nr_ : -INFINITY; \
            _Pragma("unroll") for (int r = 0; r < 16; ++r) { a0_[r] = cv_; a1_[r] = cv_; } } \
        else { _Pragma("unroll") for (int r = 0; r < 16; ++r) { a0_[r] = nr_; a1_[r] = nr_; } } \
        _Pragma("unroll") for (int db = 0; db < DQK / 32; ++db) { f16x8 kf0_[2], kf1_[2]; \
            _Pragma("unroll") for (int d = 0; d < 2; ++d) { kf0_[d] = *(const LAS f16x8*)(sb_ + koff[2 * db + d]); kf1_[d] = *(const LAS f16x8*)(sb_ + koff[2 * db + d] + 32 * L::CPRK * 16); } \
            _Pragma("unroll") for (int d = 0; d < 2; ++d) { \
                a0_ = __builtin_amdgcn_mfma_f32_32x32x16_f16(kf0_[d], qf[2 * db + d], a0_, 0, 0, 0); \
                a1_ = __builtin_amdgcn_mfma_f32_32x32x16_f16(kf1_[d], qf[2 * db + d], a1_, 0, 0, 0); } } } while (0)
#define FP_PREP(a0_, a1_, kt_) do { const int k0_ = (kt_) * 64; \
        if (qpos0 - (k0_ + 63) < 128) { const int j0_ = 224 - (qpos0 + r32 - k0_ - 4 * hi), sf_ = j0_ & 1; const LAS float* rp_ = tab + sf_ * TAB2 + (j0_ - sf_); \
            _Pragma("unroll") for (int g = 0; g < 4; ++g) { const f32x2 x0_ = *(const LAS f32x2*)(rp_ + 8 * g), x1_ = *(const LAS f32x2*)(rp_ + 8 * g + 2), y0_ = *(const LAS f32x2*)(rp_ + 32 + 8 * g), y1_ = *(const LAS f32x2*)(rp_ + 34 + 8 * g); \
                a0_[4 * g] += x0_.x; a0_[4 * g + 1] += x0_.y; a0_[4 * g + 2] += x1_.x; a0_[4 * g + 3] += x1_.y; a1_[4 * g] += y0_.x; a1_[4 * g + 1] += y0_.y; a1_[4 * g + 2] += y1_.x; a1_[4 * g + 3] += y1_.y; } } \
        rmrel = half_max(rowmax32(a0_, a1_)); } while (0)
#define FP_VREAD(dst_, ks_, st_) do { const LAS unsigned char* sv_ = lds + (st_) * L::STG; _Pragma("unroll") for (int blk = 0; blk < NB_; ++blk) { \
        const v4i16_t a_ = __builtin_amdgcn_ds_read_tr16_b64_v4i16((LAS v4i16_t*)(sv_ + voff[0][blk] + 16 * (ks_) * L::CPRV * 16)); \
        const v4i16_t b_ = __builtin_amdgcn_ds_read_tr16_b64_v4i16((LAS v4i16_t*)(sv_ + voff[1][blk] + 16 * (ks_) * L::CPRV * 16)); \
        const f16x4 a4_ = __builtin_bit_cast(f16x4, a_), b4_ = __builtin_bit_cast(f16x4, b_); \
        dst_[blk] = (f16x8){a4_[0], a4_[1], a4_[2], a4_[3], b4_[0], b4_[1], b4_[2], b4_[3]}; } } while (0)
#define FP_PV(src_, ks_) do { _Pragma("unroll") for (int blk = 0; blk < NB_; ++blk) o[blk] = __builtin_amdgcn_mfma_f32_32x32x16_f16(src_[blk], pf[ks_], o[blk], 0, 0, 0); } while (0)
#define FP_STEP(c0_, c1_, n0_, n1_, kt_) do { \
        if (S > 3 && (kt_) + S - 2 < ntiles) FA_WAITV(L::NPW * (S - 3)); else FA_WAITV(0); \
        __builtin_amdgcn_s_barrier(); asm volatile("" ::: "memory"); \
        if ((kt_) + S - 1 < ntiles) FP_ISSUE((kt_) + S - 1, sti); \
        if ((kt_) < nact) { \
            const float mu_ = (m == -INFINITY) ? 0.f : m; const bool more_ = (kt_) + 1 < nact; float rmrel = -INFINITY; \
            if (more_) FP_QK(n0_, n1_, (kt_) + 1, st1, mu_); \
            if (__any(dl != 0.f)) { _Pragma("unroll") for (int r = 0; r < 16; ++r) { c0_[r] -= dl; c1_[r] -= dl; } } \
            float ls_ = 0.f; \
            _Pragma("unroll") for (int r = 0; r < 16; ++r) { c0_[r] = __builtin_amdgcn_exp2f(c0_[r]); c1_[r] = __builtin_amdgcn_exp2f(c1_[r]); ls_ += c0_[r] + c1_[r]; } \
            l += ls_; \
            f16x8 pf[4]; pf[0] = pack8(c0_, 0); pf[1] = pack8(c0_, 8); pf[2] = pack8(c1_, 0); pf[3] = pack8(c1_, 8); \
            if (NB_ <= 2) { f16x8 vfa[NB_], vfb[NB_]; \
                FP_VREAD(vfa, 0, st); FP_VREAD(vfb, 1, st); \
                if (more_) FP_PREP(n0_, n1_, (kt_) + 1); \
                FP_PV(vfa, 0); FP_VREAD(vfa, 2, st); FP_PV(vfb, 1); FP_VREAD(vfb, 3, st); FP_PV(vfa, 2); FP_PV(vfb, 3); \
            } else { f16x8 vfa[NB_]; \
                FP_VREAD(vfa, 0, st); \
                if (more_) FP_PREP(n0_, n1_, (kt_) + 1); \
                FP_PV(vfa, 0); __builtin_amdgcn_sched_barrier(0); FP_VREAD(vfa, 1, st); FP_PV(vfa, 1); __builtin_amdgcn_sched_barrier(0); \
                FP_VREAD(vfa, 2, st); FP_PV(vfa, 2); __builtin_amdgcn_sched_barrier(0); FP_VREAD(vfa, 3, st); FP_PV(vfa, 3); } \
            dl = 0.f; \
              \
            if (more_ && __any(rmrel > 8.f || (m == -INFINITY && rmrel > -INFINITY))) { \
                const float mnew_ = fmaxf(m, rmrel + mu_), mun_ = (mnew_ == -INFINITY) ? 0.f : mnew_; dl = mun_ - mu_; m = mnew_; \
                const float al_ = __builtin_amdgcn_exp2f(-dl); l *= al_; \
                _Pragma("unroll") for (int blk = 0; blk < NB_; ++blk) _Pragma("unroll") for (int r = 0; r < 16; ++r) o[blk][r] *= al_; } \
        } \
        st = st1; st1 = (st1 + 1 == S) ? 0 : st1 + 1; sti = (sti + 1 == S) ? 0 : sti + 1; } while (0)
#pragma unroll
    for (int t0 = 0; t0 < S - 1; ++t0) if (t0 < ntiles) FP_ISSUE(t0, t0);
    f32x16 sa0, sa1, sb0, sb1; float dl;
    if (ntiles >= S - 1) FA_WAITV(L::NPW * (S - 2)); else FA_WAITV(0);
    __builtin_amdgcn_s_barrier(); asm volatile("" ::: "memory");
    { float rmrel; FP_QK(sa0, sa1, 0, 0, 0.f); FP_PREP(sa0, sa1, 0); m = rmrel; dl = (m == -INFINITY) ? 0.f : m; }
    int st = 0, st1 = 1, sti = S - 1;
#pragma unroll 1
    for (int kt = 0; kt < ntiles; kt += 2) {
        FP_STEP(sa0, sa1, sb0, sb1, kt);
        if (kt + 1 < ntiles) FP_STEP(sb0, sb1, sa0, sa1, kt + 1);
    }
    asm volatile("s_waitcnt lgkmcnt(0)" ::: "memory");
    __builtin_amdgcn_s_barrier(); asm volatile("" ::: "memory");
#undef FP_ISSUE
#undef FP_QK
#undef FP_PREP
#undef FP_VREAD
#undef FP_PV
#undef FP_STEP
    l = half_sum(l);
    const float inv = 1.f / l;
#pragma unroll
    for (int blk = 0; blk < NB_; ++blk)
#pragma unroll
        for (int r = 0; r < 16; ++r) o[blk][r] *= inv;
}
template <int DV> __device__ __forceinline__ void store_o(const f32x16 (&o)[DV / 32], f16* dst, int hi) {
#pragma unroll
    for (int blk = 0; blk < DV / 32; ++blk)
#pragma unroll
        for (int g = 0; g < 4; ++g) { u32x2 w; w.x = pk2h(o[blk][4 * g], o[blk][4 * g + 1]); w.y = pk2h(o[blk][4 * g + 2], o[blk][4 * g + 3]);
            *(u32x2*)(dst + 32 * blk + 8 * g + 4 * hi) = w; }
}
}

struct Args { const float* in[20]; float* out; unsigned char* ws; };

__global__ void __launch_bounds__(NWAVES * 64, 2) mega_fwd(Args args) {
    extern __shared__ __attribute__((aligned(16))) unsigned char lds_raw[];
    Frame F;
    F.lds = (LAS unsigned char*)0;
    (void)lds_raw;
    F.wave = __builtin_amdgcn_readfirstlane(threadIdx.x >> 6);
    F.G = gridDim.x; F.gw = blockIdx.x * NWAVES + F.wave; F.NGW = F.G * NWAVES;
    volatile LAS unsigned* MISC = (volatile LAS unsigned*)(F.lds + MISC_OFF);
    for (int u = threadIdx.x; u < (LDS_BYTES - LDSCTL_OFF) / 4; u += NWAVES * 64) ((LAS unsigned*)(F.lds + LDSCTL_OFF))[u] = 0u;
    __syncthreads();
    unsigned* ctl = (unsigned*)(args.ws + WS_CTL);
    XcdBarrier bar = xcd_barrier_post(ctl + CW_BAR, MISC + 8, F.wave);
    if (threadIdx.x == 0) __hip_atomic_fetch_or(ctl + CW_LB + 64 * (16 + (int)(blockIdx.x & 7u)), 1u << xb_xcc_id(), __ATOMIC_RELAXED, __HIP_MEMORY_SCOPE_AGENT);

    if (threadIdx.x < 20) ((volatile LAS unsigned long long*)(F.lds + PTAB_OFF))[threadIdx.x] = (unsigned long long)args.in[threadIdx.x];
    __syncthreads();
#define IN(i) inptr(F.lds, (i))
#define LANE lane_id()
#define LL launder_i(l)
#define GW launder_i(F.gw)
#define GWX ((gridDim.x == 256u) ? (int)((((blockIdx.x & 7u) << 5) + (blockIdx.x >> 3)) * 8u) + F.wave : GW)
#define SEAM_L() do { if (__builtin_amdgcn_readfirstlane((int)MISC[19])) xcd_local_barrier((unsigned*)launder(args.ws) + CW_LB, bar, F.wave); else xcd_barrier(bar, F.wave); } while (0)
#define TID (F.wave * 64 + lane_id())
#define WSP(T, off) ((T*)(launder(args.ws) + (off)))
    enum { I_X = 0, I_C, I_RELB, I_ADAW, I_ADAB, I_NMIX, I_WIN, I_GATEB, I_DLAM, I_SUBLN, I_KVNORM, I_WUV, I_WBRA, I_WBRB, I_WBRC, I_WO, I_NMLP, I_WFF1, I_WFF2, I_NFINAL };
    float* xout = args.out;
    for (int rp0 = 0; rp0 < launder_i(REP_P0); ++rp0) {
        LAS float* scr = (LAS float*)(F.lds + F.wave * 16384);
        { auto decode = [&](int it) -> TItem { const int l = it >> 13; int r = it & 8191;
              if (r < 1664) return TItem{IN(I_WIN) + (size_t)l * DM * IN_COLS, IN_COLS, 0, PCOLS, DM, WSP(f16, WS_WIN) + (size_t)l * PP * DM, PP / 32, (unsigned*)launder(args.ws) + CW_CMAX + (l * 3 + 0) * 4096, r, true, false}; r -= 1664;
              if (r < 1536) return TItem{IN(I_WIN) + (size_t)l * DM * IN_COLS, IN_COLS, C_G, GCOLS, DM, WSP(f16, WS_WG) + (size_t)l * GCOLS * DM, GCOLS / 32, (unsigned*)launder(args.ws) + CW_CMAX + (l * 3 + 1) * 4096, r, false, false}; r -= 1536;
              if (r < 256) return TItem{IN(I_WBRA) + (size_t)l * 512 * DM, DM, 0, DM, 512, WSP(f16, WS_WA) + (size_t)l * DM * 512, DM / 32, (unsigned*)nullptr, r, false, false}; r -= 256;
              if (r < 128) return TItem{IN(I_WBRC) + (size_t)l * 256 * DM, DM, 0, DM, 256, WSP(f16, WS_WC) + (size_t)l * DM * 256, DM / 32, (unsigned*)nullptr, r, false, false}; r -= 128;
              if (r < 512) return TItem{IN(I_WO) + (size_t)l * DM * DM, DM, 0, DM, DM, WSP(f16, WS_WO) + (size_t)l * DM * DM, DM / 32, (unsigned*)nullptr, r, false, false}; r -= 512;
              if (r < 2048) return TItem{IN(I_WFF1) + (size_t)l * DM * DFF, DFF, 0, DFF, DM, WSP(f16, WS_W1) + (size_t)l * DFF * DM, DFF / 32, (unsigned*)launder(args.ws) + CW_CMAX + (l * 3 + 2) * 4096, r, false, false}; r -= 2048;
              return TItem{IN(I_WFF2) + (size_t)l * DFF * DM, DM, 0, DM, DFF, WSP(f16, WS_W2) + (size_t)l * DM * DFF, DM / 32, (unsigned*)nullptr, r, false, false}; };
          int it = F.gw;
          if (it < 2 * 8192) { TItem cur = decode(it); float wv[32]; float sc; titem_load(cur, LANE, wv, sc);
#pragma unroll 1
            for (;;) { const int itn = it + F.NGW; const bool more = itn < 2 * 8192;
                TItem nxt = cur; float wn[32]; float scn = 1.f;
                if (more) { nxt = decode(itn); titem_load(nxt, LANE, wn, scn); }
                titem_store(cur, LANE, wv, sc, scr);
                if (!more) break;
#pragma unroll
                for (int i = 0; i < 32; ++i) wv[i] = wn[i];
                sc = scn; cur = nxt; it = itn; } } }
        for (int it = F.gw; it < 2048; it += F.NGW) {
            const int l = it >> 10, kb = (it >> 4) & 63, nb = it & 15; const int kk0 = kb * 8, h = kk0 >> 7, r0 = kk0 & 127, n = nb * 64 + LANE;
            const float* uv = IN(I_WUV) + ((size_t)(l * 4 + h) * 128 + r0) * 64; const float* wb = IN(I_WBRB) + ((size_t)l * 256 + h * 64) * DM + n;
            float a[8];
#pragma unroll
            for (int j = 0; j < 8; ++j) a[j] = 0.f;
#pragma unroll 1
            for (int e0 = 0; e0 < 64; e0 += 16) { float bw[16];
#pragma unroll
                for (int e = 0; e < 16; ++e) bw[e] = *(const GAS float*)(wb + (size_t)(e0 + e) * DM);
#pragma unroll
                for (int e = 0; e < 16; ++e)
#pragma unroll
                    for (int j = 0; j < 8; ++j) a[j] += uv[j * 64 + e0 + e] * bw[e]; }
            u32x4 o; o.x = pk2h(a[0], a[1]); o.y = pk2h(a[2], a[3]); o.z = pk2h(a[4], a[5]); o.w = pk2h(a[6], a[7]);
            *(u32x4*)(WSP(f16, WS_WBC) + ((size_t)l * DM + n) * 512 + kk0) = o;
        }
        __syncthreads();
        if (blockIdx.x < 192) {
            const int l = blockIdx.x / 96, j0 = (blockIdx.x % 96) * 64;
            LAS float* cond = (LAS float*)F.lds;
            LAS float* part = (LAS float*)(F.lds + 65536);
            const float* c_in = IN(I_C);
            for (int i = TID; i < NB * DM; i += 512) { const float v = c_in[i]; cond[i] = v / (1.f + __expf(-v)); }
            __syncthreads();
            float a[16];
#pragma unroll
            for (int b = 0; b < 16; ++b) a[b] = 0.f;
            const float* wp = IN(I_ADAW) + (size_t)l * DM * 6144 + j0 + LANE;
#pragma unroll 1
            for (int k0 = F.wave * 128; k0 < F.wave * 128 + 128; k0 += 16) { float w[16];
#pragma unroll
                for (int i = 0; i < 16; ++i) w[i] = *(const GAS float*)(wp + (size_t)(k0 + i) * 6144);
#pragma unroll
                for (int b = 0; b < 16; ++b)
#pragma unroll
                    for (int i4 = 0; i4 < 4; ++i4) { const f32x4 cvv = *(const LAS f32x4*)(cond + b * 1024 + k0 + 4 * i4);
                        a[b] += (cvv.x * w[4 * i4] + cvv.y * w[4 * i4 + 1]) + (cvv.z * w[4 * i4 + 2] + cvv.w * w[4 * i4 + 3]); } }
#pragma unroll
            for (int b = 0; b < 16; ++b) part[(F.wave * 16 + b) * 64 + LANE] = a[b];
            __syncthreads();
            const float* ada_b = IN(I_ADAB); float* mod = WSP(float, WS_MOD);
            for (int i = TID; i < 1024; i += 512) { const int b = i >> 6, j = i & 63; float s = ada_b[l * 6144 + j0 + j];
#pragma unroll
                for (int w = 0; w < 8; ++w) s += part[(w * 16 + b) * 64 + j];
                mod[((size_t)l * 16 + b) * 6144 + j0 + j] = s; }
            __syncthreads();
        } else if (blockIdx.x == 192) {
            const float* rel_bias = IN(I_RELB); float* tabs = WSP(float, WS_MISC + 1024); float* lamv = WSP(float, WS_MISC);
            for (int i = TID; i < 12 * TABN; i += 512) { const int hh = i / TABN, idx = i % TABN, dist = idx - 255;
                float v; if (dist < 0) v = -INFINITY; else if (dist >= 128) v = 0.f; else v = (rel_bias[t5_bucket(dist) * 12 + hh] - rel_bias[31 * 12 + hh]) * LOG2E;
                tabs[i] = v; }
            float* tabs2 = WSP(float, WS_MISC + 32768);
            for (int i = TID; i < 12 * TAB2H; i += 512) { const int hh = i / TAB2H, sft = (i % TAB2H) / TAB2, j = (i % TAB2) + sft, dist = 224 - j;
                float v; if (dist < 0) v = -INFINITY; else if (dist >= 128) v = 0.f; else v = (rel_bias[t5_bucket(dist) * 12 + hh] - rel_bias[31 * 12 + hh]) * LOG2E;
                tabs2[i] = v; }
            if (F.wave < 2) { const int l = F.wave; const float* dl = IN(I_DLAM) + l * 256;
                const float s1 = wave_sum(dl[LANE] * dl[64 + LANE]), s2 = wave_sum(dl[128 + LANE] * dl[192 + LANE]);
                const float lam_init = 0.8f - 0.6f * expf(-0.3f * (float)l);
                if (LANE == 0) lamv[l] = expf(s1) - expf(s2) + lam_init; }
        }
    }
    xcd_barrier(bar, F.wave);
    if (threadIdx.x == 0) { unsigned ok = (gridDim.x == 256u) ? 1u : 0u, seen = 0u;
#pragma unroll 1
        for (int r = 0; r < 8; ++r) { const unsigned mk = xb_ld((unsigned*)launder(args.ws) + CW_LB + 64 * (16 + r)); if (__builtin_popcount(mk) != 1 || (seen & mk)) ok = 0u; seen |= mk; }
        MISC[19] = ok; }
    __syncthreads();
    { const int grp = blockIdx.x % 6, bi = blockIdx.x / 6, nbl = (F.G - grp + 5) / 6, l = grp / 3, which = grp % 3; const int lane = LANE;
      const float* modl = WSP(float, WS_MOD) + (size_t)l * 16 * 6144 + (which == 2 ? 3 : 0) * DM;
      LAS float* sh = (LAS float*)F.lds;
      for (int i2 = F.wave * 64 + lane; i2 < 16 * 1024; i2 += 512) sh[i2] = modl[(size_t)(i2 >> 10) * 6144 + (i2 & 1023)];
      __syncthreads();
      const f16* Bt = which == 0 ? WSP(f16, WS_WIN) + (size_t)l * PP * DM : (which == 1 ? WSP(f16, WS_WG) + (size_t)l * GCOLS * DM : WSP(f16, WS_W1) + (size_t)l * DFF * DM);
      const int nrows = which == 0 ? PP : (which == 1 ? GCOLS : DFF);
      float* cv = WSP(float, WS_CVEC) + (size_t)grp * 16 * 4096;
      u32x2 nxw[4]; unsigned nxc = 0u;
      { const int n = bi * 8 + F.wave;
        if (n < nrows) { nxc = ((const GAS unsigned*)launder(args.ws))[CW_CMAX + grp * 4096 + n];
#pragma unroll
          for (int j = 0; j < 4; ++j) nxw[j] = *(const GAS u32x2*)(Bt + (size_t)n * DM + 256 * j + lane * 4); } }
      for (int n = bi * 8 + F.wave; n < nrows; n += nbl * 8) {
          float w[16]; const unsigned cmb = nxc;
#pragma unroll
          for (int j = 0; j < 4; ++j) { const unsigned wx = nxw[j].x, wy = nxw[j].y; const f16x2 a = __builtin_bit_cast(f16x2, wx), b2 = __builtin_bit_cast(f16x2, wy);
              w[4 * j] = (float)a[0]; w[4 * j + 1] = (float)a[1]; w[4 * j + 2] = (float)b2[0]; w[4 * j + 3] = (float)b2[1]; }
          { const int n2 = n + nbl * 8;
            if (n2 < nrows) { nxc = ((const GAS unsigned*)launder(args.ws))[CW_CMAX + grp * 4096 + n2];
#pragma unroll
              for (int j = 0; j < 4; ++j) nxw[j] = *(const GAS u32x2*)(Bt + (size_t)n2 * DM + 256 * j + lane * 4); } }
          {
              const float cm = __uint_as_float(cmb), inv = cm > 0.f ? 127.f / cm : 0.f;
              unsigned char* wq = launder(args.ws) + (which == 0 ? WS_WQIN : (which == 1 ? WS_WQG : WS_WQ1)) + ((size_t)l * nrows + n) * 1024;
#pragma unroll
              for (int j = 0; j < 4; ++j) { unsigned pk = 0u;
#pragma unroll
                  for (int e = 0; e < 4; ++e) pk |= ((unsigned)(int)__builtin_rintf(w[4 * j + e] * inv) & 255u) << (8 * e);
                  *(unsigned*)(wq + 256 * j + lane * 4) = pk; }
              if (lane == 0) WSP(float, WS_SB)[grp * 4096 + n] = cm * (1.f / 127.f); }
          float a[16];
#pragma unroll
          for (int b = 0; b < 16; ++b) { a[b] = 0.f;
#pragma unroll
              for (int j = 0; j < 4; ++j) { const f32x4 sv = *(const LAS f32x4*)(sh + b * 1024 + 256 * j + lane * 4); a[b] += (w[4 * j] * sv.x + w[4 * j + 1] * sv.y) + (w[4 * j + 2] * sv.z + w[4 * j + 3] * sv.w); } }
#pragma unroll
          for (int st = 0; st < 4; ++st) { const int msk = 32 >> st, nh = 8 >> st; const bool up = (lane & msk) != 0;
#pragma unroll
              for (int i3 = 0; i3 < nh; ++i3) { const float send = up ? a[i3] : a[i3 + nh], keep = up ? a[i3 + nh] : a[i3]; a[i3] = keep + __shfl_xor(send, msk); } }
          a[0] += __shfl_xor(a[0], 1); a[0] += __shfl_xor(a[0], 2);
          if ((lane & 3) == 0) cv[(size_t)(((lane >> 5) & 1) * 8 + ((lane >> 4) & 1) * 4 + ((lane >> 3) & 1) * 2 + ((lane >> 2) & 1)) * 4096 + n] = a[0];
      }
      __syncthreads();
    }

#pragma unroll 1
    for (int l = 0; l < DEPTH; ++l) {
        if (LL == 0) for (int rep = 0; rep < REP_N1; ++rep) {
        { const float* xcur = IN(I_X); const float* modl = WSP(float, WS_MOD); const float* nw = IN(I_NMIX); unsigned char* U8 = (unsigned char*)xout + (size_t)64 * MiB; float* rf = (float*)launder(args.ws) + CW_RF;
          for (int m0 = GWX * 16; m0 < MTOK; m0 += F.NGW * 16) { const int b = m0 / SEQ;
            norm_quant_rows16_0(xcur, nw, modl + (size_t)b * 6144 + 1 * DM, (f16*)xout, U8, rf, m0, LANE); } }
        xcd_barrier(bar, F.wave);
        if (__builtin_amdgcn_readfirstlane((int)MISC[19])) { for (unsigned i = 0; i < (blockIdx.x & 7u); ++i) __builtin_amdgcn_s_sleep(40); }
        }
        for (int rep = 0; rep < REP_G1; ++rep) {
#ifndef NO_G1
        { pg8::Gemm g{(const f16*)((const unsigned char*)xout + (size_t)64 * MiB), (const f16*)(launder(args.ws) + WS_WQIN + (size_t)LL * PP * 1024), MTOK, PP, DM / 2}; pg8::StaticOrder S; S.init(MTOK, PP, F.G, (int)blockIdx.x);
          pg8::EpiNormF16<0, true> E{WSP(f16, WS_R1), PP, GAPP};
          pg8::fill_tabs_q((const float*)launder(args.ws) + CW_RF, WSP(float, WS_CVEC) + (size_t)(LL * 3 + 0) * 16 * 4096, (const float*)nullptr, WSP(float, WS_SB) + (LL * 3 + 0) * 4096, S, TID);
          pg8::gemm_phase<pg8::EpiNormF16<0, true>, pg8::StaticOrder, true, true, true>(F.lds, g, S, E, F.wave); }
#endif
        SEAM_L();
        }
        for (int rep = 0; rep < launder_i(REP_SEL); ++rep) {
        { const f16* P = WSP(f16, WS_R1); f16* KVN = WSP(f16, WS_KVN); const float* kvw = IN(I_KVNORM) + LL * 128; float* kmean = WSP(float, WS_MISC + 65536);
          { const int lane = LANE, sub = lane >> 4, cl = lane & 15;
            float kw[8];
#pragma unroll
            for (int e = 0; e < 8; ++e) kw[e] = kvw[cl * 8 + e];
            for (int m0 = GWX * 16; m0 < MTOK; m0 += 16 * F.NGW) {
                f16x8 v[4]; float ss[4];
#pragma unroll
                for (int j = 0; j < 4; ++j) v[j] = __builtin_bit_cast(f16x8, *(const GAS u32x4*)(P + (size_t)(m0 + j * 4 + sub) * PP + (size_t)((m0 + j * 4 + sub) >> 12) * GAPP + C_BKV + cl * 8));
#pragma unroll
                for (int j = 0; j < 4; ++j) { ss[j] = 0.f;
#pragma unroll
                    for (int e = 0; e < 8; ++e) ss[j] += (float)v[j][e] * (float)v[j][e]; }
#pragma unroll
                for (int o = 1; o < 16; o <<= 1)
#pragma unroll
                    for (int j = 0; j < 4; ++j) ss[j] += __shfl_xor(ss[j], o);
#pragma unroll
                for (int j = 0; j < 4; ++j) { const float r = __builtin_amdgcn_rsqf(ss[j] * (1.f / 128.f) + EPS);
                    u32x4 w; w.x = pk2h((float)v[j][0] * r * kw[0], (float)v[j][1] * r * kw[1]); w.y = pk2h((float)v[j][2] * r * kw[2], (float)v[j][3] * r * kw[3]);
                    w.z = pk2h((float)v[j][4] * r * kw[4], (float)v[j][5] * r * kw[5]); w.w = pk2h((float)v[j][6] * r * kw[6], (float)v[j][7] * r * kw[7]);
                    *(GAS u32x4*)(KVN + (size_t)(m0 + j * 4 + sub) * 128 + cl * 8) = w; }
            } }
          for (int it = (gridDim.x == 256u) ? (((int)(blockIdx.x >> 3) * 8 + F.wave < 64) ? (int)(blockIdx.x & 7u) * 64 + (int)(blockIdx.x >> 3) * 8 + F.wave : NB * 4 * 8) : GW; it < NB * 4 * 8; it += F.NGW) {
            const int b = it >> 5, h = (it >> 3) & 3, blk = it & 7; const int lane = LANE, rg = lane >> 3, ch = lane & 7;
            const f16* src = P + ((size_t)b * SEQ + blk * 256 + rg) * PP + (size_t)(b >> 1) * GAPP + C_CK + h * 64 + ch * 8; float a8[8];
#pragma unroll
            for (int e = 0; e < 8; ++e) a8[e] = 0.f;
#pragma unroll 8
            for (int r = 0; r < 32; ++r) { const f16x8 v = __builtin_bit_cast(f16x8, *(const GAS u32x4*)(src + (size_t)(8 * r) * PP));
#pragma unroll
                for (int e = 0; e < 8; ++e) a8[e] += (float)v[e]; }
#pragma unroll
            for (int e = 0; e < 8; ++e) { a8[e] += __shfl_xor(a8[e], 8); a8[e] += __shfl_xor(a8[e], 16); a8[e] += __shfl_xor(a8[e], 32); }
            if (rg == 0) { f32x4 o0 = {a8[0], a8[1], a8[2], a8[3]}, o1 = {a8[4], a8[5], a8[6], a8[7]};
                *(f32x4*)(kmean + (size_t)it * 64 + ch * 8) = o0 * (1.f / 256.f); *(f32x4*)(kmean + (size_t)it * 64 + ch * 8 + 4) = o1 * (1.f / 256.f); } } }
#ifndef NAIVE_DSA
#ifdef NAIVE_SELECT
        { const f16* P = WSP(f16, WS_R1); unsigned* MASK = WSP(unsigned, WS_MASK); LAS unsigned* keyl = (LAS unsigned*)(F.lds + F.wave * 16384 + 8192);
          for (int task = GW; task < NB * SEQ; task += F.NGW) {
            const int b = task / SEQ, t = (task % SEQ + 37 * b) % SEQ; const size_t row = (size_t)b * SEQ + t; const int lane = LANE;
            const int nslots = (t >> 6) + 1;
            unsigned sel = 0xffffffffu;
            if (t >= 256) {
                const f16* iq = P + row * PP + C_BIQ; const f16* iwp = P + row * PP + C_BIW;
#pragma unroll 1
                for (int j = 0; j < nslots; ++j) { unsigned kk = 0u; const int k = 64 * j + lane;
                    if (k <= t) { const f16* ik = P + ((size_t)b * SEQ + k) * PP + C_BIK; f16x8 kv[4];
#pragma unroll
                        for (int c = 0; c < 4; ++c) kv[c] = *(const f16x8*)(ik + 8 * c);
                        float sc = 0.f;
#pragma unroll 1
                        for (int hh = 0; hh < 8; ++hh) { float d = 0.f;
#pragma unroll
                            for (int c = 0; c < 4; ++c) { const f16x8 qv = *(const f16x8*)(iq + hh * 32 + 8 * c);
#pragma unroll
                                for (int e = 0; e < 8; ++e) d += (float)qv[e] * (float)kv[c][e]; }
                            sc += fmaxf(d, 0.f) * (float)iwp[hh]; }
                        kk = ordkey(sc); }
                    keyl[k] = kk; }
                unsigned thr = 0u;
#pragma unroll 1
                for (int bit = 31; bit >= 0; --bit) { const unsigned cand = thr | (1u << bit); int c = 0;
#pragma unroll 1
                    for (int j = 0; j < nslots; ++j) c += (keyl[64 * j + lane] >= cand) ? 1 : 0;
                    if (wave_isum(c) >= 256) thr = cand; }
                int cgt = 0;
#pragma unroll 1
                for (int j = 0; j < nslots; ++j) cgt += (keyl[64 * j + lane] > thr) ? 1 : 0;
                cgt = wave_isum(cgt);
                const int need = 256 - cgt; int run = 0; sel = 0u;
#pragma unroll 1
                for (int j = 0; j < nslots; ++j) { const unsigned kk = keyl[64 * j + lane]; const bool tie = kk == thr; const unsigned long long bal = __ballot(tie);
                    const int pre = run + __popcll(bal & ((1ull << lane) - 1ull));
                    if (kk > thr || (tie && pre < need)) sel |= 1u << j;
                    run += __popcll(bal); }
            }
            const int bb = lane & 31, kkq = 32 * (bb >> 4) + (bb & 3) + 8 * ((bb & 15) >> 2) + 4 * (lane >> 5);
            unsigned* mrow = MASK + ((size_t)(b * 64 + (t >> 5)) * 32) * 64 + (t & 31);
#pragma unroll 1
            for (int j = 0; j < nslots; ++j) { const unsigned long long bal = __ballot((sel >> j) & 1u);
                const unsigned long long w64 = __ballot((bal >> kkq) & 1ull);
                if (lane == 0) { mrow[j * 64] = (unsigned)w64; mrow[j * 64 + 32] = (unsigned)(w64 >> 32); } }
          } }
#else
        { const f16* P = WSP(f16, WS_R1); unsigned* MASK = WSP(unsigned, WS_MASK);
          unsigned* qctr = (unsigned*)launder(args.ws) + CW_QUEUE + 512 * ((rep * 2 + LL) * 4 + 3);
          LAS unsigned* hist = (LAS unsigned*)F.lds;
          constexpr int HSTR = 257;
          if (TID == 0) MISC[17] = 0u;
          for (int uk = 0;; ++uk) {
            const int ui = unit_pick(uk, 128, qctr, MISC);
            if (ui < 0) break;
            const int qg = 63 - ((ui & 127) >> 1), b = 2 * (ui >> 7) + (ui & 1); const int lane = LANE, tid = F.wave * 64 + lane, r32 = lane & 31, hi = lane >> 5;
            const int ntiles = (qg >> 1) + 1, t = 32 * qg + r32; const size_t brow = (size_t)b * SEQ; const f16* Pg = P + (size_t)(b >> 1) * GAPP;
            unsigned* mbase = MASK + ((size_t)(b * 64 + qg) * 32) * 64 + lane;
            if (qg < 8) { for (int kt = F.wave; kt < ntiles; kt += 8) mbase[kt * 64] = 0xffffffffu; continue; }
            unsigned keys[4][32];
            {
              const f16* iqp = Pg + (brow + t) * PP + C_BIQ; const f16* iwp = Pg + (brow + t) * PP + C_BIW;
              LAS u32x4* iqL = (LAS u32x4*)(F.lds + 45056);
              const f16x8 iwv = *(const f16x8*)iwp;
              unsigned sgnbits = 0u;
#pragma unroll
              for (int h = 0; h < 8; ++h) sgnbits |= ((float)iwv[h] < 0.f) ? (1u << h) : 0u;
              { float wsel = 0.f;
#pragma unroll
                for (int h = 0; h < 8; ++h) wsel = (h == F.wave) ? (float)iwv[h] : wsel;
#pragma unroll
                for (int s2 = 0; s2 < 2; ++s2) { const f16x8 v = *(const f16x8*)(iqp + F.wave * 32 + 16 * s2 + 8 * hi);
                    u32x4 pw; pw.x = pk2h(wsel * (float)v[0], wsel * (float)v[1]); pw.y = pk2h(wsel * (float)v[2], wsel * (float)v[3]); pw.z = pk2h(wsel * (float)v[4], wsel * (float)v[5]); pw.w = pk2h(wsel * (float)v[6], wsel * (float)v[7]);
                    iqL[(F.wave * 2 + s2) * 64 + lane] = pw; } }
              if (F.wave == 0) {
#pragma unroll
                for (int s2 = 0; s2 < 2; ++s2) { float ca[8];
#pragma unroll
                    for (int e = 0; e < 8; ++e) ca[e] = 0.f;
#pragma unroll
                    for (int h = 0; h < 8; ++h) { const f16x8 v = *(const f16x8*)(iqp + h * 32 + 16 * s2 + 8 * hi); const float w = (float)iwv[h];
#pragma unroll
                        for (int e = 0; e < 8; ++e) ca[e] += w * (float)v[e]; }
                    u32x4 pw; pw.x = pk2h(ca[0], ca[1]); pw.y = pk2h(ca[2], ca[3]); pw.z = pk2h(ca[4], ca[5]); pw.w = pk2h(ca[6], ca[7]);
                    iqL[(16 + s2) * 64 + lane] = pw; } }
              __syncthreads();
#if REP_SCORE > 1
#pragma unroll 1
              for (int rs = 0; rs < launder_i(REP_SCORE); ++rs)
#endif
#pragma unroll
              for (int ti = 0; ti < 4; ++ti) { const int kt = F.wave + 8 * ti;
                if (kt < ntiles) { const int k0 = 64 * kt;
#pragma unroll
                    for (int half = 0; half < 2; ++half) { const f16* ikp = Pg + (brow + k0 + 32 * half + r32) * PP + C_BIK + 8 * hi;
                        const f16x8 kf0 = *(const f16x8*)ikp, kf1 = *(const f16x8*)(ikp + 16);
                        fa::f32x16 sc;
#pragma unroll
                        for (int r = 0; r < 16; ++r) sc[r] = 0.f;
                        sc = __builtin_amdgcn_mfma_f32_32x32x16_f16(kf0, __builtin_bit_cast(f16x8, iqL[16 * 64 + lane]), sc, 0, 0, 0);
                        sc = __builtin_amdgcn_mfma_f32_32x32x16_f16(kf1, __builtin_bit_cast(f16x8, iqL[17 * 64 + lane]), sc, 0, 0, 0);
#pragma unroll 2
                        for (int h = 0; h < 8; ++h) { fa::f32x16 a;
#pragma unroll
                            for (int r = 0; r < 16; ++r) a[r] = 0.f;
                            a = __builtin_amdgcn_mfma_f32_32x32x16_f16(kf0, __builtin_bit_cast(f16x8, iqL[(2 * h) * 64 + lane]), a, 0, 0, 0);
                            a = __builtin_amdgcn_mfma_f32_32x32x16_f16(kf1, __builtin_bit_cast(f16x8, iqL[(2 * h + 1) * 64 + lane]), a, 0, 0, 0);
                            const float sg = ((sgnbits >> h) & 1u) ? -1.f : 1.f;
#pragma unroll
                            for (int r = 0; r < 16; ++r) sc[r] = __builtin_fmaf(__builtin_fabsf(a[r]), sg, sc[r]); }
#pragma unroll
                        for (int r = 0; r < 16; ++r) keys[ti][16 * half + r] = ordkey(sc[r]);
                        if (k0 + 63 > 32 * qg) {
#pragma unroll
                            for (int r = 0; r < 16; ++r) { const int kidx = k0 + 32 * half + fa::crow(r, hi); keys[ti][16 * half + r] = (kidx <= t) ? keys[ti][16 * half + r] : 0u; } } }
                } else {
#pragma unroll
                    for (int e = 0; e < 32; ++e) keys[ti][e] = 0u; } } }
            unsigned prefix = 0u;
#if REP_RADIX > 1
#pragma unroll 1
            for (int rr = 0; rr < launder_i(REP_RADIX); ++rr)
#endif
#pragma unroll 1
            for (int pass = 0; pass < 4; ++pass) { const int shift = 24 - 8 * pass;
                LAS unsigned* qst = (LAS unsigned*)(F.lds + 40960 + (pass & 1) * 512); LAS unsigned* qstn = (LAS unsigned*)(F.lds + 40960 + ((pass & 1) ^ 1) * 512);
                for (int i2 = tid; i2 < 32 * HSTR; i2 += 512) hist[i2] = 0u;
                __syncthreads();
                if (pass > 0) prefix = qst[2 * r32];
                const int pshift = (pass == 0) ? 31 : shift + 8; const unsigned pmask = (pass == 0) ? 0u : 0xffffffffu;
#pragma unroll
                for (int ti = 0; ti < 4; ++ti)
#pragma unroll
                    for (int e = 0; e < 32; ++e) { const unsigned k = keys[ti][e];
                        const unsigned x = ((k >> pshift) ^ prefix) & pmask; const unsigned inc = 1u - __builtin_elementwise_min(x, 1u);
                        if (F.wave + 8 * ti < ntiles) __hip_atomic_fetch_add(hist + r32 * HSTR + ((k >> shift) & 255u), inc, __ATOMIC_RELAXED, __HIP_MEMORY_SCOPE_WORKGROUP);
                        if ((e & 7) == 7) __builtin_amdgcn_sched_barrier(0); }
                __syncthreads();
#pragma unroll
                for (int qq = 0; qq < 4; ++qq) { const int q = F.wave * 4 + qq; const int need = (pass == 0) ? 256 : (int)qst[2 * q + 1]; const unsigned pfx = (pass == 0) ? 0u : qst[2 * q];
                    const int c0 = (int)hist[q * HSTR + 4 * lane], c1 = (int)hist[q * HSTR + 4 * lane + 1], c2 = (int)hist[q * HSTR + 4 * lane + 2], c3 = (int)hist[q * HSTR + 4 * lane + 3];
                    const int c = c0 + c1 + c2 + c3; int S = c;
#pragma unroll
                    for (int off = 1; off < 64; off <<= 1) { const int v = __shfl_down(S, off); if (lane + off < 64) S += v; }
                    const unsigned long long bal = __ballot(S >= need); const int L = __popcll(bal) - 1;
                    if (lane == L) { int cum = S - c, d;
                        if (cum + c3 >= need) d = 3; else { cum += c3; if (cum + c2 >= need) d = 2; else { cum += c2; if (cum + c1 >= need) d = 1; else { cum += c1; d = 0; } } }
                        qstn[2 * q] = (pfx << 8) | (unsigned)(4 * L + d); qstn[2 * q + 1] = (unsigned)(need - cum); } }
                __syncthreads();
            }
            const unsigned thr = ((LAS unsigned*)(F.lds + 40960))[2 * r32];
#pragma unroll
            for (int ti = 0; ti < 4; ++ti) { const int kt = F.wave + 8 * ti;
                if (kt < ntiles) { unsigned w = 0u;
#pragma unroll
                    for (int e = 0; e < 32; ++e) { w |= (keys[ti][e] >= thr) ? (1u << e) : 0u; if ((e & 7) == 7) __builtin_amdgcn_sched_barrier(0); }
                    mbase[kt * 64] = w; } }
          } }
#endif
#endif
        SEAM_L();
        }
        for (int rep = 0; rep < REP_ATT; ++rep) {
        {
            LAS float* scl = (LAS float*)(F.lds + F.wave * 16384); LAS unsigned* keyl = (LAS unsigned*)(F.lds + F.wave * 16384 + 8192);
#ifndef NO_DIFF
            { const f16* P = WSP(f16, WS_R1); f16* OA = WSP(f16, WS_OA); const float* tabs = WSP(float, WS_MISC + 32768); const float* subln = IN(I_SUBLN) + LL * 128;
              unsigned* qctr = (unsigned*)launder(args.ws) + CW_QUEUE + 512 * ((rep * 2 + LL) * 4 + 0);
              LAS float* tabl = (LAS float*)(F.lds + fa::TAB_OFF); LAS float* subl = (LAS float*)(F.lds + fa::SUB_OFF);
              { const int tid0 = TID;
                for (int i2 = tid0; i2 < 4 * TAB2H; i2 += 512) tabl[i2] = tabs[i2];
                if (tid0 < 128) subl[tid0] = subln[tid0] * ((LL == 0) ? 0.8f : 0.6444909f); }
              if (TID == 0) MISC[17] = 0u;
              for (int uk = 0;; ++uk) {
                const int ui = unit_pick(uk, 64, qctr, MISC);
                if (ui < 0) break;
                const int qb = 7 - ((ui & 63) >> 3), bh = 8 * (ui >> 6) + (ui & 7), b = bh >> 2, h = bh & 3; const int lane = LANE, tid = F.wave * 64 + lane;
                const int qpos0 = qb * 256 + F.wave * 32, ntiles = 4 * qb + 4; const size_t brow = (size_t)b * SEQ; const f16* Pg = P + (size_t)(b >> 1) * GAPP;
                fa::f32x16 o0[4];
                fa::attn_pass_pipe<64, 128, 0, 3>(F.lds, F.wave, lane, Pg + (brow + qpos0) * PP + C_AQ + h * 128, PP, Pg + brow * PP + C_AK + h * 128, PP, Pg + brow * PP + C_AV + h * 128, PP, ntiles, qpos0, tabl + h * TAB2H, 0u, 0, nullptr, o0);
                { LAS unsigned* st = (LAS unsigned*)(F.lds + fa::STASH_OFF + F.wave * 8192) + lane;
#pragma unroll
                  for (int blk = 0; blk < 4; ++blk)
#pragma unroll
                    for (int r = 0; r < 16; r += 2) st[(blk * 8 + (r >> 1)) * 64] = pk2h(o0[blk][r], o0[blk][r + 1]); }
                fa::attn_pass_pipe<64, 128, 0, 3>(F.lds, F.wave, LANE, Pg + (brow + qpos0) * PP + C_AQ + h * 128 + 64, PP, Pg + brow * PP + C_AK + h * 128 + 64, PP, Pg + brow * PP + C_AV + h * 128, PP, ntiles, qpos0, tabl + h * TAB2H, 0u, 0, nullptr, o0);
                const int lane2 = LANE, hi = lane2 >> 5; float ss = 0.f; const float lam = WSP(float, WS_MISC)[LL];
                { const LAS unsigned* st = (const LAS unsigned*)(F.lds + fa::STASH_OFF + F.wave * 8192) + lane2;
#pragma unroll
                  for (int blk = 0; blk < 4; ++blk)
#pragma unroll
                    for (int r = 0; r < 16; r += 2) { const f16x2 v = __builtin_bit_cast(f16x2, st[(blk * 8 + (r >> 1)) * 64]);
                        const float a0 = (float)v[0] - lam * o0[blk][r], a1 = (float)v[1] - lam * o0[blk][r + 1]; o0[blk][r] = a0; o0[blk][r + 1] = a1; ss += a0 * a0 + a1 * a1; } }
                ss += __shfl_xor(ss, 32);
                const float rstd = 1.f / sqrtf(ss * (1.f / 128.f) + EPS);
#pragma unroll
                for (int blk = 0; blk < 4; ++blk)
#pragma unroll
                    for (int r = 0; r < 16; ++r) o0[blk][r] *= rstd * subl[32 * blk + fa::crow(r, hi)];
                fa::store_o<128>(o0, OA + (brow + qpos0 + (lane2 & 31)) * 512 + h * 128, hi);
              } }
#endif
#ifndef NO_MOBA
#ifdef NAIVE_MOBA
            { const f16* P = WSP(f16, WS_R1); f16* OC = WSP(f16, WS_OC); const float* tabs = WSP(float, WS_MISC + 1024); const float* kmean = WSP(float, WS_MISC + 65536);
              for (int task = GW; task < NB * 4 * SEQ; task += F.NGW) {
                const int bh = task / SEQ, b = bh >> 2, h = bh & 3, t = (task % SEQ + 37 * bh) % SEQ; const size_t row = (size_t)b * SEQ + t; const int j = t >> 8;
                const f16* q = P + row * PP + C_CQ + h * 64; const float qd = (float)q[LANE];
                float gate[8];
#pragma unroll
                for (int n = 0; n < 8; ++n) gate[n] = (n < j) ? wave_sum(qd * kmean[((size_t)bh * 8 + n) * 64 + LANE]) : -INFINITY;
                unsigned selb = 1u << j;
#pragma unroll
                for (int pick = 0; pick < 3; ++pick) { float best = -INFINITY; int bi = -1;
#pragma unroll
                    for (int n = 0; n < 8; ++n) if (!((selb >> n) & 1u) && gate[n] > best) { best = gate[n]; bi = n; }
                    if (bi >= 0) selb |= 1u << bi; }
                unsigned sel = 0u;
#pragma unroll
                for (int jj = 0; jj < 32; ++jj) sel |= ((selb >> (jj >> 2)) & 1u) << jj;
                float o[1];
                naive_attn<64, 64>(scl, q, P + (size_t)b * SEQ * PP + C_CK + h * 64, PP, P + (size_t)b * SEQ * PP + C_CV + h * 64, PP, t, sel, tabs + (8 + h) * TABN, LANE, o);
                OC[row * 256 + h * 64 + LANE] = (f16)o[0];
              } }
#else
            { const f16* P = WSP(f16, WS_R1); f16* OC = WSP(f16, WS_OC); const float* tabs2 = WSP(float, WS_MISC + 32768); const float* kmean = WSP(float, WS_MISC + 65536);
              unsigned* qctr = (unsigned*)launder(args.ws) + CW_QUEUE + 512 * ((rep * 2 + LL) * 4 + 1);
              LAS float* tabl = (LAS float*)(F.lds + fa::TAB_OFF);
              __syncthreads();
              for (int i2 = TID; i2 < 4 * TAB2H; i2 += 512) tabl[i2] = tabs2[8 * TAB2H + i2];
              if (TID == 0) MISC[17] = 0u;
              for (int uk = 0;; ++uk) {
                const int ui = unit_pick(uk, 64, qctr, MISC);
                if (ui < 0) break;
                const int qb = 7 - ((ui & 63) >> 3), bh = 8 * (ui >> 6) + (ui & 7), b = bh >> 2, h = bh & 3; const int lane = LANE, tid = F.wave * 64 + lane, r32 = lane & 31, hi = lane >> 5;
                const int qpos0 = qb * 256 + F.wave * 32, ntiles = 4 * qb + 4; const size_t brow = (size_t)b * SEQ; const f16* Pg = P + (size_t)(b >> 1) * GAPP;
                const f16* Qw = Pg + (brow + qpos0) * PP + C_CQ + h * 64;
                unsigned selb = 0u;
                { f16x8 qv[4];
#pragma unroll
                  for (int d0 = 0; d0 < 4; ++d0) qv[d0] = *(const f16x8*)(Qw + (size_t)r32 * PP + d0 * 16 + hi * 8);
                  LAS float* kmL = (LAS float*)(F.lds + 98304);
                  kmL[tid] = kmean[(size_t)bh * 512 + tid];
                  __syncthreads();
                  float gate[8];
#pragma unroll
                  for (int n = 0; n < 8; ++n) { float g = 0.f;
#pragma unroll
                    for (int d0 = 0; d0 < 4; ++d0) { const f32x4 k0 = *(const LAS f32x4*)(kmL + n * 64 + 8 * hi + 16 * d0), k1 = *(const LAS f32x4*)(kmL + n * 64 + 8 * hi + 16 * d0 + 4);
                        g += ((float)qv[d0][0] * k0.x + (float)qv[d0][1] * k0.y) + ((float)qv[d0][2] * k0.z + (float)qv[d0][3] * k0.w) + ((float)qv[d0][4] * k1.x + (float)qv[d0][5] * k1.y) + ((float)qv[d0][6] * k1.z + (float)qv[d0][7] * k1.w); }
                    g += __shfl_xor(g, 32);
                    gate[n] = (n < qb) ? g : -INFINITY; }
#pragma unroll
                  for (int pick = 0; pick < 3; ++pick) { float best = -INFINITY; int bi = -1;
#pragma unroll
                    for (int n = 0; n < 8; ++n) if (!((selb >> n) & 1u) && gate[n] > best) { best = gate[n]; bi = n; }
                    if (bi >= 0) selb |= 1u << bi; } }
                fa::f32x16 o[2];
                fa::attn_pass_pipe<64, 64, 1, 4>(F.lds, F.wave, lane, Qw, PP, Pg + brow * PP + C_CK + h * 64, PP, Pg + brow * PP + C_CV + h * 64, PP, ntiles, qpos0, tabl + h * TAB2H, selb, qb, nullptr, o);
                fa::store_o<64>(o, OC + (brow + qpos0 + r32) * 256 + h * 64, hi);
              } }
#endif
#endif
#ifndef NO_DSA
#ifdef NAIVE_DSA
            { const f16* P = WSP(f16, WS_R1); f16* OB = WSP(f16, WS_OB); const f16* KVN = WSP(f16, WS_KVN); const float* tabs = WSP(float, WS_MISC + 1024);
              for (int task = GW; task < NB * SEQ; task += F.NGW) {
                const int b = task / SEQ, t = (task % SEQ + 37 * b) % SEQ; const size_t row = (size_t)b * SEQ + t; const int lane = LANE;
                unsigned sel = 0xffffffffu;
                if (t >= 256) {
                    const int nslots = (t >> 6) + 1; const f16* iq = P + row * PP + C_BIQ; const f16* iwp = P + row * PP + C_BIW;
#pragma unroll 1
                    for (int j = 0; j < nslots; ++j) { unsigned kk = 0u; const int k = 64 * j + lane;
                        if (k <= t) { const f16* ik = P + ((size_t)b * SEQ + k) * PP + C_BIK; f16x8 kv[4];
#pragma unroll
                            for (int c = 0; c < 4; ++c) kv[c] = *(const f16x8*)(ik + 8 * c);
                            float s = 0.f;
#pragma unroll 1
                            for (int hh = 0; hh < 8; ++hh) { float d = 0.f;
#pragma unroll
                                for (int c = 0; c < 4; ++c) { const f16x8 qv = *(const f16x8*)(iq + hh * 32 + 8 * c);
#pragma unroll
                                    for (int e = 0; e < 8; ++e) d += (float)qv[e] * (float)kv[c][e]; }
                                s += fmaxf(d, 0.f) * (float)iwp[hh]; }
                            kk = ordkey(s); }
                        keyl[k] = kk; }
                    unsigned thr = 0u;
#pragma unroll 1
                    for (int bit = 31; bit >= 0; --bit) { const unsigned cand = thr | (1u << bit); int c = 0;
#pragma unroll 1
                        for (int j = 0; j < nslots; ++j) c += (keyl[64 * j + lane] >= cand) ? 1 : 0;
                        if (wave_isum(c) >= 256) thr = cand; }
                    int cgt = 0;
#pragma unroll 1
                    for (int j = 0; j < nslots; ++j) cgt += (keyl[64 * j + lane] > thr) ? 1 : 0;
                    cgt = wave_isum(cgt);
                    const int need = 256 - cgt; int run = 0; sel = 0u;
#pragma unroll 1
                    for (int j = 0; j < nslots; ++j) { const unsigned kk = keyl[64 * j + lane]; const bool tie = kk == thr; const unsigned long long bal = __ballot(tie);
                        const int pre = run + __popcll(bal & ((1ull << lane) - 1ull));
                        if (kk > thr || (tie && pre < need)) sel |= 1u << j;
                        run += __popcll(bal); }
                }
#pragma unroll 1
                for (int h = 0; h < 4; ++h) { float o[2];
                    naive_attn<128, 128>(scl, P + row * PP + C_BQ + h * 128, KVN + (size_t)b * SEQ * 128, 128, KVN + (size_t)b * SEQ * 128, 128, t, sel, tabs + (4 + h) * TABN, LANE, o);
                    OB[row * 512 + h * 128 + LANE] = (f16)o[0]; OB[row * 512 + h * 128 + 64 + LANE] = (f16)o[1]; }
              } }
#else
            { const f16* P = WSP(f16, WS_R1); f16* OB = WSP(f16, WS_OB); const f16* KVN = WSP(f16, WS_KVN); const float* tabs2 = WSP(float, WS_MISC + 32768); const unsigned* MASK = WSP(unsigned, WS_MASK);
              unsigned* qctr = (unsigned*)launder(args.ws) + CW_QUEUE + 512 * ((rep * 2 + LL) * 4 + 2);
              LAS float* tabl = (LAS float*)(F.lds + fa::TAB_OFF);
              __syncthreads();
              for (int i2 = TID; i2 < 4 * TAB2H; i2 += 512) tabl[i2] = tabs2[4 * TAB2H + i2];
              if (TID == 0) MISC[17] = 0u;
              for (int uk = 0;; ++uk) {
                const int ui = unit_pick(uk, 64, qctr, MISC);
                if (ui < 0) break;
                const int qi = 31 - ((ui & 63) >> 1), b = 2 * (ui >> 6) + (ui & 1); const int lane = LANE, tid = F.wave * 64 + lane, r32 = lane & 31, hi = lane >> 5;
                const int head = F.wave & 3, qpos0 = 64 * qi + 32 * (F.wave >> 2), ntiles = qi + 1; const size_t brow = (size_t)b * SEQ; const f16* Pg = P + (size_t)(b >> 1) * GAPP;
                fa::f32x16 o[4];
                fa::attn_pass_dma<128, 128, 2, 4>(F.lds, F.wave, lane, Pg + (brow + qpos0) * PP + C_BQ + head * 128, PP, KVN + brow * 128, 128, KVN + brow * 128, 128, ntiles, qpos0, tabl + head * TAB2H, 0u, 0,
                                           MASK + ((size_t)(b * 64 + (qpos0 >> 5)) * 32) * 64, o);
                fa::store_o<128>(o, OB + (brow + qpos0 + r32) * 512 + head * 128, hi);
              } }
#endif
#endif
        }
        SEAM_L();
        }
        for (int rep = 0; rep < REP_G2; ++rep) {
#ifndef NO_G2
        { pg8::StaticOrder S; S.init(MTOK, DM, F.G, (int)blockIdx.x);
#pragma unroll 1
          for (int yi = 0; yi < 3; ++yi) { const int y = launder_i(yi), Ky = (y == 2) ? 256 : 512;
            pg8::Gemm g{WSP(f16, WS_OA + (size_t)y * 32 * MiB), WSP(f16, WS_WA + (size_t)y * 2 * MiB) + (size_t)LL * DM * Ky, MTOK, DM, Ky}; pg8::EpiF16<0> E{WSP(f16, WS_R1) + (size_t)y * YSTR, DM, GAPY};
            pg8::gemm_phase<pg8::EpiF16<0>, pg8::StaticOrder, true, true>(F.lds, g, S, E, F.wave); } }
#endif
        SEAM_L();
        }
#ifndef NO_G3
        { pg8::Gemm g{(const f16*)((const unsigned char*)xout + (size_t)64 * MiB), (const f16*)(launder(args.ws) + WS_WQG + (size_t)LL * GCOLS * 1024), MTOK, GCOLS, DM / 2}; pg8::TripleOrder S; S.init(MTOK, F.G, (int)blockIdx.x);
          pg8::EpiGateMerge<true> E{WSP(f16, WS_R1), WSP(f16, WS_R1) + 3 * YSTR};
          pg8::fill_tabs_q((const float*)launder(args.ws) + CW_RF, WSP(float, WS_CVEC) + (size_t)(LL * 3 + 1) * 16 * 4096, IN(I_GATEB) + LL * GCOLS, WSP(float, WS_SB) + (LL * 3 + 1) * 4096, S, TID);
          pg8::gemm_phase<pg8::EpiGateMerge<true>, pg8::TripleOrder, true, true, true>(F.lds, g, S, E, F.wave); }
#endif
        SEAM_L();
#ifndef NO_G4
        { pg8::Gemm g{WSP(f16, WS_R1) + 3 * YSTR, WSP(f16, WS_WO) + (size_t)LL * DM * DM, MTOK, DM, DM, (unsigned)(GAPY * 2)}; pg8::StaticOrder S; S.init(MTOK, DM, F.G, (int)blockIdx.x);
          pg8::EpiResidual E{(const f16*)xout, (f16*)xout, WSP(float, WS_MOD) + (size_t)LL * 16 * 6144 + 2 * DM, 6144, (f16*)nullptr, (const float*)nullptr, (const float*)nullptr, (float*)nullptr};
          pg8::gemm_phase<pg8::EpiResidual, pg8::StaticOrder, true, true>(F.lds, g, S, E, F.wave); }
#endif
        SEAM_L();
        for (int rep = 0; rep < REP_G5; ++rep) {
#ifndef NO_G5
        { const float* modl = WSP(float, WS_MOD) + (size_t)LL * 16 * 6144; const float* nw = IN(I_NMLP) + LL * DM; unsigned char* U8 = (unsigned char*)xout + (size_t)64 * MiB; float* rf = (float*)launder(args.ws) + CW_RF;
          for (int m0 = GWX * 16; m0 < MTOK; m0 += F.NGW * 16) { const int b = m0 / SEQ;
            norm_quant_rows16((const f16*)xout, nw, modl + (size_t)b * 6144 + 4 * DM, U8, rf, m0, LANE); } }
        SEAM_L();
        { pg8::Gemm g{(const f16*)((const unsigned char*)xout + (size_t)64 * MiB), (const f16*)(launder(args.ws) + WS_WQ1 + (size_t)LL * DFF * 1024), MTOK, DFF, DM / 2}; pg8::StaticOrder S; S.init(MTOK, DFF, F.G, (int)blockIdx.x);
          pg8::EpiNormF16<1, true, true> E{WSP(f16, WS_R1), DFF, 0};
          pg8::fill_tabs_q((const float*)launder(args.ws) + CW_RF, WSP(float, WS_CVEC) + (size_t)(LL * 3 + 2) * 16 * 4096, (const float*)nullptr, WSP(float, WS_SB) + (LL * 3 + 2) * 4096, S, TID);
          pg8::gemm_phase<pg8::EpiNormF16<1, true, true>, pg8::StaticOrder, true, true, true>(F.lds, g, S, E, F.wave); }
#endif
        SEAM_L();
        }
#ifndef NO_G6
        { pg8::Gemm g{WSP(f16, WS_R1), WSP(f16, WS_W2) + (size_t)LL * DM * DFF, MTOK, DM, DFF}; pg8::StaticOrder S; S.init(MTOK, DM, F.G, (int)blockIdx.x);
          const bool more_layers = LL + 1 < DEPTH;
          pg8::EpiResidual E{(const f16*)xout, more_layers ? (f16*)xout : WSP(f16, WS_U), WSP(float, WS_MOD) + (size_t)LL * 16 * 6144 + 5 * DM, 6144, (f16*)nullptr, (const float*)nullptr, (const float*)nullptr, (float*)nullptr};
          pg8::gemm_phase<pg8::EpiResidual, pg8::StaticOrder, true, true, false, true>(F.lds, g, S, E, F.wave); }
#endif
        if (LL + 1 < DEPTH) SEAM_L(); else xcd_barrier(bar, F.wave);
        if (LL + 1 < DEPTH) {
            const int ln = LL + 1; const float* modl = WSP(float, WS_MOD) + (size_t)ln * 16 * 6144; const float* nw = IN(I_NMIX) + ln * DM; unsigned char* U8 = (unsigned char*)xout + (size_t)64 * MiB; float* rf = (float*)launder(args.ws) + CW_RF;
            for (int m0 = GWX * 16; m0 < MTOK; m0 += F.NGW * 16) { const int b = m0 / SEQ;
                norm_quant_rows16((const f16*)xout, nw, modl + (size_t)b * 6144 + 1 * DM, U8, rf, m0, LANE); }
            SEAM_L(); }
    }
    { const float* nf = IN(I_NFINAL); const f16* xf = WSP(f16, WS_U);
      for (int m0 = GWX * 16; m0 < MTOK; m0 += F.NGW * 16) { const int lane = LANE;
        f32x4 gn[4];
#pragma unroll
        for (int j = 0; j < 4; ++j) gn[j] = ((const GAS f32x4*)nf)[lane + 64 * j];
        u32x2 nx[4];
#pragma unroll
        for (int j = 0; j < 4; ++j) nx[j] = ((const GAS u32x2*)(xf + (size_t)m0 * DM) + lane)[64 * j];
#pragma unroll 1
        for (int r = 0; r < 16; ++r) { const int m = m0 + r;
            f32x4 v[4]; float s = 0.f;
#pragma unroll
            for (int j = 0; j < 4; ++j) { const unsigned wx = nx[j].x, wy = nx[j].y; const f16x2 a = __builtin_bit_cast(f16x2, wx), b2 = __builtin_bit_cast(f16x2, wy);
                v[j] = (f32x4){(float)a[0], (float)a[1], (float)b2[0], (float)b2[1]}; s += (v[j].x * v[j].x + v[j].y * v[j].y) + (v[j].z * v[j].z + v[j].w * v[j].w); }
            if (r + 1 < 16) {
#pragma unroll
                for (int j = 0; j < 4; ++j) nx[j] = ((const GAS u32x2*)(xf + (size_t)(m + 1) * DM) + lane)[64 * j]; }
            const float rstd = 1.f / sqrtf(wave_sum(s) * (1.f / DM) + EPS);
            GAS f32x4* orow = (GAS f32x4*)(xout + (size_t)m * DM) + lane;
#pragma unroll
            for (int j = 0; j < 4; ++j) orow[64 * j] = v[j] * rstd * gn[j]; }
      } }
#undef IN
#undef WSP
#undef LANE
#undef LL
#undef GW
#undef TID
}

extern "C" void kernel_launch(void* const* d_in, const int* in_sizes, int n_in, void* d_out, int out_size, void* d_ws, size_t ws_size, hipStream_t stream) {
    static int grid = 0;
    if (grid == 0) {
        if (n_in != 20 || in_sizes[0] != MTOK * DM || out_size != MTOK * DM || ws_size < WS_END) { fprintf(stderr, "kernel_launch: shape/workspace mismatch (n_in %d, ws %zu); nothing launched\n", n_in, ws_size); grid = -1; return; }
        int dev = 0, cus = 0, per_cu = 0;
        if (hipGetDevice(&dev) != hipSuccess || hipDeviceGetAttribute(&cus, hipDeviceAttributeMultiprocessorCount, dev) != hipSuccess) { grid = -1; return; }
        if (hipFuncSetAttribute((const void*)mega_fwd, hipFuncAttributeMaxDynamicSharedMemorySize, LDS_BYTES) != hipSuccess) { fprintf(stderr, "kernel_launch: hipFuncSetAttribute failed\n"); grid = -1; return; }
        if (hipOccupancyMaxActiveBlocksPerMultiprocessor(&per_cu, (const void*)mega_fwd, NWAVES * 64, LDS_BYTES) != hipSuccess || per_cu < 1) { fprintf(stderr, "kernel_launch: occupancy query says %d blocks per CU\n", per_cu); }
        (void)hipGetLastError();
        grid = cus;
    }
    if (grid < 0) return;
    if (hipMemsetAsync((char*)d_ws + WS_CTL, 0, CTL_ZERO_BYTES, stream) != hipSuccess) return;
    Args a{};
    for (int i = 0; i < 20; ++i) a.in[i] = (const float*)d_in[i];
    a.out = (float*)d_out; a.ws = (unsigned char*)d_ws;
    hipLaunchKernelGGL(mega_fwd, dim3(grid), dim3(NWAVES * 64), LDS_BYTES, stream, a);
}
```

```cpp
#include <hip/hip_runtime.h>
#include <cstdio>
#include <cstdint>
#ifndef REP_N1
#define REP_N1 1
#endif
#ifndef REP_G1
#define REP_G1 1
#endif
#ifndef REP_SEL
#define REP_SEL 1
#endif
#ifndef REP_ATT
#define REP_ATT 1
#endif
#ifndef REP_G2
#define REP_G2 1
#endif
#ifndef REP_G5
#define REP_G5 1
#endif
#ifndef REP_P0
#define REP_P0 1
#endif
#ifndef REP_SCORE
#define REP_SCORE 1
#endif
#ifndef REP_RADIX
#define REP_RADIX 1
#endif
#ifndef REP_DIFF
#define REP_DIFF 1
#endif
#ifndef REP_MOBA
#define REP_MOBA 1
#endif
#ifndef REP_DSA
#define REP_DSA 1
#endif

#define LAS __attribute__((address_space(3)))
#define GAS __attribute__((address_space(1)))
typedef _Float16 f16;
typedef _Float16 f16x8 __attribute__((ext_vector_type(8)));
typedef _Float16 f16x4 __attribute__((ext_vector_type(4)));
typedef _Float16 f16x2 __attribute__((ext_vector_type(2)));
typedef float f32x4 __attribute__((ext_vector_type(4)));
typedef float f32x2 __attribute__((ext_vector_type(2)));
typedef unsigned u32x4 __attribute__((ext_vector_type(4)));
typedef unsigned u32x2 __attribute__((ext_vector_type(2)));

constexpr int NB = 16, SEQ = 2048, DM = 1024, MTOK = NB * SEQ, DEPTH = 2, DFF = 4096;
constexpr int IN_COLS = 6312, PCOLS = 3240, PP = 3328  , GCOLS = 3072;
constexpr int C_AQ = 0, C_AK = 512, C_AV = 1024, C_BQ = 1536, C_BKV = 2048, C_BIQ = 2176, C_BIK = 2432, C_BIW = 2464, C_CQ = 2472, C_CK = 2728, C_CV = 2984, C_G = 3240;
constexpr float EPS = 1e-6f, LOG2E = 1.4426950408889634f;
constexpr int TABN = 384;
constexpr int TAB2 = 320, TAB2H = 2 * TAB2;

__device__ __forceinline__ unsigned pk2h(float lo, float hi) { f32x2 v = {lo, hi}; f16x2 h = __builtin_convertvector(v, f16x2); return __builtin_bit_cast(unsigned, h); }

__device__ __forceinline__ int lane_id() { int l; asm volatile("v_mbcnt_lo_u32_b32 %0, -1, 0\n\tv_mbcnt_hi_u32_b32 %0, -1, %0" : "=v"(l)); return l; }

constexpr size_t SLAB_E = 16u * 1024u * 1024u;
constexpr size_t GAPP = SLAB_E - (size_t)4096 * 3328, GAPY = SLAB_E - (size_t)4096 * 1024, YSTR = (size_t)4096 * 1024;
namespace pg8 {
#define PG8_LAS __attribute__((address_space(3)))
#ifndef PG8_GRACE
#define PG8_GRACE 1
#endif
constexpr int BM = 256, BK = 64, HALF = 128, HTB = HALF * BK * 2, STAGE_BYTES = 8 * HTB, NXCD = 8, WGM = 8;
__host__ __device__ __forceinline__ int lds_byte(int r, int c) { const int st = (r >> 4) * 2 + (c >> 5), rr = r & 15, cc = c & 31, ob = rr * 64 + cc * 2; return st * 1024 + (ob ^ (((ob >> 9) & 1) << 5)); }
__host__ __device__ __forceinline__ void stage_rc(int b, int& R, int& C) { const int st = b / 1024, sb = b % 1024, swz = sb ^ (((sb >> 9) & 1) << 5); R = (st >> 1) * 16 + swz / 64; C = (st & 1) * 32 + (swz % 64) / 2; }
__host__ __device__ __forceinline__ int perm32(int rho) { const int n = rho >> 4, i = rho & 15; return 8 * (i >> 2) + 4 * n + (i & 3); }

struct Unit { int pm, pn, idx; };
struct Gemm { const f16* A; const f16* Bt; int M, N, K; unsigned gapA = 0u; };

struct StaticOrder {
    int nM, nN, nwg, G, c;
    __host__ __device__ void init(int M, int N, int G_, int c_) { nM = M / BM; nN = N / BM; nwg = nM * nN; G = G_; c = c_; }
    __host__ __device__ bool next(int i, Unit& u) const {
        const long L = (long)i * G + c; if (L >= nwg) return false;
        int wgid = (int)L; { const int q = nwg / NXCD, r = nwg % NXCD, xcd = wgid % NXCD, off = wgid / NXCD; wgid = (xcd < r ? xcd * (q + 1) : r * (q + 1) + (xcd - r) * q) + off; }
        const int nig = WGM * nN, gid = wgid / nig, fm = gid * WGM, gsz = (nM - fm) < WGM ? (nM - fm) : WGM;
        u.pm = fm + ((wgid % nig) % gsz); u.pn = (wgid % nig) / gsz; u.idx = i; return true;
    }
    __device__ __forceinline__ void a_ready(const Unit&) const {}
    __device__ __forceinline__ void done(const Unit&) const {}
};
struct TripleOrder {
    StaticOrder so;
    __host__ __device__ void init(int M, int G_, int c_) { so.init(M, 1024, G_, c_); }
    __host__ __device__ bool next(int i, Unit& u) const { if (!so.next(i / 3, u)) return false; u.pn += 4 * (i % 3); u.idx = i; return true; }
    __device__ __forceinline__ void a_ready(const Unit&) const {}
    __device__ __forceinline__ void done(const Unit&) const {}
};

typedef int i32x4 __attribute__((ext_vector_type(4)));
typedef u32x4 __attribute__((address_space(1))) g_u32x4;
typedef u32x2 __attribute__((address_space(1))) g_u32x2;
typedef f32x4 __attribute__((address_space(1))) g_f32x4;
typedef float __attribute__((address_space(1))) g_f32;
typedef f16x8 __attribute__((address_space(1))) g_f16x8;
__device__ __forceinline__ void gst16(void* p, const u32x4 w) { *(g_u32x4*)(p) = w; }
__device__ __forceinline__ void gst8(void* p, const u32x2 w) { *(g_u32x2*)(p) = w; }
template <int ACT  > struct EpiF16 {
    static constexpr bool PERM = true, AFTER_DRAIN = false; static constexpr int NSTORE = 16;
    f16* O; int ldc; size_t gap;
    __device__ __forceinline__ void operator()(const f32x4 (&acc)[2][2][4][2], const Unit& u, int wr, int wc, int fr, int fq) const {
        const int row0 = u.pm * BM + wr * 64 + fr; const int col0 = u.pn * BM + wc * 32 + 8 * fq;
#pragma unroll
        for (int ai = 0; ai < 2; ++ai)
#pragma unroll
            for (int m = 0; m < 4; ++m) { f16* rowp = O + (size_t)(row0 + ai * HALF + m * 16) * ldc + (size_t)((row0 + ai * HALF + m * 16) >> 12) * gap + col0;
#pragma unroll
                for (int bj = 0; bj < 2; ++bj) { f32x4 v0 = acc[ai][bj][m][0], v1 = acc[ai][bj][m][1];
                    if (ACT == 1) {
#pragma unroll
                        for (int e = 0; e < 4; ++e) { const float a = fmaxf(v0[e], 0.f), b = fmaxf(v1[e], 0.f); v0[e] = a * a; v1[e] = b * b; } }
                    u32x4 w; w.x = pk2h(v0[0], v0[1]); w.y = pk2h(v0[2], v0[3]); w.z = pk2h(v1[0], v1[1]); w.w = pk2h(v1[2], v1[3]);
                    gst16(rowp + bj * HALF, w); } }
    }
};
constexpr int RSTD_LDS = 131072, CV_LDS_ = 139264 + 1024, SB_LDS = CV_LDS_ + 8192;
__device__ __forceinline__ void row_rstd(const Unit& u, int wr, int fr, float (&rs)[2][4]) {
    const PG8_LAS float* rt = (const PG8_LAS float*)(uintptr_t)(RSTD_LDS + u.idx * 1024) + wr * 64 + fr;
#pragma unroll
    for (int ai = 0; ai < 2; ++ai)
#pragma unroll
        for (int m = 0; m < 4; ++m) rs[ai][m] = rt[ai * HALF + m * 16];
}
constexpr int CV_LDS = 139264 + 1024;
template <class Sched> __device__ __forceinline__ void fill_rstd(const float* SS, const float* cvec, const float* gb, const Sched& S, int tid) {
    for (int i = 0; i < 8; ++i) { Unit u; if (!S.next(i, u)) break;
        if (tid < 256) { const f32x4* sp = (const f32x4*)(SS + (size_t)(u.pm * BM + tid) * 16);
            const f32x4 a = sp[0], b = sp[1], c = sp[2], d = sp[3]; const f32x4 t = (a + b) + (c + d);
            ((PG8_LAS float*)(uintptr_t)(RSTD_LDS + i * 1024))[tid] = __builtin_amdgcn_rsqf(((t.x + t.y) + (t.z + t.w)) * (1.f / DM) + EPS); }
        else { const int c = tid - 256; float v = cvec[(size_t)((u.pm * BM) / SEQ) * 4096 + u.pn * BM + c]; if (gb) v += gb[u.pn * BM + c];
            ((PG8_LAS float*)(uintptr_t)(CV_LDS + i * 1024))[c] = v; } }
    __syncthreads();
}
template <class Sched> __device__ __forceinline__ void fill_tabs_q(const float* rowfac, const float* cvec, const float* gb, const float* sbv, const Sched& S, int tid) {
    const int c = tid & 255;
#pragma unroll 1
    for (int i0 = 0; i0 < 8; i0 += 4) {
        float va[4], vb[4], vc[4]; bool ok[4];
#pragma unroll
        for (int j = 0; j < 4; ++j) { Unit u; ok[j] = S.next(i0 + j, u); if (!ok[j]) { u.pm = 0; u.pn = 0; }
            if (tid < 256) va[j] = *(const g_f32*)(rowfac + u.pm * BM + c);
            else { va[j] = *(const g_f32*)(cvec + (size_t)((u.pm * BM) / SEQ) * 4096 + u.pn * BM + c); vb[j] = *(const g_f32*)(sbv + u.pn * BM + c); vc[j] = gb ? *(const g_f32*)(gb + u.pn * BM + c) : 0.f; } }
#pragma unroll
        for (int j = 0; j < 4; ++j) if (ok[j]) {
            if (tid < 256) ((PG8_LAS float*)(uintptr_t)(RSTD_LDS + (i0 + j) * 1024))[c] = va[j];
            else { ((PG8_LAS float*)(uintptr_t)(CV_LDS + (i0 + j) * 1024))[c] = va[j] + vc[j]; ((PG8_LAS float*)(uintptr_t)(SB_LDS + (i0 + j) * 1024))[c] = vb[j]; } } }
    __syncthreads();
}
template <int ACT  , bool I8 = false, bool TILED = false> struct EpiNormF16 {
    static constexpr bool PERM = true, AFTER_DRAIN = false; static constexpr int NSTORE = 16;
    f16* O; int ldc; size_t gap;
    __device__ __forceinline__ void operator()(const f32x4 (&acc)[2][2][4][2], const Unit& u, int wr, int wc, int fr, int fq) const {
        const int row0 = u.pm * BM + wr * 64 + fr; const int col0 = u.pn * BM + wc * 32 + 8 * fq; const int b = (u.pm * BM) / SEQ;
        float rs[2][4]; row_rstd(u, wr, fr, rs);
        f32x4 cv[2][2];
#pragma unroll
        for (int bj = 0; bj < 2; ++bj)
#pragma unroll
            for (int n = 0; n < 2; ++n) cv[bj][n] = *(const PG8_LAS f32x4*)(uintptr_t)(CV_LDS + u.idx * 1024 + (wc * 32 + 8 * fq + bj * HALF + 4 * n) * 4);
        f32x4 sv[2][2];
        if constexpr (I8) {
#pragma unroll
            for (int bj = 0; bj < 2; ++bj)
#pragma unroll
                for (int n = 0; n < 2; ++n) sv[bj][n] = *(const PG8_LAS f32x4*)(uintptr_t)(SB_LDS + u.idx * 1024 + (wc * 32 + 8 * fq + bj * HALF + 4 * n) * 4); }
#pragma unroll
        for (int ai = 0; ai < 2; ++ai)
#pragma unroll
            for (int m = 0; m < 4; ++m) { const int rowg = row0 + ai * HALF + m * 16;
                f16* rowp = TILED ? O + ((size_t)((rowg >> 8) * (ldc >> 6) + (col0 >> 6)) * 256 + (rowg & 255)) * 64 + (col0 & 63) : O + (size_t)rowg * ldc + (size_t)(rowg >> 12) * gap + col0; const float r = rs[ai][m];
#pragma unroll
                for (int bj = 0; bj < 2; ++bj) { f32x4 a0 = acc[ai][bj][m][0], a1 = acc[ai][bj][m][1];
                    if constexpr (I8) { const i32x4 i0 = __builtin_bit_cast(i32x4, a0), i1 = __builtin_bit_cast(i32x4, a1);
                        a0 = (f32x4){(float)i0.x, (float)i0.y, (float)i0.z, (float)i0.w} * sv[bj][0]; a1 = (f32x4){(float)i1.x, (float)i1.y, (float)i1.z, (float)i1.w} * sv[bj][1]; }
                    f32x4 v0 = a0 * r + cv[bj][0], v1 = a1 * r + cv[bj][1];
                    if (ACT == 1) {
#pragma unroll
                        for (int e = 0; e < 4; ++e) { const float a = fmaxf(v0[e], 0.f), b2 = fmaxf(v1[e], 0.f); v0[e] = a * a; v1[e] = b2 * b2; } }
                    u32x4 w; w.x = pk2h(v0[0], v0[1]); w.y = pk2h(v0[2], v0[3]); w.z = pk2h(v1[0], v1[1]); w.w = pk2h(v1[2], v1[3]);
                    gst16(rowp + (TILED ? bj * 2 * 256 * 64 : bj * HALF), w); } }
    }
};
template <bool I8> struct EpiGateMerge {
    static constexpr bool PERM = true, AFTER_DRAIN = false; static constexpr int NSTORE = 28;
    f16* Y; f16* merged;
    __device__ __forceinline__ void operator()(const f32x4 (&acc)[2][2][4][2], const Unit& u, int wr, int wc, int fr, int fq) const {
        const int br = u.pn >> 2, pc = u.pn & 3;
        const int row0 = u.pm * BM + wr * 64 + fr; const int col0 = pc * BM + wc * 32 + 8 * fq;
        if (br == 2) { __builtin_amdgcn_fence(__ATOMIC_ACQUIRE, "agent"); }
        const int b = (u.pm * BM) / SEQ; float rs[2][4]; row_rstd(u, wr, fr, rs);
        f32x4 bv[2][2];
#pragma unroll
        for (int bj = 0; bj < 2; ++bj)
#pragma unroll
            for (int n = 0; n < 2; ++n) bv[bj][n] = *(const PG8_LAS f32x4*)(uintptr_t)(CV_LDS + u.idx * 1024 + (wc * 32 + 8 * fq + bj * HALF + 4 * n) * 4);
        f32x4 sv[2][2];
        if constexpr (I8) {
#pragma unroll
            for (int bj = 0; bj < 2; ++bj)
#pragma unroll
                for (int n = 0; n < 2; ++n) sv[bj][n] = *(const PG8_LAS f32x4*)(uintptr_t)(SB_LDS + u.idx * 1024 + (wc * 32 + 8 * fq + bj * HALF + 4 * n) * 4); }
        f16* Yb = Y + (size_t)br * YSTR;
#pragma unroll
        for (int ai = 0; ai < 2; ++ai) {
            const int rowa = row0 + ai * HALF; const size_t offa = (size_t)rowa * 1024 + (size_t)(rowa >> 12) * GAPY + col0;
#pragma unroll
            for (int mp = 0; mp < 2; ++mp) {
            f16x8 yv[4][2];
#pragma unroll
            for (int m = 2 * mp; m < 2 * mp + 2; ++m)
#pragma unroll
                for (int bj = 0; bj < 2; ++bj) yv[m][bj] = *(const g_f16x8*)(Yb + offa + (size_t)m * 16 * 1024 + bj * HALF);
#pragma unroll
            for (int m = 2 * mp; m < 2 * mp + 2; ++m) { const size_t off = offa + (size_t)m * 16 * 1024;
                f16x8 za[2], zb[2];
                if (br == 2) {
#pragma unroll
                    for (int bj = 0; bj < 2; ++bj) { za[bj] = *(const g_f16x8*)(Y + off + bj * HALF); zb[bj] = *(const g_f16x8*)(Y + YSTR + off + bj * HALF); } }
#pragma unroll
                for (int bj = 0; bj < 2; ++bj) {
                    f32x4 a0 = acc[ai][bj][m][0], a1 = acc[ai][bj][m][1];
                    if constexpr (I8) { const i32x4 i0 = __builtin_bit_cast(i32x4, a0), i1 = __builtin_bit_cast(i32x4, a1);
                        a0 = (f32x4){(float)i0.x, (float)i0.y, (float)i0.z, (float)i0.w} * sv[bj][0]; a1 = (f32x4){(float)i1.x, (float)i1.y, (float)i1.z, (float)i1.w} * sv[bj][1]; }
                    const f32x4 g0 = a0 * rs[ai][m] + bv[bj][0], g1 = a1 * rs[ai][m] + bv[bj][1];
                    const f16x8 yy = yv[m][bj];
                    float z[8];
#pragma unroll
                    for (int e = 0; e < 4; ++e) { z[e] = (float)yy[e] * __builtin_amdgcn_rcpf(1.f + __builtin_amdgcn_exp2f(-LOG2E * g0[e])); z[4 + e] = (float)yy[4 + e] * __builtin_amdgcn_rcpf(1.f + __builtin_amdgcn_exp2f(-LOG2E * g1[e])); }
                    if (br == 2) {
#pragma unroll
                        for (int e = 0; e < 8; ++e) z[e] += (float)za[bj][e] + (float)zb[bj][e]; }
                    u32x4 w; w.x = pk2h(z[0], z[1]); w.y = pk2h(z[2], z[3]); w.z = pk2h(z[4], z[5]); w.w = pk2h(z[6], z[7]);
                    f16* dst = (br == 2) ? merged : Yb;
                    gst16(dst + off + bj * HALF, w); } } } }
    }
};
struct EpiResidual {
    static constexpr bool PERM = true, AFTER_DRAIN = false; static constexpr int NSTORE = 32;
    const f16* xin16; f16* out; const float* gate; int gpitch; f16* U; const float* nw; const float* nsc; float* SS;
    __device__ __forceinline__ void operator()(const f32x4 (&acc)[2][2][4][2], const Unit& u, int wr, int wc, int fr, int fq) const {
        const int col0 = u.pn * BM + wc * 32 + 8 * fq; const int b = (u.pm * BM) / SEQ;
        f32x4 gv[2][2], Gv[2][2];
#pragma unroll
        for (int bj = 0; bj < 2; ++bj)
#pragma unroll
            for (int n = 0; n < 2; ++n) gv[bj][n] = *(const g_f32x4*)(gate + (size_t)b * gpitch + col0 + bj * HALF + 4 * n);
        if (U) {
#pragma unroll
            for (int bj = 0; bj < 2; ++bj)
#pragma unroll
                for (int n = 0; n < 2; ++n) Gv[bj][n] = *(const g_f32x4*)(nw + col0 + bj * HALF + 4 * n) * (*(const g_f32x4*)(nsc + (size_t)b * gpitch + col0 + bj * HALF + 4 * n) + 1.f); }
#pragma unroll
        for (int ai = 0; ai < 2; ++ai) {
            const int rowa = u.pm * BM + ai * HALF + wr * 64 + fr;
            f16x8 xh[4][2];
#pragma unroll
            for (int m = 0; m < 4; ++m)
#pragma unroll
                for (int bj = 0; bj < 2; ++bj) xh[m][bj] = *(const g_f16x8*)(xin16 + (size_t)(rowa + m * 16) * DM + col0 + bj * HALF);
#pragma unroll
            for (int m = 0; m < 4; ++m) { const int row = rowa + m * 16; const size_t off = (size_t)row * DM + col0; float ss = 0.f;
#pragma unroll
                for (int bj = 0; bj < 2; ++bj) { const f16x8 h = xh[m][bj];
                    const f32x4 xn0 = (f32x4){(float)h[0], (float)h[1], (float)h[2], (float)h[3]} + gv[bj][0] * acc[ai][bj][m][0];
                    const f32x4 xn1 = (f32x4){(float)h[4], (float)h[5], (float)h[6], (float)h[7]} + gv[bj][1] * acc[ai][bj][m][1];
                    { u32x4 w; w.x = pk2h(xn0.x, xn0.y); w.y = pk2h(xn0.z, xn0.w); w.z = pk2h(xn1.x, xn1.y); w.w = pk2h(xn1.z, xn1.w); gst16(out + off + bj * HALF, w); }
                    if (U) { ss += ((xn0.x * xn0.x + xn0.y * xn0.y) + (xn0.z * xn0.z + xn0.w * xn0.w)) + ((xn1.x * xn1.x + xn1.y * xn1.y) + (xn1.z * xn1.z + xn1.w * xn1.w));
                        const f32x4 y0 = xn0 * Gv[bj][0], y1 = xn1 * Gv[bj][1];
                        u32x4 w; w.x = pk2h(y0.x, y0.y); w.y = pk2h(y0.z, y0.w); w.z = pk2h(y1.x, y1.y); w.w = pk2h(y1.z, y1.w); gst16(U + off + bj * HALF, w); } }
                if (U) { ss += __shfl_xor(ss, 16); ss += __shfl_xor(ss, 32); if (fq == 0) *(g_f32*)(SS + (size_t)row * 16 + u.pn * 4 + wc) = ss; } } }
    }
};

__device__ __forceinline__ unsigned sgpr_opaque(unsigned x) { asm volatile("" : "+s"(x)); return x; }
template <class Epi, class Sched, bool ALIGN_EPI = false, bool SP2 = false, bool I8 = false, bool ATILED = false>
__device__ __forceinline__ void gemm_phase(PG8_LAS unsigned char* lds, const Gemm g, const Sched& S, const Epi& E, const int wid) {
    const int lane = lane_id(), tid = wid * 64 + lane, wr = wid >> 2, wc = wid & 3, fr = lane & 15, fq = lane >> 4;
    const int K = g.K, nt = K / BK;
    unsigned voffA[2], voffB[2];
#pragma unroll
    for (int i = 0; i < 2; ++i) { int R, C; stage_rc(tid * 16 + i * 8192, R, C); const int Rb = Epi::PERM ? ((R & ~31) + perm32(R & 31)) : R;
        voffA[i] = (unsigned)(R * (ATILED ? BK : K) + C) * 2u; voffB[i] = (unsigned)(Rb * K + C) * 2u; }
    const unsigned kstep = (unsigned)(BK * 2);
    const unsigned hstep = (unsigned)HALF * K * 2;
    const unsigned tstep = 2 * hstep;
    const unsigned kstepA = ATILED ? (unsigned)(BM * BK * 2) : kstep, hstepA = ATILED ? (unsigned)(HALF * BK * 2) : hstep, tstepA = ATILED ? (unsigned)nt * (unsigned)(BM * BK * 2) : tstep;
    const __amdgpu_buffer_rsrc_t rsA = __builtin_amdgcn_make_buffer_rsrc((void*)g.A, 0, 0x7fffffff, 0x00020000), rsB = __builtin_amdgcn_make_buffer_rsrc((void*)g.Bt, 0, 0x7fffffff, 0x00020000);
    const unsigned ldsw = (unsigned)wid * 1024u;
    const int aoff = lds_byte(wr * 64 + fr, fq * 8), boff = lds_byte(wc * 32 + fr, fq * 8);
#define PG8_SA(b, h) (((b) * 2 + (h)) * HTB)
#define PG8_SB(b, h) ((4 + (b) * 2 + (h)) * HTB)
#define PG8_STAGE(bufoff, RS, soff, voff) do { _Pragma("unroll") for (int _i = 0; _i < 2; ++_i) \
        __builtin_amdgcn_raw_ptr_buffer_load_lds(RS, (PG8_LAS void*)(lds + (bufoff) + sgpr_opaque(ldsw) + _i * 8192), 16, (int)(voff)[_i], (int)(soff), 0, 0); } while (0)
#define PG8_LDA(dst, b, h) do { _Pragma("unroll") for (int m = 0; m < 4; ++m) _Pragma("unroll") for (int k = 0; k < 2; ++k) dst[m][k] = *(const PG8_LAS f16x8*)(lds + PG8_SA(b, h) + aoff + m * 2048 + k * 1024); } while (0)
#define PG8_LDB(dst, b, h) do { _Pragma("unroll") for (int n = 0; n < 2; ++n) _Pragma("unroll") for (int k = 0; k < 2; ++k) dst[n][k] = *(const PG8_LAS f16x8*)(lds + PG8_SB(b, h) + boff + n * 2048 + k * 1024); } while (0)
#define PG8_MMA(ai, bj, At, Bt) do { __builtin_amdgcn_s_setprio(1); _Pragma("unroll") for (int m = 0; m < 4; ++m) _Pragma("unroll") for (int n = 0; n < 2; ++n) _Pragma("unroll") for (int k = 0; k < 2; ++k) \
        { if constexpr (I8) acc[ai][bj][m][n] = __builtin_bit_cast(f32x4, __builtin_amdgcn_mfma_i32_16x16x64_i8(__builtin_bit_cast(i32x4, Bt[n][k]), __builtin_bit_cast(i32x4, At[m][k]), __builtin_bit_cast(i32x4, acc[ai][bj][m][n]), 0, 0, 0)); \
          else acc[ai][bj][m][n] = __builtin_amdgcn_mfma_f32_16x16x32_f16(Bt[n][k], At[m][k], acc[ai][bj][m][n], 0, 0, 0); } __builtin_amdgcn_s_setprio(0); } while (0)
#define PG8_WAIT_V(n) asm volatile("s_waitcnt vmcnt(" #n ")" ::: "memory")
#define PG8_WAIT_L(n) asm volatile("s_waitcnt lgkmcnt(" #n ")" ::: "memory")
#define PG8_BAR __builtin_amdgcn_s_barrier()
#define PG8_SCHED __builtin_amdgcn_sched_barrier(0)
    Unit cur, nxt; int ui = 0;
    if (!S.next(0, cur)) return;
    f32x4 acc[2][2][4][2];
#pragma unroll
    for (int a = 0; a < 2; ++a)
#pragma unroll
        for (int b = 0; b < 2; ++b)
#pragma unroll
            for (int m = 0; m < 4; ++m)
#pragma unroll
                for (int n = 0; n < 2; ++n) acc[a][b][m][n] = (f32x4){0.f, 0.f, 0.f, 0.f};
    f16x8 At[4][2], B0[2][2], B1[2][2];
    unsigned cA = (unsigned)cur.pm * tstepA + (unsigned)(cur.pm >> 4) * g.gapA, cB = (unsigned)cur.pn * tstep;
    S.a_ready(cur);
    if constexpr (SP2) {
        PG8_STAGE(PG8_SB(0, 0), rsB, cB, voffB); PG8_STAGE(PG8_SB(0, 1), rsB, cB + hstep, voffB); PG8_STAGE(PG8_SA(0, 0), rsA, cA, voffA); PG8_STAGE(PG8_SA(0, 1), rsA, cA + hstepA, voffA);
        if (wr == 1) PG8_BAR;
        PG8_WAIT_V(2); PG8_BAR;
        PG8_STAGE(PG8_SB(1, 0), rsB, cB + kstep, voffB); PG8_STAGE(PG8_SA(1, 0), rsA, cA + kstepA, voffA); PG8_STAGE(PG8_SB(1, 1), rsB, cB + hstep + kstep, voffB);
        PG8_WAIT_V(6); PG8_BAR;
    } else {
        PG8_STAGE(PG8_SB(0, 0), rsB, cB, voffB); PG8_STAGE(PG8_SA(0, 0), rsA, cA, voffA); PG8_STAGE(PG8_SB(0, 1), rsB, cB + hstep, voffB); PG8_STAGE(PG8_SA(0, 1), rsA, cA + hstepA, voffA);
        if (wr == 1) PG8_BAR;
        PG8_WAIT_V(4); PG8_BAR;
        PG8_STAGE(PG8_SB(1, 0), rsB, cB + kstep, voffB); PG8_STAGE(PG8_SA(1, 0), rsA, cA + kstepA, voffA); PG8_STAGE(PG8_SB(1, 1), rsB, cB + hstep + kstep, voffB);
        PG8_WAIT_V(6); PG8_BAR;
    }
    for (;;) {
        const bool has_next = S.next(ui + 1, nxt);
        const unsigned nA = has_next ? (unsigned)nxt.pm * tstepA + (unsigned)(nxt.pm >> 4) * g.gapA : cA, nB = has_next ? (unsigned)nxt.pn * tstep : cB;
        for (int t = 0; t < nt; t += 2) {
            const bool last = (t == nt - 2);
            const unsigned a1 = cA + (unsigned)(t + 1) * kstepA;
            const unsigned a2 = last ? nA : cA + (unsigned)(t + 2) * kstepA, b2 = last ? nB : cB + (unsigned)(t + 2) * kstep;
            const unsigned a3 = a2 + kstepA, b3 = b2 + kstep;
            if (last && has_next) S.a_ready(nxt);
            if constexpr (SP2) {
            const int grace = __builtin_amdgcn_readfirstlane((PG8_GRACE && Epi::NSTORE > 0 && t == 0 && ui > 0) ? 1 : 0);
#define PG8_WAIT_VG do { if constexpr (PG8_GRACE && Epi::NSTORE > 0) asm volatile("s_cmp_lg_u32 %0, 0\n\ts_cbranch_scc1 .Lgr%=\n\ts_waitcnt vmcnt(8)\n.Lgr%=:\n\ts_waitcnt vmcnt(%1)" :: "s"(grace), "n"(8 + Epi::NSTORE) : "memory", "scc"); \
                         else PG8_WAIT_V(8); } while (0)
            PG8_LDB(B0, 0, 0); PG8_LDB(B1, 0, 1); PG8_SCHED; PG8_LDA(At, 0, 0); PG8_STAGE(PG8_SA(1, 1), rsA, a1 + hstepA, voffA);
            PG8_WAIT_VG; PG8_WAIT_L(0); PG8_BAR; PG8_MMA(0, 0, At, B0); PG8_MMA(0, 1, At, B1); PG8_BAR; PG8_SCHED;
            PG8_LDA(At, 0, 1); PG8_STAGE(PG8_SB(0, 0), rsB, b2, voffB); PG8_STAGE(PG8_SB(0, 1), rsB, b2 + hstep, voffB); PG8_STAGE(PG8_SA(0, 0), rsA, a2, voffA);
            PG8_WAIT_VG; PG8_WAIT_L(0); PG8_BAR; PG8_MMA(1, 0, At, B0); PG8_MMA(1, 1, At, B1); PG8_BAR; PG8_SCHED;
            PG8_LDB(B0, 1, 0); PG8_LDB(B1, 1, 1); PG8_SCHED; PG8_LDA(At, 1, 0); PG8_STAGE(PG8_SA(0, 1), rsA, a2 + hstepA, voffA);
            PG8_WAIT_VG; PG8_WAIT_L(0); PG8_BAR; PG8_MMA(0, 0, At, B0); PG8_MMA(0, 1, At, B1); PG8_BAR; PG8_SCHED;
            PG8_LDA(At, 1, 1); PG8_STAGE(PG8_SB(1, 0), rsB, b3, voffB); PG8_STAGE(PG8_SB(1, 1), rsB, b3 + hstep, voffB); PG8_STAGE(PG8_SA(1, 0), rsA, a3, voffA);
            PG8_WAIT_VG; PG8_WAIT_L(0); PG8_BAR; PG8_MMA(1, 0, At, B0); PG8_MMA(1, 1, At, B1); PG8_BAR; PG8_SCHED;
#undef PG8_WAIT_VG
            } else {
            PG8_LDB(B0, 0, 0); PG8_SCHED; PG8_LDA(At, 0, 0); PG8_STAGE(PG8_SA(1, 1), rsA, a1 + hstepA, voffA);
            PG8_WAIT_L(8); PG8_BAR; PG8_WAIT_L(0); PG8_MMA(0, 0, At, B0); PG8_BAR; PG8_SCHED;
            PG8_LDB(B1, 0, 1); PG8_STAGE(PG8_SB(0, 0), rsB, b2, voffB);
            PG8_BAR; PG8_WAIT_L(0); PG8_MMA(0, 1, At, B1); PG8_BAR;
            PG8_LDA(At, 0, 1); PG8_STAGE(PG8_SA(0, 0), rsA, a2, voffA);
            PG8_BAR; PG8_WAIT_L(0); PG8_MMA(1, 0, At, B0); PG8_BAR; PG8_SCHED;
            PG8_STAGE(PG8_SB(0, 1), rsB, b2 + hstep, voffB);
            PG8_WAIT_V(6); PG8_BAR; PG8_MMA(1, 1, At, B1); PG8_BAR;
            PG8_LDB(B0, 1, 0); PG8_SCHED; PG8_LDA(At, 1, 0); PG8_STAGE(PG8_SA(0, 1), rsA, a2 + hstepA, voffA);
            PG8_WAIT_L(8); PG8_BAR; PG8_WAIT_L(0); PG8_MMA(0, 0, At, B0); PG8_BAR; PG8_SCHED;
            PG8_LDB(B1, 1, 1); PG8_STAGE(PG8_SB(1, 0), rsB, b3, voffB);
            PG8_BAR; PG8_WAIT_L(0); PG8_MMA(0, 1, At, B1); PG8_BAR;
            PG8_LDA(At, 1, 1); PG8_STAGE(PG8_SA(1, 0), rsA, a3, voffA);
            PG8_BAR; PG8_WAIT_L(0); PG8_MMA(1, 0, At, B0); PG8_BAR; PG8_SCHED;
            PG8_STAGE(PG8_SB(1, 1), rsB, b3 + hstep, voffB);
            PG8_WAIT_V(6); PG8_BAR; PG8_MMA(1, 1, At, B1); PG8_BAR;
            }
        }
        if constexpr (ALIGN_EPI) { if (wr == 0) PG8_BAR; }
        if constexpr (!Epi::AFTER_DRAIN) { E(acc, cur, wr, wc, fr, fq); S.done(cur); }
        if (!has_next) break;
#pragma unroll
        for (int a = 0; a < 2; ++a)
#pragma unroll
            for (int b = 0; b < 2; ++b)
#pragma unroll
                for (int m = 0; m < 4; ++m)
#pragma unroll
                    for (int n = 0; n < 2; ++n) acc[a][b][m][n] = (f32x4){0.f, 0.f, 0.f, 0.f};
        cur = nxt; cA = nA; cB = nB; ++ui;
        if constexpr (ALIGN_EPI) { if (wr == 1) PG8_BAR; }
    }
    PG8_WAIT_V(0);
    if constexpr (!ALIGN_EPI) { if (wr == 0) PG8_BAR; }
    PG8_BAR;
#undef PG8_SA
#undef PG8_SB
#undef PG8_STAGE
#undef PG8_LDA
#undef PG8_LDB
#undef PG8_MMA
#undef PG8_WAIT_V
#undef PG8_WAIT_L
#undef PG8_BAR
#undef PG8_SCHED
}
}

constexpr size_t MiB = 1u << 20;
constexpr size_t WS_CTL = 0, CTL_ZERO_BYTES = 1 * MiB;
constexpr size_t WS_MOD = 1 * MiB;
constexpr size_t WS_MISC = 2 * MiB;
constexpr size_t WS_WIN = 4 * MiB;
constexpr size_t WS_WG = 18 * MiB;
constexpr size_t WS_WA = 30 * MiB;
constexpr size_t WS_WBC = 32 * MiB;
constexpr size_t WS_WC = 34 * MiB;
constexpr size_t WS_WO = 36 * MiB;
constexpr size_t WS_W1 = 40 * MiB;
constexpr size_t WS_W2 = 56 * MiB;
constexpr size_t WS_U = 72 * MiB;
constexpr size_t WS_KVN = 136 * MiB;
constexpr size_t WS_MASK = 144 * MiB;
constexpr size_t WS_OA = 152 * MiB;
constexpr size_t WS_OB = 184 * MiB;
constexpr size_t WS_OC = 216 * MiB;
constexpr size_t WS_R1 = 232 * MiB;
constexpr size_t WS_SS = 488 * MiB;
constexpr size_t WS_WQG = 490 * MiB;
constexpr size_t WS_WQIN = 496 * MiB;
constexpr size_t WS_WQ1 = 503 * MiB;
constexpr size_t WS_END = 511 * MiB;
constexpr size_t WS_CVEC = WS_MISC + 256 * 1024;
constexpr size_t WS_SB = WS_MISC + 1792 * 1024;
constexpr int CW_CMAX = 65536  , CW_RF = 131072  ;
constexpr int CW_TMO = 0, CW_BAR = 4096, CW_QUEUE = 16384;

constexpr int NWAVES = 8;
constexpr int RING_BYTES = 131072, LDSCTL_OFF = 139264, MISC_OFF = LDSCTL_OFF + 320, LDS_BYTES = LDSCTL_OFF + 24576;

#define RLX_AGENT __ATOMIC_RELAXED, __HIP_MEMORY_SCOPE_AGENT
#define LDS_WAIT() asm volatile("s_waitcnt lgkmcnt(0)" ::: "memory")

#define XB_TMO      128
#define XB_XCNT(j)  (256  + 64 * (j))
#define XB_XSUB(j)  (1280 + 64 * (j))
#define XB_XGEN(j)  (2304 + 64 * (j))
#define XB_TOP      3328
#define XB_TOPGEN   3392
#define XCD_BAR_WORDS 3456
#define XB_SPIN_CAP (1u << 22)
__device__ __forceinline__ unsigned xb_ld(unsigned* p)              { return __hip_atomic_load(p, __ATOMIC_RELAXED, __HIP_MEMORY_SCOPE_AGENT); }
__device__ __forceinline__ unsigned xb_add(unsigned* p, unsigned v) { return __hip_atomic_fetch_add(p, v, __ATOMIC_RELAXED, __HIP_MEMORY_SCOPE_AGENT); }
__device__ __forceinline__ unsigned xb_xcc_id() { return (unsigned)__builtin_amdgcn_s_getreg((3 << 11) | 20) & 0xFu; }
__device__ __forceinline__ int xq_take(unsigned* ctr, const int per, volatile LAS unsigned* misc) {
    __syncthreads();
    if (threadIdx.x == 0) { unsigned q = misc[17]; int res = -1; const unsigned x = xb_xcc_id();
        while (q < 8u) { const unsigned xx = (x + q) & 7u; const unsigned v = __hip_atomic_fetch_add(ctr + 64 * xx, 1u, __ATOMIC_RELAXED, __HIP_MEMORY_SCOPE_AGENT);
            if (v < (unsigned)per) { res = (int)(xx * (unsigned)per + v); break; } ++q; }
        misc[17] = q; misc[16] = (unsigned)res; }
    __syncthreads();
    return __builtin_amdgcn_readfirstlane((int)misc[16]);
}
__device__ __forceinline__ int unit_pick(const int k, const int per, unsigned* ctr, volatile LAS unsigned* misc) {
    if (gridDim.x == 256u) { __syncthreads(); if (k >= (per >> 5)) return -1;
        const int s_ = (int)(blockIdx.x >> 3), x_ = (int)(blockIdx.x & 7u); return x_ * per + (k >> 1) * 64 + ((k & 1) ? 63 - s_ : s_); }
    return xq_take(ctr, per, misc);
}
#define XB_SPIN(cond, bar) do { unsigned _sp = 0; while (cond) { __builtin_amdgcn_s_sleep(1); \
    if ((++_sp & 255u) == 0u) { if (xb_ld(&(bar)[XB_TMO])) break; if (_sp > XB_SPIN_CAP) { atomicAdd(&(bar)[XB_TMO], 1u); break; } } } } while (0)
struct XcdBarrier { unsigned* bar; unsigned x; volatile LAS unsigned* st; };
__device__ __forceinline__ XcdBarrier xcd_barrier_post(unsigned* bar, volatile LAS unsigned* st, int wave) {
    XcdBarrier b; b.bar = bar; b.x = xb_xcc_id(); b.st = st;
    if (wave == 0 && lane_id() == 0) (void)xb_add(&bar[XB_XCNT(b.x)], 1u);
    return b;
}
__device__ __forceinline__ void xcd_barrier_complete(unsigned* bar, unsigned x, unsigned& nloc, unsigned& nx) {
    const unsigned G = gridDim.x * gridDim.y * gridDim.z;
    unsigned sum, cnt, mine, sp = 0u;
    for (;;) {
        sum = 0u; cnt = 0u; mine = 0u;
#pragma unroll
        for (unsigned j = 0; j < 16; ++j) { const unsigned c = xb_ld(&bar[XB_XCNT(j)]); sum += c; cnt += (c > 0u) ? 1u : 0u; mine = (j == x) ? c : mine; }
        if (sum == G) break;
        __builtin_amdgcn_s_sleep(1);
        if ((++sp & 255u) == 0u) { if (xb_ld(&bar[XB_TMO])) break; if (sp > XB_SPIN_CAP) { atomicAdd(&bar[XB_TMO], 1u); break; } }
    }
    nloc = mine > 0u ? mine : 1u; nx = cnt > 0u ? cnt : 1u;
}
__device__ __forceinline__ void xcd_barrier(const XcdBarrier& b, int wave) {
    asm volatile("s_waitcnt vmcnt(0)" ::: "memory");
    __syncthreads();
    if (wave == 0 && lane_id() == 0) {
        unsigned* bar = b.bar; asm volatile("" : "+s"(bar)); unsigned bx = b.x; asm volatile("" : "+s"(bx));
        __builtin_amdgcn_s_waitcnt(0);
        unsigned nloc = b.st[0], nx = b.st[1];
        if (nloc == 0u) { xcd_barrier_complete(bar, bx, nloc, nx); b.st[0] = nloc; b.st[1] = nx; }
        const unsigned old = xb_add(&bar[XB_XSUB(bx)], 1u);
        const unsigned gen = old / nloc;
        if (old + 1u == (gen + 1u) * nloc) {
            __builtin_amdgcn_fence(__ATOMIC_RELEASE, "agent");
            asm volatile("s_waitcnt vmcnt(0)" ::: "memory");
            const unsigned og = xb_add(&bar[XB_TOP], 1u);
            const unsigned tg = og / nx;
            __builtin_amdgcn_fence(__ATOMIC_ACQUIRE, "agent");
            if (og + 1u == (tg + 1u) * nx) xb_add(&bar[XB_TOPGEN], 1u);
            else XB_SPIN(xb_ld(&bar[XB_TOPGEN]) == tg, bar);
            xb_add(&bar[XB_XGEN(bx)], 1u);
            asm volatile("s_waitcnt vmcnt(0)" ::: "memory");
        } else {
            __builtin_amdgcn_fence(__ATOMIC_ACQUIRE, "agent");
            XB_SPIN(xb_ld(&bar[XB_XGEN(bx)]) == gen, bar);
            asm volatile("s_waitcnt vmcnt(0)" ::: "memory");
        }
    }
    __syncthreads();
}

constexpr int CW_LB = 200000;
__device__ __forceinline__ void xcd_local_barrier(unsigned* lb, const XcdBarrier& b, int wave) {
    asm volatile("s_waitcnt vmcnt(0)" ::: "memory");
    __syncthreads();
    if (wave == 0 && lane_id() == 0) {
        unsigned* lbp = lb; asm volatile("" : "+s"(lbp));
        const unsigned x = blockIdx.x & 7u; unsigned* cnt = lbp + 64u * x; unsigned* gen = lbp + 64u * (8u + x);
        __builtin_amdgcn_s_waitcnt(0);
        const unsigned g = b.st[3];
        const unsigned old = xb_add(cnt, 1u);
        __builtin_amdgcn_fence(__ATOMIC_ACQUIRE, "agent");
        if (old + 1u == (g + 1u) * 32u) xb_add(gen, 1u);
        else XB_SPIN(xb_ld(gen) == g, b.bar);
        b.st[3] = g + 1u;
        asm volatile("s_waitcnt vmcnt(0)" ::: "memory");
    }
    __syncthreads();
}
__device__ __forceinline__ void xcd_local_arrive(unsigned* lb, const XcdBarrier& b, int wave) {
    asm volatile("s_waitcnt vmcnt(0)" ::: "memory");
    __syncthreads();
    if (wave == 0 && lane_id() == 0) {
        unsigned* lbp = lb; asm volatile("" : "+s"(lbp));
        const unsigned x = blockIdx.x & 7u; unsigned* cnt = lbp + 64u * x; unsigned* gen = lbp + 64u * (8u + x);
        __builtin_amdgcn_s_waitcnt(0);
        const unsigned g = b.st[3];
        const unsigned old = xb_add(cnt, 1u);
        if (old + 1u == (g + 1u) * 32u) xb_add(gen, 1u);
        asm volatile("s_waitcnt vmcnt(0)" ::: "memory");
    }
}
__device__ __forceinline__ void xcd_local_wait(unsigned* lb, const XcdBarrier& b, int wave) {
    asm volatile("s_waitcnt vmcnt(0)" ::: "memory");
    __syncthreads();
    if (wave == 0 && lane_id() == 0) {
        unsigned* lbp = lb; asm volatile("" : "+s"(lbp));
        const unsigned x = blockIdx.x & 7u; unsigned* gen = lbp + 64u * (8u + x);
        __builtin_amdgcn_s_waitcnt(0);
        const unsigned g = b.st[3];
        __builtin_amdgcn_fence(__ATOMIC_ACQUIRE, "agent");
        XB_SPIN(xb_ld(gen) == g, b.bar);
        b.st[3] = g + 1u;
        asm volatile("s_waitcnt vmcnt(0)" ::: "memory");
    }
    __syncthreads();
}
#define DPP_F(v, ctrl) __builtin_bit_cast(float, __builtin_amdgcn_update_dpp(0, __builtin_bit_cast(int, (v)), (ctrl), 0xf, 0xf, false))
__device__ __forceinline__ float row16_sum(float v) { v += DPP_F(v, 0xB1); v += DPP_F(v, 0x4E); v += DPP_F(v, 0x141); v += DPP_F(v, 0x140); return v; }
__device__ __forceinline__ float row16_max(float v) { v = fmaxf(v, DPP_F(v, 0xB1)); v = fmaxf(v, DPP_F(v, 0x4E)); v = fmaxf(v, DPP_F(v, 0x141)); v = fmaxf(v, DPP_F(v, 0x140)); return v; }
__device__ __forceinline__ float wave_sum(float v) {
    v = row16_sum(v); const int b = __builtin_bit_cast(int, v);
    const float r0 = __builtin_bit_cast(float, __builtin_amdgcn_readlane(b, 0)), r1 = __builtin_bit_cast(float, __builtin_amdgcn_readlane(b, 16)), r2 = __builtin_bit_cast(float, __builtin_amdgcn_readlane(b, 32)), r3 = __builtin_bit_cast(float, __builtin_amdgcn_readlane(b, 48));
    return (r0 + r1) + (r2 + r3);
}
__device__ __forceinline__ float wave_max(float v) {
    v = row16_max(v); const int b = __builtin_bit_cast(int, v);
    const float r0 = __builtin_bit_cast(float, __builtin_amdgcn_readlane(b, 0)), r1 = __builtin_bit_cast(float, __builtin_amdgcn_readlane(b, 16)), r2 = __builtin_bit_cast(float, __builtin_amdgcn_readlane(b, 32)), r3 = __builtin_bit_cast(float, __builtin_amdgcn_readlane(b, 48));
    return fmaxf(fmaxf(r0, r1), fmaxf(r2, r3));
}
__device__ __forceinline__ int wave_isum(int v) {
#pragma unroll
    for (int o = 1; o < 64; o <<= 1) v += __shfl_xor(v, o);
    return v;
}

__device__ __forceinline__ int t5_bucket(int n) {
    if (n < 16) return n;
    if (n >= 113) return 31;
    const int first[16] = {16, 19, 21, 24, 27, 31, 35, 40, 46, 52, 59, 67, 77, 87, 99, 113};
    int b = 16;
#pragma unroll
    for (int i = 1; i < 16; ++i) b += (n >= first[i]) ? 1 : 0;
    return b;
}

struct Frame {
    LAS unsigned char* lds;
    int wave, gw, NGW, G;
};

template <class ScaleFn>
__device__ __forceinline__ void transpose_item(const float* W, int ldw, int col0, int nvalid, int K, f16* WT, int nblk, LAS float* scr, int item, int lane, ScaleFn sf, unsigned* cmax = nullptr) {
    const int kb = item / nblk, nb = item % nblk, k0 = 64 * kb, n0 = 32 * nb;
    const int nn = n0 + (lane & 31);
    const bool ok = nn < nvalid;
    const float sc = sf(nn);
    float wv[32];
#pragma unroll
    for (int i = 0; i < 32; ++i) { const int kk = 2 * i + (lane >> 5); wv[i] = ok ? *(const GAS float*)(W + (size_t)(k0 + kk) * ldw + col0 + nn) : 0.f; }
#pragma unroll
    for (int i = 0; i < 32; ++i) { const int kk = 2 * i + (lane >> 5); scr[kk * 33 + (lane & 31)] = wv[i] * sc; }
    if (cmax) { float mx = 0.f;
#pragma unroll
        for (int i = 0; i < 32; ++i) mx = fmaxf(mx, __builtin_fabsf(wv[i] * sc));
        mx = fmaxf(mx, __shfl_xor(mx, 32));
        if (lane < 32) __hip_atomic_fetch_max(cmax + nn, __float_as_uint(mx), __ATOMIC_RELAXED, __HIP_MEMORY_SCOPE_AGENT); }
    LDS_WAIT(); asm volatile("" ::: "memory");
    const int c = lane & 7;
#pragma unroll
    for (int j = 0; j < 4; ++j) { const int n = (lane >> 3) + 8 * j; const LAS float* s = scr + (8 * c) * 33 + n;
        u32x4 o; o.x = pk2h(s[0 * 33], s[1 * 33]); o.y = pk2h(s[2 * 33], s[3 * 33]); o.z = pk2h(s[4 * 33], s[5 * 33]); o.w = pk2h(s[6 * 33], s[7 * 33]);
        *(u32x4*)(WT + (size_t)(n0 + n) * K + k0 + 8 * c) = o; }
    LDS_WAIT(); asm volatile("" ::: "memory");
}
struct TItem { const float* W; int ldw, col0, nvalid, K; f16* WT; int nblk; unsigned* cmax; int item; bool scale_in, tiled; };
struct ScaleOne { __device__ __forceinline__ float operator()(int) const { return 1.f; } };
struct ScaleIn {
    __device__ __forceinline__ float operator()(int n) const {
        if (n < 512) return 0.125f * LOG2E;
        if (n >= C_BQ && n < C_BKV) return 0.08838834764831845f * LOG2E;
        if (n >= C_CQ && n < C_CK) return 0.125f * LOG2E;
        return 1.f; }
};
__device__ __forceinline__ void titem_load(const TItem& d, int lane, float (&wv)[32], float& sc) {
    const int kb = d.item / d.nblk, nb = d.item % d.nblk, k0 = 64 * kb, nn = 32 * nb + (lane & 31);
    const bool ok = nn < d.nvalid;
    sc = d.scale_in ? ScaleIn()(nn) : 1.f;
#pragma unroll
    for (int i = 0; i < 32; ++i) { const int kk = 2 * i + (lane >> 5); wv[i] = ok ? *(const GAS float*)(d.W + (size_t)(k0 + kk) * d.ldw + d.col0 + nn) : 0.f; }
}
__device__ __forceinline__ void titem_store(const TItem& d, int lane, const float (&wv)[32], const float sc, LAS float* scr) {
    const int kb = d.item / d.nblk, nb = d.item % d.nblk, k0 = 64 * kb, n0 = 32 * nb, nn = n0 + (lane & 31);
#pragma unroll
    for (int i = 0; i < 32; ++i) { const int kk = 2 * i + (lane >> 5); scr[kk * 33 + (lane & 31)] = wv[i] * sc; }
    if (d.cmax) { float mx = 0.f;
#pragma unroll
        for (int i = 0; i < 32; ++i) mx = fmaxf(mx, __builtin_fabsf(wv[i] * sc));
        mx = fmaxf(mx, __shfl_xor(mx, 32));
        if (lane < 32) __hip_atomic_fetch_max(d.cmax + nn, __float_as_uint(mx), __ATOMIC_RELAXED, __HIP_MEMORY_SCOPE_AGENT); }
    LDS_WAIT(); asm volatile("" ::: "memory");
    const int c = lane & 7;
#pragma unroll
    for (int j = 0; j < 4; ++j) { const int n = (lane >> 3) + 8 * j; const LAS float* sp = scr + (8 * c) * 33 + n;
        u32x4 o; o.x = pk2h(sp[0 * 33], sp[1 * 33]); o.y = pk2h(sp[2 * 33], sp[3 * 33]); o.z = pk2h(sp[4 * 33], sp[5 * 33]); o.w = pk2h(sp[6 * 33], sp[7 * 33]);
        if (d.tiled) *(u32x4*)(d.WT + ((size_t)(((n0 + n) >> 8) * (d.K >> 6) + kb) * 256 + ((n0 + n) & 255)) * 64 + 8 * c) = o;
        else *(u32x4*)(d.WT + (size_t)(n0 + n) * d.K + k0 + 8 * c) = o; }
    LDS_WAIT(); asm volatile("" ::: "memory");
}

__device__ __forceinline__ void norm_row_pre(const float* xrow, const float* g, const float* scale, f16* orow, f16* x16row, float* ssrow, int lane) {
    const f32x4* xr = (const f32x4*)xrow + lane;
    f32x4 v[4]; float s = 0.f;
#pragma unroll
    for (int j = 0; j < 4; ++j) { v[j] = xr[64 * j]; s += (v[j].x * v[j].x + v[j].y * v[j].y) + (v[j].z * v[j].z + v[j].w * v[j].w); }
    s = wave_sum(s);
#pragma unroll
    for (int j = 0; j < 4; ++j) {
        const f32x4 gv = ((const f32x4*)g)[lane + 64 * j], sc = ((const f32x4*)scale)[lane + 64 * j];
        const f32x4 y = v[j] * gv * (sc + 1.f);
        u32x2 w; w.x = pk2h(y.x, y.y); w.y = pk2h(y.z, y.w);
        ((u32x2*)orow)[lane + 64 * j] = w;
        u32x2 wx; wx.x = pk2h(v[j].x, v[j].y); wx.y = pk2h(v[j].z, v[j].w);
        ((u32x2*)x16row)[lane + 64 * j] = wx; }
    if (lane < 4) ((f32x4*)ssrow)[lane] = (f32x4){lane == 0 ? s : 0.f, 0.f, 0.f, 0.f};
}

__device__ __forceinline__ void nq_gain(const float* g, const float* scale, int lane, float (&gl)[16]) {
#pragma unroll
    for (int c = 0; c < 2; ++c)
#pragma unroll
        for (int h = 0; h < 2; ++h) { const f32x4 gv = *(const GAS f32x4*)(g + 512 * c + 8 * lane + 4 * h), sc = *(const GAS f32x4*)(scale + 512 * c + 8 * lane + 4 * h);
#pragma unroll
            for (int e = 0; e < 4; ++e) gl[8 * c + 4 * h + e] = gv[e] * (sc[e] + 1.f); }
}
__device__ __forceinline__ void nq_finish(const float (&y)[16], float ss, float am, unsigned char* qrow, float* rowfac, int lane) {
    ss = wave_sum(ss); am = wave_max(am);
    const float inv = am > 0.f ? 127.f / am : 0.f;
#pragma unroll
    for (int c = 0; c < 2; ++c) { u32x2 pk; pk.x = 0u; pk.y = 0u;
#pragma unroll
        for (int e = 0; e < 4; ++e) { pk.x |= ((unsigned)(int)__builtin_rintf(y[8 * c + e] * inv) & 255u) << (8 * e); pk.y |= ((unsigned)(int)__builtin_rintf(y[8 * c + 4 + e] * inv) & 255u) << (8 * e); }
        *(GAS u32x2*)(qrow + 512 * c + 8 * lane) = pk; }
    if (lane == 0) *rowfac = am * (1.f / 127.f) * __builtin_amdgcn_rsqf(ss * (1.f / DM) + EPS);
}
__device__ __forceinline__ void norm_quant_rows16(const f16* x16, const float* g, const float* scale, unsigned char* q8, float* rowfac, int m0, int lane) {
    float gl[16]; nq_gain(g, scale, lane, gl);
    u32x4 nx[2];
#pragma unroll
    for (int c = 0; c < 2; ++c) nx[c] = *(const GAS u32x4*)(x16 + (size_t)m0 * DM + 512 * c + 8 * lane);
#pragma unroll 1
    for (int r = 0; r < 16; ++r) { const int m = m0 + r;
        const f16x8 xa = __builtin_bit_cast(f16x8, nx[0]), xb = __builtin_bit_cast(f16x8, nx[1]);
        if (r + 1 < 16) {
#pragma unroll
            for (int c = 0; c < 2; ++c) nx[c] = *(const GAS u32x4*)(x16 + (size_t)(m + 1) * DM + 512 * c + 8 * lane); }
        float y[16]; float ss = 0.f, am = 0.f;
#pragma unroll
        for (int e = 0; e < 8; ++e) { const float x0 = (float)xa[e], x1 = (float)xb[e]; ss += x0 * x0 + x1 * x1; y[e] = x0 * gl[e]; y[8 + e] = x1 * gl[8 + e]; am = fmaxf(am, fmaxf(__builtin_fabsf(y[e]), __builtin_fabsf(y[8 + e]))); }
        nq_finish(y, ss, am, q8 + (size_t)m * DM, rowfac + m, lane); }
}
__device__ __forceinline__ void norm_quant_rows16_0(const float* x, const float* g, const float* scale, f16* x16, unsigned char* q8, float* rowfac, int m0, int lane) {
    float gl[16]; nq_gain(g, scale, lane, gl);
    f32x4 nx[4];
#pragma unroll
    for (int c = 0; c < 2; ++c)
#pragma unroll
        for (int h = 0; h < 2; ++h) nx[2 * c + h] = *(const GAS f32x4*)(x + (size_t)m0 * DM + 512 * c + 8 * lane + 4 * h);
#pragma unroll 1
    for (int r = 0; r < 16; ++r) { const int m = m0 + r;
        f32x4 xa[4];
#pragma unroll
        for (int i = 0; i < 4; ++i) xa[i] = nx[i];
        if (r + 1 < 16) {
#pragma unroll
            for (int c = 0; c < 2; ++c)
#pragma unroll
                for (int h = 0; h < 2; ++h) nx[2 * c + h] = *(const GAS f32x4*)(x + (size_t)(m + 1) * DM + 512 * c + 8 * lane + 4 * h); }
        float y[16]; float ss = 0.f, am = 0.f;
#pragma unroll
        for (int c = 0; c < 2; ++c) { u32x4 w; w.x = pk2h(xa[2 * c].x, xa[2 * c].y); w.y = pk2h(xa[2 * c].z, xa[2 * c].w); w.z = pk2h(xa[2 * c + 1].x, xa[2 * c + 1].y); w.w = pk2h(xa[2 * c + 1].z, xa[2 * c + 1].w);
            *(GAS u32x4*)(x16 + (size_t)m * DM + 512 * c + 8 * lane) = w;
#pragma unroll
            for (int h = 0; h < 2; ++h)
#pragma unroll
                for (int e = 0; e < 4; ++e) { const float xx = xa[2 * c + h][e]; ss += xx * xx; const float v = xx * gl[8 * c + 4 * h + e]; y[8 * c + 4 * h + e] = v; am = fmaxf(am, __builtin_fabsf(v)); } }
        nq_finish(y, ss, am, q8 + (size_t)m * DM, rowfac + m, lane); }
}

template <int DQK, int DV>
__device__ __forceinline__ void naive_attn(LAS float* scl  , const f16* q, const f16* Kb, int kpitch, const f16* Vb, int vpitch, int t, unsigned sel, const float* tab, int lane, float (&o)[DV / 64]) {
    const int nslots = (t >> 6) + 1;
    float mx = -INFINITY;
#pragma unroll 1
    for (int j = 0; j < nslots; ++j) {
        float s = -INFINITY; const int k = 64 * j + lane;
        if (k <= t && ((sel >> j) & 1u)) {
            const f16* kr = Kb + (size_t)k * kpitch; float a = 0.f;
#pragma unroll 4
            for (int c = 0; c < DQK / 8; ++c) { const f16x8 kv = *(const f16x8*)(kr + 8 * c); const f16x8 qv = *(const f16x8*)(q + 8 * c);
#pragma unroll
                for (int e = 0; e < 8; ++e) a += (float)kv[e] * (float)qv[e]; }
            const int dist = t - k; s = a + tab[(dist < 128 ? dist : 128) + 255];
        }
        scl[k] = s; mx = fmaxf(mx, s);
    }
    mx = wave_max(mx);
    float l = 0.f;
#pragma unroll 1
    for (int j = 0; j < nslots; ++j) { const float p = __builtin_amdgcn_exp2f(scl[64 * j + lane] - mx); scl[64 * j + lane] = p; l += p; }
    l = wave_sum(l);
    const float inv = 1.f / l;
#pragma unroll
    for (int i = 0; i < DV / 64; ++i) o[i] = 0.f;
    LDS_WAIT(); asm volatile("" ::: "memory");
#pragma unroll 1
    for (int k = 0; k < 64 * nslots; k += 4) {
        const f32x4 p = *(const LAS f32x4*)(scl + k);
        if (p.x != 0.f || p.y != 0.f || p.z != 0.f || p.w != 0.f) { const f16* vr = Vb + (size_t)k * vpitch;
            float v[4][DV / 64];
#pragma unroll
            for (int r = 0; r < 4; ++r)
#pragma unroll
                for (int i = 0; i < DV / 64; ++i) v[r][i] = (float)vr[(size_t)r * vpitch + lane + 64 * i];
#pragma unroll
            for (int i = 0; i < DV / 64; ++i) o[i] += (p.x * v[0][i] + p.y * v[1][i]) + (p.z * v[2][i] + p.w * v[3][i]); }
    }
#pragma unroll
    for (int i = 0; i < DV / 64; ++i) o[i] *= inv;
    LDS_WAIT(); asm volatile("" ::: "memory");
}

__device__ __forceinline__ unsigned char* launder(unsigned char* p) { asm volatile("" : "+s"(p)); return p; }
__device__ __forceinline__ int launder_i(int v) { asm volatile("" : "+s"(v)); return v; }
constexpr int PTAB_OFF = LDSCTL_OFF + 512;
__device__ __forceinline__ const float* inptr(LAS unsigned char* lds, int i) {
    unsigned saddr = (unsigned)(uintptr_t)(lds + PTAB_OFF) + 8u * (unsigned)i, addr;
    asm volatile("v_mov_b32 %0, %1" : "=v"(addr) : "s"(saddr));
    const unsigned long long v = *(volatile LAS unsigned long long*)(uintptr_t)addr;
    const unsigned lo = __builtin_amdgcn_readfirstlane((unsigned)v), hi = __builtin_amdgcn_readfirstlane((unsigned)(v >> 32));
    return (const float*)(((unsigned long long)hi << 32) | lo);
}
__device__ __forceinline__ unsigned ordkey(float f) { const unsigned u = __float_as_uint(f); return u ^ ((unsigned)((int)u >> 31) | 0x80000000u); }

namespace fa {
typedef float f32x16 __attribute__((ext_vector_type(16)));
typedef short v4i16_t __attribute__((ext_vector_type(4)));
__device__ __forceinline__ int crow(int r, int hi) { return (r & 3) + 8 * (r >> 2) + 4 * hi; }
constexpr int TAB_OFF = 139264 + 1024;
constexpr int SUB_OFF = TAB_OFF + 10240;
constexpr int STASH_OFF = 73728;
template <int DQK, int DV, bool KVSAME> struct Lay {
    static constexpr int RSK = DQK * 2 + 16, RSV = DV * 2 + 64;
    static constexpr int KBUF = 64 * RSK, VBUF = 64 * RSV;
    static constexpr int VOFF0 = 2 * KBUF, END = 2 * KBUF + 2 * VBUF;
    static constexpr int NKC = DQK / 64, NVC = KVSAME ? 0 : DV / 64;
    static_assert(END <= 77824, "attention LDS map");
};
__device__ __forceinline__ f16x8 pack8(const f32x16& p, int b) {
    u32x4 w; w.x = pk2h(p[b + 0], p[b + 1]); w.y = pk2h(p[b + 2], p[b + 3]); w.z = pk2h(p[b + 4], p[b + 5]); w.w = pk2h(p[b + 6], p[b + 7]);
    return __builtin_bit_cast(f16x8, w);
}
__device__ __forceinline__ float psum8(const f16x8& p, float acc) {
    typedef _Float16 h2_t __attribute__((ext_vector_type(2)));
    const u32x4 w = __builtin_bit_cast(u32x4, p); const unsigned w0 = w.x, w1 = w.y, w2 = w.z, w3 = w.w; const h2_t one = {(_Float16)1.f, (_Float16)1.f};
    acc = __builtin_amdgcn_fdot2(__builtin_bit_cast(h2_t, w0), one, acc, false); acc = __builtin_amdgcn_fdot2(__builtin_bit_cast(h2_t, w1), one, acc, false);
    acc = __builtin_amdgcn_fdot2(__builtin_bit_cast(h2_t, w2), one, acc, false); acc = __builtin_amdgcn_fdot2(__builtin_bit_cast(h2_t, w3), one, acc, false);
    return acc;
}
__device__ __forceinline__ float max3f(float a, float b, float c) { float r; asm("v_max3_f32 %0, %1, %2, %3" : "=v"(r) : "v"(a), "v"(b), "v"(c)); return r; }
__device__ __forceinline__ float rowmax32(const f32x16& a, const f32x16& b) {
    float x = max3f(a[0], a[1], b[0]), y = max3f(a[2], a[3], b[1]); x = max3f(x, b[2], b[3]);
#pragma unroll
    for (int r = 4; r < 16; r += 4) { x = max3f(x, a[r], a[r + 1]); y = max3f(y, a[r + 2], a[r + 3]); x = max3f(x, b[r], b[r + 1]); y = max3f(y, b[r + 2], b[r + 3]); }
    return max3f(x, y, y);
}
__device__ __forceinline__ float half_max(float x) { const auto rr = __builtin_amdgcn_permlane32_swap(__float_as_uint(x), __float_as_uint(x), false, false); return fmaxf(__uint_as_float(rr[0]), __uint_as_float(rr[1])); }
__device__ __forceinline__ float half_sum(float x) { const auto rr = __builtin_amdgcn_permlane32_swap(__float_as_uint(x), __float_as_uint(x), false, false); return __uint_as_float(rr[0]) + __uint_as_float(rr[1]); }
template <int DQK, int DV, int MODE>
__device__ __forceinline__ void attn_pass(LAS unsigned char* lds, const int wave, const int lane,
        const f16* Qw, const int qpitch, const f16* Kg, const int kpitch, const f16* Vg, const int vpitch,
        const int ntiles, const int qpos0, const LAS float* tab, const unsigned selb, const int jblk, const unsigned* maskw,
        f32x16 (&o)[DV / 32]) {
    typedef Lay<DQK, DV, MODE == 2> L;
    constexpr int NB_ = DV / 32;
    const int r32 = lane & 31, hi = lane >> 5, tid = wave * 64 + lane;
    f16x8 qf[DQK / 16];
#pragma unroll
    for (int d0 = 0; d0 < DQK / 16; ++d0) qf[d0] = __builtin_bit_cast(f16x8, *(const GAS u32x4*)(Qw + (size_t)r32 * qpitch + d0 * 16 + hi * 8));
#pragma unroll
    for (int blk = 0; blk < NB_; ++blk)
#pragma unroll
        for (int r = 0; r < 16; ++r) o[blk][r] = 0.f;
    float m = -INFINITY, l = 0.f;
    u32x4 kreg[L::NKC], vreg[L::NVC > 0 ? L::NVC : 1];
    unsigned wnext = 0u;
#define FA_LOAD(kt_) do { \
        _Pragma("unroll") for (int c = 0; c < L::NKC; ++c) { const int id = tid + 512 * c, row = id / (DQK / 8), ch = id % (DQK / 8); \
            kreg[c] = *(const GAS u32x4*)(Kg + (size_t)((kt_) * 64 + row) * kpitch + ch * 8); } \
        _Pragma("unroll") for (int c = 0; c < L::NVC; ++c) { const int id = tid + 512 * c, row = id / (DV / 8), ch = id % (DV / 8); \
            vreg[c] = *(const GAS u32x4*)(Vg + (size_t)((kt_) * 64 + row) * vpitch + ch * 8); } \
        if (MODE == 2) wnext = *(const GAS unsigned*)(maskw + (kt_) * 64 + lane); } while (0)
#define FA_WRITE(buf_) do { \
        _Pragma("unroll") for (int c = 0; c < L::NKC; ++c) { const int id = tid + 512 * c, row = id / (DQK / 8), ch = id % (DQK / 8); \
            *(LAS u32x4*)(lds + (buf_) * L::KBUF + row * L::RSK + ch * 16) = kreg[c]; \
            if (MODE == 2) *(LAS u32x4*)(lds + L::VOFF0 + (buf_) * L::VBUF + row * L::RSV + ch * 16) = kreg[c]; } \
        _Pragma("unroll") for (int c = 0; c < L::NVC; ++c) { const int id = tid + 512 * c, row = id / (DV / 8), ch = id % (DV / 8); \
            *(LAS u32x4*)(lds + L::VOFF0 + (buf_) * L::VBUF + row * L::RSV + ch * 16) = vreg[c]; } } while (0)
#define FA_VREAD(dst_, ks_) do { _Pragma("unroll") for (int blk = 0; blk < NB_; ++blk) { \
        const v4i16_t a_ = __builtin_amdgcn_ds_read_tr16_b64_v4i16((LAS v4i16_t*)(vb + 16 * (ks_) * L::RSV + blk * 64)); \
        const v4i16_t b_ = __builtin_amdgcn_ds_read_tr16_b64_v4i16((LAS v4i16_t*)(vb + (16 * (ks_) + 8) * L::RSV + blk * 64)); \
        const f16x4 a4_ = __builtin_bit_cast(f16x4, a_), b4_ = __builtin_bit_cast(f16x4, b_); \
        dst_[blk] = (f16x8){a4_[0], a4_[1], a4_[2], a4_[3], b4_[0], b4_[1], b4_[2], b4_[3]}; } } while (0)
#define FA_PV(src_, ks_) do { _Pragma("unroll") for (int blk = 0; blk < NB_; ++blk) o[blk] = __builtin_amdgcn_mfma_f32_32x32x16_f16(src_[blk], pf[ks_], o[blk], 0, 0, 0); } while (0)
    FA_LOAD(0);
    unsigned wcur = wnext;
    FA_WRITE(0);
    __syncthreads();
#pragma unroll 1
    for (int kt = 0; kt < ntiles; ++kt) {
        const int cur = kt & 1;
        if (kt + 1 < ntiles) FA_LOAD(kt + 1);
        const int k0 = kt * 64;
        if (k0 <= qpos0 + 31) {
            f32x16 p0, p1;
            if (MODE == 2) {
                const unsigned nw = ~wcur;
#pragma unroll
                for (int r = 0; r < 16; ++r) { p0[r] = __uint_as_float((unsigned)__builtin_amdgcn_sbfe((int)nw, r, 1) & 0xff800000u); p1[r] = __uint_as_float((unsigned)__builtin_amdgcn_sbfe((int)nw, 16 + r, 1) & 0xff800000u); }
            } else if (MODE == 1) {
                const int n = kt >> 2; const float cv = (n == jblk || ((selb >> n) & 1u)) ? 0.f : -INFINITY;
#pragma unroll
                for (int r = 0; r < 16; ++r) { p0[r] = cv; p1[r] = cv; }
            } else {
#pragma unroll
                for (int r = 0; r < 16; ++r) { p0[r] = 0.f; p1[r] = 0.f; }
            }
            const LAS unsigned char* kb = lds + cur * L::KBUF + r32 * L::RSK + hi * 16;
            const LAS unsigned char* vb = lds + L::VOFF0 + cur * L::VBUF + (4 * hi + ((lane & 15) >> 2)) * L::RSV + (16 * ((lane >> 4) & 1) + 4 * (lane & 3)) * 2;
#pragma unroll
            for (int db = 0; db < DQK / 64; ++db) {
                f16x8 kf0[4], kf1[4];
#pragma unroll
                for (int d = 0; d < 4; ++d) { kf0[d] = *(const LAS f16x8*)(kb + (4 * db + d) * 32); kf1[d] = *(const LAS f16x8*)(kb + 32 * L::RSK + (4 * db + d) * 32); }
                __builtin_amdgcn_sched_barrier(0);
#pragma unroll
                for (int d = 0; d < 4; ++d) {
                    p0 = __builtin_amdgcn_mfma_f32_32x32x16_f16(kf0[d], qf[4 * db + d], p0, 0, 0, 0);
                    p1 = __builtin_amdgcn_mfma_f32_32x32x16_f16(kf1[d], qf[4 * db + d], p1, 0, 0, 0); }
                __builtin_amdgcn_sched_barrier(0);
            }
            f16x8 vfa[NB_], vfb[NB_];
            FA_VREAD(vfa, 0);
            __builtin_amdgcn_sched_barrier(0);
            if (qpos0 - (k0 + 63) < 128) {
                const int base = qpos0 + r32 - k0 - 4 * hi + 255;
#pragma unroll
                for (int r = 0; r < 16; ++r) { const int i0 = base - ((r & 3) + 8 * (r >> 2)), i1 = i0 - 32;
                    p0[r] += tab[i0 < 383 ? i0 : 383]; p1[r] += tab[i1 < 383 ? i1 : 383]; }
            }
            float rm = fmaxf(p0[0], p1[0]);
#pragma unroll
            for (int r = 1; r < 16; ++r) rm = fmaxf(rm, fmaxf(p0[r], p1[r]));
            rm = half_max(rm);
            const float mn = fmaxf(m, rm), mu = (mn == -INFINITY) ? 0.f : mn;
            if (__any(mn > m)) { const float al = __builtin_amdgcn_exp2f(m - mu); l *= al;
#pragma unroll
                for (int blk = 0; blk < NB_; ++blk)
#pragma unroll
                    for (int r = 0; r < 16; ++r) o[blk][r] *= al; }
            m = mn;
            float ls = 0.f;
#pragma unroll
            for (int r = 0; r < 16; ++r) { p0[r] = __builtin_amdgcn_exp2f(p0[r] - mu); p1[r] = __builtin_amdgcn_exp2f(p1[r] - mu); ls += p0[r] + p1[r]; }
            l += ls;
            f16x8 pf[4]; pf[0] = pack8(p0, 0); pf[1] = pack8(p0, 8); pf[2] = pack8(p1, 0); pf[3] = pack8(p1, 8);
            __builtin_amdgcn_sched_barrier(0);
            FA_VREAD(vfb, 1); FA_PV(vfa, 0); __builtin_amdgcn_sched_barrier(0);
            FA_VREAD(vfa, 2); FA_PV(vfb, 1); __builtin_amdgcn_sched_barrier(0);
            FA_VREAD(vfb, 3); FA_PV(vfa, 2); __builtin_amdgcn_sched_barrier(0);
            FA_PV(vfb, 3);
        }
        if (kt + 1 < ntiles) FA_WRITE(cur ^ 1);
        wcur = wnext;
        __syncthreads();
    }
#undef FA_LOAD
#undef FA_WRITE
#undef FA_VREAD
#undef FA_PV
    l = half_sum(l);
    const float inv = 1.f / l;
#pragma unroll
    for (int blk = 0; blk < NB_; ++blk)
#pragma unroll
        for (int r = 0; r < 16; ++r) o[blk][r] *= inv;
}
__device__ __forceinline__ int fsw8(int row) { return (row >> 1) & 7; }
__device__ __forceinline__ int fsw16(int row) { return ((row & 3) << 2) | ((row >> 2) & 3); }
__device__ __forceinline__ int fswv8(int row) { return ((row >> 1) & 1) << 2; }
template <int DQK, int DV, int MODE, int S> struct LayD {
    static constexpr int CPRK = DQK / 8, CPRV = DV / 8;
    static constexpr int KB = 64 * DQK * 2, VB = (MODE == 2) ? 0 : 64 * DV * 2, STG = KB + VB;
    static constexpr int PK = CPRK, PV = (MODE == 2) ? 0 : CPRV, NP = (PK + PV) / 8, NPW = NP + (MODE == 2 ? 1 : 0);
    static constexpr int MASKOFF = S * STG;
    static constexpr int END = MASKOFF + (MODE == 2 ? 8 * S * 256 : 0);
    __device__ static __forceinline__ int fk(int row) { return CPRK == 8 ? fsw8(row) : fsw16(row); }
    __device__ static __forceinline__ int fv(int row) { return MODE == 2 ? fsw16(row) : (CPRV == 8 ? fswv8(row) : fsw16(row)); }
};
#define FA_WAITV(n) asm volatile("s_waitcnt vmcnt(%0)" :: "n"(n) : "memory")
template <int DQK, int DV, int MODE, int S>
__device__ __forceinline__ void attn_pass_dma(LAS unsigned char* lds, const int wave, const int lane,
        const f16* Qw, const int qpitch, const f16* Kg, const int kpitch, const f16* Vg, const int vpitch,
        const int ntiles, const int qpos0, const LAS float* tab, const unsigned selb, const int jblk, const unsigned* maskw,
        f32x16 (&o)[DV / 32]) {
    typedef LayD<DQK, DV, MODE, S> L;
    constexpr int NB_ = DV / 32;
    const int r32 = lane & 31, hi = lane >> 5;
    f16x8 qf[DQK / 16];
#pragma unroll
    for (int d0 = 0; d0 < DQK / 16; ++d0) qf[d0] = __builtin_bit_cast(f16x8, *(const GAS u32x4*)(Qw + (size_t)r32 * qpitch + d0 * 16 + hi * 8));
#pragma unroll
    for (int blk = 0; blk < NB_; ++blk)
#pragma unroll
        for (int r = 0; r < 16; ++r) o[blk][r] = 0.f;
    float m = -INFINITY, l = 0.f;
    unsigned goff[L::NP];
#pragma unroll
    for (int c = 0; c < L::NP; ++c) { const int pc = wave + 8 * c;
        if (pc < L::PK) { const int s2 = 64 * pc + lane, row = s2 / L::CPRK, ch = (s2 % L::CPRK) ^ L::fk(row); goff[c] = (unsigned)(row * kpitch + ch * 8); }
        else { const int s2 = 64 * (pc - L::PK) + lane, row = s2 / L::CPRV, ch = (s2 % L::CPRV) ^ L::fv(row); goff[c] = (unsigned)(row * vpitch + ch * 8); } }
#define FA_ISSUE(kt_, st_) do { \
        if (MODE == 2) __builtin_amdgcn_global_load_lds((const GAS unsigned*)(maskw + (kt_) * 64 + lane), (LAS unsigned*)(lds + L::MASKOFF + (wave * S + (st_)) * 256), 4, 0, 0); \
        _Pragma("unroll") for (int c = 0; c < L::NP; ++c) { const int pc = wave + 8 * c; \
            if (pc < L::PK) __builtin_amdgcn_global_load_lds((const GAS unsigned*)(Kg + (size_t)(kt_) * 64 * kpitch + goff[c]), (LAS unsigned*)(lds + (st_) * L::STG + pc * 1024), 16, 0, 0); \
            else __builtin_amdgcn_global_load_lds((const GAS unsigned*)(Vg + (size_t)(kt_) * 64 * vpitch + goff[c]), (LAS unsigned*)(lds + (st_) * L::STG + L::KB + (pc - L::PK) * 1024), 16, 0, 0); } } while (0)
    int koff[DQK / 16];
#pragma unroll
    for (int d0 = 0; d0 < DQK / 16; ++d0) koff[d0] = (r32 * L::CPRK + ((2 * d0 + hi) ^ L::fk(r32))) * 16;
    int voff[2][NB_];
    { const int q = (lane & 15) >> 2, g1 = (lane >> 4) & 1, p = lane & 3;
#pragma unroll
      for (int sec = 0; sec < 2; ++sec)
#pragma unroll
        for (int blk = 0; blk < NB_; ++blk) { const int row = 4 * hi + q + 8 * sec; voff[sec][blk] = L::KB * (MODE == 2 ? 0 : 1) + (row * L::CPRV + ((4 * blk + 2 * g1 + (p >> 1)) ^ L::fv(row))) * 16 + 8 * (p & 1); } }
#define FA_VREADD(dst_, ks_) do { _Pragma("unroll") for (int blk = 0; blk < NB_; ++blk) { \
        const v4i16_t a_ = __builtin_amdgcn_ds_read_tr16_b64_v4i16((LAS v4i16_t*)(sb + voff[0][blk] + 16 * (ks_) * L::CPRV * 16)); \
        const v4i16_t b_ = __builtin_amdgcn_ds_read_tr16_b64_v4i16((LAS v4i16_t*)(sb + voff[1][blk] + 16 * (ks_) * L::CPRV * 16)); \
        const f16x4 a4_ = __builtin_bit_cast(f16x4, a_), b4_ = __builtin_bit_cast(f16x4, b_); \
        dst_[blk] = (f16x8){a4_[0], a4_[1], a4_[2], a4_[3], b4_[0], b4_[1], b4_[2], b4_[3]}; } } while (0)
#define FA_PVD(src_, ks_) do { _Pragma("unroll") for (int blk = 0; blk < NB_; ++blk) o[blk] = __builtin_amdgcn_mfma_f32_32x32x16_f16(src_[blk], pf[ks_], o[blk], 0, 0, 0); } while (0)
#pragma unroll
    for (int t0 = 0; t0 < S - 1; ++t0) if (t0 < ntiles) FA_ISSUE(t0, t0);
    int st = 0, sti = S - 1;
#pragma unroll 1
    for (int kt = 0; kt < ntiles; ++kt) {
        if (kt + S - 2 < ntiles) FA_WAITV(L::NPW * (S - 2)); else FA_WAITV(0);
        __builtin_amdgcn_s_barrier();
        asm volatile("" ::: "memory");
        if (kt + S - 1 < ntiles) FA_ISSUE(kt + S - 1, sti);
        const int k0 = kt * 64;
        if (k0 <= qpos0 + 31) {
            const LAS unsigned char* sb = lds + st * L::STG;
            f32x16 p0, p1;
            if (MODE == 2) {
                const unsigned nw = ~*(const LAS unsigned*)(lds + L::MASKOFF + (wave * S + st) * 256 + lane * 4);
#pragma unroll
                for (int r = 0; r < 16; ++r) { p0[r] = __uint_as_float((unsigned)__builtin_amdgcn_sbfe((int)nw, r, 1) & 0xff800000u); p1[r] = __uint_as_float((unsigned)__builtin_amdgcn_sbfe((int)nw, 16 + r, 1) & 0xff800000u); }
            } else if (MODE == 1) {
                const int n = kt >> 2; const float cv = (n == jblk || ((selb >> n) & 1u)) ? 0.f : -INFINITY;
#pragma unroll
                for (int r = 0; r < 16; ++r) { p0[r] = cv; p1[r] = cv; }
            } else {
#pragma unroll
                for (int r = 0; r < 16; ++r) { p0[r] = 0.f; p1[r] = 0.f; }
            }
#pragma unroll
            for (int db = 0; db < DQK / 64; ++db) {
                f16x8 kf0[4], kf1[4];
#pragma unroll
                for (int d = 0; d < 4; ++d) { kf0[d] = *(const LAS f16x8*)(sb + koff[4 * db + d]); kf1[d] = *(const LAS f16x8*)(sb + koff[4 * db + d] + 32 * L::CPRK * 16); }
                __builtin_amdgcn_sched_barrier(0);
#pragma unroll
                for (int d = 0; d < 4; ++d) {
                    p0 = __builtin_amdgcn_mfma_f32_32x32x16_f16(kf0[d], qf[4 * db + d], p0, 0, 0, 0);
                    p1 = __builtin_amdgcn_mfma_f32_32x32x16_f16(kf1[d], qf[4 * db + d], p1, 0, 0, 0); }
                __builtin_amdgcn_sched_barrier(0);
            }
            f16x8 vfa[NB_], vfb[NB_];
            FA_VREADD(vfa, 0);
            __builtin_amdgcn_sched_barrier(0);
            if (qpos0 - (k0 + 63) < 128) {
                const int j0 = 224 - (qpos0 + r32 - k0 - 4 * hi), sf = j0 & 1; const LAS float* rp = tab + sf * TAB2 + (j0 - sf);
#pragma unroll
                for (int g = 0; g < 4; ++g) { const f32x2 x0 = *(const LAS f32x2*)(rp + 8 * g), x1 = *(const LAS f32x2*)(rp + 8 * g + 2), y0 = *(const LAS f32x2*)(rp + 32 + 8 * g), y1 = *(const LAS f32x2*)(rp + 34 + 8 * g);
                    p0[4 * g] += x0.x; p0[4 * g + 1] += x0.y; p0[4 * g + 2] += x1.x; p0[4 * g + 3] += x1.y; p1[4 * g] += y0.x; p1[4 * g + 1] += y0.y; p1[4 * g + 2] += y1.x; p1[4 * g + 3] += y1.y; }
            }
            float rm = rowmax32(p0, p1);
            rm = half_max(rm);
            if (__any(rm > m + 8.f)) { const float mn = fmaxf(m, rm), mu2 = (mn == -INFINITY) ? 0.f : mn; const float al = __builtin_amdgcn_exp2f(m - mu2); l *= al; m = mn;
#pragma unroll
                for (int blk = 0; blk < NB_; ++blk)
#pragma unroll
                    for (int r = 0; r < 16; ++r) o[blk][r] *= al; }
            const float mu = (m == -INFINITY) ? 0.f : m;
            f32x2 lsa = {0.f, 0.f}, lsb = {0.f, 0.f}; const f32x2 mu2v = {mu, mu};
#pragma unroll
            for (int r = 0; r < 16; r += 2) { const f32x2 d0 = (f32x2){p0[r], p0[r + 1]} - mu2v, d1 = (f32x2){p1[r], p1[r + 1]} - mu2v;
                p0[r] = __builtin_amdgcn_exp2f(d0.x); p0[r + 1] = __builtin_amdgcn_exp2f(d0.y); p1[r] = __builtin_amdgcn_exp2f(d1.x); p1[r + 1] = __builtin_amdgcn_exp2f(d1.y);
                lsa += (f32x2){p0[r], p0[r + 1]}; lsb += (f32x2){p1[r], p1[r + 1]}; }
            lsa += lsb; l += lsa.x + lsa.y;
            f16x8 pf[4]; pf[0] = pack8(p0, 0); pf[1] = pack8(p0, 8); pf[2] = pack8(p1, 0); pf[3] = pack8(p1, 8);
            __builtin_amdgcn_sched_barrier(0);
            FA_VREADD(vfb, 1); FA_PVD(vfa, 0); __builtin_amdgcn_sched_barrier(0);
            FA_VREADD(vfa, 2); FA_PVD(vfb, 1); __builtin_amdgcn_sched_barrier(0);
            FA_VREADD(vfb, 3); FA_PVD(vfa, 2); __builtin_amdgcn_sched_barrier(0);
            FA_PVD(vfb, 3);
        }
        st = (st + 1 == S) ? 0 : st + 1; sti = (sti + 1 == S) ? 0 : sti + 1;
    }
    asm volatile("s_waitcnt lgkmcnt(0)" ::: "memory");
    __builtin_amdgcn_s_barrier();
    asm volatile("" ::: "memory");
#undef FA_ISSUE
#undef FA_VREADD
#undef FA_PVD
    l = half_sum(l);
    const float inv = 1.f / l;
#pragma unroll
    for (int blk = 0; blk < NB_; ++blk)
#pragma unroll
        for (int r = 0; r < 16; ++r) o[blk][r] *= inv;
}
template <int DQK, int DV, int MODE, int S>
__device__ __forceinline__ void attn_pass_pipe(LAS unsigned char* lds, const int wave, const int lane,
        const f16* Qw, const int qpitch, const f16* Kg, const int kpitch, const f16* Vg, const int vpitch,
        const int ntiles, const int qpos0, const LAS float* tab, const unsigned selb, const int jblk, const unsigned* maskw,
        f32x16 (&o)[DV / 32]) {
    typedef LayD<DQK, DV, MODE, S> L;
    constexpr int NB_ = DV / 32;
    const int r32 = lane & 31, hi = lane >> 5;
    f16x8 qf[DQK / 16];
#pragma unroll
    for (int d0 = 0; d0 < DQK / 16; ++d0) qf[d0] = __builtin_bit_cast(f16x8, *(const GAS u32x4*)(Qw + (size_t)r32 * qpitch + d0 * 16 + hi * 8));
#pragma unroll
    for (int blk = 0; blk < NB_; ++blk)
#pragma unroll
        for (int r = 0; r < 16; ++r) o[blk][r] = 0.f;
    float m = -INFINITY, l = 0.f;
    unsigned goff[L::NP];
#pragma unroll
    for (int c = 0; c < L::NP; ++c) { const int pc = wave + 8 * c;
        if (pc < L::PK) { const int s2 = 64 * pc + lane, row = s2 / L::CPRK, ch = (s2 % L::CPRK) ^ L::fk(row); goff[c] = (unsigned)(row * kpitch + ch * 8); }
        else { const int s2 = 64 * (pc - L::PK) + lane, row = s2 / L::CPRV, ch = (s2 % L::CPRV) ^ L::fv(row); goff[c] = (unsigned)(row * vpitch + ch * 8); } }
#define FP_ISSUE(kt_, st_) do { \
        if (MODE == 2) __builtin_amdgcn_global_load_lds((const GAS unsigned*)(maskw + (kt_) * 64 + lane), (LAS unsigned*)(lds + L::MASKOFF + (wave * S + (st_)) * 256), 4, 0, 0); \
        _Pragma("unroll") for (int c = 0; c < L::NP; ++c) { const int pc = wave + 8 * c; \
            if (pc < L::PK) __builtin_amdgcn_global_load_lds((const GAS unsigned*)(Kg + (size_t)(kt_) * 64 * kpitch + goff[c]), (LAS unsigned*)(lds + (st_) * L::STG + pc * 1024), 16, 0, 0); \
            else __builtin_amdgcn_global_load_lds((const GAS unsigned*)(Vg + (size_t)(kt_) * 64 * vpitch + goff[c]), (LAS unsigned*)(lds + (st_) * L::STG + L::KB + (pc - L::PK) * 1024), 16, 0, 0); } } while (0)
    int koff[DQK / 16];
#pragma unroll
    for (int d0 = 0; d0 < DQK / 16; ++d0) koff[d0] = (r32 * L::CPRK + ((2 * d0 + hi) ^ L::fk(r32))) * 16;
    int voff[2][NB_];
    { const int q = (lane & 15) >> 2, g1 = (lane >> 4) & 1, p = lane & 3;
#pragma unroll
      for (int sec = 0; sec < 2; ++sec)
#pragma unroll
        for (int blk = 0; blk < NB_; ++blk) { const int row = 4 * hi + q + 8 * sec; voff[sec][blk] = L::KB * (MODE == 2 ? 0 : 1) + (row * L::CPRV + ((4 * blk + 2 * g1 + (p >> 1)) ^ L::fv(row))) * 16 + 8 * (p & 1); } }
    const int nact = ((qpos0 + 31) >> 6) + 1 < ntiles ? ((qpos0 + 31) >> 6) + 1 : ntiles;
#define FP_QK(a0_, a1_, kt_, st_, ref_) do { \
        const LAS unsigned char* sb_ = lds + (st_) * L::STG; const float nr_ = -(ref_); \
        if (MODE == 2) { const unsigned w_ = *(const LAS unsigned*)(lds + L::MASKOFF + (wave * S + (st_)) * 256 + lane * 4); const unsigned nrb_ = __float_as_uint(nr_); \
            _Pragma("unroll") for (int r = 0; r < 16; ++r) { const unsigned s0_ = (unsigned)__builtin_amdgcn_sbfe((int)w_, r, 1), s1_ = (unsigned)__builtin_amdgcn_sbfe((int)w_, 16 + r, 1); \
                a0_[r] = __uint_as_float((s0_ & nrb_) | (~s0_ & 0xff800000u)); a1_[r] = __uint_as_float((s1_ & nrb_) | (~s1_ & 0xff800000u)); } } \
        else if (MODE == 1) { const int n_ = (kt_) >> 2; const float cv_ = (n_ == jblk || ((selb >> n_) & 1u)) ? nr_ : -INFINITY; \
            _Pragma("unroll") for (int r = 0; r < 16; ++r) { a0_[r] = cv_; a1_[r] = cv_; } } \
        else { _Pragma("unroll") for (int r = 0; r < 16; ++r) { a0_[r] = nr_; a1_[r] = nr_; } } \
        _Pragma("unroll") for (int db = 0; db < DQK / 32; ++db) { f16x8 kf0_[2], kf1_[2]; \
            _Pragma("unroll") for (int d = 0; d < 2; ++d) { kf0_[d] = *(const LAS f16x8*)(sb_ + koff[2 * db + d]); kf1_[d] = *(const LAS f16x8*)(sb_ + koff[2 * db + d] + 32 * L::CPRK * 16); } \
            _Pragma("unroll") for (int d = 0; d < 2; ++d) { \
                a0_ = __builtin_amdgcn_mfma_f32_32x32x16_f16(kf0_[d], qf[2 * db + d], a0_, 0, 0, 0); \
                a1_ = __builtin_amdgcn_mfma_f32_32x32x16_f16(kf1_[d], qf[2 * db + d], a1_, 0, 0, 0); } } } while (0)
#define FP_PREP(a0_, a1_, kt_) do { const int k0_ = (kt_) * 64; \
        if (qpos0 - (k0_ + 63) < 128) { const int j0_ = 224 - (qpos0 + r32 - k0_ - 4 * hi), sf_ = j0_ & 1; const LAS float* rp_ = tab + sf_ * TAB2 + (j0_ - sf_); \
            _Pragma("unroll") for (int g = 0; g < 4; ++g) { const f32x2 x0_ = *(const LAS f32x2*)(rp_ + 8 * g), x1_ = *(const LAS f32x2*)(rp_ + 8 * g + 2), y0_ = *(const LAS f32x2*)(rp_ + 32 + 8 * g), y1_ = *(const LAS f32x2*)(rp_ + 34 + 8 * g); \
                a0_[4 * g] += x0_.x; a0_[4 * g + 1] += x0_.y; a0_[4 * g + 2] += x1_.x; a0_[4 * g + 3] += x1_.y; a1_[4 * g] += y0_.x; a1_[4 * g + 1] += y0_.y; a1_[4 * g + 2] += y1_.x; a1_[4 * g + 3] += y1_.y; } } \
        rmrel = half_max(rowmax32(a0_, a1_)); } while (0)
#define FP_VREAD(dst_, ks_, st_) do { const LAS unsigned char* sv_ = lds + (st_) * L::STG; _Pragma("unroll") for (int blk = 0; blk < NB_; ++blk) { \
        const v4i16_t a_ = __builtin_amdgcn_ds_read_tr16_b64_v4i16((LAS v4i16_t*)(sv_ + voff[0][blk] + 16 * (ks_) * L::CPRV * 16)); \
        const v4i16_t b_ = __builtin_amdgcn_ds_read_tr16_b64_v4i16((LAS v4i16_t*)(sv_ + voff[1][blk] + 16 * (ks_) * L::CPRV * 16)); \
        const f16x4 a4_ = __builtin_bit_cast(f16x4, a_), b4_ = __builtin_bit_cast(f16x4, b_); \
        dst_[blk] = (f16x8){a4_[0], a4_[1], a4_[2], a4_[3], b4_[0], b4_[1], b4_[2], b4_[3]}; } } while (0)
#define FP_PV(src_, ks_) do { _Pragma("unroll") for (int blk = 0; blk < NB_; ++blk) o[blk] = __builtin_amdgcn_mfma_f32_32x32x16_f16(src_[blk], pf[ks_], o[blk], 0, 0, 0); } while (0)
#define FP_STEP(c0_, c1_, n0_, n1_, kt_) do { \
        if (S > 3 && (kt_) + S - 2 < ntiles) FA_WAITV(L::NPW * (S - 3)); else FA_WAITV(0); \
        __builtin_amdgcn_s_barrier(); asm volatile("" ::: "memory"); \
        if ((kt_) + S - 1 < ntiles) FP_ISSUE((kt_) + S - 1, sti); \
        if ((kt_) < nact) { \
            const float mu_ = (m == -INFINITY) ? 0.f : m; const bool more_ = (kt_) + 1 < nact; float rmrel = -INFINITY; \
            if (more_) FP_QK(n0_, n1_, (kt_) + 1, st1, mu_); \
            if (__any(dl != 0.f)) { _Pragma("unroll") for (int r = 0; r < 16; ++r) { c0_[r] -= dl; c1_[r] -= dl; } } \
            f32x2 lsa_ = {0.f, 0.f}, lsb_ = {0.f, 0.f};        \
            _Pragma("unroll") for (int r = 0; r < 16; r += 2) { c0_[r] = __builtin_amdgcn_exp2f(c0_[r]); c0_[r + 1] = __builtin_amdgcn_exp2f(c0_[r + 1]); c1_[r] = __builtin_amdgcn_exp2f(c1_[r]); c1_[r + 1] = __builtin_amdgcn_exp2f(c1_[r + 1]); \
                lsa_ += (f32x2){c0_[r], c0_[r + 1]}; lsb_ += (f32x2){c1_[r], c1_[r + 1]}; } \
            lsa_ += lsb_; l += lsa_.x + lsa_.y; \
            f16x8 pf[4]; pf[0] = pack8(c0_, 0); pf[1] = pack8(c0_, 8); pf[2] = pack8(c1_, 0); pf[3] = pack8(c1_, 8); \
            if (NB_ <= 2) { f16x8 vfa[NB_], vfb[NB_]; \
                FP_VREAD(vfa, 0, st); FP_VREAD(vfb, 1, st); \
                if (more_) FP_PREP(n0_, n1_, (kt_) + 1); \
                FP_PV(vfa, 0); FP_VREAD(vfa, 2, st); FP_PV(vfb, 1); FP_VREAD(vfb, 3, st); FP_PV(vfa, 2); FP_PV(vfb, 3); \
            } else { f16x8 vfa[NB_]; \
                FP_VREAD(vfa, 0, st); \
                if (more_) FP_PREP(n0_, n1_, (kt_) + 1); \
                FP_PV(vfa, 0); __builtin_amdgcn_sched_barrier(0); FP_VREAD(vfa, 1, st); FP_PV(vfa, 1); __builtin_amdgcn_sched_barrier(0); \
                FP_VREAD(vfa, 2, st); FP_PV(vfa, 2); __builtin_amdgcn_sched_barrier(0); FP_VREAD(vfa, 3, st); FP_PV(vfa, 3); } \
            dl = 0.f; \
              \
            if (more_ && __any(rmrel > 8.f || (m == -INFINITY && rmrel > -INFINITY))) { \
                const float mnew_ = fmaxf(m, rmrel + mu_), mun_ = (mnew_ == -INFINITY) ? 0.f : mnew_; dl = mun_ - mu_; m = mnew_; \
                const float al_ = __builtin_amdgcn_exp2f(-dl); l *= al_; \
                _Pragma("unroll") for (int blk = 0; blk < NB_; ++blk) _Pragma("unroll") for (int r = 0; r < 16; ++r) o[blk][r] *= al_; } \
        } \
        st = st1; st1 = (st1 + 1 == S) ? 0 : st1 + 1; sti = (sti + 1 == S) ? 0 : sti + 1; } while (0)
#pragma unroll
    for (int t0 = 0; t0 < S - 1; ++t0) if (t0 < ntiles) FP_ISSUE(t0, t0);
    f32x16 sa0, sa1, sb0, sb1; float dl;
    if (ntiles >= S - 1) FA_WAITV(L::NPW * (S - 2)); else FA_WAITV(0);
    __builtin_amdgcn_s_barrier(); asm volatile("" ::: "memory");
    { float rmrel; FP_QK(sa0, sa1, 0, 0, 0.f); FP_PREP(sa0, sa1, 0); m = rmrel; dl = (m == -INFINITY) ? 0.f : m; }
    int st = 0, st1 = 1, sti = S - 1;
#pragma unroll 1
    for (int kt = 0; kt < ntiles; kt += 2) {
        FP_STEP(sa0, sa1, sb0, sb1, kt);
        if (kt + 1 < ntiles) FP_STEP(sb0, sb1, sa0, sa1, kt + 1);
    }
    asm volatile("s_waitcnt lgkmcnt(0)" ::: "memory");
    __builtin_amdgcn_s_barrier(); asm volatile("" ::: "memory");
#undef FP_ISSUE
#undef FP_QK
#undef FP_PREP
#undef FP_VREAD
#undef FP_PV
#undef FP_STEP
    l = half_sum(l);
    const float inv = 1.f / l;
#pragma unroll
    for (int blk = 0; blk < NB_; ++blk)
#pragma unroll
        for (int r = 0; r < 16; ++r) o[blk][r] *= inv;
}
template <int DV> __device__ __forceinline__ void store_o(const f32x16 (&o)[DV / 32], f16* dst, int hi) {
#pragma unroll
    for (int blk = 0; blk < DV / 32; ++blk)
#pragma unroll
        for (int g = 0; g < 4; g += 2) {
            const unsigned a0 = pk2h(o[blk][4 * g], o[blk][4 * g + 1]), a1 = pk2h(o[blk][4 * g + 2], o[blk][4 * g + 3]);
            const unsigned b0 = pk2h(o[blk][4 * g + 4], o[blk][4 * g + 5]), b1 = pk2h(o[blk][4 * g + 6], o[blk][4 * g + 7]);
            const auto s0 = __builtin_amdgcn_permlane32_swap(a0, b0, false, false), s1 = __builtin_amdgcn_permlane32_swap(a1, b1, false, false);
            u32x4 w; w.x = s0[0]; w.y = s1[0]; w.z = s0[1]; w.w = s1[1];
            *(pg8::g_u32x4*)(dst + 32 * blk + 8 * (g + hi)) = w; }
}
template <int DV> __device__ __forceinline__ void store_o_rows(const f32x16 (&o)[DV / 32], LAS unsigned char* lds, int wave, int lane, f16* dst0, int pitch) {
    constexpr int RP = DV * 2 + 16, CPR = DV / 8, RPI = 64 / CPR;
    LAS unsigned char* wb = lds + wave * (32 * RP);
    const int r32 = lane & 31, hi = lane >> 5;
#pragma unroll
    for (int blk = 0; blk < DV / 32; ++blk)
#pragma unroll
        for (int g = 0; g < 4; g += 2) {
            const unsigned a0 = pk2h(o[blk][4 * g], o[blk][4 * g + 1]), a1 = pk2h(o[blk][4 * g + 2], o[blk][4 * g + 3]);
            const unsigned b0 = pk2h(o[blk][4 * g + 4], o[blk][4 * g + 5]), b1 = pk2h(o[blk][4 * g + 6], o[blk][4 * g + 7]);
            const auto s0 = __builtin_amdgcn_permlane32_swap(a0, b0, false, false), s1 = __builtin_amdgcn_permlane32_swap(a1, b1, false, false);
            u32x4 w; w.x = s0[0]; w.y = s1[0]; w.z = s0[1]; w.w = s1[1];
            *(LAS u32x4*)(wb + r32 * RP + (32 * blk + 8 * (g + hi)) * 2) = w; }
    asm volatile("s_waitcnt lgkmcnt(0)" ::: "memory");
    const int rr = lane / CPR, ch = lane % CPR;
#pragma unroll
    for (int k = 0; k < 32 / RPI; ++k) { const int row = k * RPI + rr;
        const u32x4 v = *(const LAS u32x4*)(wb + row * RP + ch * 16);
        *(pg8::g_u32x4*)(dst0 + (size_t)row * pitch + ch * 8) = v; }
}
}

struct Args { const float* in[20]; float* out; unsigned char* ws; };

__global__ void __launch_bounds__(NWAVES * 64, 2) mega_fwd(Args args) {
    extern __shared__ __attribute__((aligned(16))) unsigned char lds_raw[];
    Frame F;
    F.lds = (LAS unsigned char*)0;
    (void)lds_raw;
    F.wave = __builtin_amdgcn_readfirstlane(threadIdx.x >> 6);
    F.G = gridDim.x; F.gw = blockIdx.x * NWAVES + F.wave; F.NGW = F.G * NWAVES;
    volatile LAS unsigned* MISC = (volatile LAS unsigned*)(F.lds + MISC_OFF);
    for (int u = threadIdx.x; u < (LDS_BYTES - LDSCTL_OFF) / 4; u += NWAVES * 64) ((LAS unsigned*)(F.lds + LDSCTL_OFF))[u] = 0u;
    __syncthreads();
    unsigned* ctl = (unsigned*)(args.ws + WS_CTL);
    XcdBarrier bar = xcd_barrier_post(ctl + CW_BAR, MISC + 8, F.wave);
    if (threadIdx.x == 0) __hip_atomic_fetch_or(ctl + CW_LB + 64 * (16 + (int)(blockIdx.x & 7u)), 1u << xb_xcc_id(), __ATOMIC_RELAXED, __HIP_MEMORY_SCOPE_AGENT);

    if (threadIdx.x < 20) ((volatile LAS unsigned long long*)(F.lds + PTAB_OFF))[threadIdx.x] = (unsigned long long)args.in[threadIdx.x];
    __syncthreads();
#define IN(i) inptr(F.lds, (i))
#define LANE lane_id()
#define LL launder_i(l)
#define GW launder_i(F.gw)
#define GWX ((gridDim.x == 256u) ? (int)((((blockIdx.x & 7u) << 5) + (blockIdx.x >> 3)) * 8u) + F.wave : GW)
#define SEAM_L() do { if (__builtin_amdgcn_readfirstlane((int)MISC[19])) xcd_local_barrier((unsigned*)launder(args.ws) + CW_LB, bar, F.wave); else xcd_barrier(bar, F.wave); } while (0)
#define SEAM_L_ARRIVE() do { if (__builtin_amdgcn_readfirstlane((int)MISC[19])) xcd_local_arrive((unsigned*)launder(args.ws) + CW_LB, bar, F.wave); else xcd_barrier(bar, F.wave); } while (0)
#define SEAM_L_WAIT() do { if (__builtin_amdgcn_readfirstlane((int)MISC[19])) xcd_local_wait((unsigned*)launder(args.ws) + CW_LB, bar, F.wave); else __syncthreads(); } while (0)
#define TID (F.wave * 64 + lane_id())
#define WSP(T, off) ((T*)(launder(args.ws) + (off)))
    enum { I_X = 0, I_C, I_RELB, I_ADAW, I_ADAB, I_NMIX, I_WIN, I_GATEB, I_DLAM, I_SUBLN, I_KVNORM, I_WUV, I_WBRA, I_WBRB, I_WBRC, I_WO, I_NMLP, I_WFF1, I_WFF2, I_NFINAL };
    float* xout = args.out;
    for (int rp0 = 0; rp0 < launder_i(REP_P0); ++rp0) {
        LAS float* scr = (LAS float*)(F.lds + F.wave * 16384);
        { auto decode = [&](int it) -> TItem { const int l = it >> 13; int r = it & 8191;
              if (r < 1664) return TItem{IN(I_WIN) + (size_t)l * DM * IN_COLS, IN_COLS, 0, PCOLS, DM, WSP(f16, WS_WIN) + (size_t)l * PP * DM, PP / 32, (unsigned*)launder(args.ws) + CW_CMAX + (l * 3 + 0) * 4096, r, true, false}; r -= 1664;
              if (r < 1536) return TItem{IN(I_WIN) + (size_t)l * DM * IN_COLS, IN_COLS, C_G, GCOLS, DM, WSP(f16, WS_WG) + (size_t)l * GCOLS * DM, GCOLS / 32, (unsigned*)launder(args.ws) + CW_CMAX + (l * 3 + 1) * 4096, r, false, false}; r -= 1536;
              if (r < 256) return TItem{IN(I_WBRA) + (size_t)l * 512 * DM, DM, 0, DM, 512, WSP(f16, WS_WA) + (size_t)l * DM * 512, DM / 32, (unsigned*)nullptr, r, false, false}; r -= 256;
              if (r < 128) return TItem{IN(I_WBRC) + (size_t)l * 256 * DM, DM, 0, DM, 256, WSP(f16, WS_WC) + (size_t)l * DM * 256, DM / 32, (unsigned*)nullptr, r, false, false}; r -= 128;
              if (r < 512) return TItem{IN(I_WO) + (size_t)l * DM * DM, DM, 0, DM, DM, WSP(f16, WS_WO) + (size_t)l * DM * DM, DM / 32, (unsigned*)nullptr, r, false, false}; r -= 512;
              if (r < 2048) return TItem{IN(I_WFF1) + (size_t)l * DM * DFF, DFF, 0, DFF, DM, WSP(f16, WS_W1) + (size_t)l * DFF * DM, DFF / 32, (unsigned*)launder(args.ws) + CW_CMAX + (l * 3 + 2) * 4096, r, false, false}; r -= 2048;
              return TItem{IN(I_WFF2) + (size_t)l * DFF * DM, DM, 0, DM, DFF, WSP(f16, WS_W2) + (size_t)l * DM * DFF, DM / 32, (unsigned*)nullptr, r, false, false}; };
          int it = F.gw;
          if (it < 2 * 8192) { TItem cur = decode(it); float wv[32]; float sc; titem_load(cur, LANE, wv, sc);
#pragma unroll 1
            for (;;) { const int itn = it + F.NGW; const bool more = itn < 2 * 8192;
                TItem nxt = cur; float wn[32]; float scn = 1.f;
                if (more) { nxt = decode(itn); titem_load(nxt, LANE, wn, scn); }
                titem_store(cur, LANE, wv, sc, scr);
                if (!more) break;
#pragma unroll
                for (int i = 0; i < 32; ++i) wv[i] = wn[i];
                sc = scn; cur = nxt; it = itn; } } }
        for (int it = F.gw; it < 2048; it += F.NGW) {
            const int l = it >> 10, kb = (it >> 4) & 63, nb = it & 15; const int kk0 = kb * 8, h = kk0 >> 7, r0 = kk0 & 127, n = nb * 64 + LANE;
            const float* uv = IN(I_WUV) + ((size_t)(l * 4 + h) * 128 + r0) * 64; const float* wb = IN(I_WBRB) + ((size_t)l * 256 + h * 64) * DM + n;
            float a[8];
#pragma unroll
            for (int j = 0; j < 8; ++j) a[j] = 0.f;
#pragma unroll 1
            for (int e0 = 0; e0 < 64; e0 += 16) { float bw[16];
#pragma unroll
                for (int e = 0; e < 16; ++e) bw[e] = *(const GAS float*)(wb + (size_t)(e0 + e) * DM);
#pragma unroll
                for (int e = 0; e < 16; ++e)
#pragma unroll
                    for (int j = 0; j < 8; ++j) a[j] += uv[j * 64 + e0 + e] * bw[e]; }
            u32x4 o; o.x = pk2h(a[0], a[1]); o.y = pk2h(a[2], a[3]); o.z = pk2h(a[4], a[5]); o.w = pk2h(a[6], a[7]);
            *(u32x4*)(WSP(f16, WS_WBC) + ((size_t)l * DM + n) * 512 + kk0) = o;
        }
        __syncthreads();
        if (blockIdx.x < 192) {
            const int l = blockIdx.x / 96, j0 = (blockIdx.x % 96) * 64;
            LAS float* cond = (LAS float*)F.lds;
            LAS float* part = (LAS float*)(F.lds + 65536);
            const float* c_in = IN(I_C);
            { const int t0_ = TID;
#pragma unroll 1
              for (int i0 = t0_; i0 < NB * DM; i0 += 512 * 8) { float cv_[8];
#pragma unroll
                for (int k_ = 0; k_ < 8; ++k_) cv_[k_] = *(const GAS float*)(c_in + i0 + 512 * k_);
#pragma unroll
                for (int k_ = 0; k_ < 8; ++k_) cond[i0 + 512 * k_] = cv_[k_] / (1.f + __expf(-cv_[k_])); } }
            __syncthreads();
            float a[16];
#pragma unroll
            for (int b = 0; b < 16; ++b) a[b] = 0.f;
            const float* wp = IN(I_ADAW) + (size_t)l * DM * 6144 + j0 + LANE;
#pragma unroll 1
            for (int k0 = F.wave * 128; k0 < F.wave * 128 + 128; k0 += 32) { float w[32];
#pragma unroll
                for (int i = 0; i < 32; ++i) w[i] = *(const GAS float*)(wp + (size_t)(k0 + i) * 6144);
#pragma unroll
                for (int b = 0; b < 16; ++b)
#pragma unroll
                    for (int i4 = 0; i4 < 8; ++i4) { const f32x4 cvv = *(const LAS f32x4*)(cond + b * 1024 + k0 + 4 * i4);
                        a[b] += (cvv.x * w[4 * i4] + cvv.y * w[4 * i4 + 1]) + (cvv.z * w[4 * i4 + 2] + cvv.w * w[4 * i4 + 3]); } }
#pragma unroll
            for (int b = 0; b < 16; ++b) part[(F.wave * 16 + b) * 64 + LANE] = a[b];
            __syncthreads();
            const float* ada_b = IN(I_ADAB); float* mod = WSP(float, WS_MOD);
            for (int i = TID; i < 1024; i += 512) { const int b = i >> 6, j = i & 63; float s = ada_b[l * 6144 + j0 + j];
#pragma unroll
                for (int w = 0; w < 8; ++w) s += part[(w * 16 + b) * 64 + j];
                mod[((size_t)l * 16 + b) * 6144 + j0 + j] = s; }
            __syncthreads();
        } else if (blockIdx.x == 192) {
            const float* rel_bias = IN(I_RELB); float* tabs = WSP(float, WS_MISC + 1024); float* lamv = WSP(float, WS_MISC);
            for (int i = TID; i < 12 * TABN; i += 512) { const int hh = i / TABN, idx = i % TABN, dist = idx - 255;
                float v; if (dist < 0) v = -INFINITY; else if (dist >= 128) v = 0.f; else v = (rel_bias[t5_bucket(dist) * 12 + hh] - rel_bias[31 * 12 + hh]) * LOG2E;
                tabs[i] = v; }
            float* tabs2 = WSP(float, WS_MISC + 32768);
            for (int i = TID; i < 12 * TAB2H; i += 512) { const int hh = i / TAB2H, sft = (i % TAB2H) / TAB2, j = (i % TAB2) + sft, dist = 224 - j;
                float v; if (dist < 0) v = -INFINITY; else if (dist >= 128) v = 0.f; else v = (rel_bias[t5_bucket(dist) * 12 + hh] - rel_bias[31 * 12 + hh]) * LOG2E;
                tabs2[i] = v; }
            if (F.wave < 2) { const int l = F.wave; const float* dl = IN(I_DLAM) + l * 256;
                const float s1 = wave_sum(dl[LANE] * dl[64 + LANE]), s2 = wave_sum(dl[128 + LANE] * dl[192 + LANE]);
                const float lam_init = 0.8f - 0.6f * expf(-0.3f * (float)l);
                if (LANE == 0) lamv[l] = expf(s1) - expf(s2) + lam_init; }
        }
    }
    xcd_barrier(bar, F.wave);
    if (threadIdx.x == 0) { unsigned ok = (gridDim.x == 256u) ? 1u : 0u, seen = 0u;
#pragma unroll 1
        for (int r = 0; r < 8; ++r) { const unsigned mk = xb_ld((unsigned*)launder(args.ws) + CW_LB + 64 * (16 + r)); if (__builtin_popcount(mk) != 1 || (seen & mk)) ok = 0u; seen |= mk; }
        MISC[19] = ok; }
    __syncthreads();
    { const int grp = blockIdx.x % 6, bi = blockIdx.x / 6, nbl = (F.G - grp + 5) / 6, l = grp / 3, which = grp % 3; const int lane = LANE;
      const float* modl = WSP(float, WS_MOD) + (size_t)l * 16 * 6144 + (which == 2 ? 3 : 0) * DM;
      LAS float* sh = (LAS float*)F.lds;
#pragma unroll 1
      for (int i0 = F.wave * 64 + lane; i0 < 16 * 1024; i0 += 512 * 8) { float sv_[8];
#pragma unroll
          for (int k_ = 0; k_ < 8; ++k_) { const int i2 = i0 + 512 * k_; sv_[k_] = *(const GAS float*)(modl + (size_t)(i2 >> 10) * 6144 + (i2 & 1023)); }
#pragma unroll
          for (int k_ = 0; k_ < 8; ++k_) sh[i0 + 512 * k_] = sv_[k_]; }
      __syncthreads();
      const f16* Bt = which == 0 ? WSP(f16, WS_WIN) + (size_t)l * PP * DM : (which == 1 ? WSP(f16, WS_WG) + (size_t)l * GCOLS * DM : WSP(f16, WS_W1) + (size_t)l * DFF * DM);
      const int nrows = which == 0 ? PP : (which == 1 ? GCOLS : DFF);
      float* cv = WSP(float, WS_CVEC) + (size_t)grp * 16 * 4096;
      u32x2 nxw[4]; unsigned nxc = 0u;
      { const int n = bi * 8 + F.wave;
        if (n < nrows) { nxc = ((const GAS unsigned*)launder(args.ws))[CW_CMAX + grp * 4096 + n];
#pragma unroll
          for (int j = 0; j < 4; ++j) nxw[j] = *(const GAS u32x2*)(Bt + (size_t)n * DM + 256 * j + lane * 4); } }
      for (int n = bi * 8 + F.wave; n < nrows; n += nbl * 8) {
          float w[16]; const unsigned cmb = nxc;
#pragma unroll
          for (int j = 0; j < 4; ++j) { const unsigned wx = nxw[j].x, wy = nxw[j].y; const f16x2 a = __builtin_bit_cast(f16x2, wx), b2 = __builtin_bit_cast(f16x2, wy);
              w[4 * j] = (float)a[0]; w[4 * j + 1] = (float)a[1]; w[4 * j + 2] = (float)b2[0]; w[4 * j + 3] = (float)b2[1]; }
          { const int n2 = n + nbl * 8;
            if (n2 < nrows) { nxc = ((const GAS unsigned*)launder(args.ws))[CW_CMAX + grp * 4096 + n2];
#pragma unroll
              for (int j = 0; j < 4; ++j) nxw[j] = *(const GAS u32x2*)(Bt + (size_t)n2 * DM + 256 * j + lane * 4); } }
          {
              const float cm = __uint_as_float(cmb), inv = cm > 0.f ? 127.f / cm : 0.f;
              unsigned char* wq = launder(args.ws) + (which == 0 ? WS_WQIN : (which == 1 ? WS_WQG : WS_WQ1)) + ((size_t)l * nrows + n) * 1024;
#pragma unroll
              for (int j = 0; j < 4; ++j) { unsigned pk = 0u;
#pragma unroll
                  for (int e = 0; e < 4; ++e) pk |= ((unsigned)(int)__builtin_rintf(w[4 * j + e] * inv) & 255u) << (8 * e);
                  *(unsigned*)(wq + 256 * j + lane * 4) = pk; }
              if (lane == 0) WSP(float, WS_SB)[grp * 4096 + n] = cm * (1.f / 127.f); }
          float a[16];
#pragma unroll
          for (int b = 0; b < 16; ++b) { a[b] = 0.f;
#pragma unroll
              for (int j = 0; j < 4; ++j) { const f32x4 sv = *(const LAS f32x4*)(sh + b * 1024 + 256 * j + lane * 4); a[b] += (w[4 * j] * sv.x + w[4 * j + 1] * sv.y) + (w[4 * j + 2] * sv.z + w[4 * j + 3] * sv.w); } }
#pragma unroll
          for (int st = 0; st < 4; ++st) { const int msk = 32 >> st, nh = 8 >> st; const bool up = (lane & msk) != 0;
#pragma unroll
              for (int i3 = 0; i3 < nh; ++i3) { const float send = up ? a[i3] : a[i3 + nh], keep = up ? a[i3 + nh] : a[i3]; a[i3] = keep + __shfl_xor(send, msk); } }
          a[0] += __shfl_xor(a[0], 1); a[0] += __shfl_xor(a[0], 2);
          if ((lane & 3) == 0) cv[(size_t)(((lane >> 5) & 1) * 8 + ((lane >> 4) & 1) * 4 + ((lane >> 3) & 1) * 2 + ((lane >> 2) & 1)) * 4096 + n] = a[0];
      }
      __syncthreads();
    }

#pragma unroll 1
    for (int l = 0; l < DEPTH; ++l) {
        if (LL == 0) for (int rep = 0; rep < REP_N1; ++rep) {
        { const float* xcur = IN(I_X); const float* modl = WSP(float, WS_MOD); const float* nw = IN(I_NMIX); unsigned char* U8 = (unsigned char*)xout + (size_t)64 * MiB; float* rf = (float*)launder(args.ws) + CW_RF;
          for (int m0 = GWX * 16; m0 < MTOK; m0 += F.NGW * 16) { const int b = m0 / SEQ;
            norm_quant_rows16_0(xcur, nw, modl + (size_t)b * 6144 + 1 * DM, (f16*)xout, U8, rf, m0, LANE); } }
        xcd_barrier(bar, F.wave);
        if (__builtin_amdgcn_readfirstlane((int)MISC[19])) { for (unsigned i = 0; i < (blockIdx.x & 7u); ++i) __builtin_amdgcn_s_sleep(20); }
        }
        for (int rep = 0; rep < REP_G1; ++rep) {
#ifndef NO_G1
        { pg8::Gemm g{(const f16*)((const unsigned char*)xout + (size_t)64 * MiB), (const f16*)(launder(args.ws) + WS_WQIN + (size_t)LL * PP * 1024), MTOK, PP, DM / 2}; pg8::StaticOrder S; S.init(MTOK, PP, F.G, (int)blockIdx.x);
          pg8::EpiNormF16<0, true> E{WSP(f16, WS_R1), PP, GAPP};
          pg8::fill_tabs_q((const float*)launder(args.ws) + CW_RF, WSP(float, WS_CVEC) + (size_t)(LL * 3 + 0) * 16 * 4096, (const float*)nullptr, WSP(float, WS_SB) + (LL * 3 + 0) * 4096, S, TID);
          pg8::gemm_phase<pg8::EpiNormF16<0, true>, pg8::StaticOrder, true, true, true>(F.lds, g, S, E, F.wave); }
#endif
        SEAM_L();
        }
        for (int rep = 0; rep < launder_i(REP_SEL); ++rep) {
        { const f16* P = WSP(f16, WS_R1); f16* KVN = WSP(f16, WS_KVN); const float* kvw = IN(I_KVNORM) + LL * 128; float* kmean = WSP(float, WS_MISC + 65536);
          { const int lane = LANE, sub = lane >> 4, cl = lane & 15;
            float kw[8];
#pragma unroll
            for (int e = 0; e < 8; ++e) kw[e] = kvw[cl * 8 + e];
            for (int m0 = GWX * 16; m0 < MTOK; m0 += 16 * F.NGW) {
                f16x8 v[4]; float ss[4];
#pragma unroll
                for (int j = 0; j < 4; ++j) v[j] = __builtin_bit_cast(f16x8, *(const GAS u32x4*)(P + (size_t)(m0 + j * 4 + sub) * PP + (size_t)((m0 + j * 4 + sub) >> 12) * GAPP + C_BKV + cl * 8));
#pragma unroll
                for (int j = 0; j < 4; ++j) { ss[j] = 0.f;
#pragma unroll
                    for (int e = 0; e < 8; ++e) ss[j] += (float)v[j][e] * (float)v[j][e]; }
#pragma unroll
                for (int o = 1; o < 16; o <<= 1)
#pragma unroll
                    for (int j = 0; j < 4; ++j) ss[j] += __shfl_xor(ss[j], o);
#pragma unroll
                for (int j = 0; j < 4; ++j) { const float r = __builtin_amdgcn_rsqf(ss[j] * (1.f / 128.f) + EPS);
                    u32x4 w; w.x = pk2h((float)v[j][0] * r * kw[0], (float)v[j][1] * r * kw[1]); w.y = pk2h((float)v[j][2] * r * kw[2], (float)v[j][3] * r * kw[3]);
                    w.z = pk2h((float)v[j][4] * r * kw[4], (float)v[j][5] * r * kw[5]); w.w = pk2h((float)v[j][6] * r * kw[6], (float)v[j][7] * r * kw[7]);
                    *(GAS u32x4*)(KVN + (size_t)(m0 + j * 4 + sub) * 128 + cl * 8) = w; }
            } }
          for (int it = (gridDim.x == 256u) ? (((int)(blockIdx.x >> 3) * 8 + F.wave < 64) ? (int)(blockIdx.x & 7u) * 64 + (int)(blockIdx.x >> 3) * 8 + F.wave : NB * 4 * 8) : GW; it < NB * 4 * 8; it += F.NGW) {
            const int b = it >> 5, h = (it >> 3) & 3, blk = it & 7; const int lane = LANE, rg = lane >> 3, ch = lane & 7;
            const f16* src = P + ((size_t)b * SEQ + blk * 256 + rg) * PP + (size_t)(b >> 1) * GAPP + C_CK + h * 64 + ch * 8; float a8[8];
#pragma unroll
            for (int e = 0; e < 8; ++e) a8[e] = 0.f;
#pragma unroll
            for (int r = 0; r < 32; ++r) { const f16x8 v = __builtin_bit_cast(f16x8, *(const GAS u32x4*)(src + (size_t)(8 * r) * PP));
#pragma unroll
                for (int e = 0; e < 8; ++e) a8[e] += (float)v[e]; }
#pragma unroll
            for (int e = 0; e < 8; ++e) { a8[e] += __shfl_xor(a8[e], 8); a8[e] += __shfl_xor(a8[e], 16); a8[e] += __shfl_xor(a8[e], 32); }
            if (rg == 0) { f32x4 o0 = {a8[0], a8[1], a8[2], a8[3]}, o1 = {a8[4], a8[5], a8[6], a8[7]};
                *(f32x4*)(kmean + (size_t)it * 64 + ch * 8) = o0 * (1.f / 256.f); *(f32x4*)(kmean + (size_t)it * 64 + ch * 8 + 4) = o1 * (1.f / 256.f); } } }
#ifndef NAIVE_DSA
#ifdef NAIVE_SELECT
        { const f16* P = WSP(f16, WS_R1); unsigned* MASK = WSP(unsigned, WS_MASK); LAS unsigned* keyl = (LAS unsigned*)(F.lds + F.wave * 16384 + 8192);
          for (int task = GW; task < NB * SEQ; task += F.NGW) {
            const int b = task / SEQ, t = (task % SEQ + 37 * b) % SEQ; const size_t row = (size_t)b * SEQ + t; const int lane = LANE;
            const int nslots = (t >> 6) + 1;
            unsigned sel = 0xffffffffu;
            if (t >= 256) {
                const f16* iq = P + row * PP + C_BIQ; const f16* iwp = P + row * PP + C_BIW;
#pragma unroll 1
                for (int j = 0; j < nslots; ++j) { unsigned kk = 0u; const int k = 64 * j + lane;
                    if (k <= t) { const f16* ik = P + ((size_t)b * SEQ + k) * PP + C_BIK; f16x8 kv[4];
#pragma unroll
                        for (int c = 0; c < 4; ++c) kv[c] = *(const f16x8*)(ik + 8 * c);
                        float sc = 0.f;
#pragma unroll 1
                        for (int hh = 0; hh < 8; ++hh) { float d = 0.f;
#pragma unroll
                            for (int c = 0; c < 4; ++c) { const f16x8 qv = *(const f16x8*)(iq + hh * 32 + 8 * c);
#pragma unroll
                                for (int e = 0; e < 8; ++e) d += (float)qv[e] * (float)kv[c][e]; }
                            sc += fmaxf(d, 0.f) * (float)iwp[hh]; }
                        kk = ordkey(sc); }
                    keyl[k] = kk; }
                unsigned thr = 0u;
#pragma unroll 1
                for (int bit = 31; bit >= 0; --bit) { const unsigned cand = thr | (1u << bit); int c = 0;
#pragma unroll 1
                    for (int j = 0; j < nslots; ++j) c += (keyl[64 * j + lane] >= cand) ? 1 : 0;
                    if (wave_isum(c) >= 256) thr = cand; }
                int cgt = 0;
#pragma unroll 1
                for (int j = 0; j < nslots; ++j) cgt += (keyl[64 * j + lane] > thr) ? 1 : 0;
                cgt = wave_isum(cgt);
                const int need = 256 - cgt; int run = 0; sel = 0u;
#pragma unroll 1
                for (int j = 0; j < nslots; ++j) { const unsigned kk = keyl[64 * j + lane]; const bool tie = kk == thr; const unsigned long long bal = __ballot(tie);
                    const int pre = run + __popcll(bal & ((1ull << lane) - 1ull));
                    if (kk > thr || (tie && pre < need)) sel |= 1u << j;
                    run += __popcll(bal); }
            }
            const int bb = lane & 31, kkq = 32 * (bb >> 4) + (bb & 3) + 8 * ((bb & 15) >> 2) + 4 * (lane >> 5);
            unsigned* mrow = MASK + ((size_t)(b * 64 + (t >> 5)) * 32) * 64 + (t & 31);
#pragma unroll 1
            for (int j = 0; j < nslots; ++j) { const unsigned long long bal = __ballot((sel >> j) & 1u);
                const unsigned long long w64 = __ballot((bal >> kkq) & 1ull);
                if (lane == 0) { mrow[j * 64] = (unsigned)w64; mrow[j * 64 + 32] = (unsigned)(w64 >> 32); } }
          } }
#else
        { const f16* P = WSP(f16, WS_R1); unsigned* MASK = WSP(unsigned, WS_MASK);
          unsigned* qctr = (unsigned*)launder(args.ws) + CW_QUEUE + 512 * ((rep * 2 + LL) * 4 + 3);
          LAS unsigned* hist = (LAS unsigned*)F.lds;
          constexpr int HSTR = 257;
          if (TID == 0) MISC[17] = 0u;
          for (int uk = 0;; ++uk) {
            const int ui = unit_pick(uk, 128, qctr, MISC);
            if (ui < 0) break;
            const int qg = 63 - ((ui & 127) >> 1), b = 2 * (ui >> 7) + (ui & 1); const int lane = LANE, tid = F.wave * 64 + lane, r32 = lane & 31, hi = lane >> 5;
            const int ntiles = (qg >> 1) + 1, t = 32 * qg + r32; const size_t brow = (size_t)b * SEQ; const f16* Pg = P + (size_t)(b >> 1) * GAPP;
            unsigned* mbase = MASK + ((size_t)(b * 64 + qg) * 32) * 64 + lane;
            if (qg < 8) { for (int kt = F.wave; kt < ntiles; kt += 8) mbase[kt * 64] = 0xffffffffu; continue; }
            unsigned keys[4][32];
            {
              const f16* iqp = Pg + (brow + t) * PP + C_BIQ; const f16* iwp = Pg + (brow + t) * PP + C_BIW;
              LAS u32x4* iqL = (LAS u32x4*)(F.lds + 45056);
              const f16x8 iwv = *(const pg8::g_f16x8*)iwp;
              f16x8 vown[2];
#pragma unroll
              for (int s2 = 0; s2 < 2; ++s2) vown[s2] = *(const pg8::g_f16x8*)(iqp + F.wave * 32 + 16 * s2 + 8 * hi);
              f16x8 kfr[4][2][2];
#pragma unroll
              for (int ti = 0; ti < 4; ++ti) { const int kt = F.wave + 8 * ti;
#pragma unroll
                for (int half = 0; half < 2; ++half) { const f16* ikp = Pg + (brow + 64 * kt + 32 * half + r32) * PP + C_BIK + 8 * hi;
                    if (kt < ntiles) { kfr[ti][half][0] = *(const pg8::g_f16x8*)ikp; kfr[ti][half][1] = *(const pg8::g_f16x8*)(ikp + 16); }
                    else { kfr[ti][half][0] = (f16x8)(f16)0; kfr[ti][half][1] = (f16x8)(f16)0; } } }
              unsigned sgnbits = 0u;
#pragma unroll
              for (int h = 0; h < 8; ++h) sgnbits |= ((float)iwv[h] < 0.f) ? (1u << h) : 0u;
              { float wsel = 0.f;
#pragma unroll
                for (int h = 0; h < 8; ++h) wsel = (h == F.wave) ? (float)iwv[h] : wsel;
#pragma unroll
                for (int s2 = 0; s2 < 2; ++s2) { const f16x8 v = vown[s2];
                    u32x4 pw; pw.x = pk2h(wsel * (float)v[0], wsel * (float)v[1]); pw.y = pk2h(wsel * (float)v[2], wsel * (float)v[3]); pw.z = pk2h(wsel * (float)v[4], wsel * (float)v[5]); pw.w = pk2h(wsel * (float)v[6], wsel * (float)v[7]);
                    iqL[(F.wave * 2 + s2) * 64 + lane] = pw; } }
              __syncthreads();
              if (F.wave == 0) {
#pragma unroll
                for (int s2 = 0; s2 < 2; ++s2) { float ca[8];
#pragma unroll
                    for (int e = 0; e < 8; ++e) ca[e] = 0.f;
#pragma unroll
                    for (int h = 0; h < 8; ++h) { const f16x8 v = __builtin_bit_cast(f16x8, iqL[(h * 2 + s2) * 64 + lane]);
#pragma unroll
                        for (int e = 0; e < 8; ++e) ca[e] += (float)v[e]; }
                    u32x4 pw; pw.x = pk2h(ca[0], ca[1]); pw.y = pk2h(ca[2], ca[3]); pw.z = pk2h(ca[4], ca[5]); pw.w = pk2h(ca[6], ca[7]);
                    iqL[(16 + s2) * 64 + lane] = pw; } }
              __syncthreads();
#if REP_SCORE > 1
#pragma unroll 1
              for (int rs = 0; rs < launder_i(REP_SCORE); ++rs)
#endif
#pragma unroll
              for (int ti = 0; ti < 4; ++ti) { const int kt = F.wave + 8 * ti;
                if (kt < ntiles) { const int k0 = 64 * kt;
#pragma unroll
                    for (int half = 0; half < 2; ++half) { const f16x8 kf0 = kfr[ti][half][0], kf1 = kfr[ti][half][1];
                        fa::f32x16 sc;
#pragma unroll
                        for (int r = 0; r < 16; ++r) sc[r] = 0.f;
                        sc = __builtin_amdgcn_mfma_f32_32x32x16_f16(kf0, __builtin_bit_cast(f16x8, iqL[16 * 64 + lane]), sc, 0, 0, 0);
                        sc = __builtin_amdgcn_mfma_f32_32x32x16_f16(kf1, __builtin_bit_cast(f16x8, iqL[17 * 64 + lane]), sc, 0, 0, 0);
#pragma unroll 2
                        for (int h = 0; h < 8; ++h) { fa::f32x16 a;
#pragma unroll
                            for (int r = 0; r < 16; ++r) a[r] = 0.f;
                            a = __builtin_amdgcn_mfma_f32_32x32x16_f16(kf0, __builtin_bit_cast(f16x8, iqL[(2 * h) * 64 + lane]), a, 0, 0, 0);
                            a = __builtin_amdgcn_mfma_f32_32x32x16_f16(kf1, __builtin_bit_cast(f16x8, iqL[(2 * h + 1) * 64 + lane]), a, 0, 0, 0);
                            const float sg = ((sgnbits >> h) & 1u) ? -1.f : 1.f;
#pragma unroll
                            for (int r = 0; r < 16; ++r) sc[r] = __builtin_fmaf(__builtin_fabsf(a[r]), sg, sc[r]); }
#pragma unroll
                        for (int r = 0; r < 16; ++r) keys[ti][16 * half + r] = ordkey(sc[r]);
                        if (k0 + 63 > 32 * qg) {
#pragma unroll
                            for (int r = 0; r < 16; ++r) { const int kidx = k0 + 32 * half + fa::crow(r, hi); keys[ti][16 * half + r] = (kidx <= t) ? keys[ti][16 * half + r] : 0u; } } }
                } else {
#pragma unroll
                    for (int e = 0; e < 32; ++e) keys[ti][e] = 0u; } } }
            unsigned prefix = 0u;
#if REP_RADIX > 1
#pragma unroll 1
            for (int rr = 0; rr < launder_i(REP_RADIX); ++rr)
#endif
#pragma unroll 1
            for (int pass = 0; pass < 4; ++pass) { const int shift = 24 - 8 * pass;
                LAS unsigned* qst = (LAS unsigned*)(F.lds + 40960 + (pass & 1) * 512); LAS unsigned* qstn = (LAS unsigned*)(F.lds + 40960 + ((pass & 1) ^ 1) * 512);
                for (int i2 = tid; i2 < 32 * HSTR; i2 += 512) hist[i2] = 0u;
                __syncthreads();
                if (pass > 0) prefix = qst[2 * r32];
                const int pshift = (pass == 0) ? 31 : shift + 8; const unsigned pmask = (pass == 0) ? 0u : 0xffffffffu;
#pragma unroll
                for (int ti = 0; ti < 4; ++ti)
#pragma unroll
                    for (int e = 0; e < 32; ++e) { const unsigned k = keys[ti][e];
                        const unsigned x = ((k >> pshift) ^ prefix) & pmask; const unsigned inc = 1u - __builtin_elementwise_min(x, 1u);
                        if (F.wave + 8 * ti < ntiles) __hip_atomic_fetch_add(hist + r32 * HSTR + ((k >> shift) & 255u), inc, __ATOMIC_RELAXED, __HIP_MEMORY_SCOPE_WORKGROUP);
                        if ((e & 7) == 7) __builtin_amdgcn_sched_barrier(0); }
                __syncthreads();
#pragma unroll
                for (int qq = 0; qq < 4; ++qq) { const int q = F.wave * 4 + qq; const int need = (pass == 0) ? 256 : (int)qst[2 * q + 1]; const unsigned pfx = (pass == 0) ? 0u : qst[2 * q];
                    const int c0 = (int)hist[q * HSTR + 4 * lane], c1 = (int)hist[q * HSTR + 4 * lane + 1], c2 = (int)hist[q * HSTR + 4 * lane + 2], c3 = (int)hist[q * HSTR + 4 * lane + 3];
                    const int c = c0 + c1 + c2 + c3; int S = c;
#pragma unroll
                    for (int off = 1; off < 64; off <<= 1) { const int v = __shfl_down(S, off); if (lane + off < 64) S += v; }
                    const unsigned long long bal = __ballot(S >= need); const int L = __popcll(bal) - 1;
                    if (lane == L) { int cum = S - c, d;
                        if (cum + c3 >= need) d = 3; else { cum += c3; if (cum + c2 >= need) d = 2; else { cum += c2; if (cum + c1 >= need) d = 1; else { cum += c1; d = 0; } } }
                        qstn[2 * q] = (pfx << 8) | (unsigned)(4 * L + d); qstn[2 * q + 1] = (unsigned)(need - cum); } }
                __syncthreads();
            }
            const unsigned thr = ((LAS unsigned*)(F.lds + 40960))[2 * r32];
#pragma unroll
            for (int ti = 0; ti < 4; ++ti) { const int kt = F.wave + 8 * ti;
                if (kt < ntiles) { unsigned w = 0u;
#pragma unroll
                    for (int e = 0; e < 32; ++e) { w |= (keys[ti][e] >= thr) ? (1u << e) : 0u; if ((e & 7) == 7) __builtin_amdgcn_sched_barrier(0); }
                    mbase[kt * 64] = w; } }
          } }
#endif
#endif
        SEAM_L_ARRIVE();
        }
        for (int rep = 0; rep < REP_ATT; ++rep) {
        {
            LAS float* scl = (LAS float*)(F.lds + F.wave * 16384); LAS unsigned* keyl = (LAS unsigned*)(F.lds + F.wave * 16384 + 8192);
#ifndef NO_DIFF
            { const f16* P = WSP(f16, WS_R1); f16* OA = WSP(f16, WS_OA); const float* tabs = WSP(float, WS_MISC + 32768); const float* subln = IN(I_SUBLN) + LL * 128;
              unsigned* qctr = (unsigned*)launder(args.ws) + CW_QUEUE + 512 * ((rep * 2 + LL) * 4 + 0);
              LAS float* tabl = (LAS float*)(F.lds + fa::TAB_OFF); LAS float* subl = (LAS float*)(F.lds + fa::SUB_OFF);
              { const int tid0 = TID;
                { float tv_[5];
#pragma unroll
                for (int k_ = 0; k_ < 5; ++k_) tv_[k_] = *(const GAS float*)(tabs + tid0 + 512 * k_);
#pragma unroll
                for (int k_ = 0; k_ < 5; ++k_) tabl[tid0 + 512 * k_] = tv_[k_]; }
                if (tid0 < 128) subl[tid0] = subln[tid0] * ((LL == 0) ? 0.8f : 0.6444909f); }
              if (TID == 0) MISC[17] = 0u;
              const float lam_l = WSP(float, WS_MISC)[LL];
              for (int uk = 0;; ++uk) {
                const int ui = unit_pick(uk, 64, qctr, MISC);
                if (ui < 0) break;
                const int qb = 7 - ((ui & 63) >> 3), bh = 8 * (ui >> 6) + (ui & 7), b = bh >> 2, h = bh & 3; const int lane = LANE, tid = F.wave * 64 + lane;
                const int qpos0 = qb * 256 + F.wave * 32, ntiles = 4 * qb + 4; const size_t brow = (size_t)b * SEQ; const f16* Pg = P + (size_t)(b >> 1) * GAPP;
                fa::f32x16 o0[4];
                fa::attn_pass_pipe<64, 128, 0, 3>(F.lds, F.wave, lane, Pg + (brow + qpos0) * PP + C_AQ + h * 128, PP, Pg + brow * PP + C_AK + h * 128, PP, Pg + brow * PP + C_AV + h * 128, PP, ntiles, qpos0, tabl + h * TAB2H, 0u, 0, nullptr, o0);
                { LAS unsigned* st = (LAS unsigned*)(F.lds + fa::STASH_OFF + F.wave * 8192) + lane;
#pragma unroll
                  for (int blk = 0; blk < 4; ++blk)
#pragma unroll
                    for (int r = 0; r < 16; r += 2) st[(blk * 8 + (r >> 1)) * 64] = pk2h(o0[blk][r], o0[blk][r + 1]); }
                fa::attn_pass_pipe<64, 128, 0, 3>(F.lds, F.wave, LANE, Pg + (brow + qpos0) * PP + C_AQ + h * 128 + 64, PP, Pg + brow * PP + C_AK + h * 128 + 64, PP, Pg + brow * PP + C_AV + h * 128, PP, ntiles, qpos0, tabl + h * TAB2H, 0u, 0, nullptr, o0);
                const int lane2 = LANE, hi = lane2 >> 5; float ss = 0.f; const float lam = lam_l;
                { const LAS unsigned* st = (const LAS unsigned*)(F.lds + fa::STASH_OFF + F.wave * 8192) + lane2;
#pragma unroll
                  for (int blk = 0; blk < 4; ++blk)
#pragma unroll
                    for (int r = 0; r < 16; r += 2) { const f16x2 v = __builtin_bit_cast(f16x2, st[(blk * 8 + (r >> 1)) * 64]);
                        const float a0 = (float)v[0] - lam * o0[blk][r], a1 = (float)v[1] - lam * o0[blk][r + 1]; o0[blk][r] = a0; o0[blk][r + 1] = a1; ss += a0 * a0 + a1 * a1; } }
                ss = fa::half_sum(ss);
                const float rstd = 1.f / sqrtf(ss * (1.f / 128.f) + EPS);
#pragma unroll
                for (int blk = 0; blk < 4; ++blk)
#pragma unroll
                    for (int r = 0; r < 16; ++r) o0[blk][r] *= rstd * subl[32 * blk + fa::crow(r, hi)];
                fa::store_o_rows<128>(o0, F.lds, F.wave, lane2, OA + (brow + qpos0) * 512 + h * 128, 512);
              } }
#endif
            SEAM_L_WAIT();
#ifndef NO_MOBA
#ifdef NAIVE_MOBA
            { const f16* P = WSP(f16, WS_R1); f16* OC = WSP(f16, WS_OC); const float* tabs = WSP(float, WS_MISC + 1024); const float* kmean = WSP(float, WS_MISC + 65536);
              for (int task = GW; task < NB * 4 * SEQ; task += F.NGW) {
                const int bh = task / SEQ, b = bh >> 2, h = bh & 3, t = (task % SEQ + 37 * bh) % SEQ; const size_t row = (size_t)b * SEQ + t; const int j = t >> 8;
                const f16* q = P + row * PP + C_CQ + h * 64; const float qd = (float)q[LANE];
                float gate[8];
#pragma unroll
                for (int n = 0; n < 8; ++n) gate[n] = (n < j) ? wave_sum(qd * kmean[((size_t)bh * 8 + n) * 64 + LANE]) : -INFINITY;
                unsigned selb = 1u << j;
#pragma unroll
                for (int pick = 0; pick < 3; ++pick) { float best = -INFINITY; int bi = -1;
#pragma unroll
                    for (int n = 0; n < 8; ++n) if (!((selb >> n) & 1u) && gate[n] > best) { best = gate[n]; bi = n; }
                    if (bi >= 0) selb |= 1u << bi; }
                unsigned sel = 0u;
#pragma unroll
                for (int jj = 0; jj < 32; ++jj) sel |= ((selb >> (jj >> 2)) & 1u) << jj;
                float o[1];
                naive_attn<64, 64>(scl, q, P + (size_t)b * SEQ * PP + C_CK + h * 64, PP, P + (size_t)b * SEQ * PP + C_CV + h * 64, PP, t, sel, tabs + (8 + h) * TABN, LANE, o);
                OC[row * 256 + h * 64 + LANE] = (f16)o[0];
              } }
#else
            { const f16* P = WSP(f16, WS_R1); f16* OC = WSP(f16, WS_OC); const float* tabs2 = WSP(float, WS_MISC + 32768); const float* kmean = WSP(float, WS_MISC + 65536);
              unsigned* qctr = (unsigned*)launder(args.ws) + CW_QUEUE + 512 * ((rep * 2 + LL) * 4 + 1);
              LAS float* tabl = (LAS float*)(F.lds + fa::TAB_OFF);
              __syncthreads();
              { float tv_[5];
#pragma unroll
                for (int k_ = 0; k_ < 5; ++k_) tv_[k_] = *(const GAS float*)(tabs2 + 8 * TAB2H + TID + 512 * k_);
#pragma unroll
                for (int k_ = 0; k_ < 5; ++k_) tabl[TID + 512 * k_] = tv_[k_]; }
              if (TID == 0) MISC[17] = 0u;
              for (int uk = 0;; ++uk) {
                const int ui = unit_pick(uk, 64, qctr, MISC);
                if (ui < 0) break;
                const int qb = 7 - ((ui & 63) >> 3), bh = 8 * (ui >> 6) + (ui & 7), b = bh >> 2, h = bh & 3; const int lane = LANE, tid = F.wave * 64 + lane, r32 = lane & 31, hi = lane >> 5;
                const int qpos0 = qb * 256 + F.wave * 32, ntiles = 4 * qb + 4; const size_t brow = (size_t)b * SEQ; const f16* Pg = P + (size_t)(b >> 1) * GAPP;
                const f16* Qw = Pg + (brow + qpos0) * PP + C_CQ + h * 64;
                unsigned selb = 0u;
                { f16x8 qv[4];
#pragma unroll
                  for (int d0 = 0; d0 < 4; ++d0) qv[d0] = *(const f16x8*)(Qw + (size_t)r32 * PP + d0 * 16 + hi * 8);
                  LAS float* kmL = (LAS float*)(F.lds + 98304);
                  kmL[tid] = kmean[(size_t)bh * 512 + tid];
                  __syncthreads();
                  float gate[8];
#pragma unroll
                  for (int n = 0; n < 8; ++n) { float g = 0.f;
#pragma unroll
                    for (int d0 = 0; d0 < 4; ++d0) { const f32x4 k0 = *(const LAS f32x4*)(kmL + n * 64 + 8 * hi + 16 * d0), k1 = *(const LAS f32x4*)(kmL + n * 64 + 8 * hi + 16 * d0 + 4);
                        g += ((float)qv[d0][0] * k0.x + (float)qv[d0][1] * k0.y) + ((float)qv[d0][2] * k0.z + (float)qv[d0][3] * k0.w) + ((float)qv[d0][4] * k1.x + (float)qv[d0][5] * k1.y) + ((float)qv[d0][6] * k1.z + (float)qv[d0][7] * k1.w); }
                    g = fa::half_sum(g);
                    gate[n] = (n < qb) ? g : -INFINITY; }
#pragma unroll
                  for (int pick = 0; pick < 3; ++pick) { float best = -INFINITY; int bi = -1;
#pragma unroll
                    for (int n = 0; n < 8; ++n) if (!((selb >> n) & 1u) && gate[n] > best) { best = gate[n]; bi = n; }
                    if (bi >= 0) selb |= 1u << bi; } }
                fa::f32x16 o[2];
                fa::attn_pass_pipe<64, 64, 1, 4>(F.lds, F.wave, lane, Qw, PP, Pg + brow * PP + C_CK + h * 64, PP, Pg + brow * PP + C_CV + h * 64, PP, ntiles, qpos0, tabl + h * TAB2H, selb, qb, nullptr, o);
                fa::store_o_rows<64>(o, F.lds, F.wave, lane, OC + (brow + qpos0) * 256 + h * 64, 256);
              } }
#endif
#endif
#ifndef NO_DSA
#ifdef NAIVE_DSA
            { const f16* P = WSP(f16, WS_R1); f16* OB = WSP(f16, WS_OB); const f16* KVN = WSP(f16, WS_KVN); const float* tabs = WSP(float, WS_MISC + 1024);
              for (int task = GW; task < NB * SEQ; task += F.NGW) {
                const int b = task / SEQ, t = (task % SEQ + 37 * b) % SEQ; const size_t row = (size_t)b * SEQ + t; const int lane = LANE;
                unsigned sel = 0xffffffffu;
                if (t >= 256) {
                    const int nslots = (t >> 6) + 1; const f16* iq = P + row * PP + C_BIQ; const f16* iwp = P + row * PP + C_BIW;
#pragma unroll 1
                    for (int j = 0; j < nslots; ++j) { unsigned kk = 0u; const int k = 64 * j + lane;
                        if (k <= t) { const f16* ik = P + ((size_t)b * SEQ + k) * PP + C_BIK; f16x8 kv[4];
#pragma unroll
                            for (int c = 0; c < 4; ++c) kv[c] = *(const f16x8*)(ik + 8 * c);
                            float s = 0.f;
#pragma unroll 1
                            for (int hh = 0; hh < 8; ++hh) { float d = 0.f;
#pragma unroll
                                for (int c = 0; c < 4; ++c) { const f16x8 qv = *(const f16x8*)(iq + hh * 32 + 8 * c);
#pragma unroll
                                    for (int e = 0; e < 8; ++e) d += (float)qv[e] * (float)kv[c][e]; }
                                s += fmaxf(d, 0.f) * (float)iwp[hh]; }
                            kk = ordkey(s); }
                        keyl[k] = kk; }
                    unsigned thr = 0u;
#pragma unroll 1
                    for (int bit = 31; bit >= 0; --bit) { const unsigned cand = thr | (1u << bit); int c = 0;
#pragma unroll 1
                        for (int j = 0; j < nslots; ++j) c += (keyl[64 * j + lane] >= cand) ? 1 : 0;
                        if (wave_isum(c) >= 256) thr = cand; }
                    int cgt = 0;
#pragma unroll 1
                    for (int j = 0; j < nslots; ++j) cgt += (keyl[64 * j + lane] > thr) ? 1 : 0;
                    cgt = wave_isum(cgt);
                    const int need = 256 - cgt; int run = 0; sel = 0u;
#pragma unroll 1
                    for (int j = 0; j < nslots; ++j) { const unsigned kk = keyl[64 * j + lane]; const bool tie = kk == thr; const unsigned long long bal = __ballot(tie);
                        const int pre = run + __popcll(bal & ((1ull << lane) - 1ull));
                        if (kk > thr || (tie && pre < need)) sel |= 1u << j;
                        run += __popcll(bal); }
                }
#pragma unroll 1
                for (int h = 0; h < 4; ++h) { float o[2];
                    naive_attn<128, 128>(scl, P + row * PP + C_BQ + h * 128, KVN + (size_t)b * SEQ * 128, 128, KVN + (size_t)b * SEQ * 128, 128, t, sel, tabs + (4 + h) * TABN, LANE, o);
                    OB[row * 512 + h * 128 + LANE] = (f16)o[0]; OB[row * 512 + h * 128 + 64 + LANE] = (f16)o[1]; }
              } }
#else
            { const f16* P = WSP(f16, WS_R1); f16* OB = WSP(f16, WS_OB); const f16* KVN = WSP(f16, WS_KVN); const float* tabs2 = WSP(float, WS_MISC + 32768); const unsigned* MASK = WSP(unsigned, WS_MASK);
              unsigned* qctr = (unsigned*)launder(args.ws) + CW_QUEUE + 512 * ((rep * 2 + LL) * 4 + 2);
              LAS float* tabl = (LAS float*)(F.lds + fa::TAB_OFF);
              __syncthreads();
              { float tv_[5];
#pragma unroll
                for (int k_ = 0; k_ < 5; ++k_) tv_[k_] = *(const GAS float*)(tabs2 + 4 * TAB2H + TID + 512 * k_);
#pragma unroll
                for (int k_ = 0; k_ < 5; ++k_) tabl[TID + 512 * k_] = tv_[k_]; }
              if (TID == 0) MISC[17] = 0u;
              for (int uk = 0;; ++uk) {
                const int ui = unit_pick(uk, 64, qctr, MISC);
                if (ui < 0) break;
                const int qi = 31 - ((ui & 63) >> 1), b = 2 * (ui >> 6) + (ui & 1); const int lane = LANE, tid = F.wave * 64 + lane, r32 = lane & 31, hi = lane >> 5;
                const int head = F.wave & 3, qpos0 = 64 * qi + 32 * (F.wave >> 2), ntiles = qi + 1; const size_t brow = (size_t)b * SEQ; const f16* Pg = P + (size_t)(b >> 1) * GAPP;
                fa::f32x16 o[4];
                fa::attn_pass_dma<128, 128, 2, 4>(F.lds, F.wave, lane, Pg + (brow + qpos0) * PP + C_BQ + head * 128, PP, KVN + brow * 128, 128, KVN + brow * 128, 128, ntiles, qpos0, tabl + head * TAB2H, 0u, 0,
                                           MASK + ((size_t)(b * 64 + (qpos0 >> 5)) * 32) * 64, o);
                fa::store_o_rows<128>(o, F.lds, F.wave, lane, OB + (brow + qpos0) * 512 + head * 128, 512);
              } }
#endif
#endif
        }
        SEAM_L();
        }
        for (int rep = 0; rep < REP_G2; ++rep) {
#ifndef NO_G2
        { pg8::StaticOrder S; S.init(MTOK, DM, F.G, (int)blockIdx.x);
#pragma unroll 1
          for (int yi = 0; yi < 3; ++yi) { const int y = launder_i(yi), Ky = (y == 2) ? 256 : 512;
            pg8::Gemm g{WSP(f16, WS_OA + (size_t)y * 32 * MiB), WSP(f16, WS_WA + (size_t)y * 2 * MiB) + (size_t)LL * DM * Ky, MTOK, DM, Ky}; pg8::EpiF16<0> E{WSP(f16, WS_R1) + (size_t)y * YSTR, DM, GAPY};
            pg8::gemm_phase<pg8::EpiF16<0>, pg8::StaticOrder, true, true>(F.lds, g, S, E, F.wave); } }
#endif
        asm volatile("s_waitcnt vmcnt(0)" ::: "memory");
        __builtin_amdgcn_fence(__ATOMIC_ACQUIRE, "agent");
        __syncthreads();
        }
#ifndef NO_G3
        { pg8::Gemm g{(const f16*)((const unsigned char*)xout + (size_t)64 * MiB), (const f16*)(launder(args.ws) + WS_WQG + (size_t)LL * GCOLS * 1024), MTOK, GCOLS, DM / 2}; pg8::TripleOrder S; S.init(MTOK, F.G, (int)blockIdx.x);
          pg8::EpiGateMerge<true> E{WSP(f16, WS_R1), WSP(f16, WS_R1) + 3 * YSTR};
          pg8::fill_tabs_q((const float*)launder(args.ws) + CW_RF, WSP(float, WS_CVEC) + (size_t)(LL * 3 + 1) * 16 * 4096, IN(I_GATEB) + LL * GCOLS, WSP(float, WS_SB) + (LL * 3 + 1) * 4096, S, TID);
          pg8::gemm_phase<pg8::EpiGateMerge<true>, pg8::TripleOrder, true, true, true>(F.lds, g, S, E, F.wave); }
#endif
        SEAM_L();
#ifndef NO_G4
        { pg8::Gemm g{WSP(f16, WS_R1) + 3 * YSTR, WSP(f16, WS_WO) + (size_t)LL * DM * DM, MTOK, DM, DM, (unsigned)(GAPY * 2)}; pg8::StaticOrder S; S.init(MTOK, DM, F.G, (int)blockIdx.x);
          pg8::EpiResidual E{(const f16*)xout, (f16*)xout, WSP(float, WS_MOD) + (size_t)LL * 16 * 6144 + 2 * DM, 6144, (f16*)nullptr, (const float*)nullptr, (const float*)nullptr, (float*)nullptr};
          pg8::gemm_phase<pg8::EpiResidual, pg8::StaticOrder, true, true>(F.lds, g, S, E, F.wave); }
#endif
        SEAM_L();
        for (int rep = 0; rep < REP_G5; ++rep) {
#ifndef NO_G5
        { const float* modl = WSP(float, WS_MOD) + (size_t)LL * 16 * 6144; const float* nw = IN(I_NMLP) + LL * DM; unsigned char* U8 = (unsigned char*)xout + (size_t)64 * MiB; float* rf = (float*)launder(args.ws) + CW_RF;
          for (int m0 = GWX * 16; m0 < MTOK; m0 += F.NGW * 16) { const int b = m0 / SEQ;
            norm_quant_rows16((const f16*)xout, nw, modl + (size_t)b * 6144 + 4 * DM, U8, rf, m0, LANE); } }
        SEAM_L();
        { pg8::Gemm g{(const f16*)((const unsigned char*)xout + (size_t)64 * MiB), (const f16*)(launder(args.ws) + WS_WQ1 + (size_t)LL * DFF * 1024), MTOK, DFF, DM / 2}; pg8::StaticOrder S; S.init(MTOK, DFF, F.G, (int)blockIdx.x);
          pg8::EpiNormF16<1, true, true> E{WSP(f16, WS_R1), DFF, 0};
          pg8::fill_tabs_q((const float*)launder(args.ws) + CW_RF, WSP(float, WS_CVEC) + (size_t)(LL * 3 + 2) * 16 * 4096, (const float*)nullptr, WSP(float, WS_SB) + (LL * 3 + 2) * 4096, S, TID);
          pg8::gemm_phase<pg8::EpiNormF16<1, true, true>, pg8::StaticOrder, true, true, true>(F.lds, g, S, E, F.wave); }
#endif
        SEAM_L();
        }
#ifndef NO_G6
        { pg8::Gemm g{WSP(f16, WS_R1), WSP(f16, WS_W2) + (size_t)LL * DM * DFF, MTOK, DM, DFF}; pg8::StaticOrder S; S.init(MTOK, DM, F.G, (int)blockIdx.x);
          const bool more_layers = LL + 1 < DEPTH;
          pg8::EpiResidual E{(const f16*)xout, more_layers ? (f16*)xout : WSP(f16, WS_U), WSP(float, WS_MOD) + (size_t)LL * 16 * 6144 + 5 * DM, 6144, (f16*)nullptr, (const float*)nullptr, (const float*)nullptr, (float*)nullptr};
          pg8::gemm_phase<pg8::EpiResidual, pg8::StaticOrder, true, true, false, true>(F.lds, g, S, E, F.wave); }
#endif
        if (LL + 1 < DEPTH) SEAM_L(); else xcd_barrier(bar, F.wave);
        if (LL + 1 < DEPTH) {
            const int ln = LL + 1; const float* modl = WSP(float, WS_MOD) + (size_t)ln * 16 * 6144; const float* nw = IN(I_NMIX) + ln * DM; unsigned char* U8 = (unsigned char*)xout + (size_t)64 * MiB; float* rf = (float*)launder(args.ws) + CW_RF;
            for (int m0 = GWX * 16; m0 < MTOK; m0 += F.NGW * 16) { const int b = m0 / SEQ;
                norm_quant_rows16((const f16*)xout, nw, modl + (size_t)b * 6144 + 1 * DM, U8, rf, m0, LANE); }
            SEAM_L(); }
    }
    { const float* nf = IN(I_NFINAL); const f16* xf = WSP(f16, WS_U);
      for (int m0 = GWX * 16; m0 < MTOK; m0 += F.NGW * 16) { const int lane = LANE;
        f32x4 gn[4];
#pragma unroll
        for (int j = 0; j < 4; ++j) gn[j] = ((const GAS f32x4*)nf)[lane + 64 * j];
        u32x2 nx[4];
#pragma unroll
        for (int j = 0; j < 4; ++j) nx[j] = ((const GAS u32x2*)(xf + (size_t)m0 * DM) + lane)[64 * j];
#pragma unroll 1
        for (int r = 0; r < 16; ++r) { const int m = m0 + r;
            f32x4 v[4]; float s = 0.f;
#pragma unroll
            for (int j = 0; j < 4; ++j) { const unsigned wx = nx[j].x, wy = nx[j].y; const f16x2 a = __builtin_bit_cast(f16x2, wx), b2 = __builtin_bit_cast(f16x2, wy);
                v[j] = (f32x4){(float)a[0], (float)a[1], (float)b2[0], (float)b2[1]}; s += (v[j].x * v[j].x + v[j].y * v[j].y) + (v[j].z * v[j].z + v[j].w * v[j].w); }
            if (r + 1 < 16) {
#pragma unroll
                for (int j = 0; j < 4; ++j) nx[j] = ((const GAS u32x2*)(xf + (size_t)(m + 1) * DM) + lane)[64 * j]; }
            const float rstd = 1.f / sqrtf(wave_sum(s) * (1.f / DM) + EPS);
            GAS f32x4* orow = (GAS f32x4*)(xout + (size_t)m * DM) + lane;
#pragma unroll
            for (int j = 0; j < 4; ++j) orow[64 * j] = v[j] * rstd * gn[j]; }
      } }
#undef IN
#undef WSP
#undef LANE
#undef LL
#undef GW
#undef TID
}

extern "C" void kernel_launch(void* const* d_in, const int* in_sizes, int n_in, void* d_out, int out_size, void* d_ws, size_t ws_size, hipStream_t stream) {
    static int grid = 0;
    if (grid == 0) {
        if (n_in != 20 || in_sizes[0] != MTOK * DM || out_size != MTOK * DM || ws_size < WS_END) { fprintf(stderr, "kernel_launch: shape/workspace mismatch (n_in %d, ws %zu); nothing launched\n", n_in, ws_size); grid = -1; return; }
        int dev = 0, cus = 0, per_cu = 0;
        if (hipGetDevice(&dev) != hipSuccess || hipDeviceGetAttribute(&cus, hipDeviceAttributeMultiprocessorCount, dev) != hipSuccess) { grid = -1; return; }
        if (hipFuncSetAttribute((const void*)mega_fwd, hipFuncAttributeMaxDynamicSharedMemorySize, LDS_BYTES) != hipSuccess) { fprintf(stderr, "kernel_launch: hipFuncSetAttribute failed\n"); grid = -1; return; }
        if (hipOccupancyMaxActiveBlocksPerMultiprocessor(&per_cu, (const void*)mega_fwd, NWAVES * 64, LDS_BYTES) != hipSuccess || per_cu < 1) { fprintf(stderr, "kernel_launch: occupancy query says %d blocks per CU\n", per_cu); }
        (void)hipGetLastError();
        grid = cus;
    }
    if (grid < 0) return;
    if (hipMemsetAsync((char*)d_ws + WS_CTL, 0, CTL_ZERO_BYTES, stream) != hipSuccess) return;
    Args a{};
    for (int i = 0; i < 20; ++i) a.in[i] = (const float*)d_in[i];
    a.out = (float*)d_out; a.ws = (unsigned char*)d_ws;
    hipLaunchKernelGGL(mega_fwd, dim3(grid), dim3(NWAVES * 64), LDS_BYTES, stream, a);
}
```
